# Optimizing an MI355X kernel written in HIP

```python
import jax, jax.numpy as jnp
from jax import lax
import numpy as np

D_MODEL = 2048
BATCH = 4
SEQ = 2048
DEPTH = 1

CHUNK = 64
Q_BLOCK = 128
D_CONV = D_MODEL // 2
CONV_GROUPS = 8
CONV_K = 3
QK_NOPE = 128
QK_ROPE = 64
V_HEAD = 128
MLA_HEADS = (D_MODEL // 2) // V_HEAD
D_ATTN_OUT = MLA_HEADS * V_HEAD
Q_LORA = D_MODEL // 4
KV_LORA = D_MODEL // 4
ROPE_THETA = 10000.0
D_MIX = D_CONV + D_ATTN_OUT
IN_SPLIT_SIZES = (D_CONV, D_CONV, D_CONV, Q_LORA, KV_LORA, QK_ROPE)
IN_COLS = sum(IN_SPLIT_SIZES)
PEER_HEADS = 8
PEER_N_KEYS = 128
PEER_N_EXPERTS = PEER_N_KEYS * PEER_N_KEYS
PEER_QDIM = 256
PEER_TOPK = 16
PEER_TOKEN_BLOCK = 128
N_MOD = 6
EPS = 1e-6
NEG_INF = -1e30

kernel_name = 'hybrid_conv_mla_peer_adaln_block'


def rms_norm(x, g):
    x32 = x.astype(jnp.float32)
    y = x32 * lax.rsqrt(jnp.mean(x32 * x32, axis=-1, keepdims=True) + EPS)
    return (y * g.astype(jnp.float32)).astype(x.dtype)


def group_rms_norm(x, g, n_groups):
    shp = x.shape
    xg = x.reshape(shp[:-1] + (n_groups, shp[-1] // n_groups)).astype(jnp.float32)
    y = xg * lax.rsqrt(jnp.mean(xg * xg, axis=-1, keepdims=True) + EPS)
    return (y.reshape(shp) * g.astype(jnp.float32)).astype(x.dtype)


def rope_tables(seq, dim):
    inv = 1.0 / (ROPE_THETA ** (jnp.arange(0, dim, 2, dtype=jnp.float32) / dim))
    ang = jnp.arange(seq, dtype=jnp.float32)[:, None] * inv[None, :]
    return jnp.cos(ang), jnp.sin(ang)


def apply_rope(x, cos, sin):
    x32 = x.astype(jnp.float32)
    x1, x2 = jnp.split(x32, 2, axis=-1)
    out = jnp.concatenate([x1 * cos - x2 * sin, x2 * cos + x1 * sin], axis=-1)
    return out.astype(x.dtype)


def short_conv_mixer(b_gate, c_gate, h, conv_w):
    z = c_gate * h
    seq = z.shape[1]
    zp = jnp.pad(z, ((0, 0), (CONV_K - 1, 0), (0, 0)))
    y = conv_w[0] * zp[:, 0:seq]
    for k in range(1, CONV_K):
        y = y + conv_w[k] * zp[:, k:k + seq]
    return b_gate * y


def mla_attention(q_lat, kv_lat, k_rope_raw, g_q_lat, w_uq, g_kv_lat, w_ukv):
    bsz, seq, _ = q_lat.shape
    q = (rms_norm(q_lat, g_q_lat) @ w_uq).reshape(bsz, seq, MLA_HEADS, QK_NOPE + QK_ROPE)
    q_nope, q_rope = q[..., :QK_NOPE], q[..., QK_NOPE:]
    kv = (rms_norm(kv_lat, g_kv_lat) @ w_ukv).reshape(bsz, seq, MLA_HEADS, QK_NOPE + V_HEAD)
    k_nope, v = kv[..., :QK_NOPE], kv[..., QK_NOPE:]
    cos, sin = rope_tables(seq, QK_ROPE)
    q_rope = apply_rope(q_rope, cos[None, :, None, :], sin[None, :, None, :])
    k_rope = apply_rope(k_rope_raw, cos[None], sin[None])
    scale = (QK_NOPE + QK_ROPE) ** -0.5
    chunk_id = jnp.arange(seq) // CHUNK
    outs = []
    for blk in range(seq // Q_BLOCK):
        q0, q1 = blk * Q_BLOCK, (blk + 1) * Q_BLOCK
        s = (jnp.einsum('bqhd,bkhd->bhqk', q_nope[:, q0:q1], k_nope[:, :q1])
             + jnp.einsum('bqhr,bkr->bhqk', q_rope[:, q0:q1], k_rope[:, :q1])).astype(jnp.float32) * scale
        mask = chunk_id[None, :q1] <= chunk_id[q0:q1, None]
        s = jnp.where(mask, s, NEG_INF)
        p = jax.nn.softmax(s, axis=-1).astype(v.dtype)
        outs.append(jnp.einsum('bhqk,bkhd->bqhd', p, v[:, :q1]))
    o = jnp.concatenate(outs, axis=1)
    return o.reshape(bsz, seq, D_ATTN_OUT)


def peer_ffn(h, w_q, sub_keys, u_tab, v_tab):
    bsz, seq, d = h.shape
    q = (h @ w_q).reshape(bsz, seq, PEER_HEADS, 2, PEER_QDIM // 2)
    scores = jnp.einsum('bshpd,hpnd->bshpn', q, sub_keys).astype(jnp.float32)
    top_v, top_i = lax.top_k(scores, PEER_TOPK)
    cand = top_v[..., 0, :, None] + top_v[..., 1, None, :]
    cand = cand.reshape(bsz, seq, PEER_HEADS, PEER_TOPK * PEER_TOPK)
    best_v, best_i = lax.top_k(cand, PEER_TOPK)
    i1 = jnp.take_along_axis(top_i[..., 0, :], best_i // PEER_TOPK, axis=-1)
    i2 = jnp.take_along_axis(top_i[..., 1, :], best_i % PEER_TOPK, axis=-1)
    expert = i1 * PEER_N_KEYS + i2
    gate = jax.nn.softmax(best_v, axis=-1).astype(h.dtype)
    n_sel = PEER_HEADS * PEER_TOPK
    n_blk = (bsz * seq) // PEER_TOKEN_BLOCK
    hb = h.reshape(n_blk, PEER_TOKEN_BLOCK, d)
    eb = expert.reshape(n_blk, PEER_TOKEN_BLOCK, n_sel)
    gb = gate.reshape(n_blk, PEER_TOKEN_BLOCK, n_sel)

    def token_block(args):
        hx, ids, g = args
        u = u_tab[ids]
        a = jnp.einsum('td,tnd->tn', hx, u)
        act = jax.nn.gelu(a, approximate=False) * g
        return jnp.einsum('tn,tnd->td', act, v_tab[ids])

    out = lax.map(token_block, (hb, eb, gb))
    return out.reshape(bsz, seq, d)


def setup_inputs(seed: int = 0) -> dict:
    key = jax.random.key(seed)
    ks = jax.random.split(key, 20)
    f32 = jnp.float32
    nrm = lambda k, shape, s: jax.random.normal(k, shape, f32) * s
    gain = lambda k, shape: 1.0 + 0.02 * jax.random.normal(k, shape, f32)
    L = DEPTH
    return {
        'x': jax.random.normal(ks[0], (BATCH, SEQ, D_MODEL), f32),
        'c': jax.random.normal(ks[1], (BATCH, D_MODEL), f32),
        'w_ada': nrm(ks[2], (L, D_MODEL, N_MOD * D_MODEL), 0.5 * D_MODEL ** -0.5),
        'b_ada': nrm(ks[3], (L, N_MOD * D_MODEL), 0.02),
        'g_norm_mix': gain(ks[4], (L, D_MODEL)),
        'w_in': nrm(ks[5], (L, D_MODEL, IN_COLS), D_MODEL ** -0.5),
        'conv_w': nrm(ks[6], (L, CONV_K, D_CONV), CONV_K ** -0.5),
        'g_q_lat': gain(ks[7], (L, Q_LORA)),
        'w_uq': nrm(ks[8], (L, Q_LORA, MLA_HEADS * (QK_NOPE + QK_ROPE)), Q_LORA ** -0.5),
        'g_kv_lat': gain(ks[9], (L, KV_LORA)),
        'w_ukv': nrm(ks[10], (L, KV_LORA, MLA_HEADS * (QK_NOPE + V_HEAD)), KV_LORA ** -0.5),
        'g_out_conv': gain(ks[11], (L, D_CONV)),
        'g_out_attn': gain(ks[12], (L, D_ATTN_OUT)),
        'w_out': nrm(ks[13], (L, D_MIX, D_MODEL), D_MIX ** -0.5),
        'g_norm_ffn': gain(ks[14], (L, D_MODEL)),
        'peer_w_q': nrm(ks[15], (L, D_MODEL, PEER_HEADS * PEER_QDIM), D_MODEL ** -0.5),
        'peer_sub_keys': nrm(ks[16], (L, PEER_HEADS, 2, PEER_N_KEYS, PEER_QDIM // 2), (PEER_QDIM // 2) ** -0.5),
        'peer_u': nrm(ks[17], (L, PEER_N_EXPERTS, D_MODEL), D_MODEL ** -0.5),
        'peer_v': nrm(ks[18], (L, PEER_N_EXPERTS, D_MODEL), PEER_HEADS ** -0.5),
        'g_final': gain(ks[19], (D_MODEL,)),
    }


def reference(x, c, w_ada, b_ada, g_norm_mix, w_in, conv_w, g_q_lat, w_uq, g_kv_lat, w_ukv,
              g_out_conv, g_out_attn, w_out, g_norm_ffn, peer_w_q, peer_sub_keys, peer_u, peer_v, g_final):
    split_at = np.cumsum(IN_SPLIT_SIZES)[:-1].tolist()
    c_act = jax.nn.silu(c)
    for l in range(DEPTH):
        mod = c_act @ w_ada[l] + b_ada[l]
        sh_m, sc_m, gt_m, sh_f, sc_f, gt_f = [m[:, None, :] for m in jnp.split(mod, N_MOD, axis=-1)]
        h = rms_norm(x, g_norm_mix[l]) * (1 + sc_m) + sh_m
        proj = h @ w_in[l]
        b_g, c_g, h_c, q_lat, kv_lat, k_rope_raw = jnp.split(proj, split_at, axis=-1)
        conv_out = short_conv_mixer(b_g, c_g, h_c, conv_w[l])
        attn_out = mla_attention(q_lat, kv_lat, k_rope_raw, g_q_lat[l], w_uq[l],
                                 g_kv_lat[l], w_ukv[l])
        merged = jnp.concatenate([group_rms_norm(conv_out, g_out_conv[l], CONV_GROUPS),
                                  group_rms_norm(attn_out, g_out_attn[l], MLA_HEADS)], axis=-1)
        x = x + gt_m * (merged @ w_out[l])
        h2 = rms_norm(x, g_norm_ffn[l]) * (1 + sc_f) + sh_f
        x = x + gt_f * peer_ffn(h2, peer_w_q[l], peer_sub_keys[l], peer_u[l], peer_v[l])
    return rms_norm(x, g_final)
```

```cpp
#include <hip/hip_runtime.h>
#include <hip/hip_cooperative_groups.h>
#include <cstdio>
#include <cstdint>
namespace cg = cooperative_groups;

#ifndef N_LAUNCH_PER_PHASE
#define N_LAUNCH_PER_PHASE 1
#endif

#define DI __device__ __forceinline__
typedef unsigned short u16;
typedef __attribute__((ext_vector_type(8))) short bf16x8;
typedef __attribute__((ext_vector_type(16))) float f32x16;
typedef __attribute__((ext_vector_type(2))) __bf16 bf2_t;
typedef __attribute__((ext_vector_type(2))) float f2_t;
typedef __attribute__((ext_vector_type(4))) unsigned u32x4;
typedef __attribute__((ext_vector_type(2))) unsigned u32x2;
#define MFMA(a, b, c) __builtin_amdgcn_mfma_f32_32x32x16_bf16((a), (b), (c), 0, 0, 0)

constexpr int T_ = 8192, D_ = 2048, S_ = 2048;
constexpr int INC = 4160;
constexpr float EPS = 1e-6f;
constexpr int NPH = 10;

constexpr size_t al256(size_t x) { return (x + 255) & ~(size_t)255; }
constexpr size_t WS_BAR = 0;
constexpr size_t WS_MOD = 16384;
constexpr size_t WS_ROPE = WS_MOD + al256(4 * 12288 * 4);
constexpr size_t WS_WINT = WS_ROPE + al256(2048 * 32 * 8);
constexpr size_t WS_WUQT = WS_WINT + al256((size_t)4224 * 2048 * 2);
constexpr size_t WS_WUKVT = WS_WUQT + al256((size_t)1536 * 512 * 2);
constexpr size_t WS_WOUTT = WS_WUKVT + al256((size_t)2048 * 512 * 2);
constexpr size_t WS_WQT = WS_WOUTT + al256((size_t)2048 * 2048 * 2);
constexpr size_t WS_SK = WS_WQT + al256((size_t)2048 * 2048 * 2);
constexpr size_t WS_U = WS_SK + al256((size_t)262144 * 2);
constexpr size_t WS_V = WS_U + al256((size_t)16384 * 2048 * 2);
constexpr size_t WS_H = WS_V + al256((size_t)16384 * 2048 * 2);
constexpr size_t WS_P = WS_H + al256((size_t)T_ * D_ * 2);
constexpr size_t WS_Q = WS_P + al256((size_t)T_ * INC * 2);
constexpr size_t WS_K = WS_Q + al256((size_t)T_ * 1536 * 2);
constexpr size_t WS_VT = WS_K + al256((size_t)T_ * 1536 * 2);
constexpr size_t WS_MG = WS_VT + al256((size_t)T_ * 1024 * 2);
constexpr size_t WS_X1 = WS_MG + al256((size_t)T_ * D_ * 2);
constexpr size_t WS_IDS = WS_X1 + al256((size_t)T_ * D_ * 4);
constexpr size_t WS_GATE = WS_IDS + al256((size_t)T_ * 128 * 4);
constexpr size_t WS_END = WS_GATE + al256((size_t)T_ * 128 * 4);

constexpr int LDS_BYTES = 16 + 2 * 2 * 128 * 72 * 2 + 512;

struct Params {
  const float* in[20];
  float* out;
  char* ws;
  int ph_lo, ph_hi, coop, pad;
};

DI unsigned pk2(float a, float b) { f2_t v = {a, b}; bf2_t r = __builtin_convertvector(v, bf2_t); return __builtin_bit_cast(unsigned, r); }
DI float bflo(unsigned u) { return __uint_as_float(u << 16); }
DI float bfhi(unsigned u) { return __uint_as_float(u & 0xffff0000u); }
DI float dot2(unsigned a, unsigned b, float c) { return __builtin_amdgcn_fdot2_f32_bf16(__builtin_bit_cast(bf2_t, a), __builtin_bit_cast(bf2_t, b), c, false); }
DI float wave_sum(float v) {
#pragma unroll
  for (int o = 32; o >= 1; o >>= 1) v += __shfl_xor(v, o);
  return v;
}

#define XB_TMO      128
#define XB_XCNT(j)  (256  + 64 * (j))
#define XB_XSUB(j)  (1280 + 64 * (j))
#define XB_XGEN(j)  (2304 + 64 * (j))
#define XB_TOP      3328
#define XB_TOPGEN   3392
#define XCD_BAR_WORDS 3456
#define XB_SPIN_CAP (1u << 22)
#define LAS __attribute__((address_space(3)))
DI unsigned xb_ld(unsigned* p) { return __hip_atomic_load(p, __ATOMIC_RELAXED, __HIP_MEMORY_SCOPE_AGENT); }
DI unsigned xb_add(unsigned* p, unsigned v) { return __hip_atomic_fetch_add(p, v, __ATOMIC_RELAXED, __HIP_MEMORY_SCOPE_AGENT); }
DI unsigned xb_xcc_id() { return (unsigned)__builtin_amdgcn_s_getreg((3 << 11) | 20) & 0xFu; }
#define XB_SPIN(cond, bar) do { unsigned _sp = 0; while (cond) { __builtin_amdgcn_s_sleep(1); \
    if ((++_sp & 255u) == 0u) { if (xb_ld(&(bar)[XB_TMO])) break; if (_sp > XB_SPIN_CAP) { atomicAdd(&(bar)[XB_TMO], 1u); break; } } } } while (0)
struct XcdBarrier { unsigned* bar; unsigned x; volatile LAS unsigned* st; };
DI XcdBarrier xcd_barrier_post(unsigned* bar, volatile LAS unsigned* st) {
  XcdBarrier b; b.bar = bar; b.x = xb_xcc_id(); b.st = st;
  if (threadIdx.x == 0) (void)xb_add(&bar[XB_XCNT(b.x)], 1u);
  return b;
}
DI void xcd_barrier_complete(unsigned* bar, unsigned x, unsigned& nloc, unsigned& nx) {
  const unsigned G = gridDim.x * gridDim.y * gridDim.z;
  unsigned sum, cnt, mine, sp = 0u;
  for (;;) {
    sum = 0u; cnt = 0u; mine = 0u;
#pragma unroll
    for (unsigned j = 0; j < 16; ++j) { const unsigned c = xb_ld(&bar[XB_XCNT(j)]); sum += c; cnt += (c > 0u) ? 1u : 0u; mine = (j == x) ? c : mine; }
    if (sum == G) break;
    __builtin_amdgcn_s_sleep(1);
    if ((++sp & 255u) == 0u) { if (xb_ld(&bar[XB_TMO])) break; if (sp > XB_SPIN_CAP) { atomicAdd(&bar[XB_TMO], 1u); break; } }
  }
  nloc = mine > 0u ? mine : 1u; nx = cnt > 0u ? cnt : 1u;
}
DI void xcd_barrier(const XcdBarrier& b) {
  asm volatile("s_waitcnt vmcnt(0)" ::: "memory");
  __syncthreads();
  if (threadIdx.x == 0) {
    unsigned* bar = b.bar;
    __builtin_amdgcn_s_waitcnt(0);
    unsigned nloc = b.st[0], nx = b.st[1];
    if (nloc == 0u) { xcd_barrier_complete(bar, b.x, nloc, nx); b.st[0] = nloc; b.st[1] = nx; }
    const unsigned old = xb_add(&bar[XB_XSUB(b.x)], 1u);
    const unsigned gen = old / nloc;
    if (old + 1u == (gen + 1u) * nloc) {
      __builtin_amdgcn_fence(__ATOMIC_RELEASE, "agent");
      asm volatile("s_waitcnt vmcnt(0)" ::: "memory");
      const unsigned og = xb_add(&bar[XB_TOP], 1u);
      const unsigned tg = og / nx;
      if (og + 1u == (tg + 1u) * nx) xb_add(&bar[XB_TOPGEN], 1u);
      else XB_SPIN(xb_ld(&bar[XB_TOPGEN]) == tg, bar);
      __builtin_amdgcn_fence(__ATOMIC_ACQUIRE, "agent");
      xb_add(&bar[XB_XGEN(b.x)], 1u);
      asm volatile("s_waitcnt vmcnt(0)" ::: "memory");
    } else {
      XB_SPIN(xb_ld(&bar[XB_XGEN(b.x)]) == gen, bar);
      __builtin_amdgcn_fence(__ATOMIC_ACQUIRE, "agent");
      asm volatile("s_waitcnt vmcnt(0)" ::: "memory");
    }
  }
  __syncthreads();
}

template <bool SWAP, class Epi>
DI void gemm_tile(const u16* __restrict__ A, int lda, const u16* __restrict__ Bt, int ldb, int K, int m0, int n0, char* smem, Epi&& epi) {
  u16* As = (u16*)(smem + 16);
  u16* Bs = As + 2 * 128 * 72;
  const int tid = threadIdx.x, lane = tid & 63, w = tid >> 6, wm = w >> 1, wn = w & 1;
  const int r = lane & 31, hi = lane >> 5;
  f32x16 acc[2][2];
#pragma unroll
  for (int a = 0; a < 2; ++a)
#pragma unroll
    for (int b = 0; b < 2; ++b)
#pragma unroll
      for (int i = 0; i < 16; ++i) acc[a][b][i] = 0.f;
  const int srow = tid >> 3, skc = tid & 7;
  const u16* ag = A + (size_t)(m0 + srow) * lda + skc * 8;
  const u16* bg = Bt + (size_t)(n0 + srow) * ldb + skc * 8;
  u32x4 ra[4], rb[4];
#pragma unroll
  for (int i = 0; i < 4; ++i) { ra[i] = *(const u32x4*)(ag + (size_t)i * 32 * lda); rb[i] = *(const u32x4*)(bg + (size_t)i * 32 * ldb); }
  __syncthreads();
#pragma unroll
  for (int i = 0; i < 4; ++i) { *(u32x4*)(As + (srow + 32 * i) * 72 + skc * 8) = ra[i]; *(u32x4*)(Bs + (srow + 32 * i) * 72 + skc * 8) = rb[i]; }
  __syncthreads();
  const int KT = K >> 6;
  for (int kt = 0; kt < KT; ++kt) {
    const int buf = kt & 1;
    if (kt + 1 < KT) {
      const int k0 = (kt + 1) << 6;
#pragma unroll
      for (int i = 0; i < 4; ++i) { ra[i] = *(const u32x4*)(ag + (size_t)i * 32 * lda + k0); rb[i] = *(const u32x4*)(bg + (size_t)i * 32 * ldb + k0); }
    }
    const u16* Asb = As + buf * 128 * 72 + (wm * 64 + r) * 72 + hi * 8;
    const u16* Bsb = Bs + buf * 128 * 72 + (wn * 64 + r) * 72 + hi * 8;
#pragma unroll
    for (int ks = 0; ks < 4; ++ks) {
      bf16x8 af[2], bfr[2];
      af[0] = *(const bf16x8*)(Asb + ks * 16);
      af[1] = *(const bf16x8*)(Asb + 32 * 72 + ks * 16);
      bfr[0] = *(const bf16x8*)(Bsb + ks * 16);
      bfr[1] = *(const bf16x8*)(Bsb + 32 * 72 + ks * 16);
#pragma unroll
      for (int mi = 0; mi < 2; ++mi)
#pragma unroll
        for (int ni = 0; ni < 2; ++ni) {
          if (SWAP) acc[mi][ni] = MFMA(bfr[ni], af[mi], acc[mi][ni]);
          else acc[mi][ni] = MFMA(af[mi], bfr[ni], acc[mi][ni]);
        }
    }
    if (kt + 1 < KT) {
      const int nb = buf ^ 1;
#pragma unroll
      for (int i = 0; i < 4; ++i) { *(u32x4*)(As + nb * 128 * 72 + (srow + 32 * i) * 72 + skc * 8) = ra[i]; *(u32x4*)(Bs + nb * 128 * 72 + (srow + 32 * i) * 72 + skc * 8) = rb[i]; }
    }
    __syncthreads();
  }
  epi(acc, m0 + wm * 64, n0 + wn * 64, r, hi);
}

DI void tile_rstd512(const u16* __restrict__ A, int lda, int m0, float* rs) {
  const int tid = threadIdx.x, row = tid >> 1, half = tid & 1;
  const uint4* p = (const uint4*)(A + (size_t)(m0 + row) * lda + half * 256);
  float ss = 0.f;
#pragma unroll 8
  for (int i = 0; i < 32; ++i) {
    uint4 v = p[i];
    ss = dot2(v.x, v.x, ss); ss = dot2(v.y, v.y, ss); ss = dot2(v.z, v.z, ss); ss = dot2(v.w, v.w, ss);
  }
  ss += __shfl_xor(ss, 1);
  if (half == 0) rs[row] = rsqrtf(ss * (1.f / 512.f) + EPS);
}

DI void transpose_item(const float* __restrict__ src, int N, int K, const float* __restrict__ scale, u16* __restrict__ dst, int tk, int tn, char* smem) {
  float* tile = (float*)(smem + 16);
  const int t = threadIdx.x;
  __syncthreads();
  {
    const int rr = t >> 4, c4 = (t & 15) * 4;
#pragma unroll
    for (int ps = 0; ps < 4; ++ps) {
      const int kk = ps * 16 + rr, k = tk * 64 + kk;
      float4 v = *(const float4*)(src + (size_t)k * N + tn * 64 + c4);
      const float sc = scale ? scale[k] : 1.f;
      tile[kk * 65 + c4 + 0] = v.x * sc; tile[kk * 65 + c4 + 1] = v.y * sc; tile[kk * 65 + c4 + 2] = v.z * sc; tile[kk * 65 + c4 + 3] = v.w * sc;
    }
  }
  __syncthreads();
  {
    const int n = t & 63, kc = (t >> 6) * 16;
    unsigned o[8];
#pragma unroll
    for (int j = 0; j < 8; ++j) o[j] = pk2(tile[(kc + 2 * j) * 65 + n], tile[(kc + 2 * j + 1) * 65 + n]);
    uint4* d = (uint4*)(dst + (size_t)(tn * 64 + n) * K + tk * 64 + kc);
    d[0] = make_uint4(o[0], o[1], o[2], o[3]); d[1] = make_uint4(o[4], o[5], o[6], o[7]);
  }
}

DI void convert_item(const float* __restrict__ src, u16* __restrict__ dst, size_t base) {
  const int t = threadIdx.x;
#pragma unroll
  for (int st = 0; st < 4; ++st) {
    const size_t idx = base + st * 2048 + t * 8;
    float4 a = *(const float4*)(src + idx), b = *(const float4*)(src + idx + 4);
    *(uint4*)(dst + idx) = make_uint4(pk2(a.x, a.y), pk2(a.z, a.w), pk2(b.x, b.y), pk2(b.z, b.w));
  }
}

DI void mod_item(const Params& p, int cgi, char* smem) {
  float* cact = (float*)(smem + 16);
  float* red = cact + 4 * 2048;
  const int t = threadIdx.x;
  const float* c = p.in[1]; const float* W = p.in[2]; const float* bias = p.in[3];
  float* mod = (float*)(p.ws + WS_MOD);
  __syncthreads();
  for (int i = t; i < 4 * 2048; i += 256) { float v = c[i]; cact[i] = v / (1.f + __expf(-v)); }
  __syncthreads();
  const int cq = t & 15, kl = t >> 4, c0 = cgi * 64;
  float acc[4][4];
#pragma unroll
  for (int b = 0; b < 4; ++b)
#pragma unroll
    for (int j = 0; j < 4; ++j) acc[b][j] = 0.f;
  const float* wp = W + (size_t)kl * 12288 + c0 + cq * 4;
#pragma unroll 8
  for (int i = 0; i < 128; ++i) {
    const int k = kl + 16 * i;
    float4 w4 = *(const float4*)(wp + (size_t)i * 16 * 12288);
#pragma unroll
    for (int b = 0; b < 4; ++b) {
      const float a = cact[b * 2048 + k];
      acc[b][0] += a * w4.x; acc[b][1] += a * w4.y; acc[b][2] += a * w4.z; acc[b][3] += a * w4.w;
    }
  }
#pragma unroll
  for (int b = 0; b < 4; ++b)
#pragma unroll
    for (int j = 0; j < 4; ++j) red[(kl * 16 + cq) * 17 + b * 4 + j] = acc[b][j];
  __syncthreads();
  {
    const int b = t >> 6, col = t & 63, q = col >> 2, j = col & 3;
    float s = 0.f;
#pragma unroll
    for (int k2 = 0; k2 < 16; ++k2) s += red[(k2 * 16 + q) * 17 + b * 4 + j];
    mod[b * 12288 + c0 + col] = s + bias[c0 + col];
  }
}

constexpr int P0_MOD = 192;
constexpr int P0_TIN = 32 * 65, P0_TUQ = 8 * 24, P0_TUKV = 8 * 32, P0_TOUT = 32 * 32, P0_TWQ = 32 * 32;
constexpr int P0_SK = 32, P0_UV = 4096, P0_ROPE = 32;
DI void phase0(const Params& p, char* smem) {
  constexpr int o1 = P0_MOD, o2 = o1 + P0_TIN, o3 = o2 + P0_TUQ, o4 = o3 + P0_TUKV, o5 = o4 + P0_TOUT, o6 = o5 + P0_TWQ, o7 = o6 + P0_SK, o8 = o7 + P0_UV, o9 = o8 + P0_UV, o10 = o9 + P0_ROPE;
  for (int it = blockIdx.x; it < o10; it += gridDim.x) {
    if (it < o1) mod_item(p, it, smem);
    else if (it < o2) { int j = it - o1; transpose_item(p.in[5], INC, 2048, nullptr, (u16*)(p.ws + WS_WINT), j / 65, j % 65, smem); }
    else if (it < o3) { int j = it - o2; transpose_item(p.in[8], 1536, 512, p.in[7], (u16*)(p.ws + WS_WUQT), j / 24, j % 24, smem); }
    else if (it < o4) { int j = it - o3; transpose_item(p.in[10], 2048, 512, p.in[9], (u16*)(p.ws + WS_WUKVT), j / 32, j % 32, smem); }
    else if (it < o5) { int j = it - o4; int tk = j / 32; transpose_item(p.in[13], 2048, 2048, tk < 16 ? p.in[11] : p.in[12] - 1024, (u16*)(p.ws + WS_WOUTT), tk, j % 32, smem); }
    else if (it < o6) { int j = it - o5; transpose_item(p.in[15], 2048, 2048, nullptr, (u16*)(p.ws + WS_WQT), j / 32, j % 32, smem); }
    else if (it < o7) convert_item(p.in[16], (u16*)(p.ws + WS_SK), (size_t)(it - o6) * 8192);
    else if (it < o8) convert_item(p.in[17], (u16*)(p.ws + WS_U), (size_t)(it - o7) * 8192);
    else if (it < o9) convert_item(p.in[18], (u16*)(p.ws + WS_V), (size_t)(it - o8) * 8192);
    else {
      float2* rope = (float2*)(p.ws + WS_ROPE);
      const int base = (it - o9) * 2048;
      for (int e = threadIdx.x; e < 2048; e += 256) {
        const int idx = base + e, pos = idx >> 5, j = idx & 31;
        const float inv = 1.0f / powf(10000.0f, (float)(2 * j) / 64.0f);
        const float ang = (float)pos * inv;
        rope[idx] = make_float2(cosf(ang), sinf(ang));
      }
    }
  }
}

DI void norm_rows(const float* __restrict__ X, const float* __restrict__ g, const float* __restrict__ mod, int sh_chunk, u16* __restrict__ out) {
  const int lane = threadIdx.x & 63, w = threadIdx.x >> 6;
  for (int row = blockIdx.x * 4 + w; row < T_; row += gridDim.x * 4) {
    const float* xr = X + (size_t)row * D_;
    float4 v[8];
    float ss = 0.f;
#pragma unroll
    for (int j = 0; j < 8; ++j) { v[j] = *(const float4*)(xr + j * 256 + lane * 4); ss += v[j].x * v[j].x + v[j].y * v[j].y + v[j].z * v[j].z + v[j].w * v[j].w; }
    ss = wave_sum(ss);
    const float rstd = rsqrtf(ss * (1.f / D_) + EPS);
    const int b = row >> 11;
    const float* sh = mod + b * 12288 + sh_chunk * 2048;
    const float* sc = sh + 2048;
#pragma unroll
    for (int j = 0; j < 8; ++j) {
      const int d = j * 256 + lane * 4;
      float4 gg = *(const float4*)(g + d), s4 = *(const float4*)(sc + d), h4 = *(const float4*)(sh + d);
      const float o0 = v[j].x * rstd * gg.x * (1.f + s4.x) + h4.x;
      const float o1 = v[j].y * rstd * gg.y * (1.f + s4.y) + h4.y;
      const float o2 = v[j].z * rstd * gg.z * (1.f + s4.z) + h4.z;
      const float o3 = v[j].w * rstd * gg.w * (1.f + s4.w) + h4.w;
      *(uint2*)(out + (size_t)row * D_ + d) = make_uint2(pk2(o0, o1), pk2(o2, o3));
    }
  }
}

DI void phase2(const Params& p, char* smem) {
  const u16* H = (const u16*)(p.ws + WS_H); const u16* W = (const u16*)(p.ws + WS_WINT); u16* P = (u16*)(p.ws + WS_P);
  for (int it = blockIdx.x; it < 64 * 33; it += gridDim.x) {
    const int tn = it / 64, tm = it % 64;
    gemm_tile<true>(H, D_, W, D_, D_, tm * 128, tn * 128, smem, [&](f32x16 (&acc)[2][2], int mb, int nb, int r, int hi) __attribute__((always_inline)) {
      if (nb >= INC) return;
#pragma unroll
      for (int mi = 0; mi < 2; ++mi)
#pragma unroll
        for (int ni = 0; ni < 2; ++ni)
#pragma unroll
          for (int g = 0; g < 4; ++g) {
            const int row = mb + mi * 32 + r, col = nb + ni * 32 + hi * 4 + 8 * g;
            *(uint2*)(P + (size_t)row * INC + col) = make_uint2(pk2(acc[mi][ni][4 * g], acc[mi][ni][4 * g + 1]), pk2(acc[mi][ni][4 * g + 2], acc[mi][ni][4 * g + 3]));
          }
    });
  }
}

DI void phase3(const Params& p, char* smem) {
  const u16* P = (const u16*)(p.ws + WS_P);
  u16* Q = (u16*)(p.ws + WS_Q); u16* Kb = (u16*)(p.ws + WS_K); u16* VT = (u16*)(p.ws + WS_VT); u16* MG = (u16*)(p.ws + WS_MG);
  const float2* rope = (const float2*)(p.ws + WS_ROPE);
  float* rs = (float*)(smem + 16 + 2 * 2 * 128 * 72 * 2);
  constexpr int NQ = 64 * 12, NKV = 64 * 16, NKR = 1024, NCV = 1024;
  const float qscale = 0.07216878364870322f * 1.4426950408889634f;
  for (int it = blockIdx.x; it < NQ + NKV + NKR + NCV; it += gridDim.x) {
    if (it < NQ) {
      const int tn = it / 64, tm = it % 64;
      __syncthreads();
      tile_rstd512(P + 3072, INC, tm * 128, rs);
      gemm_tile<true>(P + 3072, INC, (const u16*)(p.ws + WS_WUQT), 512, 512, tm * 128, tn * 128, smem, [&](f32x16 (&acc)[2][2], int mb, int nb, int r, int hi) __attribute__((always_inline)) {
        const bool is_rope = ((nb >> 6) % 3) == 2;
#pragma unroll
        for (int mi = 0; mi < 2; ++mi) {
          const int row = mb + mi * 32 + r;
          const float sc = rs[row - tm * 128] * qscale;
          const int pos = row & (S_ - 1);
#pragma unroll
          for (int g = 0; g < 4; ++g) {
            const int j = hi * 4 + 8 * g;
            float a0[4], a1[4];
#pragma unroll
            for (int e = 0; e < 4; ++e) { a0[e] = acc[mi][0][4 * g + e] * sc; a1[e] = acc[mi][1][4 * g + e] * sc; }
            if (is_rope) {
#pragma unroll
              for (int e = 0; e < 4; ++e) {
                const float2 cs = rope[pos * 32 + j + e];
                const float x1 = a0[e], x2 = a1[e];
                a0[e] = x1 * cs.x - x2 * cs.y; a1[e] = x2 * cs.x + x1 * cs.y;
              }
            }
            *(uint2*)(Q + (size_t)row * 1536 + nb + j) = make_uint2(pk2(a0[0], a0[1]), pk2(a0[2], a0[3]));
            *(uint2*)(Q + (size_t)row * 1536 + nb + 32 + j) = make_uint2(pk2(a1[0], a1[1]), pk2(a1[2], a1[3]));
          }
        }
      });
    } else if (it < NQ + NKV) {
      const int j2 = it - NQ, tn = j2 / 64, tm = j2 % 64;
      __syncthreads();
      tile_rstd512(P + 3584, INC, tm * 128, rs);
      const int head = tn >> 1;
      if ((tn & 1) == 0) {
        gemm_tile<true>(P + 3584, INC, (const u16*)(p.ws + WS_WUKVT), 512, 512, tm * 128, tn * 128, smem, [&](f32x16 (&acc)[2][2], int mb, int nb, int r, int hi) __attribute__((always_inline)) {
#pragma unroll
          for (int mi = 0; mi < 2; ++mi) {
            const int row = mb + mi * 32 + r;
            const float sc = rs[row - tm * 128];
#pragma unroll
            for (int ni = 0; ni < 2; ++ni)
#pragma unroll
              for (int g = 0; g < 4; ++g) {
                const int d = (nb & 127) + ni * 32 + hi * 4 + 8 * g;
                *(uint2*)(Kb + (size_t)row * 1536 + head * 192 + d) = make_uint2(pk2(acc[mi][ni][4 * g] * sc, acc[mi][ni][4 * g + 1] * sc), pk2(acc[mi][ni][4 * g + 2] * sc, acc[mi][ni][4 * g + 3] * sc));
              }
          }
        });
      } else {
        gemm_tile<false>(P + 3584, INC, (const u16*)(p.ws + WS_WUKVT), 512, 512, tm * 128, tn * 128, smem, [&](f32x16 (&acc)[2][2], int mb, int nb, int r, int hi) __attribute__((always_inline)) {
#pragma unroll
          for (int mi = 0; mi < 2; ++mi)
#pragma unroll
            for (int g = 0; g < 4; ++g) {
              const int row0 = mb + mi * 32 + hi * 4 + 8 * g;
              const float s0 = rs[row0 - tm * 128], s1 = rs[row0 + 1 - tm * 128], s2 = rs[row0 + 2 - tm * 128], s3 = rs[row0 + 3 - tm * 128];
              const int b = row0 >> 11, t = row0 & (S_ - 1);
#pragma unroll
              for (int ni = 0; ni < 2; ++ni) {
                const int d = (nb & 127) + ni * 32 + r;
                *(uint2*)(VT + ((size_t)((b * 8 + head) * 128 + d)) * S_ + t) = make_uint2(pk2(acc[mi][ni][4 * g] * s0, acc[mi][ni][4 * g + 1] * s1), pk2(acc[mi][ni][4 * g + 2] * s2, acc[mi][ni][4 * g + 3] * s3));
              }
            }
        });
      }
    } else if (it < NQ + NKV + NKR) {
      const int j2 = it - NQ - NKV;
      const int row = j2 * 8 + (threadIdx.x >> 5), j = threadIdx.x & 31, pos = row & (S_ - 1);
      const float x1 = bflo((unsigned)P[(size_t)row * INC + 4096 + j]), x2 = bflo((unsigned)P[(size_t)row * INC + 4096 + 32 + j]);
      const float2 cs = rope[pos * 32 + j];
      const float o1 = x1 * cs.x - x2 * cs.y, o2 = x2 * cs.x + x1 * cs.y;
      const u16 b1 = (u16)(pk2(o1, 0.f) & 0xffffu), b2 = (u16)(pk2(o2, 0.f) & 0xffffu);
#pragma unroll
      for (int h = 0; h < 8; ++h) { Kb[(size_t)row * 1536 + h * 192 + 128 + j] = b1; Kb[(size_t)row * 1536 + h * 192 + 160 + j] = b2; }
    } else {
      const int j2 = it - NQ - NKV - NKR;
      const int wi = j2 * 4 + (threadIdx.x >> 6), lane = threadIdx.x & 63;
      const int g = wi & 7, run = wi >> 3;
      const int row0 = run * 16, t0 = row0 & (S_ - 1);
      const int ch = g * 128 + lane * 2;
      const float* cw = p.in[6];
      const float w00 = cw[ch], w01 = cw[ch + 1], w10 = cw[1024 + ch], w11 = cw[1024 + ch + 1], w20 = cw[2048 + ch], w21 = cw[2048 + ch + 1];
      float zm1a = 0.f, zm1b = 0.f, zm2a = 0.f, zm2b = 0.f;
      if (t0 > 0) {
        const unsigned c1 = *(const unsigned*)(P + (size_t)(row0 - 1) * INC + 1024 + ch), h1 = *(const unsigned*)(P + (size_t)(row0 - 1) * INC + 2048 + ch);
        const unsigned c2 = *(const unsigned*)(P + (size_t)(row0 - 2) * INC + 1024 + ch), h2 = *(const unsigned*)(P + (size_t)(row0 - 2) * INC + 2048 + ch);
        zm1a = bflo(c1) * bflo(h1); zm1b = bfhi(c1) * bfhi(h1); zm2a = bflo(c2) * bflo(h2); zm2b = bfhi(c2) * bfhi(h2);
      }
#pragma unroll 4
      for (int tt = 0; tt < 16; ++tt) {
        const size_t ro = (size_t)(row0 + tt) * INC;
        const unsigned bb = *(const unsigned*)(P + ro + ch), cc = *(const unsigned*)(P + ro + 1024 + ch), hh = *(const unsigned*)(P + ro + 2048 + ch);
        const float za = bflo(cc) * bflo(hh), zb = bfhi(cc) * bfhi(hh);
        const float ya = bflo(bb) * (w00 * zm2a + w10 * zm1a + w20 * za), yb = bfhi(bb) * (w01 * zm2b + w11 * zm1b + w21 * zb);
        zm2a = zm1a; zm2b = zm1b; zm1a = za; zm1b = zb;
        const float ss = wave_sum(ya * ya + yb * yb);
        const float rstd = rsqrtf(ss * (1.f / 128.f) + EPS);
        *(unsigned*)(MG + (size_t)(row0 + tt) * D_ + ch) = pk2(ya * rstd, yb * rstd);
      }
    }
  }
}

DI void phase4(const Params& p, char* smem) {
  const u16* Q = (const u16*)(p.ws + WS_Q); const u16* Kb = (const u16*)(p.ws + WS_K); const u16* VT = (const u16*)(p.ws + WS_VT);
  u16* MG = (u16*)(p.ws + WS_MG);
  u16* Ks = (u16*)(smem + 16);
  u16* Vs = Ks + 64 * 200;
  float* mrg = (float*)(smem + 16);
  const int tid = threadIdx.x, lane = tid & 63, w = tid >> 6, qh = w & 1, kh = w >> 1, r = lane & 31, hi = lane >> 5;
  for (int it = blockIdx.x; it < 512; it += gridDim.x) {
    const int pi = it & 15, h = (it >> 4) & 7, b = it >> 7;
    for (int sub = 0; sub < 2; ++sub) {
      const int c = sub ? (31 - pi) : pi;
      const size_t qrow = (size_t)b * S_ + c * 64 + qh * 32 + r;
      bf16x8 qf[12];
#pragma unroll
      for (int ks = 0; ks < 12; ++ks) qf[ks] = *(const bf16x8*)(Q + qrow * 1536 + h * 192 + ks * 16 + hi * 8);
      f32x16 O[4];
#pragma unroll
      for (int dt = 0; dt < 4; ++dt)
#pragma unroll
        for (int i = 0; i < 16; ++i) O[dt][i] = 0.f;
      float m = -1e30f, l = 0.f;
      u32x4 kr[6]; u32x4 vr[4];
      const u16* kg = Kb + ((size_t)b * S_ + (tid >> 2)) * 1536 + h * 192 + (tid & 3) * 8;
      const u16* vg = VT + ((size_t)((b * 8 + h) * 128 + (tid >> 1))) * S_ + (tid & 1) * 8;
      u16* ksw = Ks + (tid >> 2) * 200 + (tid & 3) * 8;
      u16* vsw = Vs + (tid >> 1) * 68 + (tid & 1) * 8;
      auto load_tile = [&]() __attribute__((always_inline)) {
#pragma unroll
        for (int i = 0; i < 6; ++i) kr[i] = *(const u32x4*)(kg + i * 32);
#pragma unroll
        for (int i = 0; i < 4; ++i) vr[i] = *(const u32x4*)(vg + i * 16);
        kg += 64 * 1536; vg += 64;
      };
      load_tile();
      for (int kt = 0; kt <= c; ++kt) {
        __syncthreads();
#pragma unroll
        for (int i = 0; i < 6; ++i) *(u32x4*)(ksw + i * 32) = kr[i];
#pragma unroll
        for (int i = 0; i < 4; ++i) { u32x2 lo2 = {vr[i][0], vr[i][1]}, hi2 = {vr[i][2], vr[i][3]}; *(u32x2*)(vsw + i * 16) = lo2; *(u32x2*)(vsw + i * 16 + 4) = hi2; }
        __syncthreads();
        if (kt < c) load_tile();
        f32x16 s;
#pragma unroll
        for (int i = 0; i < 16; ++i) s[i] = 0.f;
        const u16* kp = Ks + (kh * 32 + r) * 200 + hi * 8;
#pragma unroll
        for (int ks = 0; ks < 12; ++ks) { bf16x8 kf = *(const bf16x8*)(kp + ks * 16); s = MFMA(kf, qf[ks], s); }
        float mx = s[0];
#pragma unroll
        for (int i = 1; i < 16; ++i) mx = fmaxf(mx, s[i]);
        mx = fmaxf(mx, __shfl_xor(mx, 32));
        const float mn = fmaxf(m, mx);
        const float alpha = exp2f(m - mn);
        m = mn;
        float rsum = 0.f;
#pragma unroll
        for (int i = 0; i < 16; ++i) { s[i] = exp2f(s[i] - mn); rsum += s[i]; }
        l = l * alpha + rsum;
#pragma unroll
        for (int dt = 0; dt < 4; ++dt)
#pragma unroll
          for (int i = 0; i < 16; ++i) O[dt][i] *= alpha;
#pragma unroll
        for (int st = 0; st < 2; ++st) {
          uint4 pu = make_uint4(pk2(s[8 * st], s[8 * st + 1]), pk2(s[8 * st + 2], s[8 * st + 3]), pk2(s[8 * st + 4], s[8 * st + 5]), pk2(s[8 * st + 6], s[8 * st + 7]));
          const bf16x8 pf = __builtin_bit_cast(bf16x8, pu);
#pragma unroll
          for (int dt = 0; dt < 4; ++dt) {
            const u16* vp = Vs + (dt * 32 + r) * 68 + kh * 32 + 16 * st + 4 * hi;
            uint2 v0 = *(const uint2*)vp, v1 = *(const uint2*)(vp + 8);
            const bf16x8 vf = __builtin_bit_cast(bf16x8, make_uint4(v0.x, v0.y, v1.x, v1.y));
            O[dt] = MFMA(vf, pf, O[dt]);
          }
        }
      }
      l += __shfl_xor(l, 32);
      __syncthreads();
      float* mq = mrg + qh * 66 * 64;
      if (kh == 1) {
#pragma unroll
        for (int dt = 0; dt < 4; ++dt)
#pragma unroll
          for (int i = 0; i < 16; ++i) mq[(dt * 16 + i) * 64 + lane] = O[dt][i];
        mq[64 * 64 + lane] = m; mq[65 * 64 + lane] = l;
      }
      __syncthreads();
      if (kh == 0) {
        const float m1 = mq[64 * 64 + lane], l1 = mq[65 * 64 + lane];
        const float mt = fmaxf(m, m1), a0 = exp2f(m - mt), a1 = exp2f(m1 - mt);
        const float inv = 1.f / (l * a0 + l1 * a1);
        float ss = 0.f;
#pragma unroll
        for (int dt = 0; dt < 4; ++dt)
#pragma unroll
          for (int i = 0; i < 16; ++i) { const float o = (O[dt][i] * a0 + mq[(dt * 16 + i) * 64 + lane] * a1) * inv; O[dt][i] = o; ss += o * o; }
        ss += __shfl_xor(ss, 32);
        const float rstd = rsqrtf(ss * (1.f / 128.f) + EPS);
#pragma unroll
        for (int dt = 0; dt < 4; ++dt)
#pragma unroll
          for (int g = 0; g < 4; ++g) {
            const int d = dt * 32 + hi * 4 + 8 * g;
            *(uint2*)(MG + qrow * D_ + 1024 + h * 128 + d) = make_uint2(pk2(O[dt][4 * g] * rstd, O[dt][4 * g + 1] * rstd), pk2(O[dt][4 * g + 2] * rstd, O[dt][4 * g + 3] * rstd));
          }
      }
    }
  }
}

DI void phase5(const Params& p, char* smem) {
  const u16* MG = (const u16*)(p.ws + WS_MG); const u16* W = (const u16*)(p.ws + WS_WOUTT);
  const float* X = p.in[0]; const float* mod = (const float*)(p.ws + WS_MOD); float* X1 = (float*)(p.ws + WS_X1);
  for (int it = blockIdx.x; it < 64 * 16; it += gridDim.x) {
    const int tn = it / 64, tm = it % 64;
    gemm_tile<true>(MG, D_, W, D_, D_, tm * 128, tn * 128, smem, [&](f32x16 (&acc)[2][2], int mb, int nb, int r, int hi) __attribute__((always_inline)) {
#pragma unroll
      for (int mi = 0; mi < 2; ++mi) {
        const int row = mb + mi * 32 + r, b = row >> 11;
        const float* gt = mod + b * 12288 + 2 * 2048;
#pragma unroll
        for (int ni = 0; ni < 2; ++ni)
#pragma unroll
          for (int g = 0; g < 4; ++g) {
            const int col = nb + ni * 32 + hi * 4 + 8 * g;
            const float4 xv = *(const float4*)(X + (size_t)row * D_ + col), gv = *(const float4*)(gt + col);
            float4 o;
            o.x = xv.x + gv.x * acc[mi][ni][4 * g]; o.y = xv.y + gv.y * acc[mi][ni][4 * g + 1]; o.z = xv.z + gv.z * acc[mi][ni][4 * g + 2]; o.w = xv.w + gv.w * acc[mi][ni][4 * g + 3];
            *(float4*)(X1 + (size_t)row * D_ + col) = o;
          }
      }
    });
  }
}

DI void phase7(const Params& p, char* smem) {
  const u16* H2 = (const u16*)(p.ws + WS_H); const u16* W = (const u16*)(p.ws + WS_WQT); u16* PQ = (u16*)(p.ws + WS_P);
  for (int it = blockIdx.x; it < 64 * 16; it += gridDim.x) {
    const int tn = it / 64, tm = it % 64;
    gemm_tile<true>(H2, D_, W, D_, D_, tm * 128, tn * 128, smem, [&](f32x16 (&acc)[2][2], int mb, int nb, int r, int hi) __attribute__((always_inline)) {
#pragma unroll
      for (int mi = 0; mi < 2; ++mi)
#pragma unroll
        for (int ni = 0; ni < 2; ++ni)
#pragma unroll
          for (int g = 0; g < 4; ++g) {
            const int row = mb + mi * 32 + r, col = nb + ni * 32 + hi * 4 + 8 * g;
            *(uint2*)(PQ + (size_t)row * D_ + col) = make_uint2(pk2(acc[mi][ni][4 * g], acc[mi][ni][4 * g + 1]), pk2(acc[mi][ni][4 * g + 2], acc[mi][ni][4 * g + 3]));
          }
    });
  }
}

DI unsigned f2ord(float v) { unsigned u = __float_as_uint(v); return u ^ ((unsigned)((int)u >> 31) | 0x80000000u); }
#define TOPK_INSERT(keys, x) { _Pragma("unroll") for (int _j = 0; _j < 16; ++_j) { const unsigned _h = max(keys[_j], x); x = min(keys[_j], x); keys[_j] = _h; } }
DI void phase8(const Params& p, char* smem) {
  const u16* PQ = (const u16*)(p.ws + WS_P); const u16* SK = (const u16*)(p.ws + WS_SK);
  int* IDS = (int*)(p.ws + WS_IDS); float* GATE = (float*)(p.ws + WS_GATE);
  float* sc = (float*)(smem + 16);
  const int tid = threadIdx.x, lane = tid & 63, w = tid >> 6, r = lane & 31, hi = lane >> 5;
  for (int it = blockIdx.x; it < 128 * 8; it += gridDim.x) {
    const int h = it & 7, tile = it >> 3;
    const int pp = w >> 1, rh = w & 1;
    __syncthreads();
    {
      f32x16 acc[4];
#pragma unroll
      for (int nt = 0; nt < 4; ++nt)
#pragma unroll
        for (int i = 0; i < 16; ++i) acc[nt][i] = 0.f;
      const u16* ap = PQ + (size_t)(tile * 64 + rh * 32 + r) * D_ + h * 256 + pp * 128 + hi * 8;
      const u16* bp = SK + ((size_t)(h * 2 + pp) * 128 + r) * 128 + hi * 8;
#pragma unroll
      for (int ks = 0; ks < 8; ++ks) {
        const bf16x8 af = *(const bf16x8*)(ap + ks * 16);
#pragma unroll
        for (int nt = 0; nt < 4; ++nt) { const bf16x8 bf = *(const bf16x8*)(bp + nt * 32 * 128 + ks * 16); acc[nt] = MFMA(af, bf, acc[nt]); }
      }
#pragma unroll
      for (int nt = 0; nt < 4; ++nt)
#pragma unroll
        for (int i = 0; i < 16; ++i) sc[(pp * 64 + rh * 32 + hi * 4 + (i & 3) + 8 * (i >> 2)) * 129 + nt * 32 + r] = acc[nt][i];
    }
    __syncthreads();
    if (tid < 128) {
      float* row = sc + tid * 129;
      unsigned keys[16];
#pragma unroll
      for (int j = 0; j < 16; ++j) keys[j] = 0u;
#pragma unroll 4
      for (int n = 0; n < 128; ++n) {
        unsigned x = (f2ord(row[n]) & 0xFFFFFF80u) | (unsigned)(127 - n);
        TOPK_INSERT(keys, x);
      }
      float vals[16];
#pragma unroll
      for (int j = 0; j < 16; ++j) vals[j] = row[127 - (keys[j] & 127u)];
#pragma unroll
      for (int j = 0; j < 16; ++j) { row[j] = vals[j]; row[16 + j] = __int_as_float((int)(127 - (keys[j] & 127u))); }
    }
    __syncthreads();
    if (tid < 64) {
      const float* ra = sc + tid * 129; const float* rb = sc + (64 + tid) * 129;
      float a[16], bq[16];
#pragma unroll
      for (int j = 0; j < 16; ++j) { a[j] = ra[j]; bq[j] = rb[j]; }
      unsigned keys[16];
#pragma unroll
      for (int j = 0; j < 16; ++j) keys[j] = 0u;
#pragma unroll
      for (int i = 0; i < 16; ++i)
#pragma unroll
        for (int j = 0; j < 16; ++j)
          if ((i + 1) * (j + 1) <= 16) {
            unsigned x = (f2ord(a[i] + bq[j]) & 0xFFFFFF00u) | (unsigned)(255 - (i * 16 + j));
            TOPK_INSERT(keys, x);
          }
      float bv[16]; int ex[16];
      float mx = -1e30f;
#pragma unroll
      for (int q = 0; q < 16; ++q) {
        const int flat = 255 - (int)(keys[q] & 255u), i = flat >> 4, j = flat & 15;
        bv[q] = ra[i] + rb[j];
        ex[q] = __float_as_int(ra[16 + i]) * 128 + __float_as_int(rb[16 + j]);
        mx = fmaxf(mx, bv[q]);
      }
      float sum = 0.f;
#pragma unroll
      for (int q = 0; q < 16; ++q) { bv[q] = __expf(bv[q] - mx); sum += bv[q]; }
      const float inv = 1.f / sum;
      const size_t o = (size_t)(tile * 64 + tid) * 128 + h * 16;
#pragma unroll
      for (int q = 0; q < 16; q += 4) {
        *(int4*)(IDS + o + q) = make_int4(ex[q], ex[q + 1], ex[q + 2], ex[q + 3]);
        *(float4*)(GATE + o + q) = make_float4(bv[q] * inv, bv[q + 1] * inv, bv[q + 2] * inv, bv[q + 3] * inv);
      }
    }
  }
}

DI void phase9(const Params& p, char* smem) {
  const u16* H2 = (const u16*)(p.ws + WS_H); const u16* U = (const u16*)(p.ws + WS_U); const u16* V = (const u16*)(p.ws + WS_V);
  const int* IDS = (const int*)(p.ws + WS_IDS); const float* GATE = (const float*)(p.ws + WS_GATE);
  const float* X1 = (const float*)(p.ws + WS_X1); const float* mod = (const float*)(p.ws + WS_MOD); const float* gfin = p.in[19];
  const int lane = threadIdx.x & 63, w = threadIdx.x >> 6;
  float* aw = (float*)(smem + 16) + w * 128;
  const int b5 = (lane >> 5) & 1, b4 = (lane >> 4) & 1;
  for (int tok0 = blockIdx.x * 4 + w; tok0 < T_; tok0 += gridDim.x * 4) {
    const int tok = __builtin_amdgcn_readfirstlane(tok0);
    uint4 hq[4];
#pragma unroll
    for (int j = 0; j < 4; ++j) hq[j] = *(const uint4*)(H2 + (size_t)tok * D_ + j * 512 + lane * 8);
    const int* ids = IDS + (size_t)tok * 128;
    for (int n0 = 0; n0 < 128; n0 += 4) {
      float ps[4];
      uint4 uu[4][4];
#pragma unroll
      for (int e = 0; e < 4; ++e) {
        const int ex = ids[n0 + e];
#pragma unroll
        for (int j = 0; j < 4; ++j) uu[e][j] = *(const uint4*)(U + (size_t)ex * D_ + j * 512 + lane * 8);
      }
#pragma unroll
      for (int e = 0; e < 4; ++e) {
        float s = 0.f;
#pragma unroll
        for (int j = 0; j < 4; ++j) { s = dot2(hq[j].x, uu[e][j].x, s); s = dot2(hq[j].y, uu[e][j].y, s); s = dot2(hq[j].z, uu[e][j].z, s); s = dot2(hq[j].w, uu[e][j].w, s); }
        ps[e] = s;
      }
      const float k0 = b5 ? ps[2] : ps[0], s0 = b5 ? ps[0] : ps[2];
      const float k1 = b5 ? ps[3] : ps[1], s1 = b5 ? ps[1] : ps[3];
      const float r0 = k0 + __shfl_xor(s0, 32), r1 = k1 + __shfl_xor(s1, 32);
      float rr = (b4 ? r1 : r0) + __shfl_xor(b4 ? r0 : r1, 16);
      rr += __shfl_xor(rr, 8); rr += __shfl_xor(rr, 4); rr += __shfl_xor(rr, 2); rr += __shfl_xor(rr, 1);
      if ((lane & 15) == 0) aw[n0 + 2 * b5 + b4] = rr;
    }
    asm volatile("s_waitcnt lgkmcnt(0)" ::: "memory");
    __builtin_amdgcn_wave_barrier();
#pragma unroll
    for (int q = 0; q < 2; ++q) {
      const int n = lane + 64 * q;
      const float a = aw[n];
      const float act = 0.5f * a * (1.f + erff(a * 0.70710678118654752f)) * GATE[(size_t)tok * 128 + n];
      aw[n] = act;
    }
    asm volatile("s_waitcnt lgkmcnt(0)" ::: "memory");
    __builtin_amdgcn_wave_barrier();
    float o[32];
#pragma unroll
    for (int i = 0; i < 32; ++i) o[i] = 0.f;
    for (int n0 = 0; n0 < 128; n0 += 4) {
      uint4 vv[4][4];
      const float4 a4 = *(const float4*)(aw + n0);
      const float av[4] = {a4.x, a4.y, a4.z, a4.w};
#pragma unroll
      for (int e = 0; e < 4; ++e) {
        const int ex = ids[n0 + e];
#pragma unroll
        for (int j = 0; j < 4; ++j) vv[e][j] = *(const uint4*)(V + (size_t)ex * D_ + j * 512 + lane * 8);
      }
#pragma unroll
      for (int e = 0; e < 4; ++e)
#pragma unroll
        for (int j = 0; j < 4; ++j) {
          const float a = av[e];
          o[j * 8 + 0] += a * bflo(vv[e][j].x); o[j * 8 + 1] += a * bfhi(vv[e][j].x);
          o[j * 8 + 2] += a * bflo(vv[e][j].y); o[j * 8 + 3] += a * bfhi(vv[e][j].y);
          o[j * 8 + 4] += a * bflo(vv[e][j].z); o[j * 8 + 5] += a * bfhi(vv[e][j].z);
          o[j * 8 + 6] += a * bflo(vv[e][j].w); o[j * 8 + 7] += a * bfhi(vv[e][j].w);
        }
    }
    const int b = tok >> 11;
    const float* gt = mod + b * 12288 + 5 * 2048;
    float ss = 0.f;
#pragma unroll
    for (int j = 0; j < 4; ++j)
#pragma unroll
      for (int q = 0; q < 2; ++q) {
        const int d = j * 512 + lane * 8 + q * 4;
        const float4 xv = *(const float4*)(X1 + (size_t)tok * D_ + d), gv = *(const float4*)(gt + d);
        float* oo = o + j * 8 + q * 4;
        oo[0] = xv.x + gv.x * oo[0]; oo[1] = xv.y + gv.y * oo[1]; oo[2] = xv.z + gv.z * oo[2]; oo[3] = xv.w + gv.w * oo[3];
        ss += oo[0] * oo[0] + oo[1] * oo[1] + oo[2] * oo[2] + oo[3] * oo[3];
      }
    ss = wave_sum(ss);
    const float rstd = rsqrtf(ss * (1.f / D_) + EPS);
#pragma unroll
    for (int j = 0; j < 4; ++j)
#pragma unroll
      for (int q = 0; q < 2; ++q) {
        const int d = j * 512 + lane * 8 + q * 4;
        const float4 gv = *(const float4*)(gfin + d);
        const float* oo = o + j * 8 + q * 4;
        *(float4*)(p.out + (size_t)tok * D_ + d) = make_float4(oo[0] * rstd * gv.x, oo[1] * rstd * gv.y, oo[2] * rstd * gv.z, oo[3] * rstd * gv.w);
      }
    asm volatile("s_waitcnt lgkmcnt(0)" ::: "memory");
    __builtin_amdgcn_wave_barrier();
  }
}

__global__ void __launch_bounds__(256, 2) mega(Params p) {
  extern __shared__ __attribute__((aligned(16))) char smem[];
  XcdBarrier xb;
  const bool multi = (p.ph_hi - p.ph_lo) > 1;
  if (multi) {
    if (threadIdx.x == 0) *(uint4*)smem = make_uint4(0u, 0u, 0u, 0u);
    __syncthreads();
    xb = xcd_barrier_post((unsigned*)(p.ws + WS_BAR), (volatile LAS unsigned*)smem);
  }
#ifndef PHMASK
#define PHMASK 0x3ff
#endif
#define RUN_PHASE(n, call) if (p.ph_lo <= (n) && (n) < p.ph_hi) { \
    if ((n) > p.ph_lo) { if ((n) == p.ph_lo + 1 && p.coop) cg::this_grid().sync(); else xcd_barrier(xb); } \
    if (PHMASK & (1 << (n))) { call; } }
  RUN_PHASE(0, phase0(p, smem))
  RUN_PHASE(1, norm_rows(p.in[0], p.in[4], (const float*)(p.ws + WS_MOD), 0, (u16*)(p.ws + WS_H)))
  RUN_PHASE(2, phase2(p, smem))
  RUN_PHASE(3, phase3(p, smem))
  RUN_PHASE(4, phase4(p, smem))
  RUN_PHASE(5, phase5(p, smem))
  RUN_PHASE(6, norm_rows((const float*)(p.ws + WS_X1), p.in[14], (const float*)(p.ws + WS_MOD), 3, (u16*)(p.ws + WS_H)))
  RUN_PHASE(7, phase7(p, smem))
  RUN_PHASE(8, phase8(p, smem))
  RUN_PHASE(9, phase9(p, smem))
}

extern "C" void kernel_launch(void* const* d_in, const int* in_sizes, int n_in, void* d_out, int out_size, void* d_ws, size_t ws_size, hipStream_t stream) {
  static int grid = 0;
  if (grid == 0) {
    if (n_in != 20 || ws_size < WS_END) { fprintf(stderr, "kernel_launch: unexpected n_in %d / ws_size %zu (need %zu)\n", n_in, ws_size, (size_t)WS_END); grid = -1; return; }
    int dev = 0, cus = 0, per_cu = 0;
    hipGetDevice(&dev);
    hipDeviceGetAttribute(&cus, hipDeviceAttributeMultiprocessorCount, dev);
    hipFuncSetAttribute((const void*)mega, hipFuncAttributeMaxDynamicSharedMemorySize, LDS_BYTES);
    hipOccupancyMaxActiveBlocksPerMultiprocessor(&per_cu, (const void*)mega, 256, LDS_BYTES);
    if (per_cu < 1) { fprintf(stderr, "kernel_launch: occupancy query says %d\n", per_cu); per_cu = 1; }
    if (per_cu > 2) per_cu = 2;
    grid = cus * per_cu;
    fprintf(stderr, "kernel_launch: grid %d (%d per CU)\n", grid, per_cu);
  }
  if (grid < 0) return;
  Params p{};
  for (int i = 0; i < 20; ++i) p.in[i] = (const float*)d_in[i];
  p.out = (float*)d_out; p.ws = (char*)d_ws;
#if N_LAUNCH_PER_PHASE
  p.coop = 0;
  for (int ph = 0; ph < NPH; ++ph) {
    p.ph_lo = ph; p.ph_hi = ph + 1;
    hipLaunchKernelGGL(mega, dim3(grid), dim3(256), LDS_BYTES, stream, p);
  }
#else
  hipMemsetAsync((char*)d_ws + WS_BAR, 0, XCD_BAR_WORDS * 4, stream);
  p.coop = 1; p.ph_lo = 0; p.ph_hi = NPH;
  void* args[] = {&p};
  hipError_t e = hipLaunchCooperativeKernel((const void*)mega, dim3(grid), dim3(256), args, LDS_BYTES, stream);
  if (e != hipSuccess) fprintf(stderr, "cooperative launch failed: %s (grid %d)\n", hipGetErrorString(e), grid);
#endif
}
```

```cpp
#include <hip/hip_runtime.h>
#include <hip/hip_cooperative_groups.h>
#include <cstdio>
#include <cstdint>
namespace cg = cooperative_groups;

#ifndef N_LAUNCH_PER_PHASE
#define N_LAUNCH_PER_PHASE 0
#endif

#define DI __device__ __forceinline__
typedef unsigned short u16;
typedef __attribute__((ext_vector_type(8))) short bf16x8;
typedef __attribute__((ext_vector_type(16))) float f32x16;
typedef __attribute__((ext_vector_type(2))) __bf16 bf2_t;
typedef __attribute__((ext_vector_type(2))) float f2_t;
typedef __attribute__((ext_vector_type(4))) unsigned u32x4;
typedef __attribute__((ext_vector_type(2))) unsigned u32x2;
#define MFMA(a, b, c) __builtin_amdgcn_mfma_f32_32x32x16_bf16((a), (b), (c), 0, 0, 0)

constexpr int T_ = 8192, D_ = 2048, S_ = 2048;
constexpr int INC = 4160;
constexpr float EPS = 1e-6f;
constexpr int NPH = 10;

constexpr size_t al256(size_t x) { return (x + 255) & ~(size_t)255; }
constexpr size_t WS_BAR = 0;
constexpr size_t WS_MOD = 16384;
constexpr size_t WS_ROPE = WS_MOD + al256(4 * 12288 * 4);
constexpr size_t WS_WINT = WS_ROPE + al256(2048 * 32 * 8);
constexpr size_t WS_WUQT = WS_WINT + al256((size_t)4224 * 2048 * 2);
constexpr size_t WS_WUKVT = WS_WUQT + al256((size_t)1536 * 512 * 2);
constexpr size_t WS_WOUTT = WS_WUKVT + al256((size_t)2048 * 512 * 2);
constexpr size_t WS_WQT = WS_WOUTT + al256((size_t)2048 * 2048 * 2);
constexpr size_t WS_SK = WS_WQT + al256((size_t)2048 * 2048 * 2);
constexpr size_t WS_U = WS_SK + al256((size_t)262144 * 2);
constexpr size_t WS_V = WS_U + al256((size_t)16384 * 2048 * 2);
constexpr size_t WS_H = WS_V + al256((size_t)16384 * 2048 * 2);
constexpr size_t WS_P = WS_H + al256((size_t)T_ * D_ * 2);
constexpr size_t WS_Q = WS_P + al256((size_t)T_ * INC * 2);
constexpr size_t WS_K = WS_Q + al256((size_t)T_ * 1536 * 2);
constexpr size_t WS_VT = WS_K + al256((size_t)T_ * 1536 * 2);
constexpr size_t WS_MG = WS_VT + al256((size_t)T_ * 1024 * 2);
constexpr size_t WS_X1 = WS_MG + al256((size_t)T_ * D_ * 2);
constexpr size_t WS_IDS = WS_X1 + al256((size_t)T_ * D_ * 4);
constexpr size_t WS_GATE = WS_IDS + al256((size_t)T_ * 128 * 4);
constexpr size_t WS_END = WS_GATE + al256((size_t)T_ * 128 * 4);

constexpr int LDS_BYTES = 16 + 2 * 2 * 128 * 72 * 2 + 512;

struct Params {
  const float* in[20];
  float* out;
  char* ws;
  int ph_lo, ph_hi, coop, pad;
};

DI unsigned pk2(float a, float b) { f2_t v = {a, b}; bf2_t r = __builtin_convertvector(v, bf2_t); return __builtin_bit_cast(unsigned, r); }
DI float bflo(unsigned u) { return __uint_as_float(u << 16); }
DI float bfhi(unsigned u) { return __uint_as_float(u & 0xffff0000u); }
DI float dot2(unsigned a, unsigned b, float c) { return __builtin_amdgcn_fdot2_f32_bf16(__builtin_bit_cast(bf2_t, a), __builtin_bit_cast(bf2_t, b), c, false); }
DI float wave_sum(float v) {
#pragma unroll
  for (int o = 32; o >= 1; o >>= 1) v += __shfl_xor(v, o);
  return v;
}

#define XB_TMO      128
#define XB_XCNT(j)  (256  + 64 * (j))
#define XB_XSUB(j)  (1280 + 64 * (j))
#define XB_XGEN(j)  (2304 + 64 * (j))
#define XB_TOP      3328
#define XB_TOPGEN   3392
#define XCD_BAR_WORDS 3456
#define XB_SPIN_CAP (1u << 22)
#define LAS __attribute__((address_space(3)))
DI unsigned xb_ld(unsigned* p) { return __hip_atomic_load(p, __ATOMIC_RELAXED, __HIP_MEMORY_SCOPE_AGENT); }
DI unsigned xb_add(unsigned* p, unsigned v) { return __hip_atomic_fetch_add(p, v, __ATOMIC_RELAXED, __HIP_MEMORY_SCOPE_AGENT); }
DI unsigned xb_xcc_id() { return (unsigned)__builtin_amdgcn_s_getreg((3 << 11) | 20) & 0xFu; }
#define XB_SPIN(cond, bar) do { unsigned _sp = 0; while (cond) { __builtin_amdgcn_s_sleep(1); \
    if ((++_sp & 255u) == 0u) { if (xb_ld(&(bar)[XB_TMO])) break; if (_sp > XB_SPIN_CAP) { atomicAdd(&(bar)[XB_TMO], 1u); break; } } } } while (0)
struct XcdBarrier { unsigned* bar; unsigned x; volatile LAS unsigned* st; };
DI XcdBarrier xcd_barrier_post(unsigned* bar, volatile LAS unsigned* st) {
  XcdBarrier b; b.bar = bar; b.x = xb_xcc_id(); b.st = st;
  if (threadIdx.x == 0) (void)xb_add(&bar[XB_XCNT(b.x)], 1u);
  return b;
}
DI void xcd_barrier_complete(unsigned* bar, unsigned x, unsigned& nloc, unsigned& nx) {
  const unsigned G = gridDim.x * gridDim.y * gridDim.z;
  unsigned sum, cnt, mine, sp = 0u;
  for (;;) {
    sum = 0u; cnt = 0u; mine = 0u;
#pragma unroll
    for (unsigned j = 0; j < 16; ++j) { const unsigned c = xb_ld(&bar[XB_XCNT(j)]); sum += c; cnt += (c > 0u) ? 1u : 0u; mine = (j == x) ? c : mine; }
    if (sum == G) break;
    __builtin_amdgcn_s_sleep(1);
    if ((++sp & 255u) == 0u) { if (xb_ld(&bar[XB_TMO])) break; if (sp > XB_SPIN_CAP) { atomicAdd(&bar[XB_TMO], 1u); break; } }
  }
  nloc = mine > 0u ? mine : 1u; nx = cnt > 0u ? cnt : 1u;
}
DI void xcd_barrier(const XcdBarrier& b) {
  asm volatile("s_waitcnt vmcnt(0)" ::: "memory");
  __syncthreads();
  if (threadIdx.x == 0) {
    unsigned* bar = b.bar;
    __builtin_amdgcn_s_waitcnt(0);
    unsigned nloc = b.st[0], nx = b.st[1];
    if (nloc == 0u) { xcd_barrier_complete(bar, b.x, nloc, nx); b.st[0] = nloc; b.st[1] = nx; }
    const unsigned old = xb_add(&bar[XB_XSUB(b.x)], 1u);
    const unsigned gen = old / nloc;
    if (old + 1u == (gen + 1u) * nloc) {
      __builtin_amdgcn_fence(__ATOMIC_RELEASE, "agent");
      asm volatile("s_waitcnt vmcnt(0)" ::: "memory");
      const unsigned og = xb_add(&bar[XB_TOP], 1u);
      const unsigned tg = og / nx;
      if (og + 1u == (tg + 1u) * nx) xb_add(&bar[XB_TOPGEN], 1u);
      else XB_SPIN(xb_ld(&bar[XB_TOPGEN]) == tg, bar);
      __builtin_amdgcn_fence(__ATOMIC_ACQUIRE, "agent");
      xb_add(&bar[XB_XGEN(b.x)], 1u);
      asm volatile("s_waitcnt vmcnt(0)" ::: "memory");
    } else {
      XB_SPIN(xb_ld(&bar[XB_XGEN(b.x)]) == gen, bar);
      __builtin_amdgcn_fence(__ATOMIC_ACQUIRE, "agent");
      asm volatile("s_waitcnt vmcnt(0)" ::: "memory");
    }
  }
  __syncthreads();
}

template <bool SWAP, class Epi>
DI void gemm_tile(const u16* __restrict__ A, int lda, const u16* __restrict__ Bt, int ldb, int K, int m0, int n0, char* smem, Epi&& epi) {
  u16* As = (u16*)(smem + 16);
  u16* Bs = As + 2 * 128 * 72;
  const int tid = threadIdx.x, lane = tid & 63, w = tid >> 6, wm = w >> 1, wn = w & 1;
  const int r = lane & 31, hi = lane >> 5;
  f32x16 acc[2][2];
#pragma unroll
  for (int a = 0; a < 2; ++a)
#pragma unroll
    for (int b = 0; b < 2; ++b)
#pragma unroll
      for (int i = 0; i < 16; ++i) acc[a][b][i] = 0.f;
  const int srow = tid >> 3, skc = tid & 7;
  const u16* ag = A + (size_t)(m0 + srow) * lda + skc * 8;
  const u16* bg = Bt + (size_t)(n0 + srow) * ldb + skc * 8;
  u32x4 ra[4], rb[4];
#pragma unroll
  for (int i = 0; i < 4; ++i) { ra[i] = *(const u32x4*)(ag + (size_t)i * 32 * lda); rb[i] = *(const u32x4*)(bg + (size_t)i * 32 * ldb); }
  __syncthreads();
#pragma unroll
  for (int i = 0; i < 4; ++i) { *(u32x4*)(As + (srow + 32 * i) * 72 + skc * 8) = ra[i]; *(u32x4*)(Bs + (srow + 32 * i) * 72 + skc * 8) = rb[i]; }
  __syncthreads();
  const int KT = K >> 6;
  for (int kt = 0; kt < KT; ++kt) {
    const int buf = kt & 1;
    if (kt + 1 < KT) {
      const int k0 = (kt + 1) << 6;
#pragma unroll
      for (int i = 0; i < 4; ++i) { ra[i] = *(const u32x4*)(ag + (size_t)i * 32 * lda + k0); rb[i] = *(const u32x4*)(bg + (size_t)i * 32 * ldb + k0); }
    }
    const u16* Asb = As + buf * 128 * 72 + (wm * 64 + r) * 72 + hi * 8;
    const u16* Bsb = Bs + buf * 128 * 72 + (wn * 64 + r) * 72 + hi * 8;
#pragma unroll
    for (int ks = 0; ks < 4; ++ks) {
      bf16x8 af[2], bfr[2];
      af[0] = *(const bf16x8*)(Asb + ks * 16);
      af[1] = *(const bf16x8*)(Asb + 32 * 72 + ks * 16);
      bfr[0] = *(const bf16x8*)(Bsb + ks * 16);
      bfr[1] = *(const bf16x8*)(Bsb + 32 * 72 + ks * 16);
#pragma unroll
      for (int mi = 0; mi < 2; ++mi)
#pragma unroll
        for (int ni = 0; ni < 2; ++ni) {
          if (SWAP) acc[mi][ni] = MFMA(bfr[ni], af[mi], acc[mi][ni]);
          else acc[mi][ni] = MFMA(af[mi], bfr[ni], acc[mi][ni]);
        }
    }
    if (kt + 1 < KT) {
      const int nb = buf ^ 1;
#pragma unroll
      for (int i = 0; i < 4; ++i) { *(u32x4*)(As + nb * 128 * 72 + (srow + 32 * i) * 72 + skc * 8) = ra[i]; *(u32x4*)(Bs + nb * 128 * 72 + (srow + 32 * i) * 72 + skc * 8) = rb[i]; }
    }
    __syncthreads();
  }
  epi(acc, m0 + wm * 64, n0 + wn * 64, r, hi);
}

DI void tile_rstd512(const u16* __restrict__ A, int lda, int m0, float* rs) {
  const int tid = threadIdx.x, row = tid >> 1, half = tid & 1;
  const uint4* p = (const uint4*)(A + (size_t)(m0 + row) * lda + half * 256);
  float ss = 0.f;
#pragma unroll 8
  for (int i = 0; i < 32; ++i) {
    uint4 v = p[i];
    ss = dot2(v.x, v.x, ss); ss = dot2(v.y, v.y, ss); ss = dot2(v.z, v.z, ss); ss = dot2(v.w, v.w, ss);
  }
  ss += __shfl_xor(ss, 1);
  if (half == 0) rs[row] = rsqrtf(ss * (1.f / 512.f) + EPS);
}

DI void transpose_item(const float* __restrict__ src, int N, int K, const float* __restrict__ scale, u16* __restrict__ dst, int tk, int tn, char* smem) {
  float* tile = (float*)(smem + 16);
  const int t = threadIdx.x;
  __syncthreads();
  {
    const int rr = t >> 4, c4 = (t & 15) * 4;
#pragma unroll
    for (int ps = 0; ps < 4; ++ps) {
      const int kk = ps * 16 + rr, k = tk * 64 + kk;
      float4 v = *(const float4*)(src + (size_t)k * N + tn * 64 + c4);
      const float sc = scale ? scale[k] : 1.f;
      tile[kk * 65 + c4 + 0] = v.x * sc; tile[kk * 65 + c4 + 1] = v.y * sc; tile[kk * 65 + c4 + 2] = v.z * sc; tile[kk * 65 + c4 + 3] = v.w * sc;
    }
  }
  __syncthreads();
  {
    const int n = t & 63, kc = (t >> 6) * 16;
    unsigned o[8];
#pragma unroll
    for (int j = 0; j < 8; ++j) o[j] = pk2(tile[(kc + 2 * j) * 65 + n], tile[(kc + 2 * j + 1) * 65 + n]);
    uint4* d = (uint4*)(dst + (size_t)(tn * 64 + n) * K + tk * 64 + kc);
    d[0] = make_uint4(o[0], o[1], o[2], o[3]); d[1] = make_uint4(o[4], o[5], o[6], o[7]);
  }
}

DI void convert_item(const float* __restrict__ src, u16* __restrict__ dst, size_t base) {
  const int t = threadIdx.x;
#pragma unroll
  for (int st = 0; st < 4; ++st) {
    const size_t idx = base + st * 2048 + t * 8;
    float4 a = *(const float4*)(src + idx), b = *(const float4*)(src + idx + 4);
    *(uint4*)(dst + idx) = make_uint4(pk2(a.x, a.y), pk2(a.z, a.w), pk2(b.x, b.y), pk2(b.z, b.w));
  }
}

DI void mod_item(const Params& p, int cgi, char* smem) {
  float* cact = (float*)(smem + 16);
  float* red = cact + 4 * 2048;
  const int t = threadIdx.x;
  const float* c = p.in[1]; const float* W = p.in[2]; const float* bias = p.in[3];
  float* mod = (float*)(p.ws + WS_MOD);
  __syncthreads();
  for (int i = t; i < 4 * 2048; i += 256) { float v = c[i]; cact[i] = v / (1.f + __expf(-v)); }
  __syncthreads();
  const int cq = t & 15, kl = t >> 4, c0 = cgi * 64;
  float acc[4][4];
#pragma unroll
  for (int b = 0; b < 4; ++b)
#pragma unroll
    for (int j = 0; j < 4; ++j) acc[b][j] = 0.f;
  const float* wp = W + (size_t)kl * 12288 + c0 + cq * 4;
#pragma unroll 8
  for (int i = 0; i < 128; ++i) {
    const int k = kl + 16 * i;
    float4 w4 = *(const float4*)(wp + (size_t)i * 16 * 12288);
#pragma unroll
    for (int b = 0; b < 4; ++b) {
      const float a = cact[b * 2048 + k];
      acc[b][0] += a * w4.x; acc[b][1] += a * w4.y; acc[b][2] += a * w4.z; acc[b][3] += a * w4.w;
    }
  }
#pragma unroll
  for (int b = 0; b < 4; ++b)
#pragma unroll
    for (int j = 0; j < 4; ++j) red[(kl * 16 + cq) * 17 + b * 4 + j] = acc[b][j];
  __syncthreads();
  {
    const int b = t >> 6, col = t & 63, q = col >> 2, j = col & 3;
    float s = 0.f;
#pragma unroll
    for (int k2 = 0; k2 < 16; ++k2) s += red[(k2 * 16 + q) * 17 + b * 4 + j];
    mod[b * 12288 + c0 + col] = s + bias[c0 + col];
  }
}

constexpr int P0_MOD = 192;
constexpr int P0_TIN = 32 * 65, P0_TUQ = 8 * 24, P0_TUKV = 8 * 32, P0_TOUT = 32 * 32, P0_TWQ = 32 * 32;
constexpr int P0_SK = 32, P0_UV = 4096, P0_ROPE = 32;
DI void phase0(const Params& p, char* smem) {
  constexpr int o1 = P0_MOD, o2 = o1 + P0_TIN, o3 = o2 + P0_TUQ, o4 = o3 + P0_TUKV, o5 = o4 + P0_TOUT, o6 = o5 + P0_TWQ, o7 = o6 + P0_SK, o8 = o7 + P0_UV, o9 = o8 + P0_UV, o10 = o9 + P0_ROPE;
  for (int it = blockIdx.x; it < o10; it += gridDim.x) {
    if (it < o1) mod_item(p, it, smem);
    else if (it < o2) { int j = it - o1; transpose_item(p.in[5], INC, 2048, nullptr, (u16*)(p.ws + WS_WINT), j / 65, j % 65, smem); }
    else if (it < o3) { int j = it - o2; transpose_item(p.in[8], 1536, 512, p.in[7], (u16*)(p.ws + WS_WUQT), j / 24, j % 24, smem); }
    else if (it < o4) { int j = it - o3; transpose_item(p.in[10], 2048, 512, p.in[9], (u16*)(p.ws + WS_WUKVT), j / 32, j % 32, smem); }
    else if (it < o5) { int j = it - o4; int tk = j / 32; transpose_item(p.in[13], 2048, 2048, tk < 16 ? p.in[11] : p.in[12] - 1024, (u16*)(p.ws + WS_WOUTT), tk, j % 32, smem); }
    else if (it < o6) { int j = it - o5; transpose_item(p.in[15], 2048, 2048, nullptr, (u16*)(p.ws + WS_WQT), j / 32, j % 32, smem); }
    else if (it < o7) convert_item(p.in[16], (u16*)(p.ws + WS_SK), (size_t)(it - o6) * 8192);
    else if (it < o8) convert_item(p.in[17], (u16*)(p.ws + WS_U), (size_t)(it - o7) * 8192);
    else if (it < o9) convert_item(p.in[18], (u16*)(p.ws + WS_V), (size_t)(it - o8) * 8192);
    else {
      float2* rope = (float2*)(p.ws + WS_ROPE);
      const int base = (it - o9) * 2048;
      for (int e = threadIdx.x; e < 2048; e += 256) {
        const int idx = base + e, pos = idx >> 5, j = idx & 31;
        const float inv = 1.0f / powf(10000.0f, (float)(2 * j) / 64.0f);
        const float ang = (float)pos * inv;
        rope[idx] = make_float2(cosf(ang), sinf(ang));
      }
    }
  }
}

DI void norm_rows(const float* __restrict__ X, const float* __restrict__ g, const float* __restrict__ mod, int sh_chunk, u16* __restrict__ out) {
  const int lane = threadIdx.x & 63, w = threadIdx.x >> 6;
  for (int row = blockIdx.x * 4 + w; row < T_; row += gridDim.x * 4) {
    const float* xr = X + (size_t)row * D_;
    float4 v[8];
    float ss = 0.f;
#pragma unroll
    for (int j = 0; j < 8; ++j) { v[j] = *(const float4*)(xr + j * 256 + lane * 4); ss += v[j].x * v[j].x + v[j].y * v[j].y + v[j].z * v[j].z + v[j].w * v[j].w; }
    ss = wave_sum(ss);
    const float rstd = rsqrtf(ss * (1.f / D_) + EPS);
    const int b = row >> 11;
    const float* sh = mod + b * 12288 + sh_chunk * 2048;
    const float* sc = sh + 2048;
#pragma unroll
    for (int j = 0; j < 8; ++j) {
      const int d = j * 256 + lane * 4;
      float4 gg = *(const float4*)(g + d), s4 = *(const float4*)(sc + d), h4 = *(const float4*)(sh + d);
      const float o0 = v[j].x * rstd * gg.x * (1.f + s4.x) + h4.x;
      const float o1 = v[j].y * rstd * gg.y * (1.f + s4.y) + h4.y;
      const float o2 = v[j].z * rstd * gg.z * (1.f + s4.z) + h4.z;
      const float o3 = v[j].w * rstd * gg.w * (1.f + s4.w) + h4.w;
      *(uint2*)(out + (size_t)row * D_ + d) = make_uint2(pk2(o0, o1), pk2(o2, o3));
    }
  }
}

DI void phase2(const Params& p, char* smem) {
  const u16* H = (const u16*)(p.ws + WS_H); const u16* W = (const u16*)(p.ws + WS_WINT); u16* P = (u16*)(p.ws + WS_P);
  for (int it = blockIdx.x; it < 64 * 33; it += gridDim.x) {
    const int tn = it / 64, tm = it % 64;
    gemm_tile<true>(H, D_, W, D_, D_, tm * 128, tn * 128, smem, [&](f32x16 (&acc)[2][2], int mb, int nb, int r, int hi) __attribute__((always_inline)) {
      if (nb >= INC) return;
#pragma unroll
      for (int mi = 0; mi < 2; ++mi)
#pragma unroll
        for (int ni = 0; ni < 2; ++ni)
#pragma unroll
          for (int g = 0; g < 4; ++g) {
            const int row = mb + mi * 32 + r, col = nb + ni * 32 + hi * 4 + 8 * g;
            *(uint2*)(P + (size_t)row * INC + col) = make_uint2(pk2(acc[mi][ni][4 * g], acc[mi][ni][4 * g + 1]), pk2(acc[mi][ni][4 * g + 2], acc[mi][ni][4 * g + 3]));
          }
    });
  }
}

DI void phase3(const Params& p, char* smem) {
  const u16* P = (const u16*)(p.ws + WS_P);
  u16* Q = (u16*)(p.ws + WS_Q); u16* Kb = (u16*)(p.ws + WS_K); u16* VT = (u16*)(p.ws + WS_VT); u16* MG = (u16*)(p.ws + WS_MG);
  const float2* rope = (const float2*)(p.ws + WS_ROPE);
  float* rs = (float*)(smem + 16 + 2 * 2 * 128 * 72 * 2);
  constexpr int NQ = 64 * 12, NKV = 64 * 16, NKR = 1024, NCV = 1024;
  const float qscale = 0.07216878364870322f * 1.4426950408889634f;
  for (int it = blockIdx.x; it < NQ + NKV + NKR + NCV; it += gridDim.x) {
    if (it < NQ) {
      const int tn = it / 64, tm = it % 64;
      __syncthreads();
      tile_rstd512(P + 3072, INC, tm * 128, rs);
      gemm_tile<true>(P + 3072, INC, (const u16*)(p.ws + WS_WUQT), 512, 512, tm * 128, tn * 128, smem, [&](f32x16 (&acc)[2][2], int mb, int nb, int r, int hi) __attribute__((always_inline)) {
        const bool is_rope = ((nb >> 6) % 3) == 2;
#pragma unroll
        for (int mi = 0; mi < 2; ++mi) {
          const int row = mb + mi * 32 + r;
          const float sc = rs[row - tm * 128] * qscale;
          const int pos = row & (S_ - 1);
#pragma unroll
          for (int g = 0; g < 4; ++g) {
            const int j = hi * 4 + 8 * g;
            float a0[4], a1[4];
#pragma unroll
            for (int e = 0; e < 4; ++e) { a0[e] = acc[mi][0][4 * g + e] * sc; a1[e] = acc[mi][1][4 * g + e] * sc; }
            if (is_rope) {
#pragma unroll
              for (int e = 0; e < 4; ++e) {
                const float2 cs = rope[pos * 32 + j + e];
                const float x1 = a0[e], x2 = a1[e];
                a0[e] = x1 * cs.x - x2 * cs.y; a1[e] = x2 * cs.x + x1 * cs.y;
              }
            }
            *(uint2*)(Q + (size_t)row * 1536 + nb + j) = make_uint2(pk2(a0[0], a0[1]), pk2(a0[2], a0[3]));
            *(uint2*)(Q + (size_t)row * 1536 + nb + 32 + j) = make_uint2(pk2(a1[0], a1[1]), pk2(a1[2], a1[3]));
          }
        }
      });
    } else if (it < NQ + NKV) {
      const int j2 = it - NQ, tn = j2 / 64, tm = j2 % 64;
      __syncthreads();
      tile_rstd512(P + 3584, INC, tm * 128, rs);
      const int head = tn >> 1;
      if ((tn & 1) == 0) {
        gemm_tile<true>(P + 3584, INC, (const u16*)(p.ws + WS_WUKVT), 512, 512, tm * 128, tn * 128, smem, [&](f32x16 (&acc)[2][2], int mb, int nb, int r, int hi) __attribute__((always_inline)) {
#pragma unroll
          for (int mi = 0; mi < 2; ++mi) {
            const int row = mb + mi * 32 + r;
            const float sc = rs[row - tm * 128];
#pragma unroll
            for (int ni = 0; ni < 2; ++ni)
#pragma unroll
              for (int g = 0; g < 4; ++g) {
                const int d = (nb & 127) + ni * 32 + hi * 4 + 8 * g;
                *(uint2*)(Kb + (size_t)row * 1536 + head * 192 + d) = make_uint2(pk2(acc[mi][ni][4 * g] * sc, acc[mi][ni][4 * g + 1] * sc), pk2(acc[mi][ni][4 * g + 2] * sc, acc[mi][ni][4 * g + 3] * sc));
              }
          }
        });
      } else {
        gemm_tile<false>(P + 3584, INC, (const u16*)(p.ws + WS_WUKVT), 512, 512, tm * 128, tn * 128, smem, [&](f32x16 (&acc)[2][2], int mb, int nb, int r, int hi) __attribute__((always_inline)) {
#pragma unroll
          for (int mi = 0; mi < 2; ++mi)
#pragma unroll
            for (int g = 0; g < 4; ++g) {
              const int row0 = mb + mi * 32 + hi * 4 + 8 * g;
              const float s0 = rs[row0 - tm * 128], s1 = rs[row0 + 1 - tm * 128], s2 = rs[row0 + 2 - tm * 128], s3 = rs[row0 + 3 - tm * 128];
              const int b = row0 >> 11, t = row0 & (S_ - 1);
#pragma unroll
              for (int ni = 0; ni < 2; ++ni) {
                const int d = (nb & 127) + ni * 32 + r;
                *(uint2*)(VT + ((size_t)((b * 8 + head) * 128 + d)) * S_ + t) = make_uint2(pk2(acc[mi][ni][4 * g] * s0, acc[mi][ni][4 * g + 1] * s1), pk2(acc[mi][ni][4 * g + 2] * s2, acc[mi][ni][4 * g + 3] * s3));
              }
            }
        });
      }
    } else if (it < NQ + NKV + NKR) {
      const int j2 = it - NQ - NKV;
      const int row = j2 * 8 + (threadIdx.x >> 5), j = threadIdx.x & 31, pos = row & (S_ - 1);
      const float x1 = bflo((unsigned)P[(size_t)row * INC + 4096 + j]), x2 = bflo((unsigned)P[(size_t)row * INC + 4096 + 32 + j]);
      const float2 cs = rope[pos * 32 + j];
      const float o1 = x1 * cs.x - x2 * cs.y, o2 = x2 * cs.x + x1 * cs.y;
      const u16 b1 = (u16)(pk2(o1, 0.f) & 0xffffu), b2 = (u16)(pk2(o2, 0.f) & 0xffffu);
#pragma unroll
      for (int h = 0; h < 8; ++h) { Kb[(size_t)row * 1536 + h * 192 + 128 + j] = b1; Kb[(size_t)row * 1536 + h * 192 + 160 + j] = b2; }
    } else {
      const int j2 = it - NQ - NKV - NKR;
      const int wi = j2 * 4 + (threadIdx.x >> 6), lane = threadIdx.x & 63;
      const int g = wi & 7, run = wi >> 3;
      const int row0 = run * 16, t0 = row0 & (S_ - 1);
      const int ch = g * 128 + lane * 2;
      const float* cw = p.in[6];
      const float w00 = cw[ch], w01 = cw[ch + 1], w10 = cw[1024 + ch], w11 = cw[1024 + ch + 1], w20 = cw[2048 + ch], w21 = cw[2048 + ch + 1];
      float zm1a = 0.f, zm1b = 0.f, zm2a = 0.f, zm2b = 0.f;
      if (t0 > 0) {
        const unsigned c1 = *(const unsigned*)(P + (size_t)(row0 - 1) * INC + 1024 + ch), h1 = *(const unsigned*)(P + (size_t)(row0 - 1) * INC + 2048 + ch);
        const unsigned c2 = *(const unsigned*)(P + (size_t)(row0 - 2) * INC + 1024 + ch), h2 = *(const unsigned*)(P + (size_t)(row0 - 2) * INC + 2048 + ch);
        zm1a = bflo(c1) * bflo(h1); zm1b = bfhi(c1) * bfhi(h1); zm2a = bflo(c2) * bflo(h2); zm2b = bfhi(c2) * bfhi(h2);
      }
#pragma unroll 4
      for (int tt = 0; tt < 16; ++tt) {
        const size_t ro = (size_t)(row0 + tt) * INC;
        const unsigned bb = *(const unsigned*)(P + ro + ch), cc = *(const unsigned*)(P + ro + 1024 + ch), hh = *(const unsigned*)(P + ro + 2048 + ch);
        const float za = bflo(cc) * bflo(hh), zb = bfhi(cc) * bfhi(hh);
        const float ya = bflo(bb) * (w00 * zm2a + w10 * zm1a + w20 * za), yb = bfhi(bb) * (w01 * zm2b + w11 * zm1b + w21 * zb);
        zm2a = zm1a; zm2b = zm1b; zm1a = za; zm1b = zb;
        const float ss = wave_sum(ya * ya + yb * yb);
        const float rstd = rsqrtf(ss * (1.f / 128.f) + EPS);
        *(unsigned*)(MG + (size_t)(row0 + tt) * D_ + ch) = pk2(ya * rstd, yb * rstd);
      }
    }
  }
}

DI void phase4(const Params& p, char* smem) {
  const u16* Q = (const u16*)(p.ws + WS_Q); const u16* Kb = (const u16*)(p.ws + WS_K); const u16* VT = (const u16*)(p.ws + WS_VT);
  u16* MG = (u16*)(p.ws + WS_MG);
  u16* Ks = (u16*)(smem + 16);
  u16* Vs = Ks + 64 * 200;
  float* mrg = (float*)(smem + 16);
  const int tid = threadIdx.x, lane = tid & 63, w = tid >> 6, qh = w & 1, kh = w >> 1, r = lane & 31, hi = lane >> 5;
  for (int it = blockIdx.x; it < 512; it += gridDim.x) {
    const int pi = it & 15, h = (it >> 4) & 7, b = it >> 7;
    for (int sub = 0; sub < 2; ++sub) {
      const int c = sub ? (31 - pi) : pi;
      const size_t qrow = (size_t)b * S_ + c * 64 + qh * 32 + r;
      bf16x8 qf[12];
#pragma unroll
      for (int ks = 0; ks < 12; ++ks) qf[ks] = *(const bf16x8*)(Q + qrow * 1536 + h * 192 + ks * 16 + hi * 8);
      f32x16 O[4];
#pragma unroll
      for (int dt = 0; dt < 4; ++dt)
#pragma unroll
        for (int i = 0; i < 16; ++i) O[dt][i] = 0.f;
      float m = -1e30f, l = 0.f;
      u32x4 kr[6]; u32x4 vr[4];
      const u16* kg = Kb + ((size_t)b * S_ + (tid >> 2)) * 1536 + h * 192 + (tid & 3) * 8;
      const u16* vg = VT + ((size_t)((b * 8 + h) * 128 + (tid >> 1))) * S_ + (tid & 1) * 8;
      u16* ksw = Ks + (tid >> 2) * 200 + (tid & 3) * 8;
      u16* vsw = Vs + (tid >> 1) * 68 + (tid & 1) * 8;
      auto load_tile = [&]() __attribute__((always_inline)) {
#pragma unroll
        for (int i = 0; i < 6; ++i) kr[i] = *(const u32x4*)(kg + i * 32);
#pragma unroll
        for (int i = 0; i < 4; ++i) vr[i] = *(const u32x4*)(vg + i * 16);
        kg += 64 * 1536; vg += 64;
      };
      load_tile();
      for (int kt = 0; kt <= c; ++kt) {
        __syncthreads();
#pragma unroll
        for (int i = 0; i < 6; ++i) *(u32x4*)(ksw + i * 32) = kr[i];
#pragma unroll
        for (int i = 0; i < 4; ++i) { u32x2 lo2 = {vr[i][0], vr[i][1]}, hi2 = {vr[i][2], vr[i][3]}; *(u32x2*)(vsw + i * 16) = lo2; *(u32x2*)(vsw + i * 16 + 4) = hi2; }
        __syncthreads();
        if (kt < c) load_tile();
        f32x16 s;
#pragma unroll
        for (int i = 0; i < 16; ++i) s[i] = 0.f;
        const u16* kp = Ks + (kh * 32 + r) * 200 + hi * 8;
#pragma unroll
        for (int ks = 0; ks < 12; ++ks) { bf16x8 kf = *(const bf16x8*)(kp + ks * 16); s = MFMA(kf, qf[ks], s); }
        float mx = s[0];
#pragma unroll
        for (int i = 1; i < 16; ++i) mx = fmaxf(mx, s[i]);
        mx = fmaxf(mx, __shfl_xor(mx, 32));
        const float mn = fmaxf(m, mx);
        const float alpha = exp2f(m - mn);
        m = mn;
        float rsum = 0.f;
#pragma unroll
        for (int i = 0; i < 16; ++i) { s[i] = exp2f(s[i] - mn); rsum += s[i]; }
        l = l * alpha + rsum;
#pragma unroll
        for (int dt = 0; dt < 4; ++dt)
#pragma unroll
          for (int i = 0; i < 16; ++i) O[dt][i] *= alpha;
#pragma unroll
        for (int st = 0; st < 2; ++st) {
          uint4 pu = make_uint4(pk2(s[8 * st], s[8 * st + 1]), pk2(s[8 * st + 2], s[8 * st + 3]), pk2(s[8 * st + 4], s[8 * st + 5]), pk2(s[8 * st + 6], s[8 * st + 7]));
          const bf16x8 pf = __builtin_bit_cast(bf16x8, pu);
#pragma unroll
          for (int dt = 0; dt < 4; ++dt) {
            const u16* vp = Vs + (dt * 32 + r) * 68 + kh * 32 + 16 * st + 4 * hi;
            uint2 v0 = *(const uint2*)vp, v1 = *(const uint2*)(vp + 8);
            const bf16x8 vf = __builtin_bit_cast(bf16x8, make_uint4(v0.x, v0.y, v1.x, v1.y));
            O[dt] = MFMA(vf, pf, O[dt]);
          }
        }
      }
      l += __shfl_xor(l, 32);
      __syncthreads();
      float* mq = mrg + qh * 66 * 64;
      if (kh == 1) {
#pragma unroll
        for (int dt = 0; dt < 4; ++dt)
#pragma unroll
          for (int i = 0; i < 16; ++i) mq[(dt * 16 + i) * 64 + lane] = O[dt][i];
        mq[64 * 64 + lane] = m; mq[65 * 64 + lane] = l;
      }
      __syncthreads();
      if (kh == 0) {
        const float m1 = mq[64 * 64 + lane], l1 = mq[65 * 64 + lane];
        const float mt = fmaxf(m, m1), a0 = exp2f(m - mt), a1 = exp2f(m1 - mt);
        const float inv = 1.f / (l * a0 + l1 * a1);
        float ss = 0.f;
#pragma unroll
        for (int dt = 0; dt < 4; ++dt)
#pragma unroll
          for (int i = 0; i < 16; ++i) { const float o = (O[dt][i] * a0 + mq[(dt * 16 + i) * 64 + lane] * a1) * inv; O[dt][i] = o; ss += o * o; }
        ss += __shfl_xor(ss, 32);
        const float rstd = rsqrtf(ss * (1.f / 128.f) + EPS);
#pragma unroll
        for (int dt = 0; dt < 4; ++dt)
#pragma unroll
          for (int g = 0; g < 4; ++g) {
            const int d = dt * 32 + hi * 4 + 8 * g;
            *(uint2*)(MG + qrow * D_ + 1024 + h * 128 + d) = make_uint2(pk2(O[dt][4 * g] * rstd, O[dt][4 * g + 1] * rstd), pk2(O[dt][4 * g + 2] * rstd, O[dt][4 * g + 3] * rstd));
          }
      }
    }
  }
}

DI void phase5(const Params& p, char* smem) {
  const u16* MG = (const u16*)(p.ws + WS_MG); const u16* W = (const u16*)(p.ws + WS_WOUTT);
  const float* X = p.in[0]; const float* mod = (const float*)(p.ws + WS_MOD); float* X1 = (float*)(p.ws + WS_X1);
  for (int it = blockIdx.x; it < 64 * 16; it += gridDim.x) {
    const int tn = it / 64, tm = it % 64;
    gemm_tile<true>(MG, D_, W, D_, D_, tm * 128, tn * 128, smem, [&](f32x16 (&acc)[2][2], int mb, int nb, int r, int hi) __attribute__((always_inline)) {
#pragma unroll
      for (int mi = 0; mi < 2; ++mi) {
        const int row = mb + mi * 32 + r, b = row >> 11;
        const float* gt = mod + b * 12288 + 2 * 2048;
#pragma unroll
        for (int ni = 0; ni < 2; ++ni)
#pragma unroll
          for (int g = 0; g < 4; ++g) {
            const int col = nb + ni * 32 + hi * 4 + 8 * g;
            const float4 xv = *(const float4*)(X + (size_t)row * D_ + col), gv = *(const float4*)(gt + col);
            float4 o;
            o.x = xv.x + gv.x * acc[mi][ni][4 * g]; o.y = xv.y + gv.y * acc[mi][ni][4 * g + 1]; o.z = xv.z + gv.z * acc[mi][ni][4 * g + 2]; o.w = xv.w + gv.w * acc[mi][ni][4 * g + 3];
            *(float4*)(X1 + (size_t)row * D_ + col) = o;
          }
      }
    });
  }
}

DI void phase7(const Params& p, char* smem) {
  const u16* H2 = (const u16*)(p.ws + WS_H); const u16* W = (const u16*)(p.ws + WS_WQT); u16* PQ = (u16*)(p.ws + WS_P);
  for (int it = blockIdx.x; it < 64 * 16; it += gridDim.x) {
    const int tn = it / 64, tm = it % 64;
    gemm_tile<true>(H2, D_, W, D_, D_, tm * 128, tn * 128, smem, [&](f32x16 (&acc)[2][2], int mb, int nb, int r, int hi) __attribute__((always_inline)) {
#pragma unroll
      for (int mi = 0; mi < 2; ++mi)
#pragma unroll
        for (int ni = 0; ni < 2; ++ni)
#pragma unroll
          for (int g = 0; g < 4; ++g) {
            const int row = mb + mi * 32 + r, col = nb + ni * 32 + hi * 4 + 8 * g;
            *(uint2*)(PQ + (size_t)row * D_ + col) = make_uint2(pk2(acc[mi][ni][4 * g], acc[mi][ni][4 * g + 1]), pk2(acc[mi][ni][4 * g + 2], acc[mi][ni][4 * g + 3]));
          }
    });
  }
}

DI unsigned f2ord(float v) { unsigned u = __float_as_uint(v); return u ^ ((unsigned)((int)u >> 31) | 0x80000000u); }
#define TOPK_INSERT(keys, x) { _Pragma("unroll") for (int _j = 0; _j < 16; ++_j) { const unsigned _h = max(keys[_j], x); x = min(keys[_j], x); keys[_j] = _h; } }
DI void phase8(const Params& p, char* smem) {
  const u16* PQ = (const u16*)(p.ws + WS_P); const u16* SK = (const u16*)(p.ws + WS_SK);
  int* IDS = (int*)(p.ws + WS_IDS); float* GATE = (float*)(p.ws + WS_GATE);
  float* sc = (float*)(smem + 16);
  const int tid = threadIdx.x, lane = tid & 63, w = tid >> 6, r = lane & 31, hi = lane >> 5;
  for (int it = blockIdx.x; it < 128 * 8; it += gridDim.x) {
    const int h = it & 7, tile = it >> 3;
    const int pp = w >> 1, rh = w & 1;
    __syncthreads();
    {
      f32x16 acc[4];
#pragma unroll
      for (int nt = 0; nt < 4; ++nt)
#pragma unroll
        for (int i = 0; i < 16; ++i) acc[nt][i] = 0.f;
      const u16* ap = PQ + (size_t)(tile * 64 + rh * 32 + r) * D_ + h * 256 + pp * 128 + hi * 8;
      const u16* bp = SK + ((size_t)(h * 2 + pp) * 128 + r) * 128 + hi * 8;
#pragma unroll
      for (int ks = 0; ks < 8; ++ks) {
        const bf16x8 af = *(const bf16x8*)(ap + ks * 16);
#pragma unroll
        for (int nt = 0; nt < 4; ++nt) { const bf16x8 bf = *(const bf16x8*)(bp + nt * 32 * 128 + ks * 16); acc[nt] = MFMA(af, bf, acc[nt]); }
      }
#pragma unroll
      for (int nt = 0; nt < 4; ++nt)
#pragma unroll
        for (int i = 0; i < 16; ++i) sc[(pp * 64 + rh * 32 + hi * 4 + (i & 3) + 8 * (i >> 2)) * 129 + nt * 32 + r] = acc[nt][i];
    }
    __syncthreads();
    if (tid < 128) {
      float* row = sc + tid * 129;
      unsigned keys[16];
#pragma unroll
      for (int j = 0; j < 16; ++j) keys[j] = 0u;
#pragma unroll 4
      for (int n = 0; n < 128; ++n) {
        unsigned x = (f2ord(row[n]) & 0xFFFFFF80u) | (unsigned)(127 - n);
        TOPK_INSERT(keys, x);
      }
      float vals[16];
#pragma unroll
      for (int j = 0; j < 16; ++j) vals[j] = row[127 - (keys[j] & 127u)];
#pragma unroll
      for (int j = 0; j < 16; ++j) { row[j] = vals[j]; row[16 + j] = __int_as_float((int)(127 - (keys[j] & 127u))); }
    }
    __syncthreads();
    if (tid < 64) {
      const float* ra = sc + tid * 129; const float* rb = sc + (64 + tid) * 129;
      float a[16], bq[16];
#pragma unroll
      for (int j = 0; j < 16; ++j) { a[j] = ra[j]; bq[j] = rb[j]; }
      unsigned keys[16];
#pragma unroll
      for (int j = 0; j < 16; ++j) keys[j] = 0u;
#pragma unroll
      for (int i = 0; i < 16; ++i)
#pragma unroll
        for (int j = 0; j < 16; ++j)
          if ((i + 1) * (j + 1) <= 16) {
            unsigned x = (f2ord(a[i] + bq[j]) & 0xFFFFFF00u) | (unsigned)(255 - (i * 16 + j));
            TOPK_INSERT(keys, x);
          }
      float bv[16]; int ex[16];
      float mx = -1e30f;
#pragma unroll
      for (int q = 0; q < 16; ++q) {
        const int flat = 255 - (int)(keys[q] & 255u), i = flat >> 4, j = flat & 15;
        bv[q] = ra[i] + rb[j];
        ex[q] = __float_as_int(ra[16 + i]) * 128 + __float_as_int(rb[16 + j]);
        mx = fmaxf(mx, bv[q]);
      }
      float sum = 0.f;
#pragma unroll
      for (int q = 0; q < 16; ++q) { bv[q] = __expf(bv[q] - mx); sum += bv[q]; }
      const float inv = 1.f / sum;
      const size_t o = (size_t)(tile * 64 + tid) * 128 + h * 16;
#pragma unroll
      for (int q = 0; q < 16; q += 4) {
        *(int4*)(IDS + o + q) = make_int4(ex[q], ex[q + 1], ex[q + 2], ex[q + 3]);
        *(float4*)(GATE + o + q) = make_float4(bv[q] * inv, bv[q + 1] * inv, bv[q + 2] * inv, bv[q + 3] * inv);
      }
    }
  }
}

DI void phase9(const Params& p, char* smem) {
  const u16* H2 = (const u16*)(p.ws + WS_H); const u16* U = (const u16*)(p.ws + WS_U); const u16* V = (const u16*)(p.ws + WS_V);
  const int* IDS = (const int*)(p.ws + WS_IDS); const float* GATE = (const float*)(p.ws + WS_GATE);
  const float* X1 = (const float*)(p.ws + WS_X1); const float* mod = (const float*)(p.ws + WS_MOD); const float* gfin = p.in[19];
  const int lane = threadIdx.x & 63, w = threadIdx.x >> 6;
  float* aw = (float*)(smem + 16) + w * 128;
  const int b5 = (lane >> 5) & 1, b4 = (lane >> 4) & 1;
  for (int tok0 = blockIdx.x * 4 + w; tok0 < T_; tok0 += gridDim.x * 4) {
    const int tok = __builtin_amdgcn_readfirstlane(tok0);
    uint4 hq[4];
#pragma unroll
    for (int j = 0; j < 4; ++j) hq[j] = *(const uint4*)(H2 + (size_t)tok * D_ + j * 512 + lane * 8);
    const int* ids = IDS + (size_t)tok * 128;
    for (int n0 = 0; n0 < 128; n0 += 4) {
      float ps[4];
      uint4 uu[4][4];
#pragma unroll
      for (int e = 0; e < 4; ++e) {
        const int ex = ids[n0 + e];
#pragma unroll
        for (int j = 0; j < 4; ++j) uu[e][j] = *(const uint4*)(U + (size_t)ex * D_ + j * 512 + lane * 8);
      }
#pragma unroll
      for (int e = 0; e < 4; ++e) {
        float s = 0.f;
#pragma unroll
        for (int j = 0; j < 4; ++j) { s = dot2(hq[j].x, uu[e][j].x, s); s = dot2(hq[j].y, uu[e][j].y, s); s = dot2(hq[j].z, uu[e][j].z, s); s = dot2(hq[j].w, uu[e][j].w, s); }
        ps[e] = s;
      }
      const float k0 = b5 ? ps[2] : ps[0], s0 = b5 ? ps[0] : ps[2];
      const float k1 = b5 ? ps[3] : ps[1], s1 = b5 ? ps[1] : ps[3];
      const float r0 = k0 + __shfl_xor(s0, 32), r1 = k1 + __shfl_xor(s1, 32);
      float rr = (b4 ? r1 : r0) + __shfl_xor(b4 ? r0 : r1, 16);
      rr += __shfl_xor(rr, 8); rr += __shfl_xor(rr, 4); rr += __shfl_xor(rr, 2); rr += __shfl_xor(rr, 1);
      if ((lane & 15) == 0) aw[n0 + 2 * b5 + b4] = rr;
    }
    asm volatile("s_waitcnt lgkmcnt(0)" ::: "memory");
    __builtin_amdgcn_wave_barrier();
#pragma unroll
    for (int q = 0; q < 2; ++q) {
      const int n = lane + 64 * q;
      const float a = aw[n];
      const float act = 0.5f * a * (1.f + erff(a * 0.70710678118654752f)) * GATE[(size_t)tok * 128 + n];
      aw[n] = act;
    }
    asm volatile("s_waitcnt lgkmcnt(0)" ::: "memory");
    __builtin_amdgcn_wave_barrier();
    float o[32];
#pragma unroll
    for (int i = 0; i < 32; ++i) o[i] = 0.f;
    for (int n0 = 0; n0 < 128; n0 += 4) {
      uint4 vv[4][4];
      const float4 a4 = *(const float4*)(aw + n0);
      const float av[4] = {a4.x, a4.y, a4.z, a4.w};
#pragma unroll
      for (int e = 0; e < 4; ++e) {
        const int ex = ids[n0 + e];
#pragma unroll
        for (int j = 0; j < 4; ++j) vv[e][j] = *(const uint4*)(V + (size_t)ex * D_ + j * 512 + lane * 8);
      }
#pragma unroll
      for (int e = 0; e < 4; ++e)
#pragma unroll
        for (int j = 0; j < 4; ++j) {
          const float a = av[e];
          o[j * 8 + 0] += a * bflo(vv[e][j].x); o[j * 8 + 1] += a * bfhi(vv[e][j].x);
          o[j * 8 + 2] += a * bflo(vv[e][j].y); o[j * 8 + 3] += a * bfhi(vv[e][j].y);
          o[j * 8 + 4] += a * bflo(vv[e][j].z); o[j * 8 + 5] += a * bfhi(vv[e][j].z);
          o[j * 8 + 6] += a * bflo(vv[e][j].w); o[j * 8 + 7] += a * bfhi(vv[e][j].w);
        }
    }
    const int b = tok >> 11;
    const float* gt = mod + b * 12288 + 5 * 2048;
    float ss = 0.f;
#pragma unroll
    for (int j = 0; j < 4; ++j)
#pragma unroll
      for (int q = 0; q < 2; ++q) {
        const int d = j * 512 + lane * 8 + q * 4;
        const float4 xv = *(const float4*)(X1 + (size_t)tok * D_ + d), gv = *(const float4*)(gt + d);
        float* oo = o + j * 8 + q * 4;
        oo[0] = xv.x + gv.x * oo[0]; oo[1] = xv.y + gv.y * oo[1]; oo[2] = xv.z + gv.z * oo[2]; oo[3] = xv.w + gv.w * oo[3];
        ss += oo[0] * oo[0] + oo[1] * oo[1] + oo[2] * oo[2] + oo[3] * oo[3];
      }
    ss = wave_sum(ss);
    const float rstd = rsqrtf(ss * (1.f / D_) + EPS);
#pragma unroll
    for (int j = 0; j < 4; ++j)
#pragma unroll
      for (int q = 0; q < 2; ++q) {
        const int d = j * 512 + lane * 8 + q * 4;
        const float4 gv = *(const float4*)(gfin + d);
        const float* oo = o + j * 8 + q * 4;
        *(float4*)(p.out + (size_t)tok * D_ + d) = make_float4(oo[0] * rstd * gv.x, oo[1] * rstd * gv.y, oo[2] * rstd * gv.z, oo[3] * rstd * gv.w);
      }
    asm volatile("s_waitcnt lgkmcnt(0)" ::: "memory");
    __builtin_amdgcn_wave_barrier();
  }
}

__global__ void __launch_bounds__(256, 2) mega(Params p) {
  extern __shared__ __attribute__((aligned(16))) char smem[];
  XcdBarrier xb;
  const bool multi = (p.ph_hi - p.ph_lo) > 1;
  if (multi) {
    if (threadIdx.x == 0) *(uint4*)smem = make_uint4(0u, 0u, 0u, 0u);
    __syncthreads();
    xb = xcd_barrier_post((unsigned*)(p.ws + WS_BAR), (volatile LAS unsigned*)smem);
  }
#ifndef PHMASK
#define PHMASK 0x3ff
#endif
#define RUN_PHASE(n, call) if (p.ph_lo <= (n) && (n) < p.ph_hi) { \
    if ((n) > p.ph_lo) { if ((n) == p.ph_lo + 1 && p.coop) cg::this_grid().sync(); else xcd_barrier(xb); } \
    if (PHMASK & (1 << (n))) { call; } }
  RUN_PHASE(0, phase0(p, smem))
  RUN_PHASE(1, norm_rows(p.in[0], p.in[4], (const float*)(p.ws + WS_MOD), 0, (u16*)(p.ws + WS_H)))
  RUN_PHASE(2, phase2(p, smem))
  RUN_PHASE(3, phase3(p, smem))
  RUN_PHASE(4, phase4(p, smem))
  RUN_PHASE(5, phase5(p, smem))
  RUN_PHASE(6, norm_rows((const float*)(p.ws + WS_X1), p.in[14], (const float*)(p.ws + WS_MOD), 3, (u16*)(p.ws + WS_H)))
  RUN_PHASE(7, phase7(p, smem))
  RUN_PHASE(8, phase8(p, smem))
  RUN_PHASE(9, phase9(p, smem))
}

extern "C" void kernel_launch(void* const* d_in, const int* in_sizes, int n_in, void* d_out, int out_size, void* d_ws, size_t ws_size, hipStream_t stream) {
  static int grid = 0;
  if (grid == 0) {
    if (n_in != 20 || ws_size < WS_END) { fprintf(stderr, "kernel_launch: unexpected n_in %d / ws_size %zu (need %zu)\n", n_in, ws_size, (size_t)WS_END); grid = -1; return; }
    int dev = 0, cus = 0, per_cu = 0;
    hipGetDevice(&dev);
    hipDeviceGetAttribute(&cus, hipDeviceAttributeMultiprocessorCount, dev);
    hipFuncSetAttribute((const void*)mega, hipFuncAttributeMaxDynamicSharedMemorySize, LDS_BYTES);
    hipOccupancyMaxActiveBlocksPerMultiprocessor(&per_cu, (const void*)mega, 256, LDS_BYTES);
    if (per_cu < 1) { fprintf(stderr, "kernel_launch: occupancy query says %d\n", per_cu); per_cu = 1; }
    if (per_cu > 2) per_cu = 2;
    grid = cus * per_cu;
    fprintf(stderr, "kernel_launch: grid %d (%d per CU)\n", grid, per_cu);
  }
  if (grid < 0) return;
  Params p{};
  for (int i = 0; i < 20; ++i) p.in[i] = (const float*)d_in[i];
  p.out = (float*)d_out; p.ws = (char*)d_ws;
#if N_LAUNCH_PER_PHASE
  p.coop = 0;
  for (int ph = 0; ph < NPH; ++ph) {
    p.ph_lo = ph; p.ph_hi = ph + 1;
    hipLaunchKernelGGL(mega, dim3(grid), dim3(256), LDS_BYTES, stream, p);
  }
#else
  hipMemsetAsync((char*)d_ws + WS_BAR, 0, XCD_BAR_WORDS * 4, stream);
  p.coop = 1; p.ph_lo = 0; p.ph_hi = NPH;
  void* args[] = {&p};
  hipError_t e = hipLaunchCooperativeKernel((const void*)mega, dim3(grid), dim3(256), args, LDS_BYTES, stream);
  if (e != hipSuccess) fprintf(stderr, "cooperative launch failed: %s (grid %d)\n", hipGetErrorString(e), grid);
#endif
}
```

```cpp
#include <hip/hip_runtime.h>
#include <hip/hip_cooperative_groups.h>
#include <cstdio>
#include <cstdint>
namespace cg = cooperative_groups;

#ifndef N_LAUNCH_PER_PHASE
#define N_LAUNCH_PER_PHASE 0
#endif

#define DI __device__ __forceinline__
typedef unsigned short u16;
typedef __attribute__((ext_vector_type(8))) short bf16x8;
typedef __attribute__((ext_vector_type(16))) float f32x16;
typedef __attribute__((ext_vector_type(2))) __bf16 bf2_t;
typedef __attribute__((ext_vector_type(2))) float f2_t;
typedef __attribute__((ext_vector_type(4))) unsigned u32x4;
typedef __attribute__((ext_vector_type(2))) unsigned u32x2;
#define MFMA(a, b, c) __builtin_amdgcn_mfma_f32_32x32x16_bf16((a), (b), (c), 0, 0, 0)

constexpr int T_ = 8192, D_ = 2048, S_ = 2048;
constexpr int INC = 4160;
constexpr float EPS = 1e-6f;
constexpr int NPH = 10;

constexpr size_t al256(size_t x) { return (x + 255) & ~(size_t)255; }
constexpr size_t WS_BAR = 0;
constexpr size_t WS_MOD = 16384;
constexpr size_t WS_ROPE = WS_MOD + al256(4 * 12288 * 4);
constexpr size_t WS_WINT = WS_ROPE + al256(2048 * 32 * 8);
constexpr size_t WS_WUQT = WS_WINT + al256((size_t)4224 * 2048 * 2);
constexpr size_t WS_WUKVT = WS_WUQT + al256((size_t)1536 * 512 * 2);
constexpr size_t WS_WOUTT = WS_WUKVT + al256((size_t)2048 * 512 * 2);
constexpr size_t WS_WQT = WS_WOUTT + al256((size_t)2048 * 2048 * 2);
constexpr size_t WS_SK = WS_WQT + al256((size_t)2048 * 2048 * 2);
constexpr size_t WS_U = WS_SK + al256((size_t)262144 * 2);
constexpr size_t WS_V = WS_U + al256((size_t)16384 * 2048 * 2);
constexpr size_t WS_H = WS_V + al256((size_t)16384 * 2048 * 2);
constexpr size_t WS_P = WS_H + al256((size_t)T_ * D_ * 2);
constexpr size_t WS_Q = WS_P + al256((size_t)T_ * INC * 2);
constexpr size_t WS_K = WS_Q + al256((size_t)T_ * 1536 * 2);
constexpr size_t WS_VT = WS_K + al256((size_t)T_ * 1536 * 2);
constexpr size_t WS_MG = WS_VT + al256((size_t)T_ * 1024 * 2);
constexpr size_t WS_X1 = WS_MG + al256((size_t)T_ * D_ * 2);
constexpr size_t WS_IDS = WS_X1 + al256((size_t)T_ * D_ * 4);
constexpr size_t WS_GATE = WS_IDS + al256((size_t)T_ * 128 * 4);
constexpr size_t WS_USC = WS_GATE + al256((size_t)T_ * 128 * 4);
constexpr size_t WS_VSC = WS_USC + 65536;
constexpr size_t WS_END = WS_VSC + 65536;

constexpr int LDS_BYTES = 16 + 2 * 2 * 128 * 72 * 2 + 512;

struct Params {
  const float* in[20];
  float* out;
  char* ws;
  int ph_lo, ph_hi, coop, pad;
};

DI unsigned pk2(float a, float b) { f2_t v = {a, b}; bf2_t r = __builtin_convertvector(v, bf2_t); return __builtin_bit_cast(unsigned, r); }
DI float bflo(unsigned u) { return __uint_as_float(u << 16); }
DI float bfhi(unsigned u) { return __uint_as_float(u & 0xffff0000u); }
DI float dot2(unsigned a, unsigned b, float c) { return __builtin_amdgcn_fdot2_f32_bf16(__builtin_bit_cast(bf2_t, a), __builtin_bit_cast(bf2_t, b), c, false); }
DI float wave_sum(float v) {
#pragma unroll
  for (int o = 32; o >= 1; o >>= 1) v += __shfl_xor(v, o);
  return v;
}

#define XB_TMO      128
#define XB_XCNT(j)  (256  + 64 * (j))
#define XB_XSUB(j)  (1280 + 64 * (j))
#define XB_XGEN(j)  (2304 + 64 * (j))
#define XB_TOP      3328
#define XB_TOPGEN   3392
#define XCD_BAR_WORDS 3456
#define XB_SPIN_CAP (1u << 22)
#define LAS __attribute__((address_space(3)))
DI unsigned xb_ld(unsigned* p) { return __hip_atomic_load(p, __ATOMIC_RELAXED, __HIP_MEMORY_SCOPE_AGENT); }
DI unsigned xb_add(unsigned* p, unsigned v) { return __hip_atomic_fetch_add(p, v, __ATOMIC_RELAXED, __HIP_MEMORY_SCOPE_AGENT); }
DI unsigned xb_xcc_id() { return (unsigned)__builtin_amdgcn_s_getreg((3 << 11) | 20) & 0xFu; }
#define XB_SPIN(cond, bar) do { unsigned _sp = 0; while (cond) { __builtin_amdgcn_s_sleep(1); \
    if ((++_sp & 255u) == 0u) { if (xb_ld(&(bar)[XB_TMO])) break; if (_sp > XB_SPIN_CAP) { atomicAdd(&(bar)[XB_TMO], 1u); break; } } } } while (0)
struct XcdBarrier { unsigned* bar; unsigned x; volatile LAS unsigned* st; };
DI XcdBarrier xcd_barrier_post(unsigned* bar, volatile LAS unsigned* st) {
  XcdBarrier b; b.bar = bar; b.x = xb_xcc_id(); b.st = st;
  if (threadIdx.x == 0) (void)xb_add(&bar[XB_XCNT(b.x)], 1u);
  return b;
}
DI void xcd_barrier_complete(unsigned* bar, unsigned x, unsigned& nloc, unsigned& nx) {
  const unsigned G = gridDim.x * gridDim.y * gridDim.z;
  unsigned sum, cnt, mine, sp = 0u;
  for (;;) {
    sum = 0u; cnt = 0u; mine = 0u;
#pragma unroll
    for (unsigned j = 0; j < 16; ++j) { const unsigned c = xb_ld(&bar[XB_XCNT(j)]); sum += c; cnt += (c > 0u) ? 1u : 0u; mine = (j == x) ? c : mine; }
    if (sum == G) break;
    __builtin_amdgcn_s_sleep(1);
    if ((++sp & 255u) == 0u) { if (xb_ld(&bar[XB_TMO])) break; if (sp > XB_SPIN_CAP) { atomicAdd(&bar[XB_TMO], 1u); break; } }
  }
  nloc = mine > 0u ? mine : 1u; nx = cnt > 0u ? cnt : 1u;
}
DI void xcd_barrier(const XcdBarrier& b) {
  asm volatile("s_waitcnt vmcnt(0)" ::: "memory");
  __syncthreads();
  if (threadIdx.x == 0) {
    unsigned* bar = b.bar;
    __builtin_amdgcn_s_waitcnt(0);
    unsigned nloc = b.st[0], nx = b.st[1];
    if (nloc == 0u) { xcd_barrier_complete(bar, b.x, nloc, nx); b.st[0] = nloc; b.st[1] = nx; }
    const unsigned old = xb_add(&bar[XB_XSUB(b.x)], 1u);
    const unsigned gen = old / nloc;
    if (old + 1u == (gen + 1u) * nloc) {
      __builtin_amdgcn_fence(__ATOMIC_RELEASE, "agent");
      asm volatile("s_waitcnt vmcnt(0)" ::: "memory");
      const unsigned og = xb_add(&bar[XB_TOP], 1u);
      const unsigned tg = og / nx;
      if (og + 1u == (tg + 1u) * nx) xb_add(&bar[XB_TOPGEN], 1u);
      else XB_SPIN(xb_ld(&bar[XB_TOPGEN]) == tg, bar);
      __builtin_amdgcn_fence(__ATOMIC_ACQUIRE, "agent");
      xb_add(&bar[XB_XGEN(b.x)], 1u);
      asm volatile("s_waitcnt vmcnt(0)" ::: "memory");
    } else {
      XB_SPIN(xb_ld(&bar[XB_XGEN(b.x)]) == gen, bar);
      __builtin_amdgcn_fence(__ATOMIC_ACQUIRE, "agent");
      asm volatile("s_waitcnt vmcnt(0)" ::: "memory");
    }
  }
  __syncthreads();
}

template <bool SWAP, class Epi>
DI void gemm_tile(const u16* __restrict__ A, int lda, const u16* __restrict__ Bt, int ldb, int K, int m0, int n0, char* smem, Epi&& epi) {
  u16* As = (u16*)(smem + 16);
  u16* Bs = As + 2 * 128 * 72;
  const int tid = threadIdx.x, lane = tid & 63, w = tid >> 6, wm = w >> 1, wn = w & 1;
  const int r = lane & 31, hi = lane >> 5;
  f32x16 acc[2][2];
#pragma unroll
  for (int a = 0; a < 2; ++a)
#pragma unroll
    for (int b = 0; b < 2; ++b)
#pragma unroll
      for (int i = 0; i < 16; ++i) acc[a][b][i] = 0.f;
  const int srow = tid >> 3, skc = tid & 7;
  const u16* ag = A + (size_t)(m0 + srow) * lda + skc * 8;
  const u16* bg = Bt + (size_t)(n0 + srow) * ldb + skc * 8;
  u32x4 ra[4], rb[4];
#pragma unroll
  for (int i = 0; i < 4; ++i) { ra[i] = *(const u32x4*)(ag + (size_t)i * 32 * lda); rb[i] = *(const u32x4*)(bg + (size_t)i * 32 * ldb); }
  __syncthreads();
#pragma unroll
  for (int i = 0; i < 4; ++i) { *(u32x4*)(As + (srow + 32 * i) * 72 + skc * 8) = ra[i]; *(u32x4*)(Bs + (srow + 32 * i) * 72 + skc * 8) = rb[i]; }
  __syncthreads();
  const int KT = K >> 6;
  for (int kt = 0; kt < KT; ++kt) {
    const int buf = kt & 1;
    if (kt + 1 < KT) {
      const int k0 = (kt + 1) << 6;
#pragma unroll
      for (int i = 0; i < 4; ++i) { ra[i] = *(const u32x4*)(ag + (size_t)i * 32 * lda + k0); rb[i] = *(const u32x4*)(bg + (size_t)i * 32 * ldb + k0); }
    }
    const u16* Asb = As + buf * 128 * 72 + (wm * 64 + r) * 72 + hi * 8;
    const u16* Bsb = Bs + buf * 128 * 72 + (wn * 64 + r) * 72 + hi * 8;
#pragma unroll
    for (int ks = 0; ks < 4; ++ks) {
      bf16x8 af[2], bfr[2];
      af[0] = *(const bf16x8*)(Asb + ks * 16);
      af[1] = *(const bf16x8*)(Asb + 32 * 72 + ks * 16);
      bfr[0] = *(const bf16x8*)(Bsb + ks * 16);
      bfr[1] = *(const bf16x8*)(Bsb + 32 * 72 + ks * 16);
#pragma unroll
      for (int mi = 0; mi < 2; ++mi)
#pragma unroll
        for (int ni = 0; ni < 2; ++ni) {
          if (SWAP) acc[mi][ni] = MFMA(bfr[ni], af[mi], acc[mi][ni]);
          else acc[mi][ni] = MFMA(af[mi], bfr[ni], acc[mi][ni]);
        }
    }
    if (kt + 1 < KT) {
      const int nb = buf ^ 1;
#pragma unroll
      for (int i = 0; i < 4; ++i) { *(u32x4*)(As + nb * 128 * 72 + (srow + 32 * i) * 72 + skc * 8) = ra[i]; *(u32x4*)(Bs + nb * 128 * 72 + (srow + 32 * i) * 72 + skc * 8) = rb[i]; }
    }
    __syncthreads();
  }
  epi(acc, m0 + wm * 64, n0 + wn * 64, r, hi);
}

DI void tile_rstd512(const u16* __restrict__ A, int lda, int m0, float* rs) {
  const int tid = threadIdx.x, row = tid >> 1, half = tid & 1;
  const uint4* p = (const uint4*)(A + (size_t)(m0 + row) * lda + half * 256);
  float ss = 0.f;
#pragma unroll 8
  for (int i = 0; i < 32; ++i) {
    uint4 v = p[i];
    ss = dot2(v.x, v.x, ss); ss = dot2(v.y, v.y, ss); ss = dot2(v.z, v.z, ss); ss = dot2(v.w, v.w, ss);
  }
  ss += __shfl_xor(ss, 1);
  if (half == 0) rs[row] = rsqrtf(ss * (1.f / 512.f) + EPS);
}

DI void transpose_item(const float* __restrict__ src, int N, int K, const float* __restrict__ scale, u16* __restrict__ dst, int tk, int tn, char* smem) {
  float* tile = (float*)(smem + 16);
  const int t = threadIdx.x;
  __syncthreads();
  {
    const int rr = t >> 4, c4 = (t & 15) * 4;
#pragma unroll
    for (int ps = 0; ps < 4; ++ps) {
      const int kk = ps * 16 + rr, k = tk * 64 + kk;
      float4 v = *(const float4*)(src + (size_t)k * N + tn * 64 + c4);
      const float sc = scale ? scale[k] : 1.f;
      tile[kk * 65 + c4 + 0] = v.x * sc; tile[kk * 65 + c4 + 1] = v.y * sc; tile[kk * 65 + c4 + 2] = v.z * sc; tile[kk * 65 + c4 + 3] = v.w * sc;
    }
  }
  __syncthreads();
  {
    const int n = t & 63, kc = (t >> 6) * 16;
    unsigned o[8];
#pragma unroll
    for (int j = 0; j < 8; ++j) o[j] = pk2(tile[(kc + 2 * j) * 65 + n], tile[(kc + 2 * j + 1) * 65 + n]);
    uint4* d = (uint4*)(dst + (size_t)(tn * 64 + n) * K + tk * 64 + kc);
    d[0] = make_uint4(o[0], o[1], o[2], o[3]); d[1] = make_uint4(o[4], o[5], o[6], o[7]);
  }
}

DI void convert_item(const float* __restrict__ src, u16* __restrict__ dst, size_t base) {
  const int t = threadIdx.x;
#pragma unroll
  for (int st = 0; st < 4; ++st) {
    const size_t idx = base + st * 2048 + t * 8;
    float4 a = *(const float4*)(src + idx), b = *(const float4*)(src + idx + 4);
    *(uint4*)(dst + idx) = make_uint4(pk2(a.x, a.y), pk2(a.z, a.w), pk2(b.x, b.y), pk2(b.z, b.w));
  }
}

DI float wave_max(float v) {
#pragma unroll
  for (int o = 32; o >= 1; o >>= 1) v = fmaxf(v, __shfl_xor(v, o));
  return v;
}
DI void fp8_rows_item(const float* __restrict__ src, unsigned char* __restrict__ dst, float* __restrict__ scales, int item) {
  const int lane = threadIdx.x & 63, w = threadIdx.x >> 6;
  const int row = item * 4 + w;
  const float* sr = src + (size_t)row * 2048 + lane * 16;
  float4 v[8];
  float amax = 0.f;
#pragma unroll
  for (int j = 0; j < 2; ++j)
#pragma unroll
    for (int q = 0; q < 4; ++q) {
      const float4 t = *(const float4*)(sr + 1024 * j + q * 4);
      v[j * 4 + q] = t;
      amax = fmaxf(amax, fmaxf(fmaxf(fabsf(t.x), fabsf(t.y)), fmaxf(fabsf(t.z), fabsf(t.w))));
    }
  amax = wave_max(amax);
  int e = 0;
  if (amax > 0.f) e = (int)floorf(log2f(384.f / amax));
  e = e < -100 ? -100 : (e > 100 ? 100 : e);
  const float sc = ldexpf(1.f, e);
  if (lane == 0) scales[row] = ldexpf(1.f, -e);
#pragma unroll
  for (int j = 0; j < 2; ++j) {
    unsigned d[4];
#pragma unroll
    for (int q = 0; q < 4; ++q) {
      const float4 t = v[j * 4 + q];
      unsigned pk = __builtin_amdgcn_cvt_pk_fp8_f32(t.x * sc, t.y * sc, 0, false);
      pk = __builtin_amdgcn_cvt_pk_fp8_f32(t.z * sc, t.w * sc, pk, true);
      d[q] = pk;
    }
    *(uint4*)(dst + (size_t)row * 2048 + 1024 * j + lane * 16) = make_uint4(d[0], d[1], d[2], d[3]);
  }
}

DI void mod_item(const Params& p, int cgi, char* smem) {
  float* cact = (float*)(smem + 16);
  float* red = cact + 4 * 2048;
  const int t = threadIdx.x;
  const float* c = p.in[1]; const float* W = p.in[2]; const float* bias = p.in[3];
  float* mod = (float*)(p.ws + WS_MOD);
  __syncthreads();
  for (int i = t; i < 4 * 2048; i += 256) { float v = c[i]; cact[i] = v / (1.f + __expf(-v)); }
  __syncthreads();
  const int cq = t & 15, kl = t >> 4, c0 = cgi * 64;
  float acc[4][4];
#pragma unroll
  for (int b = 0; b < 4; ++b)
#pragma unroll
    for (int j = 0; j < 4; ++j) acc[b][j] = 0.f;
  const float* wp = W + (size_t)kl * 12288 + c0 + cq * 4;
#pragma unroll 8
  for (int i = 0; i < 128; ++i) {
    const int k = kl + 16 * i;
    float4 w4 = *(const float4*)(wp + (size_t)i * 16 * 12288);
#pragma unroll
    for (int b = 0; b < 4; ++b) {
      const float a = cact[b * 2048 + k];
      acc[b][0] += a * w4.x; acc[b][1] += a * w4.y; acc[b][2] += a * w4.z; acc[b][3] += a * w4.w;
    }
  }
#pragma unroll
  for (int b = 0; b < 4; ++b)
#pragma unroll
    for (int j = 0; j < 4; ++j) red[(kl * 16 + cq) * 17 + b * 4 + j] = acc[b][j];
  __syncthreads();
  {
    const int b = t >> 6, col = t & 63, q = col >> 2, j = col & 3;
    float s = 0.f;
#pragma unroll
    for (int k2 = 0; k2 < 16; ++k2) s += red[(k2 * 16 + q) * 17 + b * 4 + j];
    mod[b * 12288 + c0 + col] = s + bias[c0 + col];
  }
}

constexpr int P0_MOD = 192;
constexpr int P0_TIN = 32 * 65, P0_TUQ = 8 * 24, P0_TUKV = 8 * 32, P0_TOUT = 32 * 32, P0_TWQ = 32 * 32;
constexpr int P0_SK = 32, P0_UV = 4096, P0_ROPE = 32;
DI void phase0(const Params& p, char* smem) {
  constexpr int o1 = P0_MOD, o2 = o1 + P0_TIN, o3 = o2 + P0_TUQ, o4 = o3 + P0_TUKV, o5 = o4 + P0_TOUT, o6 = o5 + P0_TWQ, o7 = o6 + P0_SK, o8 = o7 + P0_UV, o9 = o8 + P0_UV, o10 = o9 + P0_ROPE;
  for (int it = blockIdx.x; it < o10; it += gridDim.x) {
    if (it < o1) mod_item(p, it, smem);
    else if (it < o2) { int j = it - o1; transpose_item(p.in[5], INC, 2048, nullptr, (u16*)(p.ws + WS_WINT), j / 65, j % 65, smem); }
    else if (it < o3) { int j = it - o2; transpose_item(p.in[8], 1536, 512, p.in[7], (u16*)(p.ws + WS_WUQT), j / 24, j % 24, smem); }
    else if (it < o4) { int j = it - o3; transpose_item(p.in[10], 2048, 512, p.in[9], (u16*)(p.ws + WS_WUKVT), j / 32, j % 32, smem); }
    else if (it < o5) { int j = it - o4; int tk = j / 32; transpose_item(p.in[13], 2048, 2048, tk < 16 ? p.in[11] : p.in[12] - 1024, (u16*)(p.ws + WS_WOUTT), tk, j % 32, smem); }
    else if (it < o6) { int j = it - o5; transpose_item(p.in[15], 2048, 2048, nullptr, (u16*)(p.ws + WS_WQT), j / 32, j % 32, smem); }
    else if (it < o7) convert_item(p.in[16], (u16*)(p.ws + WS_SK), (size_t)(it - o6) * 8192);
    else if (it < o8) fp8_rows_item(p.in[17], (unsigned char*)(p.ws + WS_U), (float*)(p.ws + WS_USC), it - o7);
    else if (it < o9) fp8_rows_item(p.in[18], (unsigned char*)(p.ws + WS_V), (float*)(p.ws + WS_VSC), it - o8);
    else {
      float2* rope = (float2*)(p.ws + WS_ROPE);
      const int base = (it - o9) * 2048;
      for (int e = threadIdx.x; e < 2048; e += 256) {
        const int idx = base + e, pos = idx >> 5, j = idx & 31;
        const float inv = 1.0f / powf(10000.0f, (float)(2 * j) / 64.0f);
        const float ang = (float)pos * inv;
        rope[idx] = make_float2(cosf(ang), sinf(ang));
      }
    }
  }
}

DI void norm_rows(const float* __restrict__ X, const float* __restrict__ g, const float* __restrict__ mod, int sh_chunk, u16* __restrict__ out) {
  const int lane = threadIdx.x & 63, w = threadIdx.x >> 6;
  for (int row = blockIdx.x * 4 + w; row < T_; row += gridDim.x * 4) {
    const float* xr = X + (size_t)row * D_;
    float4 v[8];
    float ss = 0.f;
#pragma unroll
    for (int j = 0; j < 8; ++j) { v[j] = *(const float4*)(xr + j * 256 + lane * 4); ss += v[j].x * v[j].x + v[j].y * v[j].y + v[j].z * v[j].z + v[j].w * v[j].w; }
    ss = wave_sum(ss);
    const float rstd = rsqrtf(ss * (1.f / D_) + EPS);
    const int b = row >> 11;
    const float* sh = mod + b * 12288 + sh_chunk * 2048;
    const float* sc = sh + 2048;
#pragma unroll
    for (int j = 0; j < 8; ++j) {
      const int d = j * 256 + lane * 4;
      float4 gg = *(const float4*)(g + d), s4 = *(const float4*)(sc + d), h4 = *(const float4*)(sh + d);
      const float o0 = v[j].x * rstd * gg.x * (1.f + s4.x) + h4.x;
      const float o1 = v[j].y * rstd * gg.y * (1.f + s4.y) + h4.y;
      const float o2 = v[j].z * rstd * gg.z * (1.f + s4.z) + h4.z;
      const float o3 = v[j].w * rstd * gg.w * (1.f + s4.w) + h4.w;
      *(uint2*)(out + (size_t)row * D_ + d) = make_uint2(pk2(o0, o1), pk2(o2, o3));
    }
  }
}

DI void phase2(const Params& p, char* smem) {
  const u16* H = (const u16*)(p.ws + WS_H); const u16* W = (const u16*)(p.ws + WS_WINT); u16* P = (u16*)(p.ws + WS_P);
  for (int it = blockIdx.x; it < 64 * 33; it += gridDim.x) {
    const int tn = it / 64, tm = it % 64;
    gemm_tile<true>(H, D_, W, D_, D_, tm * 128, tn * 128, smem, [&](f32x16 (&acc)[2][2], int mb, int nb, int r, int hi) __attribute__((always_inline)) {
      if (nb >= INC) return;
#pragma unroll
      for (int mi = 0; mi < 2; ++mi)
#pragma unroll
        for (int ni = 0; ni < 2; ++ni)
#pragma unroll
          for (int g = 0; g < 4; ++g) {
            const int row = mb + mi * 32 + r, col = nb + ni * 32 + hi * 4 + 8 * g;
            *(uint2*)(P + (size_t)row * INC + col) = make_uint2(pk2(acc[mi][ni][4 * g], acc[mi][ni][4 * g + 1]), pk2(acc[mi][ni][4 * g + 2], acc[mi][ni][4 * g + 3]));
          }
    });
  }
}

DI void phase3(const Params& p, char* smem) {
  const u16* P = (const u16*)(p.ws + WS_P);
  u16* Q = (u16*)(p.ws + WS_Q); u16* Kb = (u16*)(p.ws + WS_K); u16* VT = (u16*)(p.ws + WS_VT); u16* MG = (u16*)(p.ws + WS_MG);
  const float2* rope = (const float2*)(p.ws + WS_ROPE);
  float* rs = (float*)(smem + 16 + 2 * 2 * 128 * 72 * 2);
  constexpr int NQ = 64 * 12, NKV = 64 * 16, NKR = 1024, NCV = 1024;
  const float qscale = 0.07216878364870322f * 1.4426950408889634f;
  for (int it = blockIdx.x; it < NQ + NKV + NKR + NCV; it += gridDim.x) {
    if (it < NQ) {
      const int tn = it / 64, tm = it % 64;
      __syncthreads();
      tile_rstd512(P + 3072, INC, tm * 128, rs);
      gemm_tile<true>(P + 3072, INC, (const u16*)(p.ws + WS_WUQT), 512, 512, tm * 128, tn * 128, smem, [&](f32x16 (&acc)[2][2], int mb, int nb, int r, int hi) __attribute__((always_inline)) {
        const bool is_rope = ((nb >> 6) % 3) == 2;
#pragma unroll
        for (int mi = 0; mi < 2; ++mi) {
          const int row = mb + mi * 32 + r;
          const float sc = rs[row - tm * 128] * qscale;
          const int pos = row & (S_ - 1);
#pragma unroll
          for (int g = 0; g < 4; ++g) {
            const int j = hi * 4 + 8 * g;
            float a0[4], a1[4];
#pragma unroll
            for (int e = 0; e < 4; ++e) { a0[e] = acc[mi][0][4 * g + e] * sc; a1[e] = acc[mi][1][4 * g + e] * sc; }
            if (is_rope) {
#pragma unroll
              for (int e = 0; e < 4; ++e) {
                const float2 cs = rope[pos * 32 + j + e];
                const float x1 = a0[e], x2 = a1[e];
                a0[e] = x1 * cs.x - x2 * cs.y; a1[e] = x2 * cs.x + x1 * cs.y;
              }
            }
            *(uint2*)(Q + (size_t)row * 1536 + nb + j) = make_uint2(pk2(a0[0], a0[1]), pk2(a0[2], a0[3]));
            *(uint2*)(Q + (size_t)row * 1536 + nb + 32 + j) = make_uint2(pk2(a1[0], a1[1]), pk2(a1[2], a1[3]));
          }
        }
      });
    } else if (it < NQ + NKV) {
      const int j2 = it - NQ, tn = j2 / 64, tm = j2 % 64;
      __syncthreads();
      tile_rstd512(P + 3584, INC, tm * 128, rs);
      const int head = tn >> 1;
      if ((tn & 1) == 0) {
        gemm_tile<true>(P + 3584, INC, (const u16*)(p.ws + WS_WUKVT), 512, 512, tm * 128, tn * 128, smem, [&](f32x16 (&acc)[2][2], int mb, int nb, int r, int hi) __attribute__((always_inline)) {
#pragma unroll
          for (int mi = 0; mi < 2; ++mi) {
            const int row = mb + mi * 32 + r;
            const float sc = rs[row - tm * 128];
#pragma unroll
            for (int ni = 0; ni < 2; ++ni)
#pragma unroll
              for (int g = 0; g < 4; ++g) {
                const int d = (nb & 127) + ni * 32 + hi * 4 + 8 * g;
                *(uint2*)(Kb + (size_t)row * 1536 + head * 192 + d) = make_uint2(pk2(acc[mi][ni][4 * g] * sc, acc[mi][ni][4 * g + 1] * sc), pk2(acc[mi][ni][4 * g + 2] * sc, acc[mi][ni][4 * g + 3] * sc));
              }
          }
        });
      } else {
        gemm_tile<false>(P + 3584, INC, (const u16*)(p.ws + WS_WUKVT), 512, 512, tm * 128, tn * 128, smem, [&](f32x16 (&acc)[2][2], int mb, int nb, int r, int hi) __attribute__((always_inline)) {
#pragma unroll
          for (int mi = 0; mi < 2; ++mi)
#pragma unroll
            for (int g = 0; g < 4; ++g) {
              const int row0 = mb + mi * 32 + hi * 4 + 8 * g;
              const float s0 = rs[row0 - tm * 128], s1 = rs[row0 + 1 - tm * 128], s2 = rs[row0 + 2 - tm * 128], s3 = rs[row0 + 3 - tm * 128];
              const int b = row0 >> 11, t = row0 & (S_ - 1);
#pragma unroll
              for (int ni = 0; ni < 2; ++ni) {
                const int d = (nb & 127) + ni * 32 + r;
                *(uint2*)(VT + ((size_t)((b * 8 + head) * 128 + d)) * S_ + t) = make_uint2(pk2(acc[mi][ni][4 * g] * s0, acc[mi][ni][4 * g + 1] * s1), pk2(acc[mi][ni][4 * g + 2] * s2, acc[mi][ni][4 * g + 3] * s3));
              }
            }
        });
      }
    } else if (it < NQ + NKV + NKR) {
      const int j2 = it - NQ - NKV;
      const int row = j2 * 8 + (threadIdx.x >> 5), j = threadIdx.x & 31, pos = row & (S_ - 1);
      const float x1 = bflo((unsigned)P[(size_t)row * INC + 4096 + j]), x2 = bflo((unsigned)P[(size_t)row * INC + 4096 + 32 + j]);
      const float2 cs = rope[pos * 32 + j];
      const float o1 = x1 * cs.x - x2 * cs.y, o2 = x2 * cs.x + x1 * cs.y;
      const u16 b1 = (u16)(pk2(o1, 0.f) & 0xffffu), b2 = (u16)(pk2(o2, 0.f) & 0xffffu);
#pragma unroll
      for (int h = 0; h < 8; ++h) { Kb[(size_t)row * 1536 + h * 192 + 128 + j] = b1; Kb[(size_t)row * 1536 + h * 192 + 160 + j] = b2; }
    } else {
      const int j2 = it - NQ - NKV - NKR;
      const int wi = j2 * 4 + (threadIdx.x >> 6), lane = threadIdx.x & 63;
      const int g = wi & 7, run = wi >> 3;
      const int row0 = run * 16, t0 = row0 & (S_ - 1);
      const int ch = g * 128 + lane * 2;
      const float* cw = p.in[6];
      const float w00 = cw[ch], w01 = cw[ch + 1], w10 = cw[1024 + ch], w11 = cw[1024 + ch + 1], w20 = cw[2048 + ch], w21 = cw[2048 + ch + 1];
      float zm1a = 0.f, zm1b = 0.f, zm2a = 0.f, zm2b = 0.f;
      if (t0 > 0) {
        const unsigned c1 = *(const unsigned*)(P + (size_t)(row0 - 1) * INC + 1024 + ch), h1 = *(const unsigned*)(P + (size_t)(row0 - 1) * INC + 2048 + ch);
        const unsigned c2 = *(const unsigned*)(P + (size_t)(row0 - 2) * INC + 1024 + ch), h2 = *(const unsigned*)(P + (size_t)(row0 - 2) * INC + 2048 + ch);
        zm1a = bflo(c1) * bflo(h1); zm1b = bfhi(c1) * bfhi(h1); zm2a = bflo(c2) * bflo(h2); zm2b = bfhi(c2) * bfhi(h2);
      }
#pragma unroll 4
      for (int tt = 0; tt < 16; ++tt) {
        const size_t ro = (size_t)(row0 + tt) * INC;
        const unsigned bb = *(const unsigned*)(P + ro + ch), cc = *(const unsigned*)(P + ro + 1024 + ch), hh = *(const unsigned*)(P + ro + 2048 + ch);
        const float za = bflo(cc) * bflo(hh), zb = bfhi(cc) * bfhi(hh);
        const float ya = bflo(bb) * (w00 * zm2a + w10 * zm1a + w20 * za), yb = bfhi(bb) * (w01 * zm2b + w11 * zm1b + w21 * zb);
        zm2a = zm1a; zm2b = zm1b; zm1a = za; zm1b = zb;
        const float ss = wave_sum(ya * ya + yb * yb);
        const float rstd = rsqrtf(ss * (1.f / 128.f) + EPS);
        *(unsigned*)(MG + (size_t)(row0 + tt) * D_ + ch) = pk2(ya * rstd, yb * rstd);
      }
    }
  }
}

DI void phase4(const Params& p, char* smem) {
  const u16* Q = (const u16*)(p.ws + WS_Q); const u16* Kb = (const u16*)(p.ws + WS_K); const u16* VT = (const u16*)(p.ws + WS_VT);
  u16* MG = (u16*)(p.ws + WS_MG);
  u16* Ks = (u16*)(smem + 16);
  u16* Vs = Ks + 64 * 200;
  float* mrg = (float*)(smem + 16);
  const int tid = threadIdx.x, lane = tid & 63, w = tid >> 6, qh = w & 1, kh = w >> 1, r = lane & 31, hi = lane >> 5;
  for (int it = blockIdx.x; it < 512; it += gridDim.x) {
    const int pi = it & 15, h = (it >> 4) & 7, b = it >> 7;
    for (int sub = 0; sub < 2; ++sub) {
      const int c = sub ? (31 - pi) : pi;
      const size_t qrow = (size_t)b * S_ + c * 64 + qh * 32 + r;
      bf16x8 qf[12];
#pragma unroll
      for (int ks = 0; ks < 12; ++ks) qf[ks] = *(const bf16x8*)(Q + qrow * 1536 + h * 192 + ks * 16 + hi * 8);
      f32x16 O[4];
#pragma unroll
      for (int dt = 0; dt < 4; ++dt)
#pragma unroll
        for (int i = 0; i < 16; ++i) O[dt][i] = 0.f;
      float m = -1e30f, l = 0.f;
      u32x4 kr[6]; u32x4 vr[4];
      const u16* kg = Kb + ((size_t)b * S_ + (tid >> 2)) * 1536 + h * 192 + (tid & 3) * 8;
      const u16* vg = VT + ((size_t)((b * 8 + h) * 128 + (tid >> 1))) * S_ + (tid & 1) * 8;
      u16* ksw = Ks + (tid >> 2) * 200 + (tid & 3) * 8;
      u16* vsw = Vs + (tid >> 1) * 68 + (tid & 1) * 8;
      auto load_tile = [&]() __attribute__((always_inline)) {
#pragma unroll
        for (int i = 0; i < 6; ++i) kr[i] = *(const u32x4*)(kg + i * 32);
#pragma unroll
        for (int i = 0; i < 4; ++i) vr[i] = *(const u32x4*)(vg + i * 16);
        kg += 64 * 1536; vg += 64;
      };
      load_tile();
      for (int kt = 0; kt <= c; ++kt) {
        __syncthreads();
#pragma unroll
        for (int i = 0; i < 6; ++i) *(u32x4*)(ksw + i * 32) = kr[i];
#pragma unroll
        for (int i = 0; i < 4; ++i) { u32x2 lo2 = {vr[i][0], vr[i][1]}, hi2 = {vr[i][2], vr[i][3]}; *(u32x2*)(vsw + i * 16) = lo2; *(u32x2*)(vsw + i * 16 + 4) = hi2; }
        __syncthreads();
        if (kt < c) load_tile();
        f32x16 s;
#pragma unroll
        for (int i = 0; i < 16; ++i) s[i] = 0.f;
        const u16* kp = Ks + (kh * 32 + r) * 200 + hi * 8;
#pragma unroll
        for (int ks = 0; ks < 12; ++ks) { bf16x8 kf = *(const bf16x8*)(kp + ks * 16); s = MFMA(kf, qf[ks], s); }
        float mx = s[0];
#pragma unroll
        for (int i = 1; i < 16; ++i) mx = fmaxf(mx, s[i]);
        mx = fmaxf(mx, __shfl_xor(mx, 32));
        const float mn = fmaxf(m, mx);
        const float alpha = exp2f(m - mn);
        m = mn;
        float rsum = 0.f;
#pragma unroll
        for (int i = 0; i < 16; ++i) { s[i] = exp2f(s[i] - mn); rsum += s[i]; }
        l = l * alpha + rsum;
#pragma unroll
        for (int dt = 0; dt < 4; ++dt)
#pragma unroll
          for (int i = 0; i < 16; ++i) O[dt][i] *= alpha;
#pragma unroll
        for (int st = 0; st < 2; ++st) {
          uint4 pu = make_uint4(pk2(s[8 * st], s[8 * st + 1]), pk2(s[8 * st + 2], s[8 * st + 3]), pk2(s[8 * st + 4], s[8 * st + 5]), pk2(s[8 * st + 6], s[8 * st + 7]));
          const bf16x8 pf = __builtin_bit_cast(bf16x8, pu);
#pragma unroll
          for (int dt = 0; dt < 4; ++dt) {
            const u16* vp = Vs + (dt * 32 + r) * 68 + kh * 32 + 16 * st + 4 * hi;
            uint2 v0 = *(const uint2*)vp, v1 = *(const uint2*)(vp + 8);
            const bf16x8 vf = __builtin_bit_cast(bf16x8, make_uint4(v0.x, v0.y, v1.x, v1.y));
            O[dt] = MFMA(vf, pf, O[dt]);
          }
        }
      }
      l += __shfl_xor(l, 32);
      __syncthreads();
      float* mq = mrg + qh * 66 * 64;
      if (kh == 1) {
#pragma unroll
        for (int dt = 0; dt < 4; ++dt)
#pragma unroll
          for (int i = 0; i < 16; ++i) mq[(dt * 16 + i) * 64 + lane] = O[dt][i];
        mq[64 * 64 + lane] = m; mq[65 * 64 + lane] = l;
      }
      __syncthreads();
      if (kh == 0) {
        const float m1 = mq[64 * 64 + lane], l1 = mq[65 * 64 + lane];
        const float mt = fmaxf(m, m1), a0 = exp2f(m - mt), a1 = exp2f(m1 - mt);
        const float inv = 1.f / (l * a0 + l1 * a1);
        float ss = 0.f;
#pragma unroll
        for (int dt = 0; dt < 4; ++dt)
#pragma unroll
          for (int i = 0; i < 16; ++i) { const float o = (O[dt][i] * a0 + mq[(dt * 16 + i) * 64 + lane] * a1) * inv; O[dt][i] = o; ss += o * o; }
        ss += __shfl_xor(ss, 32);
        const float rstd = rsqrtf(ss * (1.f / 128.f) + EPS);
#pragma unroll
        for (int dt = 0; dt < 4; ++dt)
#pragma unroll
          for (int g = 0; g < 4; ++g) {
            const int d = dt * 32 + hi * 4 + 8 * g;
            *(uint2*)(MG + qrow * D_ + 1024 + h * 128 + d) = make_uint2(pk2(O[dt][4 * g] * rstd, O[dt][4 * g + 1] * rstd), pk2(O[dt][4 * g + 2] * rstd, O[dt][4 * g + 3] * rstd));
          }
      }
    }
  }
}

DI void phase5(const Params& p, char* smem) {
  const u16* MG = (const u16*)(p.ws + WS_MG); const u16* W = (const u16*)(p.ws + WS_WOUTT);
  const float* X = p.in[0]; const float* mod = (const float*)(p.ws + WS_MOD); float* X1 = (float*)(p.ws + WS_X1);
  for (int it = blockIdx.x; it < 64 * 16; it += gridDim.x) {
    const int tn = it / 64, tm = it % 64;
    gemm_tile<true>(MG, D_, W, D_, D_, tm * 128, tn * 128, smem, [&](f32x16 (&acc)[2][2], int mb, int nb, int r, int hi) __attribute__((always_inline)) {
#pragma unroll
      for (int mi = 0; mi < 2; ++mi) {
        const int row = mb + mi * 32 + r, b = row >> 11;
        const float* gt = mod + b * 12288 + 2 * 2048;
#pragma unroll
        for (int ni = 0; ni < 2; ++ni)
#pragma unroll
          for (int g = 0; g < 4; ++g) {
            const int col = nb + ni * 32 + hi * 4 + 8 * g;
            const float4 xv = *(const float4*)(X + (size_t)row * D_ + col), gv = *(const float4*)(gt + col);
            float4 o;
            o.x = xv.x + gv.x * acc[mi][ni][4 * g]; o.y = xv.y + gv.y * acc[mi][ni][4 * g + 1]; o.z = xv.z + gv.z * acc[mi][ni][4 * g + 2]; o.w = xv.w + gv.w * acc[mi][ni][4 * g + 3];
            *(float4*)(X1 + (size_t)row * D_ + col) = o;
          }
      }
    });
  }
}

DI void phase7(const Params& p, char* smem) {
  const u16* H2 = (const u16*)(p.ws + WS_H); const u16* W = (const u16*)(p.ws + WS_WQT); u16* PQ = (u16*)(p.ws + WS_P);
  for (int it = blockIdx.x; it < 64 * 16; it += gridDim.x) {
    const int tn = it / 64, tm = it % 64;
    gemm_tile<true>(H2, D_, W, D_, D_, tm * 128, tn * 128, smem, [&](f32x16 (&acc)[2][2], int mb, int nb, int r, int hi) __attribute__((always_inline)) {
#pragma unroll
      for (int mi = 0; mi < 2; ++mi)
#pragma unroll
        for (int ni = 0; ni < 2; ++ni)
#pragma unroll
          for (int g = 0; g < 4; ++g) {
            const int row = mb + mi * 32 + r, col = nb + ni * 32 + hi * 4 + 8 * g;
            *(uint2*)(PQ + (size_t)row * D_ + col) = make_uint2(pk2(acc[mi][ni][4 * g], acc[mi][ni][4 * g + 1]), pk2(acc[mi][ni][4 * g + 2], acc[mi][ni][4 * g + 3]));
          }
    });
  }
}

DI unsigned f2ord(float v) { unsigned u = __float_as_uint(v); return u ^ ((unsigned)((int)u >> 31) | 0x80000000u); }
#define TOPK_INSERT(keys, x) { _Pragma("unroll") for (int _j = 0; _j < 16; ++_j) { const unsigned _h = max(keys[_j], x); x = min(keys[_j], x); keys[_j] = _h; } }
DI void phase8(const Params& p, char* smem) {
  const u16* PQ = (const u16*)(p.ws + WS_P); const u16* SK = (const u16*)(p.ws + WS_SK);
  int* IDS = (int*)(p.ws + WS_IDS); float* GATE = (float*)(p.ws + WS_GATE);
  float* sc = (float*)(smem + 16);
  const int tid = threadIdx.x, lane = tid & 63, w = tid >> 6, r = lane & 31, hi = lane >> 5;
  for (int it = blockIdx.x; it < 128 * 8; it += gridDim.x) {
    const int h = it & 7, tile = it >> 3;
    const int pp = w >> 1, rh = w & 1;
    __syncthreads();
    {
      f32x16 acc[4];
#pragma unroll
      for (int nt = 0; nt < 4; ++nt)
#pragma unroll
        for (int i = 0; i < 16; ++i) acc[nt][i] = 0.f;
      const u16* ap = PQ + (size_t)(tile * 64 + rh * 32 + r) * D_ + h * 256 + pp * 128 + hi * 8;
      const u16* bp = SK + ((size_t)(h * 2 + pp) * 128 + r) * 128 + hi * 8;
#pragma unroll
      for (int ks = 0; ks < 8; ++ks) {
        const bf16x8 af = *(const bf16x8*)(ap + ks * 16);
#pragma unroll
        for (int nt = 0; nt < 4; ++nt) { const bf16x8 bf = *(const bf16x8*)(bp + nt * 32 * 128 + ks * 16); acc[nt] = MFMA(af, bf, acc[nt]); }
      }
#pragma unroll
      for (int nt = 0; nt < 4; ++nt)
#pragma unroll
        for (int i = 0; i < 16; ++i) sc[(pp * 64 + rh * 32 + hi * 4 + (i & 3) + 8 * (i >> 2)) * 129 + nt * 32 + r] = acc[nt][i];
    }
    __syncthreads();
    if (tid < 128) {
      float* row = sc + tid * 129;
      unsigned keys[16];
#pragma unroll
      for (int j = 0; j < 16; ++j) keys[j] = 0u;
#pragma unroll 4
      for (int n = 0; n < 128; ++n) {
        unsigned x = (f2ord(row[n]) & 0xFFFFFF80u) | (unsigned)(127 - n);
        TOPK_INSERT(keys, x);
      }
      float vals[16];
#pragma unroll
      for (int j = 0; j < 16; ++j) vals[j] = row[127 - (keys[j] & 127u)];
#pragma unroll
      for (int j = 0; j < 16; ++j) { row[j] = vals[j]; row[16 + j] = __int_as_float((int)(127 - (keys[j] & 127u))); }
    }
    __syncthreads();
    if (tid < 64) {
      const float* ra = sc + tid * 129; const float* rb = sc + (64 + tid) * 129;
      float a[16], bq[16];
#pragma unroll
      for (int j = 0; j < 16; ++j) { a[j] = ra[j]; bq[j] = rb[j]; }
      unsigned keys[16];
#pragma unroll
      for (int j = 0; j < 16; ++j) keys[j] = 0u;
#pragma unroll
      for (int i = 0; i < 16; ++i)
#pragma unroll
        for (int j = 0; j < 16; ++j)
          if ((i + 1) * (j + 1) <= 16) {
            unsigned x = (f2ord(a[i] + bq[j]) & 0xFFFFFF00u) | (unsigned)(255 - (i * 16 + j));
            TOPK_INSERT(keys, x);
          }
      float bv[16]; int ex[16];
      float mx = -1e30f;
#pragma unroll
      for (int q = 0; q < 16; ++q) {
        const int flat = 255 - (int)(keys[q] & 255u), i = flat >> 4, j = flat & 15;
        bv[q] = ra[i] + rb[j];
        ex[q] = __float_as_int(ra[16 + i]) * 128 + __float_as_int(rb[16 + j]);
        mx = fmaxf(mx, bv[q]);
      }
      float sum = 0.f;
#pragma unroll
      for (int q = 0; q < 16; ++q) { bv[q] = __expf(bv[q] - mx); sum += bv[q]; }
      const float inv = 1.f / sum;
      const size_t o = (size_t)(tile * 64 + tid) * 128 + h * 16;
#pragma unroll
      for (int q = 0; q < 16; q += 4) {
        *(int4*)(IDS + o + q) = make_int4(ex[q], ex[q + 1], ex[q + 2], ex[q + 3]);
        *(float4*)(GATE + o + q) = make_float4(bv[q] * inv, bv[q + 1] * inv, bv[q + 2] * inv, bv[q + 3] * inv);
      }
    }
  }
}

DI f2_t cvt8lo(unsigned w) { return __builtin_amdgcn_cvt_pk_f32_fp8(w, false); }
DI f2_t cvt8hi(unsigned w) { return __builtin_amdgcn_cvt_pk_f32_fp8(w, true); }
DI void phase9(const Params& p, char* smem) {
  const u16* H2 = (const u16*)(p.ws + WS_H); const unsigned char* U8 = (const unsigned char*)(p.ws + WS_U); const unsigned char* V8 = (const unsigned char*)(p.ws + WS_V);
  const float* USC = (const float*)(p.ws + WS_USC); const float* VSC = (const float*)(p.ws + WS_VSC);
  const int* IDS = (const int*)(p.ws + WS_IDS); const float* GATE = (const float*)(p.ws + WS_GATE);
  const float* X1 = (const float*)(p.ws + WS_X1); const float* mod = (const float*)(p.ws + WS_MOD); const float* gfin = p.in[19];
  const int lane = threadIdx.x & 63, w = threadIdx.x >> 6;
  float* aw = (float*)(smem + 16) + w * 128;
  const int b5 = (lane >> 5) & 1, b4 = (lane >> 4) & 1, b3 = (lane >> 3) & 1;
  for (int tok0 = blockIdx.x * 4 + w; tok0 < T_; tok0 += gridDim.x * 4) {
    const int tok = __builtin_amdgcn_readfirstlane(tok0);
    f2_t hp[16];
#pragma unroll
    for (int j = 0; j < 2; ++j)
#pragma unroll
      for (int q = 0; q < 2; ++q) {
        const uint4 hv = *(const uint4*)(H2 + (size_t)tok * D_ + 1024 * j + lane * 16 + q * 8);
        hp[j * 8 + q * 4 + 0] = f2_t{bflo(hv.x), bfhi(hv.x)}; hp[j * 8 + q * 4 + 1] = f2_t{bflo(hv.y), bfhi(hv.y)};
        hp[j * 8 + q * 4 + 2] = f2_t{bflo(hv.z), bfhi(hv.z)}; hp[j * 8 + q * 4 + 3] = f2_t{bflo(hv.w), bfhi(hv.w)};
      }
    const int idv[2] = {IDS[(size_t)tok * 128 + lane], IDS[(size_t)tok * 128 + 64 + lane]};
#pragma unroll
    for (int half = 0; half < 2; ++half) {
      for (int n0 = 0; n0 < 64; n0 += 8) {
        u32x4 uu[8][2];
#pragma unroll
        for (int e = 0; e < 8; ++e) {
          const int ex = __builtin_amdgcn_readlane(idv[half], n0 + e);
          const unsigned char* rp = U8 + (size_t)ex * 2048 + lane * 16;
          uu[e][0] = *(const u32x4*)rp; uu[e][1] = *(const u32x4*)(rp + 1024);
        }
        float ps[8];
#pragma unroll
        for (int e = 0; e < 8; ++e) {
          f2_t acc = {0.f, 0.f};
#pragma unroll
          for (int j = 0; j < 2; ++j)
#pragma unroll
            for (int d = 0; d < 4; ++d) { const unsigned ww = uu[e][j][d]; acc += cvt8lo(ww) * hp[j * 8 + d * 2]; acc += cvt8hi(ww) * hp[j * 8 + d * 2 + 1]; }
          ps[e] = acc.x + acc.y;
        }
        float q4[4], r2[2];
#pragma unroll
        for (int i = 0; i < 4; ++i) { const float keep = b5 ? ps[4 + i] : ps[i], send = b5 ? ps[i] : ps[4 + i]; q4[i] = keep + __shfl_xor(send, 32); }
#pragma unroll
        for (int i = 0; i < 2; ++i) { const float keep = b4 ? q4[2 + i] : q4[i], send = b4 ? q4[i] : q4[2 + i]; r2[i] = keep + __shfl_xor(send, 16); }
        float tt = (b3 ? r2[1] : r2[0]) + __shfl_xor(b3 ? r2[0] : r2[1], 8);
        tt += __shfl_xor(tt, 4); tt += __shfl_xor(tt, 2); tt += __shfl_xor(tt, 1);
        if ((lane & 7) == 0) aw[half * 64 + n0 + 4 * b5 + 2 * b4 + b3] = tt;
      }
    }
    asm volatile("s_waitcnt lgkmcnt(0)" ::: "memory");
    __builtin_amdgcn_wave_barrier();
#pragma unroll
    for (int q = 0; q < 2; ++q) {
      const int n = lane + 64 * q;
      const float a = aw[n] * USC[idv[q]];
      const float act = 0.5f * a * (1.f + erff(a * 0.70710678118654752f)) * GATE[(size_t)tok * 128 + n] * VSC[idv[q]];
      aw[n] = act;
    }
    asm volatile("s_waitcnt lgkmcnt(0)" ::: "memory");
    __builtin_amdgcn_wave_barrier();
    f2_t o2[16];
#pragma unroll
    for (int i = 0; i < 16; ++i) o2[i] = f2_t{0.f, 0.f};
#pragma unroll
    for (int half = 0; half < 2; ++half) {
      for (int n0 = 0; n0 < 64; n0 += 8) {
        u32x4 vv[8][2];
#pragma unroll
        for (int e = 0; e < 8; ++e) {
          const int ex = __builtin_amdgcn_readlane(idv[half], n0 + e);
          const unsigned char* rp = V8 + (size_t)ex * 2048 + lane * 16;
          vv[e][0] = *(const u32x4*)rp; vv[e][1] = *(const u32x4*)(rp + 1024);
        }
        const float4 a4 = *(const float4*)(aw + half * 64 + n0), a5 = *(const float4*)(aw + half * 64 + n0 + 4);
        const float av[8] = {a4.x, a4.y, a4.z, a4.w, a5.x, a5.y, a5.z, a5.w};
#pragma unroll
        for (int e = 0; e < 8; ++e) {
          const f2_t a2 = {av[e], av[e]};
#pragma unroll
          for (int j = 0; j < 2; ++j)
#pragma unroll
            for (int d = 0; d < 4; ++d) { const unsigned ww = vv[e][j][d]; o2[j * 8 + d * 2] += a2 * cvt8lo(ww); o2[j * 8 + d * 2 + 1] += a2 * cvt8hi(ww); }
        }
      }
    }
    const int b = tok >> 11;
    const float* gt = mod + b * 12288 + 5 * 2048;
    float ss = 0.f;
#pragma unroll
    for (int j = 0; j < 2; ++j)
#pragma unroll
      for (int q = 0; q < 4; ++q) {
        const int d = 1024 * j + lane * 16 + q * 4;
        const float4 xv = *(const float4*)(X1 + (size_t)tok * D_ + d), gv = *(const float4*)(gt + d);
        f2_t& oa = o2[j * 8 + q * 2]; f2_t& ob = o2[j * 8 + q * 2 + 1];
        oa.x = xv.x + gv.x * oa.x; oa.y = xv.y + gv.y * oa.y; ob.x = xv.z + gv.z * ob.x; ob.y = xv.w + gv.w * ob.y;
        ss += oa.x * oa.x + oa.y * oa.y + ob.x * ob.x + ob.y * ob.y;
      }
    ss = wave_sum(ss);
    const float rstd = rsqrtf(ss * (1.f / D_) + EPS);
#pragma unroll
    for (int j = 0; j < 2; ++j)
#pragma unroll
      for (int q = 0; q < 4; ++q) {
        const int d = 1024 * j + lane * 16 + q * 4;
        const float4 gv = *(const float4*)(gfin + d);
        const f2_t oa = o2[j * 8 + q * 2], ob = o2[j * 8 + q * 2 + 1];
        *(float4*)(p.out + (size_t)tok * D_ + d) = make_float4(oa.x * rstd * gv.x, oa.y * rstd * gv.y, ob.x * rstd * gv.z, ob.y * rstd * gv.w);
      }
    asm volatile("s_waitcnt lgkmcnt(0)" ::: "memory");
    __builtin_amdgcn_wave_barrier();
  }
}

__global__ void __launch_bounds__(256, 2) mega(Params p) {
  extern __shared__ __attribute__((aligned(16))) char smem[];
  XcdBarrier xb;
  const bool multi = (p.ph_hi - p.ph_lo) > 1;
  if (multi) {
    if (threadIdx.x == 0) *(uint4*)smem = make_uint4(0u, 0u, 0u, 0u);
    __syncthreads();
    xb = xcd_barrier_post((unsigned*)(p.ws + WS_BAR), (volatile LAS unsigned*)smem);
  }
#ifndef PHMASK
#define PHMASK 0x3ff
#endif
#ifndef REPMASK
#define REPMASK 0
#endif
#define RUN_PHASE(n, call) if (p.ph_lo <= (n) && (n) < p.ph_hi) { \
    if ((n) > p.ph_lo) { if ((n) == p.ph_lo + 1 && p.coop) cg::this_grid().sync(); else xcd_barrier(xb); } \
    if (PHMASK & (1 << (n))) { call; if (REPMASK & (1 << (n))) { __syncthreads(); call; } } }
  RUN_PHASE(0, phase0(p, smem))
  RUN_PHASE(1, norm_rows(p.in[0], p.in[4], (const float*)(p.ws + WS_MOD), 0, (u16*)(p.ws + WS_H)))
  RUN_PHASE(2, phase2(p, smem))
  RUN_PHASE(3, phase3(p, smem))
  RUN_PHASE(4, phase4(p, smem))
  RUN_PHASE(5, phase5(p, smem))
  RUN_PHASE(6, norm_rows((const float*)(p.ws + WS_X1), p.in[14], (const float*)(p.ws + WS_MOD), 3, (u16*)(p.ws + WS_H)))
  RUN_PHASE(7, phase7(p, smem))
  RUN_PHASE(8, phase8(p, smem))
  RUN_PHASE(9, phase9(p, smem))
}

extern "C" void kernel_launch(void* const* d_in, const int* in_sizes, int n_in, void* d_out, int out_size, void* d_ws, size_t ws_size, hipStream_t stream) {
  static int grid = 0;
  if (grid == 0) {
    if (n_in != 20 || ws_size < WS_END) { fprintf(stderr, "kernel_launch: unexpected n_in %d / ws_size %zu (need %zu)\n", n_in, ws_size, (size_t)WS_END); grid = -1; return; }
    int dev = 0, cus = 0, per_cu = 0;
    hipGetDevice(&dev);
    hipDeviceGetAttribute(&cus, hipDeviceAttributeMultiprocessorCount, dev);
    hipFuncSetAttribute((const void*)mega, hipFuncAttributeMaxDynamicSharedMemorySize, LDS_BYTES);
    hipOccupancyMaxActiveBlocksPerMultiprocessor(&per_cu, (const void*)mega, 256, LDS_BYTES);
    if (per_cu < 1) { fprintf(stderr, "kernel_launch: occupancy query says %d\n", per_cu); per_cu = 1; }
    if (per_cu > 2) per_cu = 2;
    grid = cus * per_cu;
    fprintf(stderr, "kernel_launch: grid %d (%d per CU)\n", grid, per_cu);
  }
  if (grid < 0) return;
  Params p{};
  for (int i = 0; i < 20; ++i) p.in[i] = (const float*)d_in[i];
  p.out = (float*)d_out; p.ws = (char*)d_ws;
#if N_LAUNCH_PER_PHASE
  p.coop = 0;
  for (int ph = 0; ph < NPH; ++ph) {
    p.ph_lo = ph; p.ph_hi = ph + 1;
    hipLaunchKernelGGL(mega, dim3(grid), dim3(256), LDS_BYTES, stream, p);
  }
#else
  hipMemsetAsync((char*)d_ws + WS_BAR, 0, XCD_BAR_WORDS * 4, stream);
  p.coop = 1; p.ph_lo = 0; p.ph_hi = NPH;
  void* args[] = {&p};
  hipError_t e = hipLaunchCooperativeKernel((const void*)mega, dim3(grid), dim3(256), args, LDS_BYTES, stream);
  if (e != hipSuccess) fprintf(stderr, "cooperative launch failed: %s (grid %d)\n", hipGetErrorString(e), grid);
#endif
}
```

```cpp
#include <hip/hip_runtime.h>
#include <cstdio>
#include <cstdint>

#ifndef N_LAUNCH_PER_PHASE
#define N_LAUNCH_PER_PHASE 0
#endif

#define DI __device__ __forceinline__
typedef unsigned short u16;
typedef __attribute__((ext_vector_type(8))) short bf16x8;
typedef __attribute__((ext_vector_type(16))) float f32x16;
typedef __attribute__((ext_vector_type(2))) __bf16 bf2_t;
typedef __attribute__((ext_vector_type(2))) float f2_t;
typedef __attribute__((ext_vector_type(4))) unsigned u32x4;
typedef __attribute__((ext_vector_type(2))) unsigned u32x2;
#define MFMA(a, b, c) __builtin_amdgcn_mfma_f32_32x32x16_bf16((a), (b), (c), 0, 0, 0)

constexpr int T_ = 8192, D_ = 2048, S_ = 2048;
constexpr int INC = 4160;
constexpr float EPS = 1e-6f;
constexpr int NPH = 10;

constexpr size_t al256(size_t x) { return (x + 255) & ~(size_t)255; }
constexpr size_t WS_BAR = 0;
constexpr size_t WS_MOD = 16384;
constexpr size_t WS_ROPE = WS_MOD + al256(4 * 12288 * 4);
constexpr size_t WS_WINT = WS_ROPE + al256(2048 * 32 * 8);
constexpr size_t WS_WUQT = WS_WINT + al256((size_t)4224 * 2048 * 2);
constexpr size_t WS_WUKVT = WS_WUQT + al256((size_t)1536 * 512 * 2);
constexpr size_t WS_WOUTT = WS_WUKVT + al256((size_t)2048 * 512 * 2);
constexpr size_t WS_WQT = WS_WOUTT + al256((size_t)2048 * 2048 * 2);
constexpr size_t WS_SK = WS_WQT + al256((size_t)2048 * 2048 * 2);
constexpr size_t WS_U = WS_SK + al256((size_t)262144 * 2);
constexpr size_t WS_V = WS_U + al256((size_t)16384 * 2048 * 2);
constexpr size_t WS_H = WS_V + al256((size_t)16384 * 2048 * 2);
constexpr size_t WS_P = WS_H + al256((size_t)T_ * D_ * 2);
constexpr size_t WS_Q = WS_P + al256((size_t)T_ * INC * 2);
constexpr size_t WS_K = WS_Q + al256((size_t)T_ * 1536 * 2);
constexpr size_t WS_VT = WS_K + al256((size_t)T_ * 1536 * 2);
constexpr size_t WS_MG = WS_VT + al256((size_t)T_ * 1024 * 2);
constexpr size_t WS_X1 = WS_MG + al256((size_t)T_ * D_ * 2);
constexpr size_t WS_IDS = WS_X1 + al256((size_t)T_ * D_ * 4);
constexpr size_t WS_GATE = WS_IDS + al256((size_t)T_ * 128 * 4);
constexpr size_t WS_USC = WS_GATE + al256((size_t)T_ * 128 * 4);
constexpr size_t WS_VSC = WS_USC + 65536;
constexpr size_t WS_MODP = WS_VSC + 65536;
constexpr size_t WS_END = WS_MODP + al256((size_t)4 * 4 * 12288 * 4);

constexpr int LDS_BYTES = 16 + 2 * 2 * 128 * 72 * 2 + 512;

struct Params {
  const float* in[20];
  float* out;
  char* ws;
  int ph_lo, ph_hi, coop, pad;
};

DI unsigned pk2(float a, float b) { f2_t v = {a, b}; bf2_t r = __builtin_convertvector(v, bf2_t); return __builtin_bit_cast(unsigned, r); }
DI float bflo(unsigned u) { return __uint_as_float(u << 16); }
DI float bfhi(unsigned u) { return __uint_as_float(u & 0xffff0000u); }
DI float dot2(unsigned a, unsigned b, float c) { return __builtin_amdgcn_fdot2_f32_bf16(__builtin_bit_cast(bf2_t, a), __builtin_bit_cast(bf2_t, b), c, false); }
DI float wave_sum(float v) {
#pragma unroll
  for (int o = 32; o >= 1; o >>= 1) v += __shfl_xor(v, o);
  return v;
}

#define XB_TMO      128
#define XB_XCNT(j)  (256  + 64 * (j))
#define XB_XSUB(j)  (1280 + 64 * (j))
#define XB_XGEN(j)  (2304 + 64 * (j))
#define XB_TOP      3328
#define XB_TOPGEN   3392
#define XCD_BAR_WORDS 3456
#define XB_SPIN_CAP (1u << 22)
#define LAS __attribute__((address_space(3)))
DI unsigned xb_ld(unsigned* p) { return __hip_atomic_load(p, __ATOMIC_RELAXED, __HIP_MEMORY_SCOPE_AGENT); }
DI unsigned xb_add(unsigned* p, unsigned v) { return __hip_atomic_fetch_add(p, v, __ATOMIC_RELAXED, __HIP_MEMORY_SCOPE_AGENT); }
DI unsigned xb_xcc_id() { return (unsigned)__builtin_amdgcn_s_getreg((3 << 11) | 20) & 0xFu; }
#define XB_SPIN(cond, bar) do { unsigned _sp = 0; while (cond) { __builtin_amdgcn_s_sleep(1); \
    if ((++_sp & 255u) == 0u) { if (xb_ld(&(bar)[XB_TMO])) break; if (_sp > XB_SPIN_CAP) { atomicAdd(&(bar)[XB_TMO], 1u); break; } } } } while (0)
struct XcdBarrier { unsigned* bar; unsigned x; volatile LAS unsigned* st; };
DI XcdBarrier xcd_barrier_post(unsigned* bar, volatile LAS unsigned* st) {
  XcdBarrier b; b.bar = bar; b.x = xb_xcc_id(); b.st = st;
  if (threadIdx.x == 0) (void)xb_add(&bar[XB_XCNT(b.x)], 1u);
  return b;
}
DI void xcd_barrier_complete(unsigned* bar, unsigned x, unsigned& nloc, unsigned& nx) {
  const unsigned G = gridDim.x * gridDim.y * gridDim.z;
  unsigned sum, cnt, mine, sp = 0u;
  for (;;) {
    sum = 0u; cnt = 0u; mine = 0u;
#pragma unroll
    for (unsigned j = 0; j < 16; ++j) { const unsigned c = xb_ld(&bar[XB_XCNT(j)]); sum += c; cnt += (c > 0u) ? 1u : 0u; mine = (j == x) ? c : mine; }
    if (sum == G) break;
    __builtin_amdgcn_s_sleep(1);
    if ((++sp & 255u) == 0u) { if (xb_ld(&bar[XB_TMO])) break; if (sp > XB_SPIN_CAP) { atomicAdd(&bar[XB_TMO], 1u); break; } }
  }
  nloc = mine > 0u ? mine : 1u; nx = cnt > 0u ? cnt : 1u;
}
DI void xcd_barrier(const XcdBarrier& b) {
  asm volatile("s_waitcnt vmcnt(0)" ::: "memory");
  __syncthreads();
  if (threadIdx.x == 0) {
    unsigned* bar = b.bar;
    __builtin_amdgcn_s_waitcnt(0);
    unsigned nloc = b.st[0], nx = b.st[1];
    if (nloc == 0u) { xcd_barrier_complete(bar, b.x, nloc, nx); b.st[0] = nloc; b.st[1] = nx; }
    const unsigned old = xb_add(&bar[XB_XSUB(b.x)], 1u);
    const unsigned gen = old / nloc;
    if (old + 1u == (gen + 1u) * nloc) {
      __builtin_amdgcn_fence(__ATOMIC_RELEASE, "agent");
      asm volatile("s_waitcnt vmcnt(0)" ::: "memory");
      const unsigned og = xb_add(&bar[XB_TOP], 1u);
      const unsigned tg = og / nx;
      if (og + 1u == (tg + 1u) * nx) xb_add(&bar[XB_TOPGEN], 1u);
      else XB_SPIN(xb_ld(&bar[XB_TOPGEN]) == tg, bar);
      __builtin_amdgcn_fence(__ATOMIC_ACQUIRE, "agent");
      xb_add(&bar[XB_XGEN(b.x)], 1u);
      asm volatile("s_waitcnt vmcnt(0)" ::: "memory");
    } else {
      XB_SPIN(xb_ld(&bar[XB_XGEN(b.x)]) == gen, bar);
      __builtin_amdgcn_fence(__ATOMIC_ACQUIRE, "agent");
      asm volatile("s_waitcnt vmcnt(0)" ::: "memory");
    }
  }
  __syncthreads();
}

template <bool SWAP, class Epi>
DI void gemm_tile(const u16* __restrict__ A, int lda, const u16* __restrict__ Bt, int ldb, int K, int m0, int n0, char* smem, Epi&& epi) {
  u16* As = (u16*)(smem + 16);
  u16* Bs = As + 2 * 128 * 72;
  const int tid = threadIdx.x, lane = tid & 63, w = tid >> 6, wm = w >> 1, wn = w & 1;
  const int r = lane & 31, hi = lane >> 5;
  f32x16 acc[2][2];
#pragma unroll
  for (int a = 0; a < 2; ++a)
#pragma unroll
    for (int b = 0; b < 2; ++b)
#pragma unroll
      for (int i = 0; i < 16; ++i) acc[a][b][i] = 0.f;
  const int srow = tid >> 3, skc = tid & 7;
  const u16* ag = A + (size_t)(m0 + srow) * lda + skc * 8;
  const u16* bg = Bt + (size_t)(n0 + srow) * ldb + skc * 8;
  u32x4 ra[4], rb[4];
#pragma unroll
  for (int i = 0; i < 4; ++i) { ra[i] = *(const u32x4*)(ag + (size_t)i * 32 * lda); rb[i] = *(const u32x4*)(bg + (size_t)i * 32 * ldb); }
  __syncthreads();
#pragma unroll
  for (int i = 0; i < 4; ++i) { *(u32x4*)(As + (srow + 32 * i) * 72 + skc * 8) = ra[i]; *(u32x4*)(Bs + (srow + 32 * i) * 72 + skc * 8) = rb[i]; }
  __syncthreads();
  const int KT = K >> 6;
  for (int kt = 0; kt < KT; ++kt) {
    const int buf = kt & 1;
    if (kt + 1 < KT) {
      const int k0 = (kt + 1) << 6;
#pragma unroll
      for (int i = 0; i < 4; ++i) { ra[i] = *(const u32x4*)(ag + (size_t)i * 32 * lda + k0); rb[i] = *(const u32x4*)(bg + (size_t)i * 32 * ldb + k0); }
    }
    const u16* Asb = As + buf * 128 * 72 + (wm * 64 + r) * 72 + hi * 8;
    const u16* Bsb = Bs + buf * 128 * 72 + (wn * 64 + r) * 72 + hi * 8;
#pragma unroll
    for (int ks = 0; ks < 4; ++ks) {
      bf16x8 af[2], bfr[2];
      af[0] = *(const bf16x8*)(Asb + ks * 16);
      af[1] = *(const bf16x8*)(Asb + 32 * 72 + ks * 16);
      bfr[0] = *(const bf16x8*)(Bsb + ks * 16);
      bfr[1] = *(const bf16x8*)(Bsb + 32 * 72 + ks * 16);
#pragma unroll
      for (int mi = 0; mi < 2; ++mi)
#pragma unroll
        for (int ni = 0; ni < 2; ++ni) {
          if (SWAP) acc[mi][ni] = MFMA(bfr[ni], af[mi], acc[mi][ni]);
          else acc[mi][ni] = MFMA(af[mi], bfr[ni], acc[mi][ni]);
        }
    }
    if (kt + 1 < KT) {
      const int nb = buf ^ 1;
#pragma unroll
      for (int i = 0; i < 4; ++i) { *(u32x4*)(As + nb * 128 * 72 + (srow + 32 * i) * 72 + skc * 8) = ra[i]; *(u32x4*)(Bs + nb * 128 * 72 + (srow + 32 * i) * 72 + skc * 8) = rb[i]; }
    }
    __syncthreads();
  }
  epi(acc, m0 + wm * 64, n0 + wn * 64, r, hi);
}

DI void tile_rstd512(const u16* __restrict__ A, int lda, int m0, float* rs) {
  const int tid = threadIdx.x, row = tid >> 1, half = tid & 1;
  const uint4* p = (const uint4*)(A + (size_t)(m0 + row) * lda + half * 256);
  float ss = 0.f;
#pragma unroll 8
  for (int i = 0; i < 32; ++i) {
    uint4 v = p[i];
    ss = dot2(v.x, v.x, ss); ss = dot2(v.y, v.y, ss); ss = dot2(v.z, v.z, ss); ss = dot2(v.w, v.w, ss);
  }
  ss += __shfl_xor(ss, 1);
  if (half == 0) rs[row] = rsqrtf(ss * (1.f / 512.f) + EPS);
}

DI void transpose_item(const float* __restrict__ src, int N, int K, const float* __restrict__ scale, u16* __restrict__ dst, int tk, int tn, char* smem) {
  float* tile = (float*)(smem + 16);
  const int t = threadIdx.x;
  __syncthreads();
  {
    const int rr = t >> 4, c4 = (t & 15) * 4;
#pragma unroll
    for (int ps = 0; ps < 4; ++ps) {
      const int kk = ps * 16 + rr, k = tk * 64 + kk;
      float4 v = *(const float4*)(src + (size_t)k * N + tn * 64 + c4);
      const float sc = scale ? scale[k] : 1.f;
      tile[kk * 65 + c4 + 0] = v.x * sc; tile[kk * 65 + c4 + 1] = v.y * sc; tile[kk * 65 + c4 + 2] = v.z * sc; tile[kk * 65 + c4 + 3] = v.w * sc;
    }
  }
  __syncthreads();
  {
    const int n = t & 63, kc = (t >> 6) * 16;
    unsigned o[8];
#pragma unroll
    for (int j = 0; j < 8; ++j) o[j] = pk2(tile[(kc + 2 * j) * 65 + n], tile[(kc + 2 * j + 1) * 65 + n]);
    uint4* d = (uint4*)(dst + (size_t)(tn * 64 + n) * K + tk * 64 + kc);
    d[0] = make_uint4(o[0], o[1], o[2], o[3]); d[1] = make_uint4(o[4], o[5], o[6], o[7]);
  }
}

DI void convert_item(const float* __restrict__ src, u16* __restrict__ dst, size_t base) {
  const int t = threadIdx.x;
#pragma unroll
  for (int st = 0; st < 4; ++st) {
    const size_t idx = base + st * 2048 + t * 8;
    float4 a = *(const float4*)(src + idx), b = *(const float4*)(src + idx + 4);
    *(uint4*)(dst + idx) = make_uint4(pk2(a.x, a.y), pk2(a.z, a.w), pk2(b.x, b.y), pk2(b.z, b.w));
  }
}

DI float wave_max(float v) {
#pragma unroll
  for (int o = 32; o >= 1; o >>= 1) v = fmaxf(v, __shfl_xor(v, o));
  return v;
}
DI void fp8_rows_item(const float* __restrict__ src, unsigned char* __restrict__ dst, float* __restrict__ scales, int item) {
  const int lane = threadIdx.x & 63, w = threadIdx.x >> 6;
  const int row = item * 4 + w;
  const float* sr = src + (size_t)row * 2048 + lane * 16;
  float4 v[8];
  float amax = 0.f;
#pragma unroll
  for (int j = 0; j < 2; ++j)
#pragma unroll
    for (int q = 0; q < 4; ++q) {
      const float4 t = *(const float4*)(sr + 1024 * j + q * 4);
      v[j * 4 + q] = t;
      amax = fmaxf(amax, fmaxf(fmaxf(fabsf(t.x), fabsf(t.y)), fmaxf(fabsf(t.z), fabsf(t.w))));
    }
  amax = wave_max(amax);
  int e = 0;
  if (amax > 0.f) e = (int)floorf(log2f(384.f / amax));
  e = e < -100 ? -100 : (e > 100 ? 100 : e);
  const float sc = ldexpf(1.f, e);
  if (lane == 0) scales[row] = ldexpf(1.f, -e);
#pragma unroll
  for (int j = 0; j < 2; ++j) {
    unsigned d[4];
#pragma unroll
    for (int q = 0; q < 4; ++q) {
      const float4 t = v[j * 4 + q];
      unsigned pk = __builtin_amdgcn_cvt_pk_fp8_f32(t.x * sc, t.y * sc, 0, false);
      pk = __builtin_amdgcn_cvt_pk_fp8_f32(t.z * sc, t.w * sc, pk, true);
      d[q] = pk;
    }
    *(uint4*)(dst + (size_t)row * 2048 + 1024 * j + lane * 16) = make_uint4(d[0], d[1], d[2], d[3]);
  }
}

DI void mod_item(const Params& p, int item, char* smem) {
  float* cact = (float*)(smem + 16);
  float* red = cact + 4 * 512;
  const int t = threadIdx.x;
  const int cgi = item % 192, ksp = item / 192, kbase = ksp * 512;
  const float* c = p.in[1]; const float* W = p.in[2];
  float* mod = (float*)(p.ws + WS_MODP);
  __syncthreads();
  for (int i = t; i < 4 * 512; i += 256) { float v = c[(i >> 9) * 2048 + kbase + (i & 511)]; cact[i] = v / (1.f + __expf(-v)); }
  __syncthreads();
  const int cq = t & 15, kl = t >> 4, c0 = cgi * 64;
  float acc[4][4];
#pragma unroll
  for (int b = 0; b < 4; ++b)
#pragma unroll
    for (int j = 0; j < 4; ++j) acc[b][j] = 0.f;
  const float* wp = W + (size_t)(kbase + kl) * 12288 + c0 + cq * 4;
#pragma unroll 8
  for (int i = 0; i < 32; ++i) {
    const int k = kl + 16 * i;
    float4 w4 = *(const float4*)(wp + (size_t)i * 16 * 12288);
#pragma unroll
    for (int b = 0; b < 4; ++b) {
      const float a = cact[b * 512 + k];
      acc[b][0] += a * w4.x; acc[b][1] += a * w4.y; acc[b][2] += a * w4.z; acc[b][3] += a * w4.w;
    }
  }
#pragma unroll
  for (int b = 0; b < 4; ++b)
#pragma unroll
    for (int j = 0; j < 4; ++j) red[(kl * 16 + cq) * 17 + b * 4 + j] = acc[b][j];
  __syncthreads();
  {
    const int b = t >> 6, col = t & 63, q = col >> 2, j = col & 3;
    float s = 0.f;
#pragma unroll
    for (int k2 = 0; k2 < 16; ++k2) s += red[(k2 * 16 + q) * 17 + b * 4 + j];
    mod[(size_t)ksp * 49152 + b * 12288 + c0 + col] = s;
  }
}

constexpr int P0_MOD = 768;
constexpr int P0_TIN = 32 * 65, P0_TUQ = 8 * 24, P0_TUKV = 8 * 32, P0_TOUT = 32 * 32, P0_TWQ = 32 * 32;
constexpr int P0_SK = 32, P0_UV = 0, P0_ROPE = 32;
DI void phase0(const Params& p, char* smem) {
  constexpr int o1 = P0_MOD, o2 = o1 + P0_TIN, o3 = o2 + P0_TUQ, o4 = o3 + P0_TUKV, o5 = o4 + P0_TOUT, o6 = o5 + P0_TWQ, o7 = o6 + P0_SK, o8 = o7 + P0_UV, o9 = o8 + P0_UV, o10 = o9 + P0_ROPE;
  for (int it = blockIdx.x; it < o10; it += gridDim.x) {
    if (it < o1) mod_item(p, it, smem);
    else if (it < o2) { int j = it - o1; transpose_item(p.in[5], INC, 2048, nullptr, (u16*)(p.ws + WS_WINT), j / 65, j % 65, smem); }
    else if (it < o3) { int j = it - o2; transpose_item(p.in[8], 1536, 512, p.in[7], (u16*)(p.ws + WS_WUQT), j / 24, j % 24, smem); }
    else if (it < o4) { int j = it - o3; transpose_item(p.in[10], 2048, 512, p.in[9], (u16*)(p.ws + WS_WUKVT), j / 32, j % 32, smem); }
    else if (it < o5) { int j = it - o4; int tk = j / 32; transpose_item(p.in[13], 2048, 2048, tk < 16 ? p.in[11] : p.in[12] - 1024, (u16*)(p.ws + WS_WOUTT), tk, j % 32, smem); }
    else if (it < o6) { int j = it - o5; transpose_item(p.in[15], 2048, 2048, nullptr, (u16*)(p.ws + WS_WQT), j / 32, j % 32, smem); }
    else if (it < o7) convert_item(p.in[16], (u16*)(p.ws + WS_SK), (size_t)(it - o6) * 8192);
    else if (it < o8) fp8_rows_item(p.in[17], (unsigned char*)(p.ws + WS_U), (float*)(p.ws + WS_USC), it - o7);
    else if (it < o9) fp8_rows_item(p.in[18], (unsigned char*)(p.ws + WS_V), (float*)(p.ws + WS_VSC), it - o8);
    else {
      float2* rope = (float2*)(p.ws + WS_ROPE);
      const int base = (it - o9) * 2048;
      for (int e = threadIdx.x; e < 2048; e += 256) {
        const int idx = base + e, pos = idx >> 5, j = idx & 31;
        const float inv = 1.0f / powf(10000.0f, (float)(2 * j) / 64.0f);
        const float ang = (float)pos * inv;
        rope[idx] = make_float2(cosf(ang), sinf(ang));
      }
    }
  }
}

DI void norm_rows(const float* __restrict__ X, const float* __restrict__ g, const float* mod, int bstride, u16* __restrict__ out) {
  const int lane = threadIdx.x & 63, w = threadIdx.x >> 6;
  for (int row = blockIdx.x * 4 + w; row < T_; row += gridDim.x * 4) {
    const float* xr = X + (size_t)row * D_;
    float4 v[8];
    float ss = 0.f;
#pragma unroll
    for (int j = 0; j < 8; ++j) { v[j] = *(const float4*)(xr + j * 256 + lane * 4); ss += v[j].x * v[j].x + v[j].y * v[j].y + v[j].z * v[j].z + v[j].w * v[j].w; }
    ss = wave_sum(ss);
    const float rstd = rsqrtf(ss * (1.f / D_) + EPS);
    const int b = row >> 11;
    const float* sh = mod + b * bstride;
    const float* sc = sh + 2048;
#pragma unroll
    for (int j = 0; j < 8; ++j) {
      const int d = j * 256 + lane * 4;
      const float4 gg = *(const float4*)(g + d), s4 = *(const float4*)(sc + d), h4 = *(const float4*)(sh + d);
      const float o0 = v[j].x * rstd * gg.x * (1.f + s4.x) + h4.x;
      const float o1 = v[j].y * rstd * gg.y * (1.f + s4.y) + h4.y;
      const float o2 = v[j].z * rstd * gg.z * (1.f + s4.z) + h4.z;
      const float o3 = v[j].w * rstd * gg.w * (1.f + s4.w) + h4.w;
      *(uint2*)(out + (size_t)row * D_ + d) = make_uint2(pk2(o0, o1), pk2(o2, o3));
    }
  }
}
DI void phase1(const Params& p, char* smem) {
  const float* mp = (const float*)(p.ws + WS_MODP); float* mod = (float*)(p.ws + WS_MOD); const float* bias = p.in[3];
  for (int i = blockIdx.x * 256 + threadIdx.x; i < 49152; i += gridDim.x * 256)
    mod[i] = ((mp[i] + mp[49152 + i]) + mp[2 * 49152 + i]) + mp[3 * 49152 + i] + bias[i % 12288];
  float* lm = (float*)(smem + 16);
  __syncthreads();
  for (int i = threadIdx.x; i < 4 * 4096; i += 256) {
    const int b = i >> 12, c = i & 4095, src = b * 12288 + c;
    lm[i] = ((mp[src] + mp[49152 + src]) + mp[2 * 49152 + src]) + mp[3 * 49152 + src] + bias[c];
  }
  __syncthreads();
  norm_rows(p.in[0], p.in[4], lm, 4096, (u16*)(p.ws + WS_H));
}

constexpr int CTR_TILE = 3520, CTR_CHUNK = 3584;
DI int grab(unsigned* ctr, char* smem) {
  __syncthreads();
  if (threadIdx.x == 0) *(volatile unsigned*)(smem + 8) = atomicAdd(ctr, 1u);
  __syncthreads();
  return (int)*(volatile unsigned*)(smem + 8);
}
DI void uv_chunk(const Params& p, int c) {
#pragma unroll 1
  for (int i = 0; i < 4; ++i) {
    const int item = c * 4 + i;
    if (item < 4096) fp8_rows_item(p.in[17], (unsigned char*)(p.ws + WS_U), (float*)(p.ws + WS_USC), item);
    else fp8_rows_item(p.in[18], (unsigned char*)(p.ws + WS_V), (float*)(p.ws + WS_VSC), item - 4096);
  }
}
DI void phase2(const Params& p, char* smem) {
  const u16* H = (const u16*)(p.ws + WS_H); const u16* W = (const u16*)(p.ws + WS_WINT); u16* P = (u16*)(p.ws + WS_P);
  unsigned* ctr = (unsigned*)(p.ws + WS_BAR);
  if (blockIdx.x & 1) {
#pragma unroll 1
    for (int q = 0; q < 4; ++q) { const int c = grab(ctr + CTR_CHUNK, smem); if (c < 2048) uv_chunk(p, c); }
  }
  for (;;) {
    const int it = grab(ctr + CTR_TILE, smem);
    if (it >= 64 * 33) break;
    const int tn = it / 64, tm = it % 64;
    gemm_tile<true>(H, D_, W, D_, D_, tm * 128, tn * 128, smem, [&](f32x16 (&acc)[2][2], int mb, int nb, int r, int hi) __attribute__((always_inline)) {
      if (nb >= INC) return;
#pragma unroll
      for (int mi = 0; mi < 2; ++mi)
#pragma unroll
        for (int ni = 0; ni < 2; ++ni)
#pragma unroll
          for (int g = 0; g < 4; ++g) {
            const int row = mb + mi * 32 + r, col = nb + ni * 32 + hi * 4 + 8 * g;
            *(uint2*)(P + (size_t)row * INC + col) = make_uint2(pk2(acc[mi][ni][4 * g], acc[mi][ni][4 * g + 1]), pk2(acc[mi][ni][4 * g + 2], acc[mi][ni][4 * g + 3]));
          }
    });
  }
  for (;;) {
    const int c = grab(ctr + CTR_CHUNK, smem);
    if (c >= 2048) break;
    uv_chunk(p, c);
  }
}

DI void phase3(const Params& p, char* smem) {
  const u16* P = (const u16*)(p.ws + WS_P);
  u16* Q = (u16*)(p.ws + WS_Q); u16* Kb = (u16*)(p.ws + WS_K); u16* VT = (u16*)(p.ws + WS_VT); u16* MG = (u16*)(p.ws + WS_MG);
  const float2* rope = (const float2*)(p.ws + WS_ROPE);
  float* rs = (float*)(smem + 16 + 2 * 2 * 128 * 72 * 2);
  constexpr int NQ = 64 * 12, NKV = 64 * 16, NKR = 1024, NCV = 1024;
  const float qscale = 0.07216878364870322f * 1.4426950408889634f;
  for (int it = blockIdx.x; it < NQ + NKV + NKR + NCV; it += gridDim.x) {
    if (it < NQ) {
      const int tn = it / 64, tm = it % 64;
      __syncthreads();
      tile_rstd512(P + 3072, INC, tm * 128, rs);
      gemm_tile<true>(P + 3072, INC, (const u16*)(p.ws + WS_WUQT), 512, 512, tm * 128, tn * 128, smem, [&](f32x16 (&acc)[2][2], int mb, int nb, int r, int hi) __attribute__((always_inline)) {
        const bool is_rope = ((nb >> 6) % 3) == 2;
#pragma unroll
        for (int mi = 0; mi < 2; ++mi) {
          const int row = mb + mi * 32 + r;
          const float sc = rs[row - tm * 128] * qscale;
          const int pos = row & (S_ - 1);
#pragma unroll
          for (int g = 0; g < 4; ++g) {
            const int j = hi * 4 + 8 * g;
            float a0[4], a1[4];
#pragma unroll
            for (int e = 0; e < 4; ++e) { a0[e] = acc[mi][0][4 * g + e] * sc; a1[e] = acc[mi][1][4 * g + e] * sc; }
            if (is_rope) {
#pragma unroll
              for (int e = 0; e < 4; ++e) {
                const float2 cs = rope[pos * 32 + j + e];
                const float x1 = a0[e], x2 = a1[e];
                a0[e] = x1 * cs.x - x2 * cs.y; a1[e] = x2 * cs.x + x1 * cs.y;
              }
            }
            *(uint2*)(Q + (size_t)row * 1536 + nb + j) = make_uint2(pk2(a0[0], a0[1]), pk2(a0[2], a0[3]));
            *(uint2*)(Q + (size_t)row * 1536 + nb + 32 + j) = make_uint2(pk2(a1[0], a1[1]), pk2(a1[2], a1[3]));
          }
        }
      });
    } else if (it < NQ + NKV) {
      const int j2 = it - NQ, tn = j2 / 64, tm = j2 % 64;
      __syncthreads();
      tile_rstd512(P + 3584, INC, tm * 128, rs);
      const int head = tn >> 1;
      if ((tn & 1) == 0) {
        gemm_tile<true>(P + 3584, INC, (const u16*)(p.ws + WS_WUKVT), 512, 512, tm * 128, tn * 128, smem, [&](f32x16 (&acc)[2][2], int mb, int nb, int r, int hi) __attribute__((always_inline)) {
#pragma unroll
          for (int mi = 0; mi < 2; ++mi) {
            const int row = mb + mi * 32 + r;
            const float sc = rs[row - tm * 128];
#pragma unroll
            for (int ni = 0; ni < 2; ++ni)
#pragma unroll
              for (int g = 0; g < 4; ++g) {
                const int d = (nb & 127) + ni * 32 + hi * 4 + 8 * g;
                *(uint2*)(Kb + (size_t)row * 1536 + head * 192 + d) = make_uint2(pk2(acc[mi][ni][4 * g] * sc, acc[mi][ni][4 * g + 1] * sc), pk2(acc[mi][ni][4 * g + 2] * sc, acc[mi][ni][4 * g + 3] * sc));
              }
          }
        });
      } else {
        gemm_tile<false>(P + 3584, INC, (const u16*)(p.ws + WS_WUKVT), 512, 512, tm * 128, tn * 128, smem, [&](f32x16 (&acc)[2][2], int mb, int nb, int r, int hi) __attribute__((always_inline)) {
#pragma unroll
          for (int mi = 0; mi < 2; ++mi)
#pragma unroll
            for (int g = 0; g < 4; ++g) {
              const int row0 = mb + mi * 32 + hi * 4 + 8 * g;
              const float s0 = rs[row0 - tm * 128], s1 = rs[row0 + 1 - tm * 128], s2 = rs[row0 + 2 - tm * 128], s3 = rs[row0 + 3 - tm * 128];
              const int b = row0 >> 11, t = row0 & (S_ - 1);
#pragma unroll
              for (int ni = 0; ni < 2; ++ni) {
                const int d = (nb & 127) + ni * 32 + r;
                *(uint2*)(VT + ((size_t)((b * 8 + head) * 128 + d)) * S_ + t) = make_uint2(pk2(acc[mi][ni][4 * g] * s0, acc[mi][ni][4 * g + 1] * s1), pk2(acc[mi][ni][4 * g + 2] * s2, acc[mi][ni][4 * g + 3] * s3));
              }
            }
        });
      }
    } else if (it < NQ + NKV + NKR) {
      const int j2 = it - NQ - NKV;
      const int row = j2 * 8 + (threadIdx.x >> 5), j = threadIdx.x & 31, pos = row & (S_ - 1);
      const float x1 = bflo((unsigned)P[(size_t)row * INC + 4096 + j]), x2 = bflo((unsigned)P[(size_t)row * INC + 4096 + 32 + j]);
      const float2 cs = rope[pos * 32 + j];
      const float o1 = x1 * cs.x - x2 * cs.y, o2 = x2 * cs.x + x1 * cs.y;
      const u16 b1 = (u16)(pk2(o1, 0.f) & 0xffffu), b2 = (u16)(pk2(o2, 0.f) & 0xffffu);
#pragma unroll
      for (int h = 0; h < 8; ++h) { Kb[(size_t)row * 1536 + h * 192 + 128 + j] = b1; Kb[(size_t)row * 1536 + h * 192 + 160 + j] = b2; }
    } else {
      const int j2 = it - NQ - NKV - NKR;
      const int wi = j2 * 4 + (threadIdx.x >> 6), lane = threadIdx.x & 63;
      const int g = wi & 7, run = wi >> 3;
      const int row0 = run * 16, t0 = row0 & (S_ - 1);
      const int ch = g * 128 + lane * 2;
      const float* cw = p.in[6];
      const float w00 = cw[ch], w01 = cw[ch + 1], w10 = cw[1024 + ch], w11 = cw[1024 + ch + 1], w20 = cw[2048 + ch], w21 = cw[2048 + ch + 1];
      float zm1a = 0.f, zm1b = 0.f, zm2a = 0.f, zm2b = 0.f;
      if (t0 > 0) {
        const unsigned c1 = *(const unsigned*)(P + (size_t)(row0 - 1) * INC + 1024 + ch), h1 = *(const unsigned*)(P + (size_t)(row0 - 1) * INC + 2048 + ch);
        const unsigned c2 = *(const unsigned*)(P + (size_t)(row0 - 2) * INC + 1024 + ch), h2 = *(const unsigned*)(P + (size_t)(row0 - 2) * INC + 2048 + ch);
        zm1a = bflo(c1) * bflo(h1); zm1b = bfhi(c1) * bfhi(h1); zm2a = bflo(c2) * bflo(h2); zm2b = bfhi(c2) * bfhi(h2);
      }
#pragma unroll 4
      for (int tt = 0; tt < 16; ++tt) {
        const size_t ro = (size_t)(row0 + tt) * INC;
        const unsigned bb = *(const unsigned*)(P + ro + ch), cc = *(const unsigned*)(P + ro + 1024 + ch), hh = *(const unsigned*)(P + ro + 2048 + ch);
        const float za = bflo(cc) * bflo(hh), zb = bfhi(cc) * bfhi(hh);
        const float ya = bflo(bb) * (w00 * zm2a + w10 * zm1a + w20 * za), yb = bfhi(bb) * (w01 * zm2b + w11 * zm1b + w21 * zb);
        zm2a = zm1a; zm2b = zm1b; zm1a = za; zm1b = zb;
        const float ss = wave_sum(ya * ya + yb * yb);
        const float rstd = rsqrtf(ss * (1.f / 128.f) + EPS);
        *(unsigned*)(MG + (size_t)(row0 + tt) * D_ + ch) = pk2(ya * rstd, yb * rstd);
      }
    }
  }
}

DI void phase4(const Params& p, char* smem) {
  const u16* Q = (const u16*)(p.ws + WS_Q); const u16* Kb = (const u16*)(p.ws + WS_K); const u16* VT = (const u16*)(p.ws + WS_VT);
  u16* MG = (u16*)(p.ws + WS_MG);
  u16* Ks = (u16*)(smem + 16);
  u16* Vs = Ks + 64 * 200;
  float* mrg = (float*)(smem + 16);
  const int tid = threadIdx.x, lane = tid & 63, w = tid >> 6, qh = w & 1, kh = w >> 1, r = lane & 31, hi = lane >> 5;
  for (int it = blockIdx.x; it < 512; it += gridDim.x) {
    const int pi = it & 15, h = (it >> 4) & 7, b = it >> 7;
    for (int sub = 0; sub < 2; ++sub) {
      const int c = sub ? (31 - pi) : pi;
      const size_t qrow = (size_t)b * S_ + c * 64 + qh * 32 + r;
      bf16x8 qf[12];
#pragma unroll
      for (int ks = 0; ks < 12; ++ks) qf[ks] = *(const bf16x8*)(Q + qrow * 1536 + h * 192 + ks * 16 + hi * 8);
      f32x16 O[4];
#pragma unroll
      for (int dt = 0; dt < 4; ++dt)
#pragma unroll
        for (int i = 0; i < 16; ++i) O[dt][i] = 0.f;
      float m = -1e30f, l = 0.f;
      u32x4 kr[6]; u32x4 vr[4];
      const u16* kg = Kb + ((size_t)b * S_ + (tid >> 2)) * 1536 + h * 192 + (tid & 3) * 8;
      const u16* vg = VT + ((size_t)((b * 8 + h) * 128 + (tid >> 1))) * S_ + (tid & 1) * 8;
      u16* ksw = Ks + (tid >> 2) * 200 + (tid & 3) * 8;
      u16* vsw = Vs + (tid >> 1) * 68 + (tid & 1) * 8;
      auto load_tile = [&]() __attribute__((always_inline)) {
#pragma unroll
        for (int i = 0; i < 6; ++i) kr[i] = *(const u32x4*)(kg + i * 32);
#pragma unroll
        for (int i = 0; i < 4; ++i) vr[i] = *(const u32x4*)(vg + i * 16);
        kg += 64 * 1536; vg += 64;
      };
      load_tile();
      for (int kt = 0; kt <= c; ++kt) {
        __syncthreads();
#pragma unroll
        for (int i = 0; i < 6; ++i) *(u32x4*)(ksw + i * 32) = kr[i];
#pragma unroll
        for (int i = 0; i < 4; ++i) { u32x2 lo2 = {vr[i][0], vr[i][1]}, hi2 = {vr[i][2], vr[i][3]}; *(u32x2*)(vsw + i * 16) = lo2; *(u32x2*)(vsw + i * 16 + 4) = hi2; }
        __syncthreads();
        if (kt < c) load_tile();
        f32x16 s;
#pragma unroll
        for (int i = 0; i < 16; ++i) s[i] = 0.f;
        const u16* kp = Ks + (kh * 32 + r) * 200 + hi * 8;
#pragma unroll
        for (int ks = 0; ks < 12; ++ks) { bf16x8 kf = *(const bf16x8*)(kp + ks * 16); s = MFMA(kf, qf[ks], s); }
        float mx = s[0];
#pragma unroll
        for (int i = 1; i < 16; ++i) mx = fmaxf(mx, s[i]);
        mx = fmaxf(mx, __shfl_xor(mx, 32));
        const float mn = fmaxf(m, mx);
        const float alpha = exp2f(m - mn);
        m = mn;
        float rsum = 0.f;
#pragma unroll
        for (int i = 0; i < 16; ++i) { s[i] = exp2f(s[i] - mn); rsum += s[i]; }
        l = l * alpha + rsum;
#pragma unroll
        for (int dt = 0; dt < 4; ++dt)
#pragma unroll
          for (int i = 0; i < 16; ++i) O[dt][i] *= alpha;
#pragma unroll
        for (int st = 0; st < 2; ++st) {
          uint4 pu = make_uint4(pk2(s[8 * st], s[8 * st + 1]), pk2(s[8 * st + 2], s[8 * st + 3]), pk2(s[8 * st + 4], s[8 * st + 5]), pk2(s[8 * st + 6], s[8 * st + 7]));
          const bf16x8 pf = __builtin_bit_cast(bf16x8, pu);
#pragma unroll
          for (int dt = 0; dt < 4; ++dt) {
            const u16* vp = Vs + (dt * 32 + r) * 68 + kh * 32 + 16 * st + 4 * hi;
            uint2 v0 = *(const uint2*)vp, v1 = *(const uint2*)(vp + 8);
            const bf16x8 vf = __builtin_bit_cast(bf16x8, make_uint4(v0.x, v0.y, v1.x, v1.y));
            O[dt] = MFMA(vf, pf, O[dt]);
          }
        }
      }
      l += __shfl_xor(l, 32);
      __syncthreads();
      float* mq = mrg + qh * 66 * 64;
      if (kh == 1) {
#pragma unroll
        for (int dt = 0; dt < 4; ++dt)
#pragma unroll
          for (int i = 0; i < 16; ++i) mq[(dt * 16 + i) * 64 + lane] = O[dt][i];
        mq[64 * 64 + lane] = m; mq[65 * 64 + lane] = l;
      }
      __syncthreads();
      if (kh == 0) {
        const float m1 = mq[64 * 64 + lane], l1 = mq[65 * 64 + lane];
        const float mt = fmaxf(m, m1), a0 = exp2f(m - mt), a1 = exp2f(m1 - mt);
        const float inv = 1.f / (l * a0 + l1 * a1);
        float ss = 0.f;
#pragma unroll
        for (int dt = 0; dt < 4; ++dt)
#pragma unroll
          for (int i = 0; i < 16; ++i) { const float o = (O[dt][i] * a0 + mq[(dt * 16 + i) * 64 + lane] * a1) * inv; O[dt][i] = o; ss += o * o; }
        ss += __shfl_xor(ss, 32);
        const float rstd = rsqrtf(ss * (1.f / 128.f) + EPS);
#pragma unroll
        for (int dt = 0; dt < 4; ++dt)
#pragma unroll
          for (int g = 0; g < 4; ++g) {
            const int d = dt * 32 + hi * 4 + 8 * g;
            *(uint2*)(MG + qrow * D_ + 1024 + h * 128 + d) = make_uint2(pk2(O[dt][4 * g] * rstd, O[dt][4 * g + 1] * rstd), pk2(O[dt][4 * g + 2] * rstd, O[dt][4 * g + 3] * rstd));
          }
      }
    }
  }
}

DI void phase5(const Params& p, char* smem) {
  const u16* MG = (const u16*)(p.ws + WS_MG); const u16* W = (const u16*)(p.ws + WS_WOUTT);
  const float* X = p.in[0]; const float* mod = (const float*)(p.ws + WS_MOD); float* X1 = (float*)(p.ws + WS_X1);
  for (int it = blockIdx.x; it < 64 * 16; it += gridDim.x) {
    const int tn = it / 64, tm = it % 64;
    gemm_tile<true>(MG, D_, W, D_, D_, tm * 128, tn * 128, smem, [&](f32x16 (&acc)[2][2], int mb, int nb, int r, int hi) __attribute__((always_inline)) {
#pragma unroll
      for (int mi = 0; mi < 2; ++mi) {
        const int row = mb + mi * 32 + r, b = row >> 11;
        const float* gt = mod + b * 12288 + 2 * 2048;
#pragma unroll
        for (int ni = 0; ni < 2; ++ni)
#pragma unroll
          for (int g = 0; g < 4; ++g) {
            const int col = nb + ni * 32 + hi * 4 + 8 * g;
            const float4 xv = *(const float4*)(X + (size_t)row * D_ + col), gv = *(const float4*)(gt + col);
            float4 o;
            o.x = xv.x + gv.x * acc[mi][ni][4 * g]; o.y = xv.y + gv.y * acc[mi][ni][4 * g + 1]; o.z = xv.z + gv.z * acc[mi][ni][4 * g + 2]; o.w = xv.w + gv.w * acc[mi][ni][4 * g + 3];
            *(float4*)(X1 + (size_t)row * D_ + col) = o;
          }
      }
    });
  }
}

DI void phase7(const Params& p, char* smem) {
  const u16* H2 = (const u16*)(p.ws + WS_H); const u16* W = (const u16*)(p.ws + WS_WQT); u16* PQ = (u16*)(p.ws + WS_P);
  for (int it = blockIdx.x; it < 64 * 16; it += gridDim.x) {
    const int tn = it / 64, tm = it % 64;
    gemm_tile<true>(H2, D_, W, D_, D_, tm * 128, tn * 128, smem, [&](f32x16 (&acc)[2][2], int mb, int nb, int r, int hi) __attribute__((always_inline)) {
#pragma unroll
      for (int mi = 0; mi < 2; ++mi)
#pragma unroll
        for (int ni = 0; ni < 2; ++ni)
#pragma unroll
          for (int g = 0; g < 4; ++g) {
            const int row = mb + mi * 32 + r, col = nb + ni * 32 + hi * 4 + 8 * g;
            *(uint2*)(PQ + (size_t)row * D_ + col) = make_uint2(pk2(acc[mi][ni][4 * g], acc[mi][ni][4 * g + 1]), pk2(acc[mi][ni][4 * g + 2], acc[mi][ni][4 * g + 3]));
          }
    });
  }
}

DI unsigned f2ord(float v) { unsigned u = __float_as_uint(v); return u ^ ((unsigned)((int)u >> 31) | 0x80000000u); }
#define TOPK_INSERT(keys, x) { _Pragma("unroll") for (int _j = 0; _j < 16; ++_j) { const unsigned _h = max(keys[_j], x); x = min(keys[_j], x); keys[_j] = _h; } }
DI void phase8(const Params& p, char* smem) {
  const u16* PQ = (const u16*)(p.ws + WS_P); const u16* SK = (const u16*)(p.ws + WS_SK);
  int* IDS = (int*)(p.ws + WS_IDS); float* GATE = (float*)(p.ws + WS_GATE);
  float* sc = (float*)(smem + 16);
  const int tid = threadIdx.x, lane = tid & 63, w = tid >> 6, r = lane & 31, hi = lane >> 5;
  for (int it = blockIdx.x; it < 128 * 8; it += gridDim.x) {
    const int h = it & 7, tile = it >> 3;
    const int pp = w >> 1, rh = w & 1;
    __syncthreads();
    {
      f32x16 acc[4];
#pragma unroll
      for (int nt = 0; nt < 4; ++nt)
#pragma unroll
        for (int i = 0; i < 16; ++i) acc[nt][i] = 0.f;
      const u16* ap = PQ + (size_t)(tile * 64 + rh * 32 + r) * D_ + h * 256 + pp * 128 + hi * 8;
      const u16* bp = SK + ((size_t)(h * 2 + pp) * 128 + r) * 128 + hi * 8;
#pragma unroll
      for (int ks = 0; ks < 8; ++ks) {
        const bf16x8 af = *(const bf16x8*)(ap + ks * 16);
#pragma unroll
        for (int nt = 0; nt < 4; ++nt) { const bf16x8 bf = *(const bf16x8*)(bp + nt * 32 * 128 + ks * 16); acc[nt] = MFMA(af, bf, acc[nt]); }
      }
#pragma unroll
      for (int nt = 0; nt < 4; ++nt)
#pragma unroll
        for (int i = 0; i < 16; ++i) sc[(pp * 64 + rh * 32 + hi * 4 + (i & 3) + 8 * (i >> 2)) * 129 + nt * 32 + r] = acc[nt][i];
    }
    __syncthreads();
    if (tid < 128) {
      float* row = sc + tid * 129;
      unsigned keys[16];
#pragma unroll
      for (int j = 0; j < 16; ++j) keys[j] = 0u;
#pragma unroll 4
      for (int n = 0; n < 128; ++n) {
        unsigned x = (f2ord(row[n]) & 0xFFFFFF80u) | (unsigned)(127 - n);
        TOPK_INSERT(keys, x);
      }
      float vals[16];
#pragma unroll
      for (int j = 0; j < 16; ++j) vals[j] = row[127 - (keys[j] & 127u)];
#pragma unroll
      for (int j = 0; j < 16; ++j) { row[j] = vals[j]; row[16 + j] = __int_as_float((int)(127 - (keys[j] & 127u))); }
    }
    __syncthreads();
    if (tid < 64) {
      const float* ra = sc + tid * 129; const float* rb = sc + (64 + tid) * 129;
      float a[16], bq[16];
#pragma unroll
      for (int j = 0; j < 16; ++j) { a[j] = ra[j]; bq[j] = rb[j]; }
      unsigned keys[16];
#pragma unroll
      for (int j = 0; j < 16; ++j) keys[j] = 0u;
#pragma unroll
      for (int i = 0; i < 16; ++i)
#pragma unroll
        for (int j = 0; j < 16; ++j)
          if ((i + 1) * (j + 1) <= 16) {
            unsigned x = (f2ord(a[i] + bq[j]) & 0xFFFFFF00u) | (unsigned)(255 - (i * 16 + j));
            TOPK_INSERT(keys, x);
          }
      float bv[16]; int ex[16];
      float mx = -1e30f;
#pragma unroll
      for (int q = 0; q < 16; ++q) {
        const int flat = 255 - (int)(keys[q] & 255u), i = flat >> 4, j = flat & 15;
        bv[q] = ra[i] + rb[j];
        ex[q] = __float_as_int(ra[16 + i]) * 128 + __float_as_int(rb[16 + j]);
        mx = fmaxf(mx, bv[q]);
      }
      float sum = 0.f;
#pragma unroll
      for (int q = 0; q < 16; ++q) { bv[q] = __expf(bv[q] - mx); sum += bv[q]; }
      const float inv = 1.f / sum;
      const size_t o = (size_t)(tile * 64 + tid) * 128 + h * 16;
#pragma unroll
      for (int q = 0; q < 16; q += 4) {
        *(int4*)(IDS + o + q) = make_int4(ex[q], ex[q + 1], ex[q + 2], ex[q + 3]);
        *(float4*)(GATE + o + q) = make_float4(bv[q] * inv, bv[q + 1] * inv, bv[q + 2] * inv, bv[q + 3] * inv);
      }
    }
  }
}

DI f2_t cvt8lo(unsigned w) { return __builtin_amdgcn_cvt_pk_f32_fp8(w, false); }
DI f2_t cvt8hi(unsigned w) { return __builtin_amdgcn_cvt_pk_f32_fp8(w, true); }
DI void phase9(const Params& p, char* smem) {
  const u16* H2 = (const u16*)(p.ws + WS_H); const unsigned char* U8 = (const unsigned char*)(p.ws + WS_U); const unsigned char* V8 = (const unsigned char*)(p.ws + WS_V);
  const float* USC = (const float*)(p.ws + WS_USC); const float* VSC = (const float*)(p.ws + WS_VSC);
  const int* IDS = (const int*)(p.ws + WS_IDS); const float* GATE = (const float*)(p.ws + WS_GATE);
  const float* X1 = (const float*)(p.ws + WS_X1); const float* mod = (const float*)(p.ws + WS_MOD); const float* gfin = p.in[19];
  const int lane = threadIdx.x & 63, w = threadIdx.x >> 6;
  float* aw = (float*)(smem + 16) + w * 128;
  const int b5 = (lane >> 5) & 1, b4 = (lane >> 4) & 1, b3 = (lane >> 3) & 1;
  for (int tok0 = blockIdx.x * 4 + w; tok0 < T_; tok0 += gridDim.x * 4) {
    const int tok = __builtin_amdgcn_readfirstlane(tok0);
    f2_t hp[16];
#pragma unroll
    for (int j = 0; j < 2; ++j)
#pragma unroll
      for (int q = 0; q < 2; ++q) {
        const uint4 hv = *(const uint4*)(H2 + (size_t)tok * D_ + 1024 * j + lane * 16 + q * 8);
        hp[j * 8 + q * 4 + 0] = f2_t{bflo(hv.x), bfhi(hv.x)}; hp[j * 8 + q * 4 + 1] = f2_t{bflo(hv.y), bfhi(hv.y)};
        hp[j * 8 + q * 4 + 2] = f2_t{bflo(hv.z), bfhi(hv.z)}; hp[j * 8 + q * 4 + 3] = f2_t{bflo(hv.w), bfhi(hv.w)};
      }
    const int idv[2] = {IDS[(size_t)tok * 128 + lane], IDS[(size_t)tok * 128 + 64 + lane]};
#pragma unroll
    for (int half = 0; half < 2; ++half) {
      for (int n0 = 0; n0 < 64; n0 += 8) {
        u32x4 uu[8][2];
#pragma unroll
        for (int e = 0; e < 8; ++e) {
          const int ex = __builtin_amdgcn_readlane(idv[half], n0 + e);
          const unsigned char* rp = U8 + (size_t)ex * 2048 + lane * 16;
          uu[e][0] = *(const u32x4*)rp; uu[e][1] = *(const u32x4*)(rp + 1024);
        }
        float ps[8];
#pragma unroll
        for (int e = 0; e < 8; ++e) {
          f2_t acc = {0.f, 0.f};
#pragma unroll
          for (int j = 0; j < 2; ++j)
#pragma unroll
            for (int d = 0; d < 4; ++d) { const unsigned ww = uu[e][j][d]; acc += cvt8lo(ww) * hp[j * 8 + d * 2]; acc += cvt8hi(ww) * hp[j * 8 + d * 2 + 1]; }
          ps[e] = acc.x + acc.y;
        }
        float q4[4], r2[2];
#pragma unroll
        for (int i = 0; i < 4; ++i) { const float keep = b5 ? ps[4 + i] : ps[i], send = b5 ? ps[i] : ps[4 + i]; q4[i] = keep + __shfl_xor(send, 32); }
#pragma unroll
        for (int i = 0; i < 2; ++i) { const float keep = b4 ? q4[2 + i] : q4[i], send = b4 ? q4[i] : q4[2 + i]; r2[i] = keep + __shfl_xor(send, 16); }
        float tt = (b3 ? r2[1] : r2[0]) + __shfl_xor(b3 ? r2[0] : r2[1], 8);
        tt += __shfl_xor(tt, 4); tt += __shfl_xor(tt, 2); tt += __shfl_xor(tt, 1);
        if ((lane & 7) == 0) aw[half * 64 + n0 + 4 * b5 + 2 * b4 + b3] = tt;
      }
    }
    asm volatile("s_waitcnt lgkmcnt(0)" ::: "memory");
    __builtin_amdgcn_wave_barrier();
#pragma unroll
    for (int q = 0; q < 2; ++q) {
      const int n = lane + 64 * q;
      const float a = aw[n] * USC[idv[q]];
      const float act = 0.5f * a * (1.f + erff(a * 0.70710678118654752f)) * GATE[(size_t)tok * 128 + n] * VSC[idv[q]];
      aw[n] = act;
    }
    asm volatile("s_waitcnt lgkmcnt(0)" ::: "memory");
    __builtin_amdgcn_wave_barrier();
    f2_t o2[16];
#pragma unroll
    for (int i = 0; i < 16; ++i) o2[i] = f2_t{0.f, 0.f};
#pragma unroll
    for (int half = 0; half < 2; ++half) {
      for (int n0 = 0; n0 < 64; n0 += 8) {
        u32x4 vv[8][2];
#pragma unroll
        for (int e = 0; e < 8; ++e) {
          const int ex = __builtin_amdgcn_readlane(idv[half], n0 + e);
          const unsigned char* rp = V8 + (size_t)ex * 2048 + lane * 16;
          vv[e][0] = *(const u32x4*)rp; vv[e][1] = *(const u32x4*)(rp + 1024);
        }
        const float4 a4 = *(const float4*)(aw + half * 64 + n0), a5 = *(const float4*)(aw + half * 64 + n0 + 4);
        const float av[8] = {a4.x, a4.y, a4.z, a4.w, a5.x, a5.y, a5.z, a5.w};
#pragma unroll
        for (int e = 0; e < 8; ++e) {
          const f2_t a2 = {av[e], av[e]};
#pragma unroll
          for (int j = 0; j < 2; ++j)
#pragma unroll
            for (int d = 0; d < 4; ++d) { const unsigned ww = vv[e][j][d]; o2[j * 8 + d * 2] += a2 * cvt8lo(ww); o2[j * 8 + d * 2 + 1] += a2 * cvt8hi(ww); }
        }
      }
    }
    const int b = tok >> 11;
    const float* gt = mod + b * 12288 + 5 * 2048;
    float ss = 0.f;
#pragma unroll
    for (int j = 0; j < 2; ++j)
#pragma unroll
      for (int q = 0; q < 4; ++q) {
        const int d = 1024 * j + lane * 16 + q * 4;
        const float4 xv = *(const float4*)(X1 + (size_t)tok * D_ + d), gv = *(const float4*)(gt + d);
        f2_t& oa = o2[j * 8 + q * 2]; f2_t& ob = o2[j * 8 + q * 2 + 1];
        oa.x = xv.x + gv.x * oa.x; oa.y = xv.y + gv.y * oa.y; ob.x = xv.z + gv.z * ob.x; ob.y = xv.w + gv.w * ob.y;
        ss += oa.x * oa.x + oa.y * oa.y + ob.x * ob.x + ob.y * ob.y;
      }
    ss = wave_sum(ss);
    const float rstd = rsqrtf(ss * (1.f / D_) + EPS);
#pragma unroll
    for (int j = 0; j < 2; ++j)
#pragma unroll
      for (int q = 0; q < 4; ++q) {
        const int d = 1024 * j + lane * 16 + q * 4;
        const float4 gv = *(const float4*)(gfin + d);
        const f2_t oa = o2[j * 8 + q * 2], ob = o2[j * 8 + q * 2 + 1];
        *(float4*)(p.out + (size_t)tok * D_ + d) = make_float4(oa.x * rstd * gv.x, oa.y * rstd * gv.y, ob.x * rstd * gv.z, ob.y * rstd * gv.w);
      }
    asm volatile("s_waitcnt lgkmcnt(0)" ::: "memory");
    __builtin_amdgcn_wave_barrier();
  }
}

__global__ void __launch_bounds__(256, 2) mega(Params p) {
  extern __shared__ __attribute__((aligned(16))) char smem[];
  XcdBarrier xb;
  const bool multi = (p.ph_hi - p.ph_lo) > 1;
  if (multi) {
    if (threadIdx.x == 0) *(uint4*)smem = make_uint4(0u, 0u, 0u, 0u);
    __syncthreads();
    xb = xcd_barrier_post((unsigned*)(p.ws + WS_BAR), (volatile LAS unsigned*)smem);
  }
#ifndef PHMASK
#define PHMASK 0x3ff
#endif
#ifndef REPMASK
#define REPMASK 0
#endif
#define RUN_PHASE(n, call) if (p.ph_lo <= (n) && (n) < p.ph_hi) { \
    if ((n) > p.ph_lo) { xcd_barrier(xb); } \
    if (PHMASK & (1 << (n))) { call; if (REPMASK & (1 << (n))) { __syncthreads(); call; } } }
  RUN_PHASE(0, phase0(p, smem))
  RUN_PHASE(1, phase1(p, smem))
#ifdef BARX
  for (int i = 0; i < BARX; ++i) xcd_barrier(xb);
#endif
  RUN_PHASE(2, phase2(p, smem))
  RUN_PHASE(3, phase3(p, smem))
  RUN_PHASE(4, phase4(p, smem))
  RUN_PHASE(5, phase5(p, smem))
  RUN_PHASE(6, norm_rows((const float*)(p.ws + WS_X1), p.in[14], (const float*)(p.ws + WS_MOD) + 3 * 2048, 12288, (u16*)(p.ws + WS_H)))
  RUN_PHASE(7, phase7(p, smem))
  RUN_PHASE(8, phase8(p, smem))
  RUN_PHASE(9, phase9(p, smem))
}

extern "C" void kernel_launch(void* const* d_in, const int* in_sizes, int n_in, void* d_out, int out_size, void* d_ws, size_t ws_size, hipStream_t stream) {
  static int grid = 0;
  if (grid == 0) {
    if (n_in != 20 || ws_size < WS_END) { fprintf(stderr, "kernel_launch: unexpected n_in %d / ws_size %zu (need %zu)\n", n_in, ws_size, (size_t)WS_END); grid = -1; return; }
    int dev = 0, cus = 0, per_cu = 0;
    hipGetDevice(&dev);
    hipDeviceGetAttribute(&cus, hipDeviceAttributeMultiprocessorCount, dev);
    hipFuncSetAttribute((const void*)mega, hipFuncAttributeMaxDynamicSharedMemorySize, LDS_BYTES);
    hipOccupancyMaxActiveBlocksPerMultiprocessor(&per_cu, (const void*)mega, 256, LDS_BYTES);
    if (per_cu < 1) { fprintf(stderr, "kernel_launch: occupancy query says %d\n", per_cu); per_cu = 1; }
    if (per_cu > 2) per_cu = 2;
    grid = cus * per_cu;
    fprintf(stderr, "kernel_launch: grid %d (%d per CU)\n", grid, per_cu);
  }
  if (grid < 0) return;
  Params p{};
  for (int i = 0; i < 20; ++i) p.in[i] = (const float*)d_in[i];
  p.out = (float*)d_out; p.ws = (char*)d_ws;
#if N_LAUNCH_PER_PHASE
  p.coop = 0;
  for (int ph = 0; ph < NPH; ++ph) {
    p.ph_lo = ph; p.ph_hi = ph + 1;
    hipLaunchKernelGGL(mega, dim3(grid), dim3(256), LDS_BYTES, stream, p);
  }
#else
  hipMemsetAsync((char*)d_ws + WS_BAR, 0, WS_MOD, stream);
  p.coop = 0; p.ph_lo = 0; p.ph_hi = NPH;
  void* args[] = {&p};
  hipError_t e = hipLaunchCooperativeKernel((const void*)mega, dim3(grid), dim3(256), args, LDS_BYTES, stream);
  if (e != hipSuccess) fprintf(stderr, "cooperative launch failed: %s (grid %d)\n", hipGetErrorString(e), grid);
#endif
}
```

```cpp
#include <hip/hip_runtime.h>
#include <cstdio>
#include <cstdint>

#ifndef N_LAUNCH_PER_PHASE
#define N_LAUNCH_PER_PHASE 0
#endif

#define DI __device__ __forceinline__
typedef unsigned short u16;
typedef __attribute__((ext_vector_type(8))) short bf16x8;
typedef __attribute__((ext_vector_type(16))) float f32x16;
typedef __attribute__((ext_vector_type(2))) __bf16 bf2_t;
typedef __attribute__((ext_vector_type(2))) float f2_t;
typedef __attribute__((ext_vector_type(4))) unsigned u32x4;
typedef __attribute__((ext_vector_type(2))) unsigned u32x2;
#define MFMA(a, b, c) __builtin_amdgcn_mfma_f32_32x32x16_bf16((a), (b), (c), 0, 0, 0)

constexpr int T_ = 8192, D_ = 2048, S_ = 2048;
constexpr int INC = 4160;
constexpr float EPS = 1e-6f;
constexpr int NPH = 13;

constexpr size_t al256(size_t x) { return (x + 255) & ~(size_t)255; }
constexpr size_t WS_BAR = 0;
constexpr size_t WS_MOD = 32768;
constexpr size_t WS_ROPE = WS_MOD + al256(4 * 12288 * 4);
constexpr size_t WS_WINT = WS_ROPE + al256(2048 * 32 * 8);
constexpr size_t WS_WUQT = WS_WINT + al256((size_t)4224 * 2048 * 2);
constexpr size_t WS_WUKVT = WS_WUQT + al256((size_t)1536 * 512 * 2);
constexpr size_t WS_WOUTT = WS_WUKVT + al256((size_t)2048 * 512 * 2);
constexpr size_t WS_WQT = WS_WOUTT + al256((size_t)2048 * 2048 * 2);
constexpr size_t WS_SK = WS_WQT + al256((size_t)2048 * 2048 * 2);
constexpr size_t WS_U = WS_SK + al256((size_t)262144 * 2);
constexpr size_t WS_V = WS_U + al256((size_t)16384 * 2048);
constexpr size_t WS_H = WS_V + al256((size_t)16384 * 2048);
constexpr size_t WS_P = WS_H + al256((size_t)T_ * D_ * 2);
constexpr size_t WS_Q = WS_P + al256((size_t)T_ * INC * 2);
constexpr size_t WS_K = WS_Q + al256((size_t)T_ * 1536 * 2);
constexpr size_t WS_VT = WS_K + al256((size_t)T_ * 1536 * 2);
constexpr size_t WS_MG = WS_VT + al256((size_t)T_ * 1024 * 2);
constexpr size_t WS_X1 = WS_MG + al256((size_t)T_ * D_ * 2);
constexpr size_t WS_IDS = WS_X1 + al256((size_t)T_ * D_ * 4);
constexpr size_t WS_GATE = WS_IDS + al256((size_t)T_ * 128 * 4);
constexpr size_t WS_USC = WS_GATE + al256((size_t)T_ * 128 * 4);
constexpr size_t WS_VSC = WS_USC + 65536;
constexpr size_t WS_MODP = WS_VSC + 65536;
constexpr size_t WS_ACT = WS_MODP + al256((size_t)4 * 4 * 12288 * 4);
constexpr size_t WS_END = WS_ACT + al256((size_t)T_ * 128 * 4);
constexpr size_t WS_PA = WS_MG;
constexpr size_t WS_OUTP = WS_Q;
static_assert(WS_VT + (size_t)T_ * 1024 * 2 - WS_Q >= (size_t)T_ * D_ * 4, "OUTP alias");
static_assert((size_t)8 * T_ * 128 * 4 <= (size_t)T_ * D_ * 2, "PA alias");

constexpr int LDS_BYTES = 16 + 2 * 2 * 128 * 72 * 2 + 512;

struct Params {
  const float* in[20];
  float* out;
  char* ws;
  int ph_lo, ph_hi, coop, pad;
};

DI unsigned pk2(float a, float b) { f2_t v = {a, b}; bf2_t r = __builtin_convertvector(v, bf2_t); return __builtin_bit_cast(unsigned, r); }
DI float bflo(unsigned u) { return __uint_as_float(u << 16); }
DI float bfhi(unsigned u) { return __uint_as_float(u & 0xffff0000u); }
DI float dot2(unsigned a, unsigned b, float c) { return __builtin_amdgcn_fdot2_f32_bf16(__builtin_bit_cast(bf2_t, a), __builtin_bit_cast(bf2_t, b), c, false); }
DI float wave_sum(float v) {
#pragma unroll
  for (int o = 32; o >= 1; o >>= 1) v += __shfl_xor(v, o);
  return v;
}

#define XB_TMO      128
#define XB_XCNT(j)  (256  + 64 * (j))
#define XB_XSUB(j)  (1280 + 64 * (j))
#define XB_XGEN(j)  (2304 + 64 * (j))
#define XB_TOP      3328
#define XB_TOPGEN   3392
#define XCD_BAR_WORDS 3456
#define XB_SPIN_CAP (1u << 22)
#define LAS __attribute__((address_space(3)))
DI unsigned xb_ld(unsigned* p) { return __hip_atomic_load(p, __ATOMIC_RELAXED, __HIP_MEMORY_SCOPE_AGENT); }
DI unsigned xb_add(unsigned* p, unsigned v) { return __hip_atomic_fetch_add(p, v, __ATOMIC_RELAXED, __HIP_MEMORY_SCOPE_AGENT); }
DI unsigned xb_xcc_id() { return (unsigned)__builtin_amdgcn_s_getreg((3 << 11) | 20) & 0xFu; }
#define XB_SPIN(cond, bar) do { unsigned _sp = 0; while (cond) { __builtin_amdgcn_s_sleep(1); \
    if ((++_sp & 255u) == 0u) { if (xb_ld(&(bar)[XB_TMO])) break; if (_sp > XB_SPIN_CAP) { atomicAdd(&(bar)[XB_TMO], 1u); break; } } } } while (0)
struct XcdBarrier { unsigned* bar; unsigned x; volatile LAS unsigned* st; };
DI XcdBarrier xcd_barrier_post(unsigned* bar, volatile LAS unsigned* st) {
  XcdBarrier b; b.bar = bar; b.x = xb_xcc_id(); b.st = st;
  if (threadIdx.x == 0) (void)xb_add(&bar[XB_XCNT(b.x)], 1u);
  return b;
}
DI void xcd_barrier_complete(unsigned* bar, unsigned x, unsigned& nloc, unsigned& nx) {
  const unsigned G = gridDim.x * gridDim.y * gridDim.z;
  unsigned sum, cnt, mine, sp = 0u;
  for (;;) {
    sum = 0u; cnt = 0u; mine = 0u;
#pragma unroll
    for (unsigned j = 0; j < 16; ++j) { const unsigned c = xb_ld(&bar[XB_XCNT(j)]); sum += c; cnt += (c > 0u) ? 1u : 0u; mine = (j == x) ? c : mine; }
    if (sum == G) break;
    __builtin_amdgcn_s_sleep(1);
    if ((++sp & 255u) == 0u) { if (xb_ld(&bar[XB_TMO])) break; if (sp > XB_SPIN_CAP) { atomicAdd(&bar[XB_TMO], 1u); break; } }
  }
  nloc = mine > 0u ? mine : 1u; nx = cnt > 0u ? cnt : 1u;
}
DI void xcd_barrier(const XcdBarrier& b) {
  asm volatile("s_waitcnt vmcnt(0)" ::: "memory");
  __syncthreads();
  if (threadIdx.x == 0) {
    unsigned* bar = b.bar;
    __builtin_amdgcn_s_waitcnt(0);
    unsigned nloc = b.st[0], nx = b.st[1];
    if (nloc == 0u) { xcd_barrier_complete(bar, b.x, nloc, nx); b.st[0] = nloc; b.st[1] = nx; }
    const unsigned old = xb_add(&bar[XB_XSUB(b.x)], 1u);
    const unsigned gen = old / nloc;
    if (old + 1u == (gen + 1u) * nloc) {
      __builtin_amdgcn_fence(__ATOMIC_RELEASE, "agent");
      asm volatile("s_waitcnt vmcnt(0)" ::: "memory");
      const unsigned og = xb_add(&bar[XB_TOP], 1u);
      const unsigned tg = og / nx;
      if (og + 1u == (tg + 1u) * nx) xb_add(&bar[XB_TOPGEN], 1u);
      else XB_SPIN(xb_ld(&bar[XB_TOPGEN]) == tg, bar);
      __builtin_amdgcn_fence(__ATOMIC_ACQUIRE, "agent");
      xb_add(&bar[XB_XGEN(b.x)], 1u);
      asm volatile("s_waitcnt vmcnt(0)" ::: "memory");
    } else {
      XB_SPIN(xb_ld(&bar[XB_XGEN(b.x)]) == gen, bar);
      __builtin_amdgcn_fence(__ATOMIC_ACQUIRE, "agent");
      asm volatile("s_waitcnt vmcnt(0)" ::: "memory");
    }
  }
  __syncthreads();
}

template <bool SWAP, class Epi>
DI void gemm_tile(const u16* __restrict__ A, int lda, const u16* __restrict__ Bt, int ldb, int K, int m0, int n0, char* smem, Epi&& epi) {
  u16* As = (u16*)(smem + 16);
  u16* Bs = As + 2 * 128 * 72;
  const int tid = threadIdx.x, lane = tid & 63, w = tid >> 6, wm = w >> 1, wn = w & 1;
  const int r = lane & 31, hi = lane >> 5;
  f32x16 acc[2][2];
#pragma unroll
  for (int a = 0; a < 2; ++a)
#pragma unroll
    for (int b = 0; b < 2; ++b)
#pragma unroll
      for (int i = 0; i < 16; ++i) acc[a][b][i] = 0.f;
  const int srow = tid >> 3, skc = tid & 7;
  const u16* ag = A + (size_t)(m0 + srow) * lda + skc * 8;
  const u16* bg = Bt + (size_t)(n0 + srow) * ldb + skc * 8;
  u32x4 ra[4], rb[4];
#pragma unroll
  for (int i = 0; i < 4; ++i) { ra[i] = *(const u32x4*)(ag + (size_t)i * 32 * lda); rb[i] = *(const u32x4*)(bg + (size_t)i * 32 * ldb); }
  __syncthreads();
#pragma unroll
  for (int i = 0; i < 4; ++i) { *(u32x4*)(As + (srow + 32 * i) * 72 + skc * 8) = ra[i]; *(u32x4*)(Bs + (srow + 32 * i) * 72 + skc * 8) = rb[i]; }
  __syncthreads();
  const int KT = K >> 6;
  for (int kt = 0; kt < KT; ++kt) {
    const int buf = kt & 1;
    if (kt + 1 < KT) {
      const int k0 = (kt + 1) << 6;
#pragma unroll
      for (int i = 0; i < 4; ++i) { ra[i] = *(const u32x4*)(ag + (size_t)i * 32 * lda + k0); rb[i] = *(const u32x4*)(bg + (size_t)i * 32 * ldb + k0); }
    }
    const u16* Asb = As + buf * 128 * 72 + (wm * 64 + r) * 72 + hi * 8;
    const u16* Bsb = Bs + buf * 128 * 72 + (wn * 64 + r) * 72 + hi * 8;
#pragma unroll
    for (int ks = 0; ks < 4; ++ks) {
      bf16x8 af[2], bfr[2];
      af[0] = *(const bf16x8*)(Asb + ks * 16);
      af[1] = *(const bf16x8*)(Asb + 32 * 72 + ks * 16);
      bfr[0] = *(const bf16x8*)(Bsb + ks * 16);
      bfr[1] = *(const bf16x8*)(Bsb + 32 * 72 + ks * 16);
#pragma unroll
      for (int mi = 0; mi < 2; ++mi)
#pragma unroll
        for (int ni = 0; ni < 2; ++ni) {
          if (SWAP) acc[mi][ni] = MFMA(bfr[ni], af[mi], acc[mi][ni]);
          else acc[mi][ni] = MFMA(af[mi], bfr[ni], acc[mi][ni]);
        }
    }
    if (kt + 1 < KT) {
      const int nb = buf ^ 1;
#pragma unroll
      for (int i = 0; i < 4; ++i) { *(u32x4*)(As + nb * 128 * 72 + (srow + 32 * i) * 72 + skc * 8) = ra[i]; *(u32x4*)(Bs + nb * 128 * 72 + (srow + 32 * i) * 72 + skc * 8) = rb[i]; }
    }
    __syncthreads();
  }
  epi(acc, m0 + wm * 64, n0 + wn * 64, r, hi);
}

DI void tile_rstd512(const u16* __restrict__ A, int lda, int m0, float* rs) {
  const int tid = threadIdx.x, row = tid >> 1, half = tid & 1;
  const uint4* p = (const uint4*)(A + (size_t)(m0 + row) * lda + half * 256);
  float ss = 0.f;
#pragma unroll 8
  for (int i = 0; i < 32; ++i) {
    uint4 v = p[i];
    ss = dot2(v.x, v.x, ss); ss = dot2(v.y, v.y, ss); ss = dot2(v.z, v.z, ss); ss = dot2(v.w, v.w, ss);
  }
  ss += __shfl_xor(ss, 1);
  if (half == 0) rs[row] = rsqrtf(ss * (1.f / 512.f) + EPS);
}

DI void transpose_item(const float* __restrict__ src, int N, int K, const float* __restrict__ scale, u16* __restrict__ dst, int tk, int tn, char* smem) {
  float* tile = (float*)(smem + 16);
  const int t = threadIdx.x;
  __syncthreads();
  {
    const int rr = t >> 4, c4 = (t & 15) * 4;
#pragma unroll
    for (int ps = 0; ps < 4; ++ps) {
      const int kk = ps * 16 + rr, k = tk * 64 + kk;
      float4 v = *(const float4*)(src + (size_t)k * N + tn * 64 + c4);
      const float sc = scale ? scale[k] : 1.f;
      tile[kk * 65 + c4 + 0] = v.x * sc; tile[kk * 65 + c4 + 1] = v.y * sc; tile[kk * 65 + c4 + 2] = v.z * sc; tile[kk * 65 + c4 + 3] = v.w * sc;
    }
  }
  __syncthreads();
  {
    const int n = t & 63, kc = (t >> 6) * 16;
    unsigned o[8];
#pragma unroll
    for (int j = 0; j < 8; ++j) o[j] = pk2(tile[(kc + 2 * j) * 65 + n], tile[(kc + 2 * j + 1) * 65 + n]);
    uint4* d = (uint4*)(dst + (size_t)(tn * 64 + n) * K + tk * 64 + kc);
    d[0] = make_uint4(o[0], o[1], o[2], o[3]); d[1] = make_uint4(o[4], o[5], o[6], o[7]);
  }
}

DI void convert_item(const float* __restrict__ src, u16* __restrict__ dst, size_t base) {
  const int t = threadIdx.x;
#pragma unroll
  for (int st = 0; st < 4; ++st) {
    const size_t idx = base + st * 2048 + t * 8;
    float4 a = *(const float4*)(src + idx), b = *(const float4*)(src + idx + 4);
    *(uint4*)(dst + idx) = make_uint4(pk2(a.x, a.y), pk2(a.z, a.w), pk2(b.x, b.y), pk2(b.z, b.w));
  }
}

DI float wave_max(float v) {
#pragma unroll
  for (int o = 32; o >= 1; o >>= 1) v = fmaxf(v, __shfl_xor(v, o));
  return v;
}
DI void fp8_rows_item(const float* __restrict__ src, unsigned char* __restrict__ dst, float* __restrict__ scales, int item) {
  const int lane = threadIdx.x & 63, w = threadIdx.x >> 6;
  const int row = item * 4 + w;
  const float* sr = src + (size_t)row * 2048 + lane * 16;
  float4 v[8];
  float amax = 0.f;
#pragma unroll
  for (int j = 0; j < 2; ++j)
#pragma unroll
    for (int q = 0; q < 4; ++q) {
      const float4 t = *(const float4*)(sr + 1024 * j + q * 4);
      v[j * 4 + q] = t;
      amax = fmaxf(amax, fmaxf(fmaxf(fabsf(t.x), fabsf(t.y)), fmaxf(fabsf(t.z), fabsf(t.w))));
    }
  amax = wave_max(amax);
  int e = 0;
  if (amax > 0.f) e = (int)floorf(log2f(384.f / amax));
  e = e < -100 ? -100 : (e > 100 ? 100 : e);
  const float sc = ldexpf(1.f, e);
  if (lane == 0) scales[row] = ldexpf(1.f, -e);
#pragma unroll
  for (int j = 0; j < 2; ++j) {
    unsigned d[4];
#pragma unroll
    for (int q = 0; q < 4; ++q) {
      const float4 t = v[j * 4 + q];
      unsigned pk = __builtin_amdgcn_cvt_pk_fp8_f32(t.x * sc, t.y * sc, 0, false);
      pk = __builtin_amdgcn_cvt_pk_fp8_f32(t.z * sc, t.w * sc, pk, true);
      d[q] = pk;
    }
    *(uint4*)(dst + (size_t)row * 2048 + 1024 * j + lane * 16) = make_uint4(d[0], d[1], d[2], d[3]);
  }
}

DI void mod_item(const Params& p, int item, char* smem) {
  float* cact = (float*)(smem + 16);
  float* red = cact + 4 * 512;
  const int t = threadIdx.x;
  const int cgi = item % 192, ksp = item / 192, kbase = ksp * 512;
  const float* c = p.in[1]; const float* W = p.in[2];
  float* mod = (float*)(p.ws + WS_MODP);
  __syncthreads();
  for (int i = t; i < 4 * 512; i += 256) { float v = c[(i >> 9) * 2048 + kbase + (i & 511)]; cact[i] = v / (1.f + __expf(-v)); }
  __syncthreads();
  const int cq = t & 15, kl = t >> 4, c0 = cgi * 64;
  float acc[4][4];
#pragma unroll
  for (int b = 0; b < 4; ++b)
#pragma unroll
    for (int j = 0; j < 4; ++j) acc[b][j] = 0.f;
  const float* wp = W + (size_t)(kbase + kl) * 12288 + c0 + cq * 4;
#pragma unroll 8
  for (int i = 0; i < 32; ++i) {
    const int k = kl + 16 * i;
    float4 w4 = *(const float4*)(wp + (size_t)i * 16 * 12288);
#pragma unroll
    for (int b = 0; b < 4; ++b) {
      const float a = cact[b * 512 + k];
      acc[b][0] += a * w4.x; acc[b][1] += a * w4.y; acc[b][2] += a * w4.z; acc[b][3] += a * w4.w;
    }
  }
#pragma unroll
  for (int b = 0; b < 4; ++b)
#pragma unroll
    for (int j = 0; j < 4; ++j) red[(kl * 16 + cq) * 17 + b * 4 + j] = acc[b][j];
  __syncthreads();
  {
    const int b = t >> 6, col = t & 63, q = col >> 2, j = col & 3;
    float s = 0.f;
#pragma unroll
    for (int k2 = 0; k2 < 16; ++k2) s += red[(k2 * 16 + q) * 17 + b * 4 + j];
    mod[(size_t)ksp * 49152 + b * 12288 + c0 + col] = s;
  }
}

constexpr int P0_MOD = 768;
constexpr int P0_TIN = 32 * 65, P0_TUQ = 8 * 24, P0_TUKV = 8 * 32, P0_TOUT = 32 * 32, P0_TWQ = 32 * 32;
constexpr int P0_SK = 32, P0_UV = 0, P0_ROPE = 32;
DI void phase0(const Params& p, char* smem) {
  constexpr int o1 = P0_MOD, o2 = o1 + P0_TIN, o3 = o2 + P0_TUQ, o4 = o3 + P0_TUKV, o5 = o4 + P0_TOUT, o6 = o5 + P0_TWQ, o7 = o6 + P0_SK, o8 = o7 + P0_UV, o9 = o8 + P0_UV, o10 = o9 + P0_ROPE;
  for (int it = blockIdx.x; it < o10; it += gridDim.x) {
    if (it < o1) mod_item(p, it, smem);
    else if (it < o2) { int j = it - o1; transpose_item(p.in[5], INC, 2048, nullptr, (u16*)(p.ws + WS_WINT), j / 65, j % 65, smem); }
    else if (it < o3) { int j = it - o2; transpose_item(p.in[8], 1536, 512, p.in[7], (u16*)(p.ws + WS_WUQT), j / 24, j % 24, smem); }
    else if (it < o4) { int j = it - o3; transpose_item(p.in[10], 2048, 512, p.in[9], (u16*)(p.ws + WS_WUKVT), j / 32, j % 32, smem); }
    else if (it < o5) { int j = it - o4; int tk = j / 32; transpose_item(p.in[13], 2048, 2048, tk < 16 ? p.in[11] : p.in[12] - 1024, (u16*)(p.ws + WS_WOUTT), tk, j % 32, smem); }
    else if (it < o6) { int j = it - o5; transpose_item(p.in[15], 2048, 2048, nullptr, (u16*)(p.ws + WS_WQT), j / 32, j % 32, smem); }
    else if (it < o7) convert_item(p.in[16], (u16*)(p.ws + WS_SK), (size_t)(it - o6) * 8192);
    else if (it < o8) fp8_rows_item(p.in[17], (unsigned char*)(p.ws + WS_U), (float*)(p.ws + WS_USC), it - o7);
    else if (it < o9) fp8_rows_item(p.in[18], (unsigned char*)(p.ws + WS_V), (float*)(p.ws + WS_VSC), it - o8);
    else {
      float2* rope = (float2*)(p.ws + WS_ROPE);
      const int base = (it - o9) * 2048;
      for (int e = threadIdx.x; e < 2048; e += 256) {
        const int idx = base + e, pos = idx >> 5, j = idx & 31;
        const float inv = 1.0f / powf(10000.0f, (float)(2 * j) / 64.0f);
        const float ang = (float)pos * inv;
        rope[idx] = make_float2(cosf(ang), sinf(ang));
      }
    }
  }
}

DI void norm_rows(const float* __restrict__ X, const float* __restrict__ g, const float* mod, int bstride, u16* __restrict__ out) {
  const int lane = threadIdx.x & 63, w = threadIdx.x >> 6;
  for (int row = blockIdx.x * 4 + w; row < T_; row += gridDim.x * 4) {
    const float* xr = X + (size_t)row * D_;
    float4 v[8];
    float ss = 0.f;
#pragma unroll
    for (int j = 0; j < 8; ++j) { v[j] = *(const float4*)(xr + j * 256 + lane * 4); ss += v[j].x * v[j].x + v[j].y * v[j].y + v[j].z * v[j].z + v[j].w * v[j].w; }
    ss = wave_sum(ss);
    const float rstd = rsqrtf(ss * (1.f / D_) + EPS);
    const int b = row >> 11;
    const float* sh = mod + b * bstride;
    const float* sc = sh + 2048;
#pragma unroll
    for (int j = 0; j < 8; ++j) {
      const int d = j * 256 + lane * 4;
      const float4 gg = *(const float4*)(g + d), s4 = *(const float4*)(sc + d), h4 = *(const float4*)(sh + d);
      const float o0 = v[j].x * rstd * gg.x * (1.f + s4.x) + h4.x;
      const float o1 = v[j].y * rstd * gg.y * (1.f + s4.y) + h4.y;
      const float o2 = v[j].z * rstd * gg.z * (1.f + s4.z) + h4.z;
      const float o3 = v[j].w * rstd * gg.w * (1.f + s4.w) + h4.w;
      *(uint2*)(out + (size_t)row * D_ + d) = make_uint2(pk2(o0, o1), pk2(o2, o3));
    }
  }
}
DI void phase1(const Params& p, char* smem) {
  const float* mp = (const float*)(p.ws + WS_MODP); float* mod = (float*)(p.ws + WS_MOD); const float* bias = p.in[3];
  for (int i = blockIdx.x * 256 + threadIdx.x; i < 49152; i += gridDim.x * 256)
    mod[i] = ((mp[i] + mp[49152 + i]) + mp[2 * 49152 + i]) + mp[3 * 49152 + i] + bias[i % 12288];
  float* lm = (float*)(smem + 16);
  __syncthreads();
  for (int i = threadIdx.x; i < 4 * 4096; i += 256) {
    const int b = i >> 12, c = i & 4095, src = b * 12288 + c;
    lm[i] = ((mp[src] + mp[49152 + src]) + mp[2 * 49152 + src]) + mp[3 * 49152 + src] + bias[c];
  }
  __syncthreads();
  norm_rows(p.in[0], p.in[4], lm, 4096, (u16*)(p.ws + WS_H));
}

constexpr int CTR_TILE = 3520, CTR_CHUNK = 3584;
DI int grab(unsigned* ctr, char* smem) {
  __syncthreads();
  if (threadIdx.x == 0) *(volatile unsigned*)(smem + 8) = atomicAdd(ctr, 1u);
  __syncthreads();
  return (int)*(volatile unsigned*)(smem + 8);
}
DI void uv_chunk(const Params& p, int c) {
#pragma unroll 1
  for (int i = 0; i < 4; ++i) {
    const int item = c * 4 + i;
    if (item < 4096) fp8_rows_item(p.in[17], (unsigned char*)(p.ws + WS_U), (float*)(p.ws + WS_USC), item);
    else fp8_rows_item(p.in[18], (unsigned char*)(p.ws + WS_V), (float*)(p.ws + WS_VSC), item - 4096);
  }
}
DI void phase2(const Params& p, char* smem) {
  const u16* H = (const u16*)(p.ws + WS_H); const u16* W = (const u16*)(p.ws + WS_WINT); u16* P = (u16*)(p.ws + WS_P);
  unsigned* ctr = (unsigned*)(p.ws + WS_BAR);
  if (blockIdx.x & 1) {
#pragma unroll 1
    for (int q = 0; q < 4; ++q) { const int c = grab(ctr + CTR_CHUNK, smem); if (c < 2048) uv_chunk(p, c); }
  }
  for (;;) {
    const int it = grab(ctr + CTR_TILE, smem);
    if (it >= 64 * 33) break;
    const int tn = it / 64, tm = it % 64;
    gemm_tile<true>(H, D_, W, D_, D_, tm * 128, tn * 128, smem, [&](f32x16 (&acc)[2][2], int mb, int nb, int r, int hi) __attribute__((always_inline)) {
      if (nb >= INC) return;
#pragma unroll
      for (int mi = 0; mi < 2; ++mi)
#pragma unroll
        for (int ni = 0; ni < 2; ++ni)
#pragma unroll
          for (int g = 0; g < 4; ++g) {
            const int row = mb + mi * 32 + r, col = nb + ni * 32 + hi * 4 + 8 * g;
            *(uint2*)(P + (size_t)row * INC + col) = make_uint2(pk2(acc[mi][ni][4 * g], acc[mi][ni][4 * g + 1]), pk2(acc[mi][ni][4 * g + 2], acc[mi][ni][4 * g + 3]));
          }
    });
  }
  for (;;) {
    const int c = grab(ctr + CTR_CHUNK, smem);
    if (c >= 2048) break;
    uv_chunk(p, c);
  }
}

DI void phase3(const Params& p, char* smem) {
  const u16* P = (const u16*)(p.ws + WS_P);
  u16* Q = (u16*)(p.ws + WS_Q); u16* Kb = (u16*)(p.ws + WS_K); u16* VT = (u16*)(p.ws + WS_VT); u16* MG = (u16*)(p.ws + WS_MG);
  const float2* rope = (const float2*)(p.ws + WS_ROPE);
  float* rs = (float*)(smem + 16 + 2 * 2 * 128 * 72 * 2);
  constexpr int NQ = 64 * 12, NKV = 64 * 16, NKR = 1024, NCV = 1024;
  const float qscale = 0.07216878364870322f * 1.4426950408889634f;
  for (int it = blockIdx.x; it < NQ + NKV + NKR + NCV; it += gridDim.x) {
    if (it < NQ) {
      const int tn = it / 64, tm = it % 64;
      __syncthreads();
      tile_rstd512(P + 3072, INC, tm * 128, rs);
      gemm_tile<true>(P + 3072, INC, (const u16*)(p.ws + WS_WUQT), 512, 512, tm * 128, tn * 128, smem, [&](f32x16 (&acc)[2][2], int mb, int nb, int r, int hi) __attribute__((always_inline)) {
        const bool is_rope = ((nb >> 6) % 3) == 2;
#pragma unroll
        for (int mi = 0; mi < 2; ++mi) {
          const int row = mb + mi * 32 + r;
          const float sc = rs[row - tm * 128] * qscale;
          const int pos = row & (S_ - 1);
#pragma unroll
          for (int g = 0; g < 4; ++g) {
            const int j = hi * 4 + 8 * g;
            float a0[4], a1[4];
#pragma unroll
            for (int e = 0; e < 4; ++e) { a0[e] = acc[mi][0][4 * g + e] * sc; a1[e] = acc[mi][1][4 * g + e] * sc; }
            if (is_rope) {
#pragma unroll
              for (int e = 0; e < 4; ++e) {
                const float2 cs = rope[pos * 32 + j + e];
                const float x1 = a0[e], x2 = a1[e];
                a0[e] = x1 * cs.x - x2 * cs.y; a1[e] = x2 * cs.x + x1 * cs.y;
              }
            }
            *(uint2*)(Q + (size_t)row * 1536 + nb + j) = make_uint2(pk2(a0[0], a0[1]), pk2(a0[2], a0[3]));
            *(uint2*)(Q + (size_t)row * 1536 + nb + 32 + j) = make_uint2(pk2(a1[0], a1[1]), pk2(a1[2], a1[3]));
          }
        }
      });
    } else if (it < NQ + NKV) {
      const int j2 = it - NQ, tn = j2 / 64, tm = j2 % 64;
      __syncthreads();
      tile_rstd512(P + 3584, INC, tm * 128, rs);
      const int head = tn >> 1;
      if ((tn & 1) == 0) {
        gemm_tile<true>(P + 3584, INC, (const u16*)(p.ws + WS_WUKVT), 512, 512, tm * 128, tn * 128, smem, [&](f32x16 (&acc)[2][2], int mb, int nb, int r, int hi) __attribute__((always_inline)) {
#pragma unroll
          for (int mi = 0; mi < 2; ++mi) {
            const int row = mb + mi * 32 + r;
            const float sc = rs[row - tm * 128];
#pragma unroll
            for (int ni = 0; ni < 2; ++ni)
#pragma unroll
              for (int g = 0; g < 4; ++g) {
                const int d = (nb & 127) + ni * 32 + hi * 4 + 8 * g;
                *(uint2*)(Kb + (size_t)row * 1536 + head * 192 + d) = make_uint2(pk2(acc[mi][ni][4 * g] * sc, acc[mi][ni][4 * g + 1] * sc), pk2(acc[mi][ni][4 * g + 2] * sc, acc[mi][ni][4 * g + 3] * sc));
              }
          }
        });
      } else {
        gemm_tile<false>(P + 3584, INC, (const u16*)(p.ws + WS_WUKVT), 512, 512, tm * 128, tn * 128, smem, [&](f32x16 (&acc)[2][2], int mb, int nb, int r, int hi) __attribute__((always_inline)) {
#pragma unroll
          for (int mi = 0; mi < 2; ++mi)
#pragma unroll
            for (int g = 0; g < 4; ++g) {
              const int row0 = mb + mi * 32 + hi * 4 + 8 * g;
              const float s0 = rs[row0 - tm * 128], s1 = rs[row0 + 1 - tm * 128], s2 = rs[row0 + 2 - tm * 128], s3 = rs[row0 + 3 - tm * 128];
              const int b = row0 >> 11, t = row0 & (S_ - 1);
#pragma unroll
              for (int ni = 0; ni < 2; ++ni) {
                const int d = (nb & 127) + ni * 32 + r;
                *(uint2*)(VT + ((size_t)((b * 8 + head) * 128 + d)) * S_ + t) = make_uint2(pk2(acc[mi][ni][4 * g] * s0, acc[mi][ni][4 * g + 1] * s1), pk2(acc[mi][ni][4 * g + 2] * s2, acc[mi][ni][4 * g + 3] * s3));
              }
            }
        });
      }
    } else if (it < NQ + NKV + NKR) {
      const int j2 = it - NQ - NKV;
      const int row = j2 * 8 + (threadIdx.x >> 5), j = threadIdx.x & 31, pos = row & (S_ - 1);
      const float x1 = bflo((unsigned)P[(size_t)row * INC + 4096 + j]), x2 = bflo((unsigned)P[(size_t)row * INC + 4096 + 32 + j]);
      const float2 cs = rope[pos * 32 + j];
      const float o1 = x1 * cs.x - x2 * cs.y, o2 = x2 * cs.x + x1 * cs.y;
      const u16 b1 = (u16)(pk2(o1, 0.f) & 0xffffu), b2 = (u16)(pk2(o2, 0.f) & 0xffffu);
#pragma unroll
      for (int h = 0; h < 8; ++h) { Kb[(size_t)row * 1536 + h * 192 + 128 + j] = b1; Kb[(size_t)row * 1536 + h * 192 + 160 + j] = b2; }
    } else {
      const int j2 = it - NQ - NKV - NKR;
      const int wi = j2 * 4 + (threadIdx.x >> 6), lane = threadIdx.x & 63;
      const int g = wi & 7, run = wi >> 3;
      const int row0 = run * 16, t0 = row0 & (S_ - 1);
      const int ch = g * 128 + lane * 2;
      const float* cw = p.in[6];
      const float w00 = cw[ch], w01 = cw[ch + 1], w10 = cw[1024 + ch], w11 = cw[1024 + ch + 1], w20 = cw[2048 + ch], w21 = cw[2048 + ch + 1];
      float zm1a = 0.f, zm1b = 0.f, zm2a = 0.f, zm2b = 0.f;
      if (t0 > 0) {
        const unsigned c1 = *(const unsigned*)(P + (size_t)(row0 - 1) * INC + 1024 + ch), h1 = *(const unsigned*)(P + (size_t)(row0 - 1) * INC + 2048 + ch);
        const unsigned c2 = *(const unsigned*)(P + (size_t)(row0 - 2) * INC + 1024 + ch), h2 = *(const unsigned*)(P + (size_t)(row0 - 2) * INC + 2048 + ch);
        zm1a = bflo(c1) * bflo(h1); zm1b = bfhi(c1) * bfhi(h1); zm2a = bflo(c2) * bflo(h2); zm2b = bfhi(c2) * bfhi(h2);
      }
#pragma unroll 4
      for (int tt = 0; tt < 16; ++tt) {
        const size_t ro = (size_t)(row0 + tt) * INC;
        const unsigned bb = *(const unsigned*)(P + ro + ch), cc = *(const unsigned*)(P + ro + 1024 + ch), hh = *(const unsigned*)(P + ro + 2048 + ch);
        const float za = bflo(cc) * bflo(hh), zb = bfhi(cc) * bfhi(hh);
        const float ya = bflo(bb) * (w00 * zm2a + w10 * zm1a + w20 * za), yb = bfhi(bb) * (w01 * zm2b + w11 * zm1b + w21 * zb);
        zm2a = zm1a; zm2b = zm1b; zm1a = za; zm1b = zb;
        const float ss = wave_sum(ya * ya + yb * yb);
        const float rstd = rsqrtf(ss * (1.f / 128.f) + EPS);
        *(unsigned*)(MG + (size_t)(row0 + tt) * D_ + ch) = pk2(ya * rstd, yb * rstd);
      }
    }
  }
}

DI void phase4(const Params& p, char* smem) {
  const u16* Q = (const u16*)(p.ws + WS_Q); const u16* Kb = (const u16*)(p.ws + WS_K); const u16* VT = (const u16*)(p.ws + WS_VT);
  u16* MG = (u16*)(p.ws + WS_MG);
  u16* Ks = (u16*)(smem + 16);
  u16* Vs = Ks + 64 * 200;
  float* mrg = (float*)(smem + 16);
  const int tid = threadIdx.x, lane = tid & 63, w = tid >> 6, qh = w & 1, kh = w >> 1, r = lane & 31, hi = lane >> 5;
  for (int it = blockIdx.x; it < 512; it += gridDim.x) {
    const int pi = it & 15, h = (it >> 4) & 7, b = it >> 7;
    for (int sub = 0; sub < 2; ++sub) {
      const int c = sub ? (31 - pi) : pi;
      const size_t qrow = (size_t)b * S_ + c * 64 + qh * 32 + r;
      bf16x8 qf[12];
#pragma unroll
      for (int ks = 0; ks < 12; ++ks) qf[ks] = *(const bf16x8*)(Q + qrow * 1536 + h * 192 + ks * 16 + hi * 8);
      f32x16 O[4];
#pragma unroll
      for (int dt = 0; dt < 4; ++dt)
#pragma unroll
        for (int i = 0; i < 16; ++i) O[dt][i] = 0.f;
      float m = -1e30f, l = 0.f;
      u32x4 kr[6]; u32x4 vr[4];
      const u16* kg = Kb + ((size_t)b * S_ + (tid >> 2)) * 1536 + h * 192 + (tid & 3) * 8;
      const u16* vg = VT + ((size_t)((b * 8 + h) * 128 + (tid >> 1))) * S_ + (tid & 1) * 8;
      u16* ksw = Ks + (tid >> 2) * 200 + (tid & 3) * 8;
      u16* vsw = Vs + (tid >> 1) * 68 + (tid & 1) * 8;
      auto load_tile = [&]() __attribute__((always_inline)) {
#pragma unroll
        for (int i = 0; i < 6; ++i) kr[i] = *(const u32x4*)(kg + i * 32);
#pragma unroll
        for (int i = 0; i < 4; ++i) vr[i] = *(const u32x4*)(vg + i * 16);
        kg += 64 * 1536; vg += 64;
      };
      load_tile();
      for (int kt = 0; kt <= c; ++kt) {
        __syncthreads();
#pragma unroll
        for (int i = 0; i < 6; ++i) *(u32x4*)(ksw + i * 32) = kr[i];
#pragma unroll
        for (int i = 0; i < 4; ++i) { u32x2 lo2 = {vr[i][0], vr[i][1]}, hi2 = {vr[i][2], vr[i][3]}; *(u32x2*)(vsw + i * 16) = lo2; *(u32x2*)(vsw + i * 16 + 4) = hi2; }
        __syncthreads();
        if (kt < c) load_tile();
        f32x16 s;
#pragma unroll
        for (int i = 0; i < 16; ++i) s[i] = 0.f;
        const u16* kp = Ks + (kh * 32 + r) * 200 + hi * 8;
#pragma unroll
        for (int ks = 0; ks < 12; ++ks) { bf16x8 kf = *(const bf16x8*)(kp + ks * 16); s = MFMA(kf, qf[ks], s); }
        float mx = s[0];
#pragma unroll
        for (int i = 1; i < 16; ++i) mx = fmaxf(mx, s[i]);
        mx = fmaxf(mx, __shfl_xor(mx, 32));
        const float mn = fmaxf(m, mx);
        const float alpha = exp2f(m - mn);
        m = mn;
        float rsum = 0.f;
#pragma unroll
        for (int i = 0; i < 16; ++i) { s[i] = exp2f(s[i] - mn); rsum += s[i]; }
        l = l * alpha + rsum;
#pragma unroll
        for (int dt = 0; dt < 4; ++dt)
#pragma unroll
          for (int i = 0; i < 16; ++i) O[dt][i] *= alpha;
#pragma unroll
        for (int st = 0; st < 2; ++st) {
          uint4 pu = make_uint4(pk2(s[8 * st], s[8 * st + 1]), pk2(s[8 * st + 2], s[8 * st + 3]), pk2(s[8 * st + 4], s[8 * st + 5]), pk2(s[8 * st + 6], s[8 * st + 7]));
          const bf16x8 pf = __builtin_bit_cast(bf16x8, pu);
#pragma unroll
          for (int dt = 0; dt < 4; ++dt) {
            const u16* vp = Vs + (dt * 32 + r) * 68 + kh * 32 + 16 * st + 4 * hi;
            uint2 v0 = *(const uint2*)vp, v1 = *(const uint2*)(vp + 8);
            const bf16x8 vf = __builtin_bit_cast(bf16x8, make_uint4(v0.x, v0.y, v1.x, v1.y));
            O[dt] = MFMA(vf, pf, O[dt]);
          }
        }
      }
      l += __shfl_xor(l, 32);
      __syncthreads();
      float* mq = mrg + qh * 66 * 64;
      if (kh == 1) {
#pragma unroll
        for (int dt = 0; dt < 4; ++dt)
#pragma unroll
          for (int i = 0; i < 16; ++i) mq[(dt * 16 + i) * 64 + lane] = O[dt][i];
        mq[64 * 64 + lane] = m; mq[65 * 64 + lane] = l;
      }
      __syncthreads();
      if (kh == 0) {
        const float m1 = mq[64 * 64 + lane], l1 = mq[65 * 64 + lane];
        const float mt = fmaxf(m, m1), a0 = exp2f(m - mt), a1 = exp2f(m1 - mt);
        const float inv = 1.f / (l * a0 + l1 * a1);
        float ss = 0.f;
#pragma unroll
        for (int dt = 0; dt < 4; ++dt)
#pragma unroll
          for (int i = 0; i < 16; ++i) { const float o = (O[dt][i] * a0 + mq[(dt * 16 + i) * 64 + lane] * a1) * inv; O[dt][i] = o; ss += o * o; }
        ss += __shfl_xor(ss, 32);
        const float rstd = rsqrtf(ss * (1.f / 128.f) + EPS);
#pragma unroll
        for (int dt = 0; dt < 4; ++dt)
#pragma unroll
          for (int g = 0; g < 4; ++g) {
            const int d = dt * 32 + hi * 4 + 8 * g;
            *(uint2*)(MG + qrow * D_ + 1024 + h * 128 + d) = make_uint2(pk2(O[dt][4 * g] * rstd, O[dt][4 * g + 1] * rstd), pk2(O[dt][4 * g + 2] * rstd, O[dt][4 * g + 3] * rstd));
          }
      }
    }
  }
}

DI void phase5(const Params& p, char* smem) {
  const u16* MG = (const u16*)(p.ws + WS_MG); const u16* W = (const u16*)(p.ws + WS_WOUTT);
  const float* X = p.in[0]; const float* mod = (const float*)(p.ws + WS_MOD); float* X1 = (float*)(p.ws + WS_X1);
  for (int it = blockIdx.x; it < 64 * 16; it += gridDim.x) {
    const int tn = it / 64, tm = it % 64;
    gemm_tile<true>(MG, D_, W, D_, D_, tm * 128, tn * 128, smem, [&](f32x16 (&acc)[2][2], int mb, int nb, int r, int hi) __attribute__((always_inline)) {
#pragma unroll
      for (int mi = 0; mi < 2; ++mi) {
        const int row = mb + mi * 32 + r, b = row >> 11;
        const float* gt = mod + b * 12288 + 2 * 2048;
#pragma unroll
        for (int ni = 0; ni < 2; ++ni)
#pragma unroll
          for (int g = 0; g < 4; ++g) {
            const int col = nb + ni * 32 + hi * 4 + 8 * g;
            const float4 xv = *(const float4*)(X + (size_t)row * D_ + col), gv = *(const float4*)(gt + col);
            float4 o;
            o.x = xv.x + gv.x * acc[mi][ni][4 * g]; o.y = xv.y + gv.y * acc[mi][ni][4 * g + 1]; o.z = xv.z + gv.z * acc[mi][ni][4 * g + 2]; o.w = xv.w + gv.w * acc[mi][ni][4 * g + 3];
            *(float4*)(X1 + (size_t)row * D_ + col) = o;
          }
      }
    });
  }
}

DI void phase7(const Params& p, char* smem) {
  const u16* H2 = (const u16*)(p.ws + WS_H); const u16* W = (const u16*)(p.ws + WS_WQT); u16* PQ = (u16*)(p.ws + WS_P);
  for (int it = blockIdx.x; it < 64 * 16; it += gridDim.x) {
    const int tn = it / 64, tm = it % 64;
    gemm_tile<true>(H2, D_, W, D_, D_, tm * 128, tn * 128, smem, [&](f32x16 (&acc)[2][2], int mb, int nb, int r, int hi) __attribute__((always_inline)) {
#pragma unroll
      for (int mi = 0; mi < 2; ++mi)
#pragma unroll
        for (int ni = 0; ni < 2; ++ni)
#pragma unroll
          for (int g = 0; g < 4; ++g) {
            const int row = mb + mi * 32 + r, col = nb + ni * 32 + hi * 4 + 8 * g;
            *(uint2*)(PQ + (size_t)row * D_ + col) = make_uint2(pk2(acc[mi][ni][4 * g], acc[mi][ni][4 * g + 1]), pk2(acc[mi][ni][4 * g + 2], acc[mi][ni][4 * g + 3]));
          }
    });
  }
}

DI unsigned f2ord(float v) { unsigned u = __float_as_uint(v); return u ^ ((unsigned)((int)u >> 31) | 0x80000000u); }
#define TOPK_INSERT(keys, x) { _Pragma("unroll") for (int _j = 0; _j < 16; ++_j) { const unsigned _h = max(keys[_j], x); x = min(keys[_j], x); keys[_j] = _h; } }
DI void phase8(const Params& p, char* smem) {
  const u16* PQ = (const u16*)(p.ws + WS_P); const u16* SK = (const u16*)(p.ws + WS_SK);
  int* IDS = (int*)(p.ws + WS_IDS); float* GATE = (float*)(p.ws + WS_GATE);
  float* sc = (float*)(smem + 16);
  const int tid = threadIdx.x, lane = tid & 63, w = tid >> 6, r = lane & 31, hi = lane >> 5;
  for (int it = blockIdx.x; it < 128 * 8; it += gridDim.x) {
    const int h = it & 7, tile = it >> 3;
    const int pp = w >> 1, rh = w & 1;
    __syncthreads();
    {
      f32x16 acc[4];
#pragma unroll
      for (int nt = 0; nt < 4; ++nt)
#pragma unroll
        for (int i = 0; i < 16; ++i) acc[nt][i] = 0.f;
      const u16* ap = PQ + (size_t)(tile * 64 + rh * 32 + r) * D_ + h * 256 + pp * 128 + hi * 8;
      const u16* bp = SK + ((size_t)(h * 2 + pp) * 128 + r) * 128 + hi * 8;
#pragma unroll
      for (int ks = 0; ks < 8; ++ks) {
        const bf16x8 af = *(const bf16x8*)(ap + ks * 16);
#pragma unroll
        for (int nt = 0; nt < 4; ++nt) { const bf16x8 bf = *(const bf16x8*)(bp + nt * 32 * 128 + ks * 16); acc[nt] = MFMA(af, bf, acc[nt]); }
      }
#pragma unroll
      for (int nt = 0; nt < 4; ++nt)
#pragma unroll
        for (int i = 0; i < 16; ++i) sc[(pp * 64 + rh * 32 + hi * 4 + (i & 3) + 8 * (i >> 2)) * 129 + nt * 32 + r] = acc[nt][i];
    }
    __syncthreads();
    if (tid < 128) {
      float* row = sc + tid * 129;
      unsigned keys[16];
#pragma unroll
      for (int j = 0; j < 16; ++j) keys[j] = 0u;
#pragma unroll 4
      for (int n = 0; n < 128; ++n) {
        unsigned x = (f2ord(row[n]) & 0xFFFFFF80u) | (unsigned)(127 - n);
        TOPK_INSERT(keys, x);
      }
      float vals[16];
#pragma unroll
      for (int j = 0; j < 16; ++j) vals[j] = row[127 - (keys[j] & 127u)];
#pragma unroll
      for (int j = 0; j < 16; ++j) { row[j] = vals[j]; row[16 + j] = __int_as_float((int)(127 - (keys[j] & 127u))); }
    }
    __syncthreads();
    if (tid < 64) {
      const float* ra = sc + tid * 129; const float* rb = sc + (64 + tid) * 129;
      float a[16], bq[16];
#pragma unroll
      for (int j = 0; j < 16; ++j) { a[j] = ra[j]; bq[j] = rb[j]; }
      unsigned keys[16];
#pragma unroll
      for (int j = 0; j < 16; ++j) keys[j] = 0u;
#pragma unroll
      for (int i = 0; i < 16; ++i)
#pragma unroll
        for (int j = 0; j < 16; ++j)
          if ((i + 1) * (j + 1) <= 16) {
            unsigned x = (f2ord(a[i] + bq[j]) & 0xFFFFFF00u) | (unsigned)(255 - (i * 16 + j));
            TOPK_INSERT(keys, x);
          }
      float bv[16]; int ex[16];
      float mx = -1e30f;
#pragma unroll
      for (int q = 0; q < 16; ++q) {
        const int flat = 255 - (int)(keys[q] & 255u), i = flat >> 4, j = flat & 15;
        bv[q] = ra[i] + rb[j];
        ex[q] = __float_as_int(ra[16 + i]) * 128 + __float_as_int(rb[16 + j]);
        mx = fmaxf(mx, bv[q]);
      }
      float sum = 0.f;
#pragma unroll
      for (int q = 0; q < 16; ++q) { bv[q] = __expf(bv[q] - mx); sum += bv[q]; }
      const float inv = 1.f / sum;
      const size_t o = (size_t)(tile * 64 + tid) * 128 + h * 16;
#pragma unroll
      for (int q = 0; q < 16; q += 4) {
        *(int4*)(IDS + o + q) = make_int4(ex[q], ex[q + 1], ex[q + 2], ex[q + 3]);
        *(float4*)(GATE + o + q) = make_float4(bv[q] * inv, bv[q + 1] * inv, bv[q + 2] * inv, bv[q + 3] * inv);
      }
    }
  }
}

constexpr int CTR_UQ = 4096, CTR_VQ = 4608;
DI f2_t cvt8lo(unsigned w) { return __builtin_amdgcn_cvt_pk_f32_fp8(w, false); }
DI f2_t cvt8hi(unsigned w) { return __builtin_amdgcn_cvt_pk_f32_fp8(w, true); }
template <class F>
DI void xcd_queue(unsigned* ctrs, int nchunks, char* smem, F&& f) {
  const int x0 = (int)(xb_xcc_id() & 7u);
#pragma unroll 1
  for (int k = 0; k < 8; ++k) {
    const int s = (x0 + k) & 7;
    for (;;) { const int c = grab(ctrs + 64 * s, smem); if (c >= nchunks) break; f(s, c); }
  }
}
DI void wave_lds_sync() { asm volatile("s_waitcnt lgkmcnt(0)" ::: "memory"); __builtin_amdgcn_wave_barrier(); }

DI void phase9(const Params& p, char* smem) {
  const u16* H2 = (const u16*)(p.ws + WS_H); const unsigned char* U8 = (const unsigned char*)(p.ws + WS_U);
  const int* IDS = (const int*)(p.ws + WS_IDS); float* PA = (float*)(p.ws + WS_PA);
  const int lane = threadIdx.x & 63, w = threadIdx.x >> 6, g = lane >> 4, l15 = lane & 15;
  const int b3 = (lane >> 3) & 1, b2 = (lane >> 2) & 1, b1 = (lane >> 1) & 1, b0 = lane & 1;
  int* lw = (int*)(smem + 16) + w * 256;
  xcd_queue((unsigned*)(p.ws + WS_BAR) + CTR_UQ, 512, smem, [&](int s, int c) __attribute__((always_inline)) {
#pragma unroll 1
    for (int t = 0; t < 4; ++t) {
      const int tok = __builtin_amdgcn_readfirstlane(c * 16 + w * 4 + t);
      const int i0 = IDS[(size_t)tok * 128 + lane], i1 = IDS[(size_t)tok * 128 + 64 + lane];
      const u16* hptr = H2 + (size_t)tok * D_ + s * 256 + l15 * 16;
      const uint4 h0 = *(const uint4*)hptr, h1 = *(const uint4*)(hptr + 8);
      wave_lds_sync();
      lw[(lane & 3) * 32 + (lane >> 2)] = i0;
      lw[(lane & 3) * 32 + 16 + (lane >> 2)] = i1;
      wave_lds_sync();
      f2_t hp[8];
      hp[0] = f2_t{bflo(h0.x), bfhi(h0.x)}; hp[1] = f2_t{bflo(h0.y), bfhi(h0.y)}; hp[2] = f2_t{bflo(h0.z), bfhi(h0.z)}; hp[3] = f2_t{bflo(h0.w), bfhi(h0.w)};
      hp[4] = f2_t{bflo(h1.x), bfhi(h1.x)}; hp[5] = f2_t{bflo(h1.y), bfhi(h1.y)}; hp[6] = f2_t{bflo(h1.z), bfhi(h1.z)}; hp[7] = f2_t{bflo(h1.w), bfhi(h1.w)};
      const unsigned char* ub = U8 + s * 256 + l15 * 16;
#pragma unroll
      for (int batch = 0; batch < 2; ++batch) {
        int ida[16];
#pragma unroll
        for (int q = 0; q < 4; ++q) { const int4 v = *(const int4*)(lw + g * 32 + batch * 16 + q * 4); ida[q * 4] = v.x; ida[q * 4 + 1] = v.y; ida[q * 4 + 2] = v.z; ida[q * 4 + 3] = v.w; }
        u32x4 rows[16];
#pragma unroll
        for (int k = 0; k < 16; ++k) rows[k] = *(const u32x4*)(ub + (size_t)ida[k] * 2048);
        float part[16];
#pragma unroll
        for (int k = 0; k < 16; ++k) {
          f2_t acc = {0.f, 0.f};
#pragma unroll
          for (int d = 0; d < 4; ++d) { const unsigned ww = rows[k][d]; acc += cvt8lo(ww) * hp[2 * d]; acc += cvt8hi(ww) * hp[2 * d + 1]; }
          part[k] = acc.x + acc.y;
        }
        float q8[8], q4[4], q2[2];
#pragma unroll
        for (int k = 0; k < 8; ++k) q8[k] = (b3 ? part[8 + k] : part[k]) + __shfl_xor(b3 ? part[k] : part[8 + k], 8);
#pragma unroll
        for (int k = 0; k < 4; ++k) q4[k] = (b2 ? q8[4 + k] : q8[k]) + __shfl_xor(b2 ? q8[k] : q8[4 + k], 4);
#pragma unroll
        for (int k = 0; k < 2; ++k) q2[k] = (b1 ? q4[2 + k] : q4[k]) + __shfl_xor(b1 ? q4[k] : q4[2 + k], 2);
        const float rr = (b0 ? q2[1] : q2[0]) + __shfl_xor(b0 ? q2[0] : q2[1], 1);
        PA[((size_t)s * T_ + tok) * 128 + 4 * (batch * 16 + l15) + g] = rr;
      }
    }
  });
}

DI void phase10(const Params& p) {
  const float* PA = (const float*)(p.ws + WS_PA); float* ACT = (float*)(p.ws + WS_ACT);
  const int* IDS = (const int*)(p.ws + WS_IDS); const float* GATE = (const float*)(p.ws + WS_GATE);
  const float* USC = (const float*)(p.ws + WS_USC); const float* VSC = (const float*)(p.ws + WS_VSC);
  for (int i = blockIdx.x * 256 + threadIdx.x; i < T_ * 128; i += gridDim.x * 256) {
    float a = 0.f;
#pragma unroll
    for (int s = 0; s < 8; ++s) a += PA[(size_t)s * T_ * 128 + i];
    const int id = IDS[i];
    a *= USC[id];
    ACT[i] = 0.5f * a * (1.f + erff(a * 0.70710678118654752f)) * GATE[i] * VSC[id];
  }
}

DI void phase11(const Params& p, char* smem) {
  const unsigned char* V8 = (const unsigned char*)(p.ws + WS_V);
  const int* IDS = (const int*)(p.ws + WS_IDS); const float* ACT = (const float*)(p.ws + WS_ACT); float* OUTP = (float*)(p.ws + WS_OUTP);
  const int lane = threadIdx.x & 63, w = threadIdx.x >> 6, g = lane >> 4, l15 = lane & 15;
  const int b5 = (lane >> 5) & 1, b4 = (lane >> 4) & 1;
  int* lw = (int*)(smem + 16) + w * 256;
  float* lf = (float*)(lw + 128);
  xcd_queue((unsigned*)(p.ws + WS_BAR) + CTR_VQ, 512, smem, [&](int s, int c) __attribute__((always_inline)) {
#pragma unroll 1
    for (int t = 0; t < 4; ++t) {
      const int tok = __builtin_amdgcn_readfirstlane(c * 16 + w * 4 + t);
      const int i0 = IDS[(size_t)tok * 128 + lane], i1 = IDS[(size_t)tok * 128 + 64 + lane];
      const float a0 = ACT[(size_t)tok * 128 + lane], a1 = ACT[(size_t)tok * 128 + 64 + lane];
      wave_lds_sync();
      lw[(lane & 3) * 32 + (lane >> 2)] = i0; lw[(lane & 3) * 32 + 16 + (lane >> 2)] = i1;
      lf[(lane & 3) * 32 + (lane >> 2)] = a0; lf[(lane & 3) * 32 + 16 + (lane >> 2)] = a1;
      wave_lds_sync();
      f2_t o[8];
#pragma unroll
      for (int i = 0; i < 8; ++i) o[i] = f2_t{0.f, 0.f};
      const unsigned char* vb = V8 + s * 256 + l15 * 16;
#pragma unroll
      for (int batch = 0; batch < 2; ++batch) {
        int ida[16]; float aa[16];
#pragma unroll
        for (int q = 0; q < 4; ++q) {
          const int4 v = *(const int4*)(lw + g * 32 + batch * 16 + q * 4); ida[q * 4] = v.x; ida[q * 4 + 1] = v.y; ida[q * 4 + 2] = v.z; ida[q * 4 + 3] = v.w;
          const float4 f = *(const float4*)(lf + g * 32 + batch * 16 + q * 4); aa[q * 4] = f.x; aa[q * 4 + 1] = f.y; aa[q * 4 + 2] = f.z; aa[q * 4 + 3] = f.w;
        }
        u32x4 rows[16];
#pragma unroll
        for (int k = 0; k < 16; ++k) rows[k] = *(const u32x4*)(vb + (size_t)ida[k] * 2048);
#pragma unroll
        for (int k = 0; k < 16; ++k) {
          const f2_t a2 = {aa[k], aa[k]};
#pragma unroll
          for (int d = 0; d < 4; ++d) { const unsigned ww = rows[k][d]; o[2 * d] += a2 * cvt8lo(ww); o[2 * d + 1] += a2 * cvt8hi(ww); }
        }
      }
      float ov[16];
#pragma unroll
      for (int d = 0; d < 4; ++d) { ov[4 * d] = o[2 * d].x; ov[4 * d + 1] = o[2 * d].y; ov[4 * d + 2] = o[2 * d + 1].x; ov[4 * d + 3] = o[2 * d + 1].y; }
      float q8[8], q4[4];
#pragma unroll
      for (int k = 0; k < 8; ++k) q8[k] = (b5 ? ov[8 + k] : ov[k]) + __shfl_xor(b5 ? ov[k] : ov[8 + k], 32);
#pragma unroll
      for (int k = 0; k < 4; ++k) q4[k] = (b4 ? q8[4 + k] : q8[k]) + __shfl_xor(b4 ? q8[k] : q8[4 + k], 16);
      *(float4*)(OUTP + (size_t)tok * D_ + s * 256 + l15 * 16 + 8 * b5 + 4 * b4) = make_float4(q4[0], q4[1], q4[2], q4[3]);
    }
  });
}

DI void phase12(const Params& p) {
  const float* X1 = (const float*)(p.ws + WS_X1); const float* OUTP = (const float*)(p.ws + WS_OUTP);
  const float* mod = (const float*)(p.ws + WS_MOD); const float* gfin = p.in[19];
  const int lane = threadIdx.x & 63, w = threadIdx.x >> 6;
  for (int row = blockIdx.x * 4 + w; row < T_; row += gridDim.x * 4) {
    const float* gt = mod + (row >> 11) * 12288 + 5 * 2048;
    float4 v[8];
    float ss = 0.f;
#pragma unroll
    for (int j = 0; j < 8; ++j) {
      const int d = j * 256 + lane * 4;
      const float4 xv = *(const float4*)(X1 + (size_t)row * D_ + d), ov = *(const float4*)(OUTP + (size_t)row * D_ + d), gv = *(const float4*)(gt + d);
      v[j] = make_float4(xv.x + gv.x * ov.x, xv.y + gv.y * ov.y, xv.z + gv.z * ov.z, xv.w + gv.w * ov.w);
      ss += v[j].x * v[j].x + v[j].y * v[j].y + v[j].z * v[j].z + v[j].w * v[j].w;
    }
    ss = wave_sum(ss);
    const float rstd = rsqrtf(ss * (1.f / D_) + EPS);
#pragma unroll
    for (int j = 0; j < 8; ++j) {
      const int d = j * 256 + lane * 4;
      const float4 gv = *(const float4*)(gfin + d);
      *(float4*)(p.out + (size_t)row * D_ + d) = make_float4(v[j].x * rstd * gv.x, v[j].y * rstd * gv.y, v[j].z * rstd * gv.z, v[j].w * rstd * gv.w);
    }
  }
}

__global__ void __launch_bounds__(256, 2) mega(Params p) {
  extern __shared__ __attribute__((aligned(16))) char smem[];
  XcdBarrier xb;
  const bool multi = (p.ph_hi - p.ph_lo) > 1;
  if (multi) {
    if (threadIdx.x == 0) *(uint4*)smem = make_uint4(0u, 0u, 0u, 0u);
    __syncthreads();
    xb = xcd_barrier_post((unsigned*)(p.ws + WS_BAR), (volatile LAS unsigned*)smem);
  }
#ifndef PHMASK
#define PHMASK 0x1fff
#endif
#ifndef REPMASK
#define REPMASK 0
#endif
#define RUN_PHASE(n, call) if (p.ph_lo <= (n) && (n) < p.ph_hi) { \
    if ((n) > p.ph_lo) { xcd_barrier(xb); } \
    if (PHMASK & (1 << (n))) { call; if (REPMASK & (1 << (n))) { __syncthreads(); call; } } }
  RUN_PHASE(0, phase0(p, smem))
  RUN_PHASE(1, phase1(p, smem))
#ifdef BARX
  for (int i = 0; i < BARX; ++i) xcd_barrier(xb);
#endif
  RUN_PHASE(2, phase2(p, smem))
  RUN_PHASE(3, phase3(p, smem))
  RUN_PHASE(4, phase4(p, smem))
  RUN_PHASE(5, phase5(p, smem))
  RUN_PHASE(6, norm_rows((const float*)(p.ws + WS_X1), p.in[14], (const float*)(p.ws + WS_MOD) + 3 * 2048, 12288, (u16*)(p.ws + WS_H)))
  RUN_PHASE(7, phase7(p, smem))
  RUN_PHASE(8, phase8(p, smem))
  RUN_PHASE(9, phase9(p, smem))
  RUN_PHASE(10, phase10(p))
  RUN_PHASE(11, phase11(p, smem))
  RUN_PHASE(12, phase12(p))
}

extern "C" void kernel_launch(void* const* d_in, const int* in_sizes, int n_in, void* d_out, int out_size, void* d_ws, size_t ws_size, hipStream_t stream) {
  static int grid = 0;
  if (grid == 0) {
    if (n_in != 20 || ws_size < WS_END) { fprintf(stderr, "kernel_launch: unexpected n_in %d / ws_size %zu (need %zu)\n", n_in, ws_size, (size_t)WS_END); grid = -1; return; }
    int dev = 0, cus = 0, per_cu = 0;
    hipGetDevice(&dev);
    hipDeviceGetAttribute(&cus, hipDeviceAttributeMultiprocessorCount, dev);
    hipFuncSetAttribute((const void*)mega, hipFuncAttributeMaxDynamicSharedMemorySize, LDS_BYTES);
    hipOccupancyMaxActiveBlocksPerMultiprocessor(&per_cu, (const void*)mega, 256, LDS_BYTES);
    if (per_cu < 1) { fprintf(stderr, "kernel_launch: occupancy query says %d\n", per_cu); per_cu = 1; }
    if (per_cu > 2) per_cu = 2;
    grid = cus * per_cu;
    fprintf(stderr, "kernel_launch: grid %d (%d per CU)\n", grid, per_cu);
  }
  if (grid < 0) return;
  Params p{};
  for (int i = 0; i < 20; ++i) p.in[i] = (const float*)d_in[i];
  p.out = (float*)d_out; p.ws = (char*)d_ws;
#if N_LAUNCH_PER_PHASE
  p.coop = 0;
  for (int ph = 0; ph < NPH; ++ph) {
    p.ph_lo = ph; p.ph_hi = ph + 1;
    hipLaunchKernelGGL(mega, dim3(grid), dim3(256), LDS_BYTES, stream, p);
  }
#else
  hipMemsetAsync((char*)d_ws + WS_BAR, 0, WS_MOD, stream);
  p.coop = 0; p.ph_lo = 0; p.ph_hi = NPH;
  void* args[] = {&p};
  hipError_t e = hipLaunchCooperativeKernel((const void*)mega, dim3(grid), dim3(256), args, LDS_BYTES, stream);
  if (e != hipSuccess) fprintf(stderr, "cooperative launch failed: %s (grid %d)\n", hipGetErrorString(e), grid);
#endif
}
```

```cpp
#include <hip/hip_runtime.h>
#include <cstdio>
#include <cstdint>

#ifndef N_LAUNCH_PER_PHASE
#define N_LAUNCH_PER_PHASE 0
#endif

#define DI __device__ __forceinline__
typedef unsigned short u16;
typedef __attribute__((ext_vector_type(8))) short bf16x8;
typedef __attribute__((ext_vector_type(16))) float f32x16;
typedef __attribute__((ext_vector_type(2))) __bf16 bf2_t;
typedef __attribute__((ext_vector_type(2))) float f2_t;
typedef __attribute__((ext_vector_type(4))) unsigned u32x4;
typedef __attribute__((ext_vector_type(2))) unsigned u32x2;
#define MFMA(a, b, c) __builtin_amdgcn_mfma_f32_32x32x16_bf16((a), (b), (c), 0, 0, 0)

constexpr int T_ = 8192, D_ = 2048, S_ = 2048;
constexpr int INC = 4160;
constexpr float EPS = 1e-6f;
constexpr int NPH = 13;

constexpr size_t al256(size_t x) { return (x + 255) & ~(size_t)255; }
constexpr size_t WS_BAR = 0;
constexpr size_t WS_MOD = 32768;
constexpr size_t WS_ROPE = WS_MOD + al256(4 * 12288 * 4);
constexpr size_t WS_WINT = WS_ROPE + al256(2048 * 32 * 8);
constexpr size_t WS_WUQT = WS_WINT + al256((size_t)4224 * 2048 * 2);
constexpr size_t WS_WUKVT = WS_WUQT + al256((size_t)1536 * 512 * 2);
constexpr size_t WS_WOUTT = WS_WUKVT + al256((size_t)2048 * 512 * 2);
constexpr size_t WS_WQT = WS_WOUTT + al256((size_t)2048 * 2048 * 2);
constexpr size_t WS_SK = WS_WQT + al256((size_t)2048 * 2048 * 2);
constexpr size_t WS_U = WS_SK + al256((size_t)262144 * 2);
constexpr size_t WS_V = WS_U + al256((size_t)16384 * 2048);
constexpr size_t WS_H = WS_V + al256((size_t)16384 * 2048);
constexpr size_t WS_P = WS_H + al256((size_t)T_ * D_ * 2);
constexpr size_t WS_Q = WS_P + al256((size_t)T_ * INC * 2);
constexpr size_t WS_K = WS_Q + al256((size_t)T_ * 1536 * 2);
constexpr size_t WS_VT = WS_K + al256((size_t)T_ * 1536 * 2);
constexpr size_t WS_MG = WS_VT + al256((size_t)T_ * 1024 * 2);
constexpr size_t WS_X1 = WS_MG + al256((size_t)T_ * D_ * 2);
constexpr size_t WS_IDS = WS_X1 + al256((size_t)T_ * D_ * 4);
constexpr size_t WS_GATE = WS_IDS + al256((size_t)T_ * 128 * 4);
constexpr size_t WS_USC = WS_GATE + al256((size_t)T_ * 128 * 4);
constexpr size_t WS_VSC = WS_USC + 65536;
constexpr size_t WS_MODP = WS_VSC + 65536;
constexpr size_t WS_ACT = WS_MODP + al256((size_t)4 * 4 * 12288 * 4);
constexpr size_t WS_H2Q = WS_ACT + al256((size_t)T_ * 128 * 4);
constexpr size_t WS_HSC = WS_H2Q + al256((size_t)T_ * D_);
constexpr size_t WS_END = WS_HSC + al256((size_t)T_ * 4);
constexpr size_t WS_PA = WS_MG;
constexpr size_t WS_OUTP = WS_Q;
static_assert(WS_VT + (size_t)T_ * 1024 * 2 - WS_Q >= (size_t)T_ * D_ * 4, "OUTP alias");
static_assert((size_t)8 * T_ * 128 * 4 <= (size_t)T_ * D_ * 2, "PA alias");

constexpr int LDS_BYTES = 16 + 2 * 2 * 128 * 72 * 2 + 512;

struct Params {
  const float* in[20];
  float* out;
  char* ws;
  int ph_lo, ph_hi, coop, pad;
};

DI unsigned pk2(float a, float b) { f2_t v = {a, b}; bf2_t r = __builtin_convertvector(v, bf2_t); return __builtin_bit_cast(unsigned, r); }
DI float bflo(unsigned u) { return __uint_as_float(u << 16); }
DI float bfhi(unsigned u) { return __uint_as_float(u & 0xffff0000u); }
DI float dot2(unsigned a, unsigned b, float c) { return __builtin_amdgcn_fdot2_f32_bf16(__builtin_bit_cast(bf2_t, a), __builtin_bit_cast(bf2_t, b), c, false); }
DI float wave_sum(float v) {
#pragma unroll
  for (int o = 32; o >= 1; o >>= 1) v += __shfl_xor(v, o);
  return v;
}

#define XB_TMO      128
#define XB_XCNT(j)  (256  + 64 * (j))
#define XB_XSUB(j)  (1280 + 64 * (j))
#define XB_XGEN(j)  (2304 + 64 * (j))
#define XB_TOP      3328
#define XB_TOPGEN   3392
#define XCD_BAR_WORDS 3456
#define XB_SPIN_CAP (1u << 22)
#define LAS __attribute__((address_space(3)))
DI unsigned xb_ld(unsigned* p) { return __hip_atomic_load(p, __ATOMIC_RELAXED, __HIP_MEMORY_SCOPE_AGENT); }
DI unsigned xb_add(unsigned* p, unsigned v) { return __hip_atomic_fetch_add(p, v, __ATOMIC_RELAXED, __HIP_MEMORY_SCOPE_AGENT); }
DI unsigned xb_xcc_id() { return (unsigned)__builtin_amdgcn_s_getreg((3 << 11) | 20) & 0xFu; }
#define XB_SPIN(cond, bar) do { unsigned _sp = 0; while (cond) { __builtin_amdgcn_s_sleep(1); \
    if ((++_sp & 255u) == 0u) { if (xb_ld(&(bar)[XB_TMO])) break; if (_sp > XB_SPIN_CAP) { atomicAdd(&(bar)[XB_TMO], 1u); break; } } } } while (0)
struct XcdBarrier { unsigned* bar; unsigned x; volatile LAS unsigned* st; };
DI XcdBarrier xcd_barrier_post(unsigned* bar, volatile LAS unsigned* st) {
  XcdBarrier b; b.bar = bar; b.x = xb_xcc_id(); b.st = st;
  if (threadIdx.x == 0) (void)xb_add(&bar[XB_XCNT(b.x)], 1u);
  return b;
}
DI void xcd_barrier_complete(unsigned* bar, unsigned x, unsigned& nloc, unsigned& nx) {
  const unsigned G = gridDim.x * gridDim.y * gridDim.z;
  unsigned sum, cnt, mine, sp = 0u;
  for (;;) {
    sum = 0u; cnt = 0u; mine = 0u;
#pragma unroll
    for (unsigned j = 0; j < 16; ++j) { const unsigned c = xb_ld(&bar[XB_XCNT(j)]); sum += c; cnt += (c > 0u) ? 1u : 0u; mine = (j == x) ? c : mine; }
    if (sum == G) break;
    __builtin_amdgcn_s_sleep(1);
    if ((++sp & 255u) == 0u) { if (xb_ld(&bar[XB_TMO])) break; if (sp > XB_SPIN_CAP) { atomicAdd(&bar[XB_TMO], 1u); break; } }
  }
  nloc = mine > 0u ? mine : 1u; nx = cnt > 0u ? cnt : 1u;
}
DI void xcd_barrier(const XcdBarrier& b) {
  asm volatile("s_waitcnt vmcnt(0)" ::: "memory");
  __syncthreads();
  if (threadIdx.x == 0) {
    unsigned* bar = b.bar;
    __builtin_amdgcn_s_waitcnt(0);
    unsigned nloc = b.st[0], nx = b.st[1];
    if (nloc == 0u) { xcd_barrier_complete(bar, b.x, nloc, nx); b.st[0] = nloc; b.st[1] = nx; }
    const unsigned old = xb_add(&bar[XB_XSUB(b.x)], 1u);
    const unsigned gen = old / nloc;
    if (old + 1u == (gen + 1u) * nloc) {
      __builtin_amdgcn_fence(__ATOMIC_RELEASE, "agent");
      asm volatile("s_waitcnt vmcnt(0)" ::: "memory");
      const unsigned og = xb_add(&bar[XB_TOP], 1u);
      const unsigned tg = og / nx;
      if (og + 1u == (tg + 1u) * nx) xb_add(&bar[XB_TOPGEN], 1u);
      else XB_SPIN(xb_ld(&bar[XB_TOPGEN]) == tg, bar);
      __builtin_amdgcn_fence(__ATOMIC_ACQUIRE, "agent");
      xb_add(&bar[XB_XGEN(b.x)], 1u);
      asm volatile("s_waitcnt vmcnt(0)" ::: "memory");
    } else {
      XB_SPIN(xb_ld(&bar[XB_XGEN(b.x)]) == gen, bar);
      __builtin_amdgcn_fence(__ATOMIC_ACQUIRE, "agent");
      asm volatile("s_waitcnt vmcnt(0)" ::: "memory");
    }
  }
  __syncthreads();
}

template <bool SWAP, class Epi>
DI void gemm_tile(const u16* __restrict__ A, int lda, const u16* __restrict__ Bt, int ldb, int K, int m0, int n0, char* smem, Epi&& epi) {
  u16* As = (u16*)(smem + 16);
  u16* Bs = As + 2 * 128 * 72;
  const int tid = threadIdx.x, lane = tid & 63, w = tid >> 6, wm = w >> 1, wn = w & 1;
  const int r = lane & 31, hi = lane >> 5;
  f32x16 acc[2][2];
#pragma unroll
  for (int a = 0; a < 2; ++a)
#pragma unroll
    for (int b = 0; b < 2; ++b)
#pragma unroll
      for (int i = 0; i < 16; ++i) acc[a][b][i] = 0.f;
  const int srow = tid >> 3, skc = tid & 7;
  const u16* ag = A + (size_t)(m0 + srow) * lda + skc * 8;
  const u16* bg = Bt + (size_t)(n0 + srow) * ldb + skc * 8;
  u32x4 ra[4], rb[4];
#pragma unroll
  for (int i = 0; i < 4; ++i) { ra[i] = *(const u32x4*)(ag + (size_t)i * 32 * lda); rb[i] = *(const u32x4*)(bg + (size_t)i * 32 * ldb); }
  __syncthreads();
#pragma unroll
  for (int i = 0; i < 4; ++i) { *(u32x4*)(As + (srow + 32 * i) * 72 + skc * 8) = ra[i]; *(u32x4*)(Bs + (srow + 32 * i) * 72 + skc * 8) = rb[i]; }
  __syncthreads();
  const int KT = K >> 6;
  for (int kt = 0; kt < KT; ++kt) {
    const int buf = kt & 1;
    if (kt + 1 < KT) {
      const int k0 = (kt + 1) << 6;
#pragma unroll
      for (int i = 0; i < 4; ++i) { ra[i] = *(const u32x4*)(ag + (size_t)i * 32 * lda + k0); rb[i] = *(const u32x4*)(bg + (size_t)i * 32 * ldb + k0); }
    }
    const u16* Asb = As + buf * 128 * 72 + (wm * 64 + r) * 72 + hi * 8;
    const u16* Bsb = Bs + buf * 128 * 72 + (wn * 64 + r) * 72 + hi * 8;
#pragma unroll
    for (int ks = 0; ks < 4; ++ks) {
      bf16x8 af[2], bfr[2];
      af[0] = *(const bf16x8*)(Asb + ks * 16);
      af[1] = *(const bf16x8*)(Asb + 32 * 72 + ks * 16);
      bfr[0] = *(const bf16x8*)(Bsb + ks * 16);
      bfr[1] = *(const bf16x8*)(Bsb + 32 * 72 + ks * 16);
#pragma unroll
      for (int mi = 0; mi < 2; ++mi)
#pragma unroll
        for (int ni = 0; ni < 2; ++ni) {
          if (SWAP) acc[mi][ni] = MFMA(bfr[ni], af[mi], acc[mi][ni]);
          else acc[mi][ni] = MFMA(af[mi], bfr[ni], acc[mi][ni]);
        }
    }
    if (kt + 1 < KT) {
      const int nb = buf ^ 1;
#pragma unroll
      for (int i = 0; i < 4; ++i) { *(u32x4*)(As + nb * 128 * 72 + (srow + 32 * i) * 72 + skc * 8) = ra[i]; *(u32x4*)(Bs + nb * 128 * 72 + (srow + 32 * i) * 72 + skc * 8) = rb[i]; }
    }
    __syncthreads();
  }
  epi(acc, m0 + wm * 64, n0 + wn * 64, r, hi);
}

DI void tile_rstd512(const u16* __restrict__ A, int lda, int m0, float* rs) {
  const int tid = threadIdx.x, row = tid >> 1, half = tid & 1;
  const uint4* p = (const uint4*)(A + (size_t)(m0 + row) * lda + half * 256);
  float ss = 0.f;
#pragma unroll 8
  for (int i = 0; i < 32; ++i) {
    uint4 v = p[i];
    ss = dot2(v.x, v.x, ss); ss = dot2(v.y, v.y, ss); ss = dot2(v.z, v.z, ss); ss = dot2(v.w, v.w, ss);
  }
  ss += __shfl_xor(ss, 1);
  if (half == 0) rs[row] = rsqrtf(ss * (1.f / 512.f) + EPS);
}

DI void transpose_item(const float* __restrict__ src, int N, int K, const float* __restrict__ scale, u16* __restrict__ dst, int tk, int tn, char* smem) {
  float* tile = (float*)(smem + 16);
  const int t = threadIdx.x;
  __syncthreads();
  {
    const int rr = t >> 4, c4 = (t & 15) * 4;
#pragma unroll
    for (int ps = 0; ps < 4; ++ps) {
      const int kk = ps * 16 + rr, k = tk * 64 + kk;
      float4 v = *(const float4*)(src + (size_t)k * N + tn * 64 + c4);
      const float sc = scale ? scale[k] : 1.f;
      tile[kk * 65 + c4 + 0] = v.x * sc; tile[kk * 65 + c4 + 1] = v.y * sc; tile[kk * 65 + c4 + 2] = v.z * sc; tile[kk * 65 + c4 + 3] = v.w * sc;
    }
  }
  __syncthreads();
  {
    const int n = t & 63, kc = (t >> 6) * 16;
    unsigned o[8];
#pragma unroll
    for (int j = 0; j < 8; ++j) o[j] = pk2(tile[(kc + 2 * j) * 65 + n], tile[(kc + 2 * j + 1) * 65 + n]);
    uint4* d = (uint4*)(dst + (size_t)(tn * 64 + n) * K + tk * 64 + kc);
    d[0] = make_uint4(o[0], o[1], o[2], o[3]); d[1] = make_uint4(o[4], o[5], o[6], o[7]);
  }
}

DI void convert_item(const float* __restrict__ src, u16* __restrict__ dst, size_t base) {
  const int t = threadIdx.x;
#pragma unroll
  for (int st = 0; st < 4; ++st) {
    const size_t idx = base + st * 2048 + t * 8;
    float4 a = *(const float4*)(src + idx), b = *(const float4*)(src + idx + 4);
    *(uint4*)(dst + idx) = make_uint4(pk2(a.x, a.y), pk2(a.z, a.w), pk2(b.x, b.y), pk2(b.z, b.w));
  }
}

DI float wave_max(float v) {
#pragma unroll
  for (int o = 32; o >= 1; o >>= 1) v = fmaxf(v, __shfl_xor(v, o));
  return v;
}
DI void fp8_rows_item(const float* __restrict__ src, unsigned char* __restrict__ dst, float* __restrict__ scales, int item) {
  const int lane = threadIdx.x & 63, w = threadIdx.x >> 6;
  const int row = item * 4 + w;
  const float* sr = src + (size_t)row * 2048 + lane * 16;
  float4 v[8];
  float amax = 0.f;
#pragma unroll
  for (int j = 0; j < 2; ++j)
#pragma unroll
    for (int q = 0; q < 4; ++q) {
      const float4 t = *(const float4*)(sr + 1024 * j + q * 4);
      v[j * 4 + q] = t;
      amax = fmaxf(amax, fmaxf(fmaxf(fabsf(t.x), fabsf(t.y)), fmaxf(fabsf(t.z), fabsf(t.w))));
    }
  amax = wave_max(amax);
  int e = 0;
  if (amax > 0.f) e = (int)floorf(log2f(384.f / amax));
  e = e < -100 ? -100 : (e > 100 ? 100 : e);
  const float sc = ldexpf(1.f, e);
  if (lane == 0) scales[row] = ldexpf(1.f, -e);
#pragma unroll
  for (int j = 0; j < 2; ++j) {
    unsigned d[4];
#pragma unroll
    for (int q = 0; q < 4; ++q) {
      const float4 t = v[j * 4 + q];
      unsigned pk = __builtin_amdgcn_cvt_pk_fp8_f32(t.x * sc, t.y * sc, 0, false);
      pk = __builtin_amdgcn_cvt_pk_fp8_f32(t.z * sc, t.w * sc, pk, true);
      d[q] = pk;
    }
    *(uint4*)(dst + (size_t)row * 2048 + 1024 * j + lane * 16) = make_uint4(d[0], d[1], d[2], d[3]);
  }
}

DI unsigned pack_i8x4(float a, float b, float c, float d) {
  const int ia = __float2int_rn(a), ib = __float2int_rn(b), ic = __float2int_rn(c), id = __float2int_rn(d);
  return (unsigned)(ia & 0xff) | ((unsigned)(ib & 0xff) << 8) | ((unsigned)(ic & 0xff) << 16) | ((unsigned)id << 24);
}
DI void i8_rows_item(const float* __restrict__ src, unsigned char* __restrict__ dst, float* __restrict__ scales, int item) {
  const int lane = threadIdx.x & 63, w = threadIdx.x >> 6;
  const int row = item * 4 + w;
  const float* sr = src + (size_t)row * 2048 + lane * 16;
  float4 v[8];
  float amax = 0.f;
#pragma unroll
  for (int j = 0; j < 2; ++j)
#pragma unroll
    for (int q = 0; q < 4; ++q) {
      const float4 t = *(const float4*)(sr + 1024 * j + q * 4);
      v[j * 4 + q] = t;
      amax = fmaxf(amax, fmaxf(fmaxf(fabsf(t.x), fabsf(t.y)), fmaxf(fabsf(t.z), fabsf(t.w))));
    }
  amax = wave_max(amax);
  const float sc = amax > 0.f ? 127.f / amax : 0.f;
  if (lane == 0) scales[row] = amax * (1.f / 127.f);
#pragma unroll
  for (int j = 0; j < 2; ++j) {
    unsigned d[4];
#pragma unroll
    for (int q = 0; q < 4; ++q) { const float4 t = v[j * 4 + q]; d[q] = pack_i8x4(t.x * sc, t.y * sc, t.z * sc, t.w * sc); }
    *(uint4*)(dst + (size_t)row * 2048 + 1024 * j + lane * 16) = make_uint4(d[0], d[1], d[2], d[3]);
  }
}

DI void mod_item(const Params& p, int item, char* smem) {
  float* cact = (float*)(smem + 16);
  float* red = cact + 4 * 512;
  const int t = threadIdx.x;
  const int cgi = item % 192, ksp = item / 192, kbase = ksp * 512;
  const float* c = p.in[1]; const float* W = p.in[2];
  float* mod = (float*)(p.ws + WS_MODP);
  __syncthreads();
  for (int i = t; i < 4 * 512; i += 256) { float v = c[(i >> 9) * 2048 + kbase + (i & 511)]; cact[i] = v / (1.f + __expf(-v)); }
  __syncthreads();
  const int cq = t & 15, kl = t >> 4, c0 = cgi * 64;
  float acc[4][4];
#pragma unroll
  for (int b = 0; b < 4; ++b)
#pragma unroll
    for (int j = 0; j < 4; ++j) acc[b][j] = 0.f;
  const float* wp = W + (size_t)(kbase + kl) * 12288 + c0 + cq * 4;
#pragma unroll 8
  for (int i = 0; i < 32; ++i) {
    const int k = kl + 16 * i;
    float4 w4 = *(const float4*)(wp + (size_t)i * 16 * 12288);
#pragma unroll
    for (int b = 0; b < 4; ++b) {
      const float a = cact[b * 512 + k];
      acc[b][0] += a * w4.x; acc[b][1] += a * w4.y; acc[b][2] += a * w4.z; acc[b][3] += a * w4.w;
    }
  }
#pragma unroll
  for (int b = 0; b < 4; ++b)
#pragma unroll
    for (int j = 0; j < 4; ++j) red[(kl * 16 + cq) * 17 + b * 4 + j] = acc[b][j];
  __syncthreads();
  {
    const int b = t >> 6, col = t & 63, q = col >> 2, j = col & 3;
    float s = 0.f;
#pragma unroll
    for (int k2 = 0; k2 < 16; ++k2) s += red[(k2 * 16 + q) * 17 + b * 4 + j];
    mod[(size_t)ksp * 49152 + b * 12288 + c0 + col] = s;
  }
}

constexpr int P0_MOD = 768;
constexpr int P0_TIN = 32 * 65, P0_TUQ = 8 * 24, P0_TUKV = 8 * 32, P0_TOUT = 32 * 32, P0_TWQ = 32 * 32;
constexpr int P0_SK = 32, P0_UV = 0, P0_ROPE = 32;
DI void phase0(const Params& p, char* smem) {
  constexpr int o1 = P0_MOD, o2 = o1 + P0_TIN, o3 = o2 + P0_TUQ, o4 = o3 + P0_TUKV, o5 = o4 + P0_TOUT, o6 = o5 + P0_TWQ, o7 = o6 + P0_SK, o8 = o7 + P0_UV, o9 = o8 + P0_UV, o10 = o9 + P0_ROPE;
  for (int it = blockIdx.x; it < o10; it += gridDim.x) {
    if (it < o1) mod_item(p, it, smem);
    else if (it < o2) { int j = it - o1; transpose_item(p.in[5], INC, 2048, nullptr, (u16*)(p.ws + WS_WINT), j / 65, j % 65, smem); }
    else if (it < o3) { int j = it - o2; transpose_item(p.in[8], 1536, 512, p.in[7], (u16*)(p.ws + WS_WUQT), j / 24, j % 24, smem); }
    else if (it < o4) { int j = it - o3; transpose_item(p.in[10], 2048, 512, p.in[9], (u16*)(p.ws + WS_WUKVT), j / 32, j % 32, smem); }
    else if (it < o5) { int j = it - o4; int tk = j / 32; transpose_item(p.in[13], 2048, 2048, tk < 16 ? p.in[11] : p.in[12] - 1024, (u16*)(p.ws + WS_WOUTT), tk, j % 32, smem); }
    else if (it < o6) { int j = it - o5; transpose_item(p.in[15], 2048, 2048, nullptr, (u16*)(p.ws + WS_WQT), j / 32, j % 32, smem); }
    else if (it < o7) convert_item(p.in[16], (u16*)(p.ws + WS_SK), (size_t)(it - o6) * 8192);
    else if (it < o8) fp8_rows_item(p.in[17], (unsigned char*)(p.ws + WS_U), (float*)(p.ws + WS_USC), it - o7);
    else if (it < o9) fp8_rows_item(p.in[18], (unsigned char*)(p.ws + WS_V), (float*)(p.ws + WS_VSC), it - o8);
    else {
      float2* rope = (float2*)(p.ws + WS_ROPE);
      const int base = (it - o9) * 2048;
      for (int e = threadIdx.x; e < 2048; e += 256) {
        const int idx = base + e, pos = idx >> 5, j = idx & 31;
        const float inv = 1.0f / powf(10000.0f, (float)(2 * j) / 64.0f);
        const float ang = (float)pos * inv;
        rope[idx] = make_float2(cosf(ang), sinf(ang));
      }
    }
  }
}

template <bool Q8>
DI void norm_rows(const float* __restrict__ X, const float* __restrict__ g, const float* mod, int bstride, u16* __restrict__ out, unsigned char* __restrict__ outq, float* __restrict__ qscale) {
  const int lane = threadIdx.x & 63, w = threadIdx.x >> 6;
  for (int row = blockIdx.x * 4 + w; row < T_; row += gridDim.x * 4) {
    const float* xr = X + (size_t)row * D_;
    float4 v[8];
    float ss = 0.f;
#pragma unroll
    for (int j = 0; j < 8; ++j) { v[j] = *(const float4*)(xr + j * 256 + lane * 4); ss += v[j].x * v[j].x + v[j].y * v[j].y + v[j].z * v[j].z + v[j].w * v[j].w; }
    ss = wave_sum(ss);
    const float rstd = rsqrtf(ss * (1.f / D_) + EPS);
    const int b = row >> 11;
    const float* sh = mod + b * bstride;
    const float* sc = sh + 2048;
    float amax = 0.f;
#pragma unroll
    for (int j = 0; j < 8; ++j) {
      const int d = j * 256 + lane * 4;
      const float4 gg = *(const float4*)(g + d), s4 = *(const float4*)(sc + d), h4 = *(const float4*)(sh + d);
      const float o0 = v[j].x * rstd * gg.x * (1.f + s4.x) + h4.x;
      const float o1 = v[j].y * rstd * gg.y * (1.f + s4.y) + h4.y;
      const float o2 = v[j].z * rstd * gg.z * (1.f + s4.z) + h4.z;
      const float o3 = v[j].w * rstd * gg.w * (1.f + s4.w) + h4.w;
      *(uint2*)(out + (size_t)row * D_ + d) = make_uint2(pk2(o0, o1), pk2(o2, o3));
      if (Q8) { v[j] = make_float4(o0, o1, o2, o3); amax = fmaxf(amax, fmaxf(fmaxf(fabsf(o0), fabsf(o1)), fmaxf(fabsf(o2), fabsf(o3)))); }
    }
    if (Q8) {
      amax = wave_max(amax);
      const float qs = amax > 0.f ? 127.f / amax : 0.f;
      if (lane == 0) qscale[row] = amax * (1.f / 127.f);
#pragma unroll
      for (int j = 0; j < 8; ++j) *(unsigned*)(outq + (size_t)row * D_ + j * 256 + lane * 4) = pack_i8x4(v[j].x * qs, v[j].y * qs, v[j].z * qs, v[j].w * qs);
    }
  }
}
DI void phase1(const Params& p, char* smem) {
  const float* mp = (const float*)(p.ws + WS_MODP); float* mod = (float*)(p.ws + WS_MOD); const float* bias = p.in[3];
  for (int i = blockIdx.x * 256 + threadIdx.x; i < 49152; i += gridDim.x * 256)
    mod[i] = ((mp[i] + mp[49152 + i]) + mp[2 * 49152 + i]) + mp[3 * 49152 + i] + bias[i % 12288];
  float* lm = (float*)(smem + 16);
  __syncthreads();
  for (int i = threadIdx.x; i < 4 * 4096; i += 256) {
    const int b = i >> 12, c = i & 4095, src = b * 12288 + c;
    lm[i] = ((mp[src] + mp[49152 + src]) + mp[2 * 49152 + src]) + mp[3 * 49152 + src] + bias[c];
  }
  __syncthreads();
  norm_rows<false>(p.in[0], p.in[4], lm, 4096, (u16*)(p.ws + WS_H), nullptr, nullptr);
}

constexpr int CTR_TILE = 3520, CTR_CHUNK = 3584;
DI int grab(unsigned* ctr, char* smem) {
  __syncthreads();
  if (threadIdx.x == 0) *(volatile unsigned*)(smem + 8) = atomicAdd(ctr, 1u);
  __syncthreads();
  return (int)*(volatile unsigned*)(smem + 8);
}
DI void uv_chunk(const Params& p, int c) {
#pragma unroll 1
  for (int i = 0; i < 4; ++i) {
    const int item = c * 4 + i;
    if (item < 4096) i8_rows_item(p.in[17], (unsigned char*)(p.ws + WS_U), (float*)(p.ws + WS_USC), item);
    else fp8_rows_item(p.in[18], (unsigned char*)(p.ws + WS_V), (float*)(p.ws + WS_VSC), item - 4096);
  }
}
DI void phase2(const Params& p, char* smem) {
  const u16* H = (const u16*)(p.ws + WS_H); const u16* W = (const u16*)(p.ws + WS_WINT); u16* P = (u16*)(p.ws + WS_P);
  unsigned* ctr = (unsigned*)(p.ws + WS_BAR);
  if (blockIdx.x & 1) {
#pragma unroll 1
    for (int q = 0; q < 4; ++q) { const int c = grab(ctr + CTR_CHUNK, smem); if (c < 2048) uv_chunk(p, c); }
  }
  for (;;) {
    const int it = grab(ctr + CTR_TILE, smem);
    if (it >= 64 * 33) break;
    const int tn = it / 64, tm = it % 64;
    gemm_tile<true>(H, D_, W, D_, D_, tm * 128, tn * 128, smem, [&](f32x16 (&acc)[2][2], int mb, int nb, int r, int hi) __attribute__((always_inline)) {
      if (nb >= INC) return;
#pragma unroll
      for (int mi = 0; mi < 2; ++mi)
#pragma unroll
        for (int ni = 0; ni < 2; ++ni)
#pragma unroll
          for (int g = 0; g < 4; ++g) {
            const int row = mb + mi * 32 + r, col = nb + ni * 32 + hi * 4 + 8 * g;
            *(uint2*)(P + (size_t)row * INC + col) = make_uint2(pk2(acc[mi][ni][4 * g], acc[mi][ni][4 * g + 1]), pk2(acc[mi][ni][4 * g + 2], acc[mi][ni][4 * g + 3]));
          }
    });
  }
  for (;;) {
    const int c = grab(ctr + CTR_CHUNK, smem);
    if (c >= 2048) break;
    uv_chunk(p, c);
  }
}

DI void phase3(const Params& p, char* smem) {
  const u16* P = (const u16*)(p.ws + WS_P);
  u16* Q = (u16*)(p.ws + WS_Q); u16* Kb = (u16*)(p.ws + WS_K); u16* VT = (u16*)(p.ws + WS_VT); u16* MG = (u16*)(p.ws + WS_MG);
  const float2* rope = (const float2*)(p.ws + WS_ROPE);
  float* rs = (float*)(smem + 16 + 2 * 2 * 128 * 72 * 2);
  constexpr int NQ = 64 * 12, NKV = 64 * 16, NKR = 1024, NCV = 1024;
  const float qscale = 0.07216878364870322f * 1.4426950408889634f;
  for (int it = blockIdx.x; it < NQ + NKV + NKR + NCV; it += gridDim.x) {
    if (it < NQ) {
      const int tn = it / 64, tm = it % 64;
      __syncthreads();
      tile_rstd512(P + 3072, INC, tm * 128, rs);
      gemm_tile<true>(P + 3072, INC, (const u16*)(p.ws + WS_WUQT), 512, 512, tm * 128, tn * 128, smem, [&](f32x16 (&acc)[2][2], int mb, int nb, int r, int hi) __attribute__((always_inline)) {
        const bool is_rope = ((nb >> 6) % 3) == 2;
#pragma unroll
        for (int mi = 0; mi < 2; ++mi) {
          const int row = mb + mi * 32 + r;
          const float sc = rs[row - tm * 128] * qscale;
          const int pos = row & (S_ - 1);
#pragma unroll
          for (int g = 0; g < 4; ++g) {
            const int j = hi * 4 + 8 * g;
            float a0[4], a1[4];
#pragma unroll
            for (int e = 0; e < 4; ++e) { a0[e] = acc[mi][0][4 * g + e] * sc; a1[e] = acc[mi][1][4 * g + e] * sc; }
            if (is_rope) {
#pragma unroll
              for (int e = 0; e < 4; ++e) {
                const float2 cs = rope[pos * 32 + j + e];
                const float x1 = a0[e], x2 = a1[e];
                a0[e] = x1 * cs.x - x2 * cs.y; a1[e] = x2 * cs.x + x1 * cs.y;
              }
            }
            *(uint2*)(Q + (size_t)row * 1536 + nb + j) = make_uint2(pk2(a0[0], a0[1]), pk2(a0[2], a0[3]));
            *(uint2*)(Q + (size_t)row * 1536 + nb + 32 + j) = make_uint2(pk2(a1[0], a1[1]), pk2(a1[2], a1[3]));
          }
        }
      });
    } else if (it < NQ + NKV) {
      const int j2 = it - NQ, tn = j2 / 64, tm = j2 % 64;
      __syncthreads();
      tile_rstd512(P + 3584, INC, tm * 128, rs);
      const int head = tn >> 1;
      if ((tn & 1) == 0) {
        gemm_tile<true>(P + 3584, INC, (const u16*)(p.ws + WS_WUKVT), 512, 512, tm * 128, tn * 128, smem, [&](f32x16 (&acc)[2][2], int mb, int nb, int r, int hi) __attribute__((always_inline)) {
#pragma unroll
          for (int mi = 0; mi < 2; ++mi) {
            const int row = mb + mi * 32 + r;
            const float sc = rs[row - tm * 128];
#pragma unroll
            for (int ni = 0; ni < 2; ++ni)
#pragma unroll
              for (int g = 0; g < 4; ++g) {
                const int d = (nb & 127) + ni * 32 + hi * 4 + 8 * g;
                *(uint2*)(Kb + (size_t)row * 1536 + head * 192 + d) = make_uint2(pk2(acc[mi][ni][4 * g] * sc, acc[mi][ni][4 * g + 1] * sc), pk2(acc[mi][ni][4 * g + 2] * sc, acc[mi][ni][4 * g + 3] * sc));
              }
          }
        });
      } else {
        gemm_tile<false>(P + 3584, INC, (const u16*)(p.ws + WS_WUKVT), 512, 512, tm * 128, tn * 128, smem, [&](f32x16 (&acc)[2][2], int mb, int nb, int r, int hi) __attribute__((always_inline)) {
#pragma unroll
          for (int mi = 0; mi < 2; ++mi)
#pragma unroll
            for (int g = 0; g < 4; ++g) {
              const int row0 = mb + mi * 32 + hi * 4 + 8 * g;
              const float s0 = rs[row0 - tm * 128], s1 = rs[row0 + 1 - tm * 128], s2 = rs[row0 + 2 - tm * 128], s3 = rs[row0 + 3 - tm * 128];
              const int b = row0 >> 11, t = row0 & (S_ - 1);
#pragma unroll
              for (int ni = 0; ni < 2; ++ni) {
                const int d = (nb & 127) + ni * 32 + r;
                *(uint2*)(VT + ((size_t)((b * 8 + head) * 128 + d)) * S_ + t) = make_uint2(pk2(acc[mi][ni][4 * g] * s0, acc[mi][ni][4 * g + 1] * s1), pk2(acc[mi][ni][4 * g + 2] * s2, acc[mi][ni][4 * g + 3] * s3));
              }
            }
        });
      }
    } else if (it < NQ + NKV + NKR) {
      const int j2 = it - NQ - NKV;
      const int row = j2 * 8 + (threadIdx.x >> 5), j = threadIdx.x & 31, pos = row & (S_ - 1);
      const float x1 = bflo((unsigned)P[(size_t)row * INC + 4096 + j]), x2 = bflo((unsigned)P[(size_t)row * INC + 4096 + 32 + j]);
      const float2 cs = rope[pos * 32 + j];
      const float o1 = x1 * cs.x - x2 * cs.y, o2 = x2 * cs.x + x1 * cs.y;
      const u16 b1 = (u16)(pk2(o1, 0.f) & 0xffffu), b2 = (u16)(pk2(o2, 0.f) & 0xffffu);
#pragma unroll
      for (int h = 0; h < 8; ++h) { Kb[(size_t)row * 1536 + h * 192 + 128 + j] = b1; Kb[(size_t)row * 1536 + h * 192 + 160 + j] = b2; }
    } else {
      const int j2 = it - NQ - NKV - NKR;
      const int wi = j2 * 4 + (threadIdx.x >> 6), lane = threadIdx.x & 63;
      const int g = wi & 7, run = wi >> 3;
      const int row0 = run * 16, t0 = row0 & (S_ - 1);
      const int ch = g * 128 + lane * 2;
      const float* cw = p.in[6];
      const float w00 = cw[ch], w01 = cw[ch + 1], w10 = cw[1024 + ch], w11 = cw[1024 + ch + 1], w20 = cw[2048 + ch], w21 = cw[2048 + ch + 1];
      float zm1a = 0.f, zm1b = 0.f, zm2a = 0.f, zm2b = 0.f;
      if (t0 > 0) {
        const unsigned c1 = *(const unsigned*)(P + (size_t)(row0 - 1) * INC + 1024 + ch), h1 = *(const unsigned*)(P + (size_t)(row0 - 1) * INC + 2048 + ch);
        const unsigned c2 = *(const unsigned*)(P + (size_t)(row0 - 2) * INC + 1024 + ch), h2 = *(const unsigned*)(P + (size_t)(row0 - 2) * INC + 2048 + ch);
        zm1a = bflo(c1) * bflo(h1); zm1b = bfhi(c1) * bfhi(h1); zm2a = bflo(c2) * bflo(h2); zm2b = bfhi(c2) * bfhi(h2);
      }
#pragma unroll 4
      for (int tt = 0; tt < 16; ++tt) {
        const size_t ro = (size_t)(row0 + tt) * INC;
        const unsigned bb = *(const unsigned*)(P + ro + ch), cc = *(const unsigned*)(P + ro + 1024 + ch), hh = *(const unsigned*)(P + ro + 2048 + ch);
        const float za = bflo(cc) * bflo(hh), zb = bfhi(cc) * bfhi(hh);
        const float ya = bflo(bb) * (w00 * zm2a + w10 * zm1a + w20 * za), yb = bfhi(bb) * (w01 * zm2b + w11 * zm1b + w21 * zb);
        zm2a = zm1a; zm2b = zm1b; zm1a = za; zm1b = zb;
        const float ss = wave_sum(ya * ya + yb * yb);
        const float rstd = rsqrtf(ss * (1.f / 128.f) + EPS);
        *(unsigned*)(MG + (size_t)(row0 + tt) * D_ + ch) = pk2(ya * rstd, yb * rstd);
      }
    }
  }
}

DI void phase4(const Params& p, char* smem) {
  const u16* Q = (const u16*)(p.ws + WS_Q); const u16* Kb = (const u16*)(p.ws + WS_K); const u16* VT = (const u16*)(p.ws + WS_VT);
  u16* MG = (u16*)(p.ws + WS_MG);
  u16* Ks = (u16*)(smem + 16);
  u16* Vs = Ks + 64 * 200;
  float* mrg = (float*)(smem + 16);
  const int tid = threadIdx.x, lane = tid & 63, w = tid >> 6, qh = w & 1, kh = w >> 1, r = lane & 31, hi = lane >> 5;
  for (int it = blockIdx.x; it < 512; it += gridDim.x) {
    const int pi = it & 15, h = (it >> 4) & 7, b = it >> 7;
    for (int sub = 0; sub < 2; ++sub) {
      const int c = sub ? (31 - pi) : pi;
      const size_t qrow = (size_t)b * S_ + c * 64 + qh * 32 + r;
      bf16x8 qf[12];
#pragma unroll
      for (int ks = 0; ks < 12; ++ks) qf[ks] = *(const bf16x8*)(Q + qrow * 1536 + h * 192 + ks * 16 + hi * 8);
      f32x16 O[4];
#pragma unroll
      for (int dt = 0; dt < 4; ++dt)
#pragma unroll
        for (int i = 0; i < 16; ++i) O[dt][i] = 0.f;
      float m = -1e30f, l = 0.f;
      u32x4 kr[6]; u32x4 vr[4];
      const u16* kg = Kb + ((size_t)b * S_ + (tid >> 2)) * 1536 + h * 192 + (tid & 3) * 8;
      const u16* vg = VT + ((size_t)((b * 8 + h) * 128 + (tid >> 1))) * S_ + (tid & 1) * 8;
      u16* ksw = Ks + (tid >> 2) * 200 + (tid & 3) * 8;
      u16* vsw = Vs + (tid >> 1) * 68 + (tid & 1) * 8;
      auto load_tile = [&]() __attribute__((always_inline)) {
#pragma unroll
        for (int i = 0; i < 6; ++i) kr[i] = *(const u32x4*)(kg + i * 32);
#pragma unroll
        for (int i = 0; i < 4; ++i) vr[i] = *(const u32x4*)(vg + i * 16);
        kg += 64 * 1536; vg += 64;
      };
      load_tile();
      for (int kt = 0; kt <= c; ++kt) {
        __syncthreads();
#pragma unroll
        for (int i = 0; i < 6; ++i) *(u32x4*)(ksw + i * 32) = kr[i];
#pragma unroll
        for (int i = 0; i < 4; ++i) { u32x2 lo2 = {vr[i][0], vr[i][1]}, hi2 = {vr[i][2], vr[i][3]}; *(u32x2*)(vsw + i * 16) = lo2; *(u32x2*)(vsw + i * 16 + 4) = hi2; }
        __syncthreads();
        if (kt < c) load_tile();
        f32x16 s;
#pragma unroll
        for (int i = 0; i < 16; ++i) s[i] = 0.f;
        const u16* kp = Ks + (kh * 32 + r) * 200 + hi * 8;
#pragma unroll
        for (int ks = 0; ks < 12; ++ks) { bf16x8 kf = *(const bf16x8*)(kp + ks * 16); s = MFMA(kf, qf[ks], s); }
        float mx = s[0];
#pragma unroll
        for (int i = 1; i < 16; ++i) mx = fmaxf(mx, s[i]);
        mx = fmaxf(mx, __shfl_xor(mx, 32));
        const float mn = fmaxf(m, mx);
        const float alpha = exp2f(m - mn);
        m = mn;
        float rsum = 0.f;
#pragma unroll
        for (int i = 0; i < 16; ++i) { s[i] = exp2f(s[i] - mn); rsum += s[i]; }
        l = l * alpha + rsum;
#pragma unroll
        for (int dt = 0; dt < 4; ++dt)
#pragma unroll
          for (int i = 0; i < 16; ++i) O[dt][i] *= alpha;
#pragma unroll
        for (int st = 0; st < 2; ++st) {
          uint4 pu = make_uint4(pk2(s[8 * st], s[8 * st + 1]), pk2(s[8 * st + 2], s[8 * st + 3]), pk2(s[8 * st + 4], s[8 * st + 5]), pk2(s[8 * st + 6], s[8 * st + 7]));
          const bf16x8 pf = __builtin_bit_cast(bf16x8, pu);
#pragma unroll
          for (int dt = 0; dt < 4; ++dt) {
            const u16* vp = Vs + (dt * 32 + r) * 68 + kh * 32 + 16 * st + 4 * hi;
            uint2 v0 = *(const uint2*)vp, v1 = *(const uint2*)(vp + 8);
            const bf16x8 vf = __builtin_bit_cast(bf16x8, make_uint4(v0.x, v0.y, v1.x, v1.y));
            O[dt] = MFMA(vf, pf, O[dt]);
          }
        }
      }
      l += __shfl_xor(l, 32);
      __syncthreads();
      float* mq = mrg + qh * 66 * 64;
      if (kh == 1) {
#pragma unroll
        for (int dt = 0; dt < 4; ++dt)
#pragma unroll
          for (int i = 0; i < 16; ++i) mq[(dt * 16 + i) * 64 + lane] = O[dt][i];
        mq[64 * 64 + lane] = m; mq[65 * 64 + lane] = l;
      }
      __syncthreads();
      if (kh == 0) {
        const float m1 = mq[64 * 64 + lane], l1 = mq[65 * 64 + lane];
        const float mt = fmaxf(m, m1), a0 = exp2f(m - mt), a1 = exp2f(m1 - mt);
        const float inv = 1.f / (l * a0 + l1 * a1);
        float ss = 0.f;
#pragma unroll
        for (int dt = 0; dt < 4; ++dt)
#pragma unroll
          for (int i = 0; i < 16; ++i) { const float o = (O[dt][i] * a0 + mq[(dt * 16 + i) * 64 + lane] * a1) * inv; O[dt][i] = o; ss += o * o; }
        ss += __shfl_xor(ss, 32);
        const float rstd = rsqrtf(ss * (1.f / 128.f) + EPS);
#pragma unroll
        for (int dt = 0; dt < 4; ++dt)
#pragma unroll
          for (int g = 0; g < 4; ++g) {
            const int d = dt * 32 + hi * 4 + 8 * g;
            *(uint2*)(MG + qrow * D_ + 1024 + h * 128 + d) = make_uint2(pk2(O[dt][4 * g] * rstd, O[dt][4 * g + 1] * rstd), pk2(O[dt][4 * g + 2] * rstd, O[dt][4 * g + 3] * rstd));
          }
      }
    }
  }
}

DI void phase5(const Params& p, char* smem) {
  const u16* MG = (const u16*)(p.ws + WS_MG); const u16* W = (const u16*)(p.ws + WS_WOUTT);
  const float* X = p.in[0]; const float* mod = (const float*)(p.ws + WS_MOD); float* X1 = (float*)(p.ws + WS_X1);
  for (int it = blockIdx.x; it < 64 * 16; it += gridDim.x) {
    const int tn = it / 64, tm = it % 64;
    gemm_tile<true>(MG, D_, W, D_, D_, tm * 128, tn * 128, smem, [&](f32x16 (&acc)[2][2], int mb, int nb, int r, int hi) __attribute__((always_inline)) {
#pragma unroll
      for (int mi = 0; mi < 2; ++mi) {
        const int row = mb + mi * 32 + r, b = row >> 11;
        const float* gt = mod + b * 12288 + 2 * 2048;
#pragma unroll
        for (int ni = 0; ni < 2; ++ni)
#pragma unroll
          for (int g = 0; g < 4; ++g) {
            const int col = nb + ni * 32 + hi * 4 + 8 * g;
            const float4 xv = *(const float4*)(X + (size_t)row * D_ + col), gv = *(const float4*)(gt + col);
            float4 o;
            o.x = xv.x + gv.x * acc[mi][ni][4 * g]; o.y = xv.y + gv.y * acc[mi][ni][4 * g + 1]; o.z = xv.z + gv.z * acc[mi][ni][4 * g + 2]; o.w = xv.w + gv.w * acc[mi][ni][4 * g + 3];
            *(float4*)(X1 + (size_t)row * D_ + col) = o;
          }
      }
    });
  }
}

DI void phase7(const Params& p, char* smem) {
  const u16* H2 = (const u16*)(p.ws + WS_H); const u16* W = (const u16*)(p.ws + WS_WQT); u16* PQ = (u16*)(p.ws + WS_P);
  for (int it = blockIdx.x; it < 64 * 16; it += gridDim.x) {
    const int tn = it / 64, tm = it % 64;
    gemm_tile<true>(H2, D_, W, D_, D_, tm * 128, tn * 128, smem, [&](f32x16 (&acc)[2][2], int mb, int nb, int r, int hi) __attribute__((always_inline)) {
#pragma unroll
      for (int mi = 0; mi < 2; ++mi)
#pragma unroll
        for (int ni = 0; ni < 2; ++ni)
#pragma unroll
          for (int g = 0; g < 4; ++g) {
            const int row = mb + mi * 32 + r, col = nb + ni * 32 + hi * 4 + 8 * g;
            *(uint2*)(PQ + (size_t)row * D_ + col) = make_uint2(pk2(acc[mi][ni][4 * g], acc[mi][ni][4 * g + 1]), pk2(acc[mi][ni][4 * g + 2], acc[mi][ni][4 * g + 3]));
          }
    });
  }
}

DI unsigned f2ord(float v) { unsigned u = __float_as_uint(v); return u ^ ((unsigned)((int)u >> 31) | 0x80000000u); }
#define TOPK_INSERT(keys, x) { _Pragma("unroll") for (int _j = 0; _j < 16; ++_j) { const unsigned _h = max(keys[_j], x); x = min(keys[_j], x); keys[_j] = _h; } }
DI void phase8(const Params& p, char* smem) {
  const u16* PQ = (const u16*)(p.ws + WS_P); const u16* SK = (const u16*)(p.ws + WS_SK);
  int* IDS = (int*)(p.ws + WS_IDS); float* GATE = (float*)(p.ws + WS_GATE);
  float* sc = (float*)(smem + 16);
  const int tid = threadIdx.x, lane = tid & 63, w = tid >> 6, r = lane & 31, hi = lane >> 5;
  for (int it = blockIdx.x; it < 128 * 8; it += gridDim.x) {
    const int h = it & 7, tile = it >> 3;
    const int pp = w >> 1, rh = w & 1;
    __syncthreads();
    {
      f32x16 acc[4];
#pragma unroll
      for (int nt = 0; nt < 4; ++nt)
#pragma unroll
        for (int i = 0; i < 16; ++i) acc[nt][i] = 0.f;
      const u16* ap = PQ + (size_t)(tile * 64 + rh * 32 + r) * D_ + h * 256 + pp * 128 + hi * 8;
      const u16* bp = SK + ((size_t)(h * 2 + pp) * 128 + r) * 128 + hi * 8;
#pragma unroll
      for (int ks = 0; ks < 8; ++ks) {
        const bf16x8 af = *(const bf16x8*)(ap + ks * 16);
#pragma unroll
        for (int nt = 0; nt < 4; ++nt) { const bf16x8 bf = *(const bf16x8*)(bp + nt * 32 * 128 + ks * 16); acc[nt] = MFMA(af, bf, acc[nt]); }
      }
#pragma unroll
      for (int nt = 0; nt < 4; ++nt)
#pragma unroll
        for (int i = 0; i < 16; ++i) sc[(pp * 64 + rh * 32 + hi * 4 + (i & 3) + 8 * (i >> 2)) * 129 + nt * 32 + r] = acc[nt][i];
    }
    __syncthreads();
    if (tid < 128) {
      float* row = sc + tid * 129;
      unsigned keys[16];
#pragma unroll
      for (int j = 0; j < 16; ++j) keys[j] = 0u;
#pragma unroll 4
      for (int n = 0; n < 128; ++n) {
        unsigned x = (f2ord(row[n]) & 0xFFFFFF80u) | (unsigned)(127 - n);
        TOPK_INSERT(keys, x);
      }
      float vals[16];
#pragma unroll
      for (int j = 0; j < 16; ++j) vals[j] = row[127 - (keys[j] & 127u)];
#pragma unroll
      for (int j = 0; j < 16; ++j) { row[j] = vals[j]; row[16 + j] = __int_as_float((int)(127 - (keys[j] & 127u))); }
    }
    __syncthreads();
    if (tid < 64) {
      const float* ra = sc + tid * 129; const float* rb = sc + (64 + tid) * 129;
      float a[16], bq[16];
#pragma unroll
      for (int j = 0; j < 16; ++j) { a[j] = ra[j]; bq[j] = rb[j]; }
      unsigned keys[16];
#pragma unroll
      for (int j = 0; j < 16; ++j) keys[j] = 0u;
#pragma unroll
      for (int i = 0; i < 16; ++i)
#pragma unroll
        for (int j = 0; j < 16; ++j)
          if ((i + 1) * (j + 1) <= 16) {
            unsigned x = (f2ord(a[i] + bq[j]) & 0xFFFFFF00u) | (unsigned)(255 - (i * 16 + j));
            TOPK_INSERT(keys, x);
          }
      float bv[16]; int ex[16];
      float mx = -1e30f;
#pragma unroll
      for (int q = 0; q < 16; ++q) {
        const int flat = 255 - (int)(keys[q] & 255u), i = flat >> 4, j = flat & 15;
        bv[q] = ra[i] + rb[j];
        ex[q] = __float_as_int(ra[16 + i]) * 128 + __float_as_int(rb[16 + j]);
        mx = fmaxf(mx, bv[q]);
      }
      float sum = 0.f;
#pragma unroll
      for (int q = 0; q < 16; ++q) { bv[q] = __expf(bv[q] - mx); sum += bv[q]; }
      const float inv = 1.f / sum;
      const size_t o = (size_t)(tile * 64 + tid) * 128 + h * 16;
#pragma unroll
      for (int q = 0; q < 16; q += 4) {
        *(int4*)(IDS + o + q) = make_int4(ex[q], ex[q + 1], ex[q + 2], ex[q + 3]);
        *(float4*)(GATE + o + q) = make_float4(bv[q] * inv, bv[q + 1] * inv, bv[q + 2] * inv, bv[q + 3] * inv);
      }
    }
  }
}

constexpr int CTR_UQ = 4096, CTR_VQ = 4608;
DI f2_t cvt8lo(unsigned w) { return __builtin_amdgcn_cvt_pk_f32_fp8(w, false); }
DI f2_t cvt8hi(unsigned w) { return __builtin_amdgcn_cvt_pk_f32_fp8(w, true); }
template <class F>
DI void xcd_queue(unsigned* ctrs, int nchunks, char* smem, F&& f) {
  const int x0 = (int)(xb_xcc_id() & 7u);
#pragma unroll 1
  for (int k = 0; k < 8; ++k) {
    const int s = (x0 + k) & 7;
    for (;;) { const int c = grab(ctrs + 64 * s, smem); if (c >= nchunks) break; f(s, c); }
  }
}
DI void wave_lds_sync() { asm volatile("s_waitcnt lgkmcnt(0)" ::: "memory"); __builtin_amdgcn_wave_barrier(); }

DI void phase9(const Params& p, char* smem, int rep) {
  const unsigned char* H2Q = (const unsigned char*)(p.ws + WS_H2Q); const unsigned char* U8 = (const unsigned char*)(p.ws + WS_U);
  const int* IDS = (const int*)(p.ws + WS_IDS); int* PA = (int*)(p.ws + WS_PA);
  const int lane = threadIdx.x & 63, w = threadIdx.x >> 6, g = lane >> 4, l15 = lane & 15;
  const int b3 = (lane >> 3) & 1, b2 = (lane >> 2) & 1, b1 = (lane >> 1) & 1, b0 = lane & 1;
  int* lw = (int*)(smem + 16) + w * 256;
  xcd_queue((unsigned*)(p.ws + WS_BAR) + CTR_UQ + rep * 8, 512, smem, [&](int s, int c) __attribute__((always_inline)) {
#pragma unroll 1
    for (int t = 0; t < 4; ++t) {
      const int tok = __builtin_amdgcn_readfirstlane(c * 16 + w * 4 + t);
      const int i0 = IDS[(size_t)tok * 128 + lane], i1 = IDS[(size_t)tok * 128 + 64 + lane];
      const u32x4 hq = *(const u32x4*)(H2Q + (size_t)tok * D_ + s * 256 + l15 * 16);
      wave_lds_sync();
      lw[(lane & 3) * 32 + (lane >> 2)] = i0;
      lw[(lane & 3) * 32 + 16 + (lane >> 2)] = i1;
      wave_lds_sync();
      const unsigned char* ub = U8 + s * 256 + l15 * 16;
#pragma unroll
      for (int batch = 0; batch < 2; ++batch) {
        int ida[16];
#pragma unroll
        for (int q = 0; q < 4; ++q) { const int4 v = *(const int4*)(lw + g * 32 + batch * 16 + q * 4); ida[q * 4] = v.x; ida[q * 4 + 1] = v.y; ida[q * 4 + 2] = v.z; ida[q * 4 + 3] = v.w; }
        u32x4 rows[16];
#pragma unroll
        for (int k = 0; k < 16; ++k) rows[k] = *(const u32x4*)(ub + (size_t)ida[k] * 2048);
        int part[16];
#pragma unroll
        for (int k = 0; k < 16; ++k) {
          int acc = 0;
#pragma unroll
          for (int d = 0; d < 4; ++d) acc = __builtin_amdgcn_sdot4((int)rows[k][d], (int)hq[d], acc, false);
          part[k] = acc;
        }
        int q8[8], q4[4], q2[2];
#pragma unroll
        for (int k = 0; k < 8; ++k) q8[k] = (b3 ? part[8 + k] : part[k]) + __shfl_xor(b3 ? part[k] : part[8 + k], 8);
#pragma unroll
        for (int k = 0; k < 4; ++k) q4[k] = (b2 ? q8[4 + k] : q8[k]) + __shfl_xor(b2 ? q8[k] : q8[4 + k], 4);
#pragma unroll
        for (int k = 0; k < 2; ++k) q2[k] = (b1 ? q4[2 + k] : q4[k]) + __shfl_xor(b1 ? q4[k] : q4[2 + k], 2);
        const int rr = (b0 ? q2[1] : q2[0]) + __shfl_xor(b0 ? q2[0] : q2[1], 1);
        PA[((size_t)s * T_ + tok) * 128 + 4 * (batch * 16 + l15) + g] = rr;
      }
    }
  });
}

DI void phase10(const Params& p) {
  const int* PA = (const int*)(p.ws + WS_PA); float* ACT = (float*)(p.ws + WS_ACT); const float* HSC = (const float*)(p.ws + WS_HSC);
  const int* IDS = (const int*)(p.ws + WS_IDS); const float* GATE = (const float*)(p.ws + WS_GATE);
  const float* USC = (const float*)(p.ws + WS_USC); const float* VSC = (const float*)(p.ws + WS_VSC);
  for (int i = blockIdx.x * 256 + threadIdx.x; i < T_ * 128; i += gridDim.x * 256) {
    int ai = 0;
#pragma unroll
    for (int s = 0; s < 8; ++s) ai += PA[(size_t)s * T_ * 128 + i];
    const int id = IDS[i];
    const float a = (float)ai * USC[id] * HSC[i >> 7];
    ACT[i] = 0.5f * a * (1.f + erff(a * 0.70710678118654752f)) * GATE[i] * VSC[id];
  }
}

DI void phase11(const Params& p, char* smem, int rep) {
  const unsigned char* V8 = (const unsigned char*)(p.ws + WS_V);
  const int* IDS = (const int*)(p.ws + WS_IDS); const float* ACT = (const float*)(p.ws + WS_ACT); u16* OUTP = (u16*)(p.ws + WS_OUTP);
  const int lane = threadIdx.x & 63, w = threadIdx.x >> 6, g = lane >> 4, l15 = lane & 15;
  const int b5 = (lane >> 5) & 1, b4 = (lane >> 4) & 1;
  int* lw = (int*)(smem + 16) + w * 256;
  float* lf = (float*)(lw + 128);
  xcd_queue((unsigned*)(p.ws + WS_BAR) + CTR_VQ + rep * 8, 512, smem, [&](int s, int c) __attribute__((always_inline)) {
#pragma unroll 1
    for (int t = 0; t < 4; ++t) {
      const int tok = __builtin_amdgcn_readfirstlane(c * 16 + w * 4 + t);
      const int i0 = IDS[(size_t)tok * 128 + lane], i1 = IDS[(size_t)tok * 128 + 64 + lane];
      const float a0 = ACT[(size_t)tok * 128 + lane], a1 = ACT[(size_t)tok * 128 + 64 + lane];
      wave_lds_sync();
      lw[(lane & 3) * 32 + (lane >> 2)] = i0; lw[(lane & 3) * 32 + 16 + (lane >> 2)] = i1;
      lf[(lane & 3) * 32 + (lane >> 2)] = a0; lf[(lane & 3) * 32 + 16 + (lane >> 2)] = a1;
      wave_lds_sync();
      f2_t o[8];
#pragma unroll
      for (int i = 0; i < 8; ++i) o[i] = f2_t{0.f, 0.f};
      const unsigned char* vb = V8 + s * 256 + l15 * 16;
#pragma unroll
      for (int batch = 0; batch < 2; ++batch) {
        int ida[16]; float aa[16];
#pragma unroll
        for (int q = 0; q < 4; ++q) {
          const int4 v = *(const int4*)(lw + g * 32 + batch * 16 + q * 4); ida[q * 4] = v.x; ida[q * 4 + 1] = v.y; ida[q * 4 + 2] = v.z; ida[q * 4 + 3] = v.w;
          const float4 f = *(const float4*)(lf + g * 32 + batch * 16 + q * 4); aa[q * 4] = f.x; aa[q * 4 + 1] = f.y; aa[q * 4 + 2] = f.z; aa[q * 4 + 3] = f.w;
        }
        u32x4 rows[16];
#pragma unroll
        for (int k = 0; k < 16; ++k) rows[k] = *(const u32x4*)(vb + (size_t)ida[k] * 2048);
#pragma unroll
        for (int k = 0; k < 16; ++k) {
          const f2_t a2 = {aa[k], aa[k]};
#pragma unroll
          for (int d = 0; d < 4; ++d) { const unsigned ww = rows[k][d]; o[2 * d] += a2 * cvt8lo(ww); o[2 * d + 1] += a2 * cvt8hi(ww); }
        }
      }
      float ov[16];
#pragma unroll
      for (int d = 0; d < 4; ++d) { ov[4 * d] = o[2 * d].x; ov[4 * d + 1] = o[2 * d].y; ov[4 * d + 2] = o[2 * d + 1].x; ov[4 * d + 3] = o[2 * d + 1].y; }
      float q8[8], q4[4];
#pragma unroll
      for (int k = 0; k < 8; ++k) q8[k] = (b5 ? ov[8 + k] : ov[k]) + __shfl_xor(b5 ? ov[k] : ov[8 + k], 32);
#pragma unroll
      for (int k = 0; k < 4; ++k) q4[k] = (b4 ? q8[4 + k] : q8[k]) + __shfl_xor(b4 ? q8[k] : q8[4 + k], 16);
      *(uint2*)(OUTP + (size_t)tok * D_ + s * 256 + l15 * 16 + 8 * b5 + 4 * b4) = make_uint2(pk2(q4[0], q4[1]), pk2(q4[2], q4[3]));
    }
  });
}

DI void phase12(const Params& p) {
  const float* X1 = (const float*)(p.ws + WS_X1); const u16* OUTP = (const u16*)(p.ws + WS_OUTP);
  const float* mod = (const float*)(p.ws + WS_MOD); const float* gfin = p.in[19];
  const int lane = threadIdx.x & 63, w = threadIdx.x >> 6;
  for (int row = blockIdx.x * 4 + w; row < T_; row += gridDim.x * 4) {
    const float* gt = mod + (row >> 11) * 12288 + 5 * 2048;
    float4 v[8];
    float ss = 0.f;
#pragma unroll
    for (int j = 0; j < 8; ++j) {
      const int d = j * 256 + lane * 4;
      const float4 xv = *(const float4*)(X1 + (size_t)row * D_ + d), gv = *(const float4*)(gt + d);
      const uint2 ob = *(const uint2*)(OUTP + (size_t)row * D_ + d);
      const float4 ov = make_float4(bflo(ob.x), bfhi(ob.x), bflo(ob.y), bfhi(ob.y));
      v[j] = make_float4(xv.x + gv.x * ov.x, xv.y + gv.y * ov.y, xv.z + gv.z * ov.z, xv.w + gv.w * ov.w);
      ss += v[j].x * v[j].x + v[j].y * v[j].y + v[j].z * v[j].z + v[j].w * v[j].w;
    }
    ss = wave_sum(ss);
    const float rstd = rsqrtf(ss * (1.f / D_) + EPS);
#pragma unroll
    for (int j = 0; j < 8; ++j) {
      const int d = j * 256 + lane * 4;
      const float4 gv = *(const float4*)(gfin + d);
      *(float4*)(p.out + (size_t)row * D_ + d) = make_float4(v[j].x * rstd * gv.x, v[j].y * rstd * gv.y, v[j].z * rstd * gv.z, v[j].w * rstd * gv.w);
    }
  }
}

__global__ void __launch_bounds__(256, 2) mega(Params p) {
  extern __shared__ __attribute__((aligned(16))) char smem[];
  XcdBarrier xb;
  const bool multi = (p.ph_hi - p.ph_lo) > 1;
  if (multi) {
    if (threadIdx.x == 0) *(uint4*)smem = make_uint4(0u, 0u, 0u, 0u);
    __syncthreads();
    xb = xcd_barrier_post((unsigned*)(p.ws + WS_BAR), (volatile LAS unsigned*)smem);
  }
#ifndef PHMASK
#define PHMASK 0x1fff
#endif
#ifndef REPMASK
#define REPMASK 0
#endif
  int rep = 0;
#define RUN_PHASE(n, call) if (p.ph_lo <= (n) && (n) < p.ph_hi) { \
    if ((n) > p.ph_lo) { xcd_barrier(xb); } \
    if (PHMASK & (1 << (n))) { call; if (REPMASK & (1 << (n))) { xcd_barrier(xb); rep = 1; call; rep = 0; } } }
  RUN_PHASE(0, phase0(p, smem))
  RUN_PHASE(1, phase1(p, smem))
#ifdef BARX
  for (int i = 0; i < BARX; ++i) xcd_barrier(xb);
#endif
  RUN_PHASE(2, phase2(p, smem))
  RUN_PHASE(3, phase3(p, smem))
  RUN_PHASE(4, phase4(p, smem))
  RUN_PHASE(5, phase5(p, smem))
  RUN_PHASE(6, norm_rows<true>((const float*)(p.ws + WS_X1), p.in[14], (const float*)(p.ws + WS_MOD) + 3 * 2048, 12288, (u16*)(p.ws + WS_H), (unsigned char*)(p.ws + WS_H2Q), (float*)(p.ws + WS_HSC)))
  RUN_PHASE(7, phase7(p, smem))
  RUN_PHASE(8, phase8(p, smem))
  RUN_PHASE(9, phase9(p, smem, rep))
  RUN_PHASE(10, phase10(p))
  RUN_PHASE(11, phase11(p, smem, rep))
  RUN_PHASE(12, phase12(p))
}

extern "C" void kernel_launch(void* const* d_in, const int* in_sizes, int n_in, void* d_out, int out_size, void* d_ws, size_t ws_size, hipStream_t stream) {
  static int grid = 0;
  if (grid == 0) {
    if (n_in != 20 || ws_size < WS_END) { fprintf(stderr, "kernel_launch: unexpected n_in %d / ws_size %zu (need %zu)\n", n_in, ws_size, (size_t)WS_END); grid = -1; return; }
    int dev = 0, cus = 0, per_cu = 0;
    hipGetDevice(&dev);
    hipDeviceGetAttribute(&cus, hipDeviceAttributeMultiprocessorCount, dev);
    hipFuncSetAttribute((const void*)mega, hipFuncAttributeMaxDynamicSharedMemorySize, LDS_BYTES);
    hipOccupancyMaxActiveBlocksPerMultiprocessor(&per_cu, (const void*)mega, 256, LDS_BYTES);
    if (per_cu < 1) { fprintf(stderr, "kernel_launch: occupancy query says %d\n", per_cu); per_cu = 1; }
    if (per_cu > 2) per_cu = 2;
    grid = cus * per_cu;
    fprintf(stderr, "kernel_launch: grid %d (%d per CU)\n", grid, per_cu);
  }
  if (grid < 0) return;
  Params p{};
  for (int i = 0; i < 20; ++i) p.in[i] = (const float*)d_in[i];
  p.out = (float*)d_out; p.ws = (char*)d_ws;
#if N_LAUNCH_PER_PHASE
  p.coop = 0;
  for (int ph = 0; ph < NPH; ++ph) {
    p.ph_lo = ph; p.ph_hi = ph + 1;
    hipLaunchKernelGGL(mega, dim3(grid), dim3(256), LDS_BYTES, stream, p);
  }
#else
  hipMemsetAsync((char*)d_ws + WS_BAR, 0, WS_MOD, stream);
  p.coop = 0; p.ph_lo = 0; p.ph_hi = NPH;
  void* args[] = {&p};
  hipError_t e = hipLaunchCooperativeKernel((const void*)mega, dim3(grid), dim3(256), args, LDS_BYTES, stream);
  if (e != hipSuccess) fprintf(stderr, "cooperative launch failed: %s (grid %d)\n", hipGetErrorString(e), grid);
#endif
}
```

```cpp
#include <hip/hip_runtime.h>
#include <cstdio>
#include <cstdint>

#ifndef N_LAUNCH_PER_PHASE
#define N_LAUNCH_PER_PHASE 0
#endif

#define DI __device__ __forceinline__
typedef unsigned short u16;
typedef __attribute__((ext_vector_type(8))) short bf16x8;
typedef __attribute__((ext_vector_type(16))) float f32x16;
typedef __attribute__((ext_vector_type(2))) __bf16 bf2_t;
typedef __attribute__((ext_vector_type(2))) float f2_t;
typedef __attribute__((ext_vector_type(4))) unsigned u32x4;
typedef __attribute__((ext_vector_type(2))) unsigned u32x2;
#define MFMA(a, b, c) __builtin_amdgcn_mfma_f32_32x32x16_bf16((a), (b), (c), 0, 0, 0)

constexpr int T_ = 8192, D_ = 2048, S_ = 2048;
constexpr int INC = 4160;
constexpr float EPS = 1e-6f;
constexpr int NPH = 13;

constexpr size_t al256(size_t x) { return (x + 255) & ~(size_t)255; }
constexpr size_t WS_BAR = 0;
constexpr size_t WS_MOD = 32768;
constexpr size_t WS_ROPE = WS_MOD + al256(4 * 12288 * 4);
constexpr size_t WS_WINT = WS_ROPE + al256(2048 * 32 * 8);
constexpr size_t WS_WUQT = WS_WINT + al256((size_t)4224 * 2048 * 2);
constexpr size_t WS_WUKVT = WS_WUQT + al256((size_t)1536 * 512 * 2);
constexpr size_t WS_WOUTT = WS_WUKVT + al256((size_t)2048 * 512 * 2);
constexpr size_t WS_WQT = WS_WOUTT + al256((size_t)2048 * 2048 * 2);
constexpr size_t WS_SK = WS_WQT + al256((size_t)2048 * 2048 * 2);
constexpr size_t WS_U = WS_SK + al256((size_t)262144 * 2);
constexpr size_t WS_V = WS_U + al256((size_t)16384 * 2048);
constexpr size_t WS_H = WS_V + al256((size_t)16384 * 2048);
constexpr size_t WS_P = WS_H + al256((size_t)T_ * D_ * 2);
constexpr size_t WS_Q = WS_P + al256((size_t)T_ * INC * 2);
constexpr size_t WS_K = WS_Q + al256((size_t)T_ * 1536 * 2);
constexpr size_t WS_VT = WS_K + al256((size_t)T_ * 1536 * 2);
constexpr size_t WS_MG = WS_VT + al256((size_t)T_ * 1024 * 2);
constexpr size_t WS_X1 = WS_MG + al256((size_t)T_ * D_ * 2);
constexpr size_t WS_IDS = WS_X1 + al256((size_t)T_ * D_ * 4);
constexpr size_t WS_GATE = WS_IDS + al256((size_t)T_ * 128 * 4);
constexpr size_t WS_USC = WS_GATE + al256((size_t)T_ * 128 * 4);
constexpr size_t WS_VSC = WS_USC + 65536;
constexpr size_t WS_MODP = WS_VSC + 65536;
constexpr size_t WS_ACT = WS_MODP + al256((size_t)4 * 4 * 12288 * 4);
constexpr size_t WS_H2Q = WS_ACT + al256((size_t)T_ * 128 * 4);
constexpr size_t WS_HSC = WS_H2Q + al256((size_t)T_ * D_);
constexpr size_t WS_SSQ = WS_HSC + al256((size_t)T_ * 4);
constexpr size_t WS_END = WS_SSQ + al256((size_t)T_ * 16 * 4);
constexpr size_t WS_PA = WS_MG;
constexpr size_t WS_OUTP = WS_Q;
static_assert(WS_VT + (size_t)T_ * 1024 * 2 - WS_Q >= (size_t)T_ * D_ * 4, "OUTP alias");
static_assert((size_t)8 * T_ * 128 * 4 <= (size_t)T_ * D_ * 2, "PA alias");

constexpr int LDS_BYTES = 16 + 2 * 2 * 128 * 72 * 2 + 512;

struct Params {
  const float* in[20];
  float* out;
  char* ws;
  int ph_lo, ph_hi, coop, pad;
};

DI unsigned pk2(float a, float b) { f2_t v = {a, b}; bf2_t r = __builtin_convertvector(v, bf2_t); return __builtin_bit_cast(unsigned, r); }
DI float bflo(unsigned u) { return __uint_as_float(u << 16); }
DI float bfhi(unsigned u) { return __uint_as_float(u & 0xffff0000u); }
DI float dot2(unsigned a, unsigned b, float c) { return __builtin_amdgcn_fdot2_f32_bf16(__builtin_bit_cast(bf2_t, a), __builtin_bit_cast(bf2_t, b), c, false); }
DI float wave_sum(float v) {
#pragma unroll
  for (int o = 32; o >= 1; o >>= 1) v += __shfl_xor(v, o);
  return v;
}

#define XB_TMO      128
#define XB_XCNT(j)  (256  + 64 * (j))
#define XB_XSUB(j)  (1280 + 64 * (j))
#define XB_XGEN(j)  (2304 + 64 * (j))
#define XB_TOP      3328
#define XB_TOPGEN   3392
#define XCD_BAR_WORDS 3456
#define XB_SPIN_CAP (1u << 22)
#define LAS __attribute__((address_space(3)))
DI unsigned xb_ld(unsigned* p) { return __hip_atomic_load(p, __ATOMIC_RELAXED, __HIP_MEMORY_SCOPE_AGENT); }
DI unsigned xb_add(unsigned* p, unsigned v) { return __hip_atomic_fetch_add(p, v, __ATOMIC_RELAXED, __HIP_MEMORY_SCOPE_AGENT); }
DI unsigned xb_xcc_id() { return (unsigned)__builtin_amdgcn_s_getreg((3 << 11) | 20) & 0xFu; }
#define XB_SPIN(cond, bar) do { unsigned _sp = 0; while (cond) { __builtin_amdgcn_s_sleep(1); \
    if ((++_sp & 255u) == 0u) { if (xb_ld(&(bar)[XB_TMO])) break; if (_sp > XB_SPIN_CAP) { atomicAdd(&(bar)[XB_TMO], 1u); break; } } } } while (0)
struct XcdBarrier { unsigned* bar; unsigned x; volatile LAS unsigned* st; };
DI XcdBarrier xcd_barrier_post(unsigned* bar, volatile LAS unsigned* st) {
  XcdBarrier b; b.bar = bar; b.x = xb_xcc_id(); b.st = st;
  if (threadIdx.x == 0) (void)xb_add(&bar[XB_XCNT(b.x)], 1u);
  return b;
}
DI void xcd_barrier_complete(unsigned* bar, unsigned x, unsigned& nloc, unsigned& nx) {
  const unsigned G = gridDim.x * gridDim.y * gridDim.z;
  unsigned sum, cnt, mine, sp = 0u;
  for (;;) {
    sum = 0u; cnt = 0u; mine = 0u;
#pragma unroll
    for (unsigned j = 0; j < 16; ++j) { const unsigned c = xb_ld(&bar[XB_XCNT(j)]); sum += c; cnt += (c > 0u) ? 1u : 0u; mine = (j == x) ? c : mine; }
    if (sum == G) break;
    __builtin_amdgcn_s_sleep(1);
    if ((++sp & 255u) == 0u) { if (xb_ld(&bar[XB_TMO])) break; if (sp > XB_SPIN_CAP) { atomicAdd(&bar[XB_TMO], 1u); break; } }
  }
  nloc = mine > 0u ? mine : 1u; nx = cnt > 0u ? cnt : 1u;
}
DI void xcd_barrier(const XcdBarrier& b) {
  asm volatile("s_waitcnt vmcnt(0)" ::: "memory");
  __syncthreads();
  if (threadIdx.x == 0) {
    unsigned* bar = b.bar;
    __builtin_amdgcn_s_waitcnt(0);
    unsigned nloc = b.st[0], nx = b.st[1];
    if (nloc == 0u) { xcd_barrier_complete(bar, b.x, nloc, nx); b.st[0] = nloc; b.st[1] = nx; }
    const unsigned old = xb_add(&bar[XB_XSUB(b.x)], 1u);
    const unsigned gen = old / nloc;
    if (old + 1u == (gen + 1u) * nloc) {
      __builtin_amdgcn_fence(__ATOMIC_RELEASE, "agent");
      asm volatile("s_waitcnt vmcnt(0)" ::: "memory");
      const unsigned og = xb_add(&bar[XB_TOP], 1u);
      const unsigned tg = og / nx;
      if (og + 1u == (tg + 1u) * nx) xb_add(&bar[XB_TOPGEN], 1u);
      else XB_SPIN(xb_ld(&bar[XB_TOPGEN]) == tg, bar);
      __builtin_amdgcn_fence(__ATOMIC_ACQUIRE, "agent");
      xb_add(&bar[XB_XGEN(b.x)], 1u);
      asm volatile("s_waitcnt vmcnt(0)" ::: "memory");
    } else {
      XB_SPIN(xb_ld(&bar[XB_XGEN(b.x)]) == gen, bar);
      __builtin_amdgcn_fence(__ATOMIC_ACQUIRE, "agent");
      asm volatile("s_waitcnt vmcnt(0)" ::: "memory");
    }
  }
  __syncthreads();
}

template <bool SWAP, class Epi>
DI void gemm_tile(const u16* __restrict__ A, int lda, const u16* __restrict__ Bt, int ldb, int K, int m0, int n0, char* smem, Epi&& epi) {
  u16* As = (u16*)(smem + 16);
  u16* Bs = As + 2 * 128 * 72;
  const int tid = threadIdx.x, lane = tid & 63, w = tid >> 6, wm = w >> 1, wn = w & 1;
  const int r = lane & 31, hi = lane >> 5;
  f32x16 acc[2][2];
#pragma unroll
  for (int a = 0; a < 2; ++a)
#pragma unroll
    for (int b = 0; b < 2; ++b)
#pragma unroll
      for (int i = 0; i < 16; ++i) acc[a][b][i] = 0.f;
  const int srow = tid >> 3, skc = tid & 7;
  const u16* ag = A + (size_t)(m0 + srow) * lda + skc * 8;
  const u16* bg = Bt + (size_t)(n0 + srow) * ldb + skc * 8;
  u32x4 ra[4], rb[4];
#pragma unroll
  for (int i = 0; i < 4; ++i) { ra[i] = *(const u32x4*)(ag + (size_t)i * 32 * lda); rb[i] = *(const u32x4*)(bg + (size_t)i * 32 * ldb); }
  __syncthreads();
#pragma unroll
  for (int i = 0; i < 4; ++i) { *(u32x4*)(As + (srow + 32 * i) * 72 + skc * 8) = ra[i]; *(u32x4*)(Bs + (srow + 32 * i) * 72 + skc * 8) = rb[i]; }
  __syncthreads();
  const int KT = K >> 6;
  for (int kt = 0; kt < KT; ++kt) {
    const int buf = kt & 1;
    if (kt + 1 < KT) {
      const int k0 = (kt + 1) << 6;
#pragma unroll
      for (int i = 0; i < 4; ++i) { ra[i] = *(const u32x4*)(ag + (size_t)i * 32 * lda + k0); rb[i] = *(const u32x4*)(bg + (size_t)i * 32 * ldb + k0); }
    }
    const u16* Asb = As + buf * 128 * 72 + (wm * 64 + r) * 72 + hi * 8;
    const u16* Bsb = Bs + buf * 128 * 72 + (wn * 64 + r) * 72 + hi * 8;
#pragma unroll
    for (int ks = 0; ks < 4; ++ks) {
      bf16x8 af[2], bfr[2];
      af[0] = *(const bf16x8*)(Asb + ks * 16);
      af[1] = *(const bf16x8*)(Asb + 32 * 72 + ks * 16);
      bfr[0] = *(const bf16x8*)(Bsb + ks * 16);
      bfr[1] = *(const bf16x8*)(Bsb + 32 * 72 + ks * 16);
#pragma unroll
      for (int mi = 0; mi < 2; ++mi)
#pragma unroll
        for (int ni = 0; ni < 2; ++ni) {
          if (SWAP) acc[mi][ni] = MFMA(bfr[ni], af[mi], acc[mi][ni]);
          else acc[mi][ni] = MFMA(af[mi], bfr[ni], acc[mi][ni]);
        }
    }
    if (kt + 1 < KT) {
      const int nb = buf ^ 1;
#pragma unroll
      for (int i = 0; i < 4; ++i) { *(u32x4*)(As + nb * 128 * 72 + (srow + 32 * i) * 72 + skc * 8) = ra[i]; *(u32x4*)(Bs + nb * 128 * 72 + (srow + 32 * i) * 72 + skc * 8) = rb[i]; }
    }
    __syncthreads();
  }
  epi(acc, m0 + wm * 64, n0 + wn * 64, r, hi);
}

DI void tile_rstd512(const u16* __restrict__ A, int lda, int m0, float* rs) {
  const int tid = threadIdx.x, row = tid >> 1, half = tid & 1;
  const uint4* p = (const uint4*)(A + (size_t)(m0 + row) * lda + half * 256);
  float ss = 0.f;
#pragma unroll 8
  for (int i = 0; i < 32; ++i) {
    uint4 v = p[i];
    ss = dot2(v.x, v.x, ss); ss = dot2(v.y, v.y, ss); ss = dot2(v.z, v.z, ss); ss = dot2(v.w, v.w, ss);
  }
  ss += __shfl_xor(ss, 1);
  if (half == 0) rs[row] = rsqrtf(ss * (1.f / 512.f) + EPS);
}

DI void transpose_item(const float* __restrict__ src, int N, int K, const float* __restrict__ scale, u16* __restrict__ dst, int tk, int tn, char* smem) {
  float* tile = (float*)(smem + 16);
  const int t = threadIdx.x;
  __syncthreads();
  {
    const int rr = t >> 4, c4 = (t & 15) * 4;
#pragma unroll
    for (int ps = 0; ps < 4; ++ps) {
      const int kk = ps * 16 + rr, k = tk * 64 + kk;
      float4 v = *(const float4*)(src + (size_t)k * N + tn * 64 + c4);
      const float sc = scale ? scale[k] : 1.f;
      tile[kk * 65 + c4 + 0] = v.x * sc; tile[kk * 65 + c4 + 1] = v.y * sc; tile[kk * 65 + c4 + 2] = v.z * sc; tile[kk * 65 + c4 + 3] = v.w * sc;
    }
  }
  __syncthreads();
  {
    const int n = t & 63, kc = (t >> 6) * 16;
    unsigned o[8];
#pragma unroll
    for (int j = 0; j < 8; ++j) o[j] = pk2(tile[(kc + 2 * j) * 65 + n], tile[(kc + 2 * j + 1) * 65 + n]);
    uint4* d = (uint4*)(dst + (size_t)(tn * 64 + n) * K + tk * 64 + kc);
    d[0] = make_uint4(o[0], o[1], o[2], o[3]); d[1] = make_uint4(o[4], o[5], o[6], o[7]);
  }
}

DI void convert_item(const float* __restrict__ src, u16* __restrict__ dst, size_t base) {
  const int t = threadIdx.x;
#pragma unroll
  for (int st = 0; st < 4; ++st) {
    const size_t idx = base + st * 2048 + t * 8;
    float4 a = *(const float4*)(src + idx), b = *(const float4*)(src + idx + 4);
    *(uint4*)(dst + idx) = make_uint4(pk2(a.x, a.y), pk2(a.z, a.w), pk2(b.x, b.y), pk2(b.z, b.w));
  }
}

DI float wave_max(float v) {
#pragma unroll
  for (int o = 32; o >= 1; o >>= 1) v = fmaxf(v, __shfl_xor(v, o));
  return v;
}
DI void fp8_rows_item(const float* __restrict__ src, unsigned char* __restrict__ dst, float* __restrict__ scales, int item) {
  const int lane = threadIdx.x & 63, w = threadIdx.x >> 6;
  const int row = item * 4 + w;
  const float* sr = src + (size_t)row * 2048 + lane * 16;
  float4 v[8];
  float amax = 0.f;
#pragma unroll
  for (int j = 0; j < 2; ++j)
#pragma unroll
    for (int q = 0; q < 4; ++q) {
      const float4 t = *(const float4*)(sr + 1024 * j + q * 4);
      v[j * 4 + q] = t;
      amax = fmaxf(amax, fmaxf(fmaxf(fabsf(t.x), fabsf(t.y)), fmaxf(fabsf(t.z), fabsf(t.w))));
    }
  amax = wave_max(amax);
  int e = 0;
  if (amax > 0.f) e = (int)floorf(log2f(384.f / amax));
  e = e < -100 ? -100 : (e > 100 ? 100 : e);
  const float sc = ldexpf(1.f, e);
  if (lane == 0) scales[row] = ldexpf(1.f, -e);
#pragma unroll
  for (int j = 0; j < 2; ++j) {
    unsigned d[4];
#pragma unroll
    for (int q = 0; q < 4; ++q) {
      const float4 t = v[j * 4 + q];
      unsigned pk = __builtin_amdgcn_cvt_pk_fp8_f32(t.x * sc, t.y * sc, 0, false);
      pk = __builtin_amdgcn_cvt_pk_fp8_f32(t.z * sc, t.w * sc, pk, true);
      d[q] = pk;
    }
    *(uint4*)(dst + (size_t)row * 2048 + 1024 * j + lane * 16) = make_uint4(d[0], d[1], d[2], d[3]);
  }
}

DI unsigned pack_i8x4(float a, float b, float c, float d) {
  const int ia = __float2int_rn(a), ib = __float2int_rn(b), ic = __float2int_rn(c), id = __float2int_rn(d);
  return (unsigned)(ia & 0xff) | ((unsigned)(ib & 0xff) << 8) | ((unsigned)(ic & 0xff) << 16) | ((unsigned)id << 24);
}
DI void i8_rows_item(const float* __restrict__ src, unsigned char* __restrict__ dst, float* __restrict__ scales, int item) {
  const int lane = threadIdx.x & 63, w = threadIdx.x >> 6;
  const int row = item * 4 + w;
  const float* sr = src + (size_t)row * 2048 + lane * 16;
  float4 v[8];
  float amax = 0.f;
#pragma unroll
  for (int j = 0; j < 2; ++j)
#pragma unroll
    for (int q = 0; q < 4; ++q) {
      const float4 t = *(const float4*)(sr + 1024 * j + q * 4);
      v[j * 4 + q] = t;
      amax = fmaxf(amax, fmaxf(fmaxf(fabsf(t.x), fabsf(t.y)), fmaxf(fabsf(t.z), fabsf(t.w))));
    }
  amax = wave_max(amax);
  const float sc = amax > 0.f ? 127.f / amax : 0.f;
  if (lane == 0) scales[row] = amax * (1.f / 127.f);
#pragma unroll
  for (int j = 0; j < 2; ++j) {
    unsigned d[4];
#pragma unroll
    for (int q = 0; q < 4; ++q) { const float4 t = v[j * 4 + q]; d[q] = pack_i8x4(t.x * sc, t.y * sc, t.z * sc, t.w * sc); }
    *(uint4*)(dst + (size_t)row * 2048 + 1024 * j + lane * 16) = make_uint4(d[0], d[1], d[2], d[3]);
  }
}

DI void mod_item(const Params& p, int item, char* smem) {
  float* cact = (float*)(smem + 16);
  float* red = cact + 4 * 512;
  const int t = threadIdx.x;
  const int cgi = item % 192, ksp = item / 192, kbase = ksp * 512;
  const float* c = p.in[1]; const float* W = p.in[2];
  float* mod = (float*)(p.ws + WS_MODP);
  __syncthreads();
  for (int i = t; i < 4 * 512; i += 256) { float v = c[(i >> 9) * 2048 + kbase + (i & 511)]; cact[i] = v / (1.f + __expf(-v)); }
  __syncthreads();
  const int cq = t & 15, kl = t >> 4, c0 = cgi * 64;
  float acc[4][4];
#pragma unroll
  for (int b = 0; b < 4; ++b)
#pragma unroll
    for (int j = 0; j < 4; ++j) acc[b][j] = 0.f;
  const float* wp = W + (size_t)(kbase + kl) * 12288 + c0 + cq * 4;
#pragma unroll 8
  for (int i = 0; i < 32; ++i) {
    const int k = kl + 16 * i;
    float4 w4 = *(const float4*)(wp + (size_t)i * 16 * 12288);
#pragma unroll
    for (int b = 0; b < 4; ++b) {
      const float a = cact[b * 512 + k];
      acc[b][0] += a * w4.x; acc[b][1] += a * w4.y; acc[b][2] += a * w4.z; acc[b][3] += a * w4.w;
    }
  }
#pragma unroll
  for (int b = 0; b < 4; ++b)
#pragma unroll
    for (int j = 0; j < 4; ++j) red[(kl * 16 + cq) * 17 + b * 4 + j] = acc[b][j];
  __syncthreads();
  {
    const int b = t >> 6, col = t & 63, q = col >> 2, j = col & 3;
    float s = 0.f;
#pragma unroll
    for (int k2 = 0; k2 < 16; ++k2) s += red[(k2 * 16 + q) * 17 + b * 4 + j];
    mod[(size_t)ksp * 49152 + b * 12288 + c0 + col] = s;
  }
}

constexpr int P0_MOD = 768;
constexpr int P0_TIN = 32 * 65, P0_TUQ = 8 * 24, P0_TUKV = 8 * 32, P0_TOUT = 32 * 32, P0_TWQ = 32 * 32;
constexpr int P0_SK = 32, P0_UV = 0, P0_ROPE = 32;
DI void phase0(const Params& p, char* smem) {
  constexpr int o1 = P0_MOD, o2 = o1 + P0_TIN, o3 = o2 + P0_TUQ, o4 = o3 + P0_TUKV, o5 = o4 + P0_TOUT, o6 = o5 + P0_TWQ, o7 = o6 + P0_SK, o8 = o7 + P0_UV, o9 = o8 + P0_UV, o10 = o9 + P0_ROPE;
  for (int it = blockIdx.x; it < o10; it += gridDim.x) {
    if (it < o1) mod_item(p, it, smem);
    else if (it < o2) { int j = it - o1; transpose_item(p.in[5], INC, 2048, nullptr, (u16*)(p.ws + WS_WINT), j / 65, j % 65, smem); }
    else if (it < o3) { int j = it - o2; transpose_item(p.in[8], 1536, 512, p.in[7], (u16*)(p.ws + WS_WUQT), j / 24, j % 24, smem); }
    else if (it < o4) { int j = it - o3; transpose_item(p.in[10], 2048, 512, p.in[9], (u16*)(p.ws + WS_WUKVT), j / 32, j % 32, smem); }
    else if (it < o5) { int j = it - o4; int tk = j / 32; transpose_item(p.in[13], 2048, 2048, tk < 16 ? p.in[11] : p.in[12] - 1024, (u16*)(p.ws + WS_WOUTT), tk, j % 32, smem); }
    else if (it < o6) { int j = it - o5; transpose_item(p.in[15], 2048, 2048, nullptr, (u16*)(p.ws + WS_WQT), j / 32, j % 32, smem); }
    else if (it < o7) convert_item(p.in[16], (u16*)(p.ws + WS_SK), (size_t)(it - o6) * 8192);
    else if (it < o8) fp8_rows_item(p.in[17], (unsigned char*)(p.ws + WS_U), (float*)(p.ws + WS_USC), it - o7);
    else if (it < o9) fp8_rows_item(p.in[18], (unsigned char*)(p.ws + WS_V), (float*)(p.ws + WS_VSC), it - o8);
    else {
      float2* rope = (float2*)(p.ws + WS_ROPE);
      const int base = (it - o9) * 2048;
      for (int e = threadIdx.x; e < 2048; e += 256) {
        const int idx = base + e, pos = idx >> 5, j = idx & 31;
        const float inv = 1.0f / powf(10000.0f, (float)(2 * j) / 64.0f);
        const float ang = (float)pos * inv;
        rope[idx] = make_float2(cosf(ang), sinf(ang));
      }
    }
  }
}

template <bool Q8>
DI void norm_rows(const float* __restrict__ X, const float* __restrict__ g, const float* mod, int bstride, u16* __restrict__ out, unsigned char* __restrict__ outq, float* __restrict__ qscale) {
  const int lane = threadIdx.x & 63, w = threadIdx.x >> 6;
  for (int row = blockIdx.x * 4 + w; row < T_; row += gridDim.x * 4) {
    const float* xr = X + (size_t)row * D_;
    float4 v[8];
    float ss = 0.f;
#pragma unroll
    for (int j = 0; j < 8; ++j) { v[j] = *(const float4*)(xr + j * 256 + lane * 4); ss += v[j].x * v[j].x + v[j].y * v[j].y + v[j].z * v[j].z + v[j].w * v[j].w; }
    ss = wave_sum(ss);
    const float rstd = rsqrtf(ss * (1.f / D_) + EPS);
    const int b = row >> 11;
    const float* sh = mod + b * bstride;
    const float* sc = sh + 2048;
    float amax = 0.f;
#pragma unroll
    for (int j = 0; j < 8; ++j) {
      const int d = j * 256 + lane * 4;
      const float4 gg = *(const float4*)(g + d), s4 = *(const float4*)(sc + d), h4 = *(const float4*)(sh + d);
      const float o0 = v[j].x * rstd * gg.x * (1.f + s4.x) + h4.x;
      const float o1 = v[j].y * rstd * gg.y * (1.f + s4.y) + h4.y;
      const float o2 = v[j].z * rstd * gg.z * (1.f + s4.z) + h4.z;
      const float o3 = v[j].w * rstd * gg.w * (1.f + s4.w) + h4.w;
      *(uint2*)(out + (size_t)row * D_ + d) = make_uint2(pk2(o0, o1), pk2(o2, o3));
      if (Q8) { v[j] = make_float4(o0, o1, o2, o3); amax = fmaxf(amax, fmaxf(fmaxf(fabsf(o0), fabsf(o1)), fmaxf(fabsf(o2), fabsf(o3)))); }
    }
    if (Q8) {
      amax = wave_max(amax);
      const float qs = amax > 0.f ? 127.f / amax : 0.f;
      if (lane == 0) qscale[row] = amax * (1.f / 127.f);
#pragma unroll
      for (int j = 0; j < 8; ++j) *(unsigned*)(outq + (size_t)row * D_ + j * 256 + lane * 4) = pack_i8x4(v[j].x * qs, v[j].y * qs, v[j].z * qs, v[j].w * qs);
    }
  }
}
DI void phase1(const Params& p, char* smem) {
  const float* mp = (const float*)(p.ws + WS_MODP); float* mod = (float*)(p.ws + WS_MOD); const float* bias = p.in[3];
  for (int i = blockIdx.x * 256 + threadIdx.x; i < 49152; i += gridDim.x * 256)
    mod[i] = ((mp[i] + mp[49152 + i]) + mp[2 * 49152 + i]) + mp[3 * 49152 + i] + bias[i % 12288];
  float* lm = (float*)(smem + 16);
  __syncthreads();
  for (int i = threadIdx.x; i < 4 * 4096; i += 256) {
    const int b = i >> 12, c = i & 4095, src = b * 12288 + c;
    lm[i] = ((mp[src] + mp[49152 + src]) + mp[2 * 49152 + src]) + mp[3 * 49152 + src] + bias[c];
  }
  __syncthreads();
  norm_rows<false>(p.in[0], p.in[4], lm, 4096, (u16*)(p.ws + WS_H), nullptr, nullptr);
}

constexpr int CTR_TILE = 3520, CTR_CHUNK = 3584;
DI int grab(unsigned* ctr, char* smem) {
  __syncthreads();
  if (threadIdx.x == 0) *(volatile unsigned*)(smem + 8) = atomicAdd(ctr, 1u);
  __syncthreads();
  return (int)*(volatile unsigned*)(smem + 8);
}
DI void uv_chunk(const Params& p, int c) {
#pragma unroll 1
  for (int i = 0; i < 4; ++i) {
    const int item = c * 4 + i;
    if (item < 4096) i8_rows_item(p.in[17], (unsigned char*)(p.ws + WS_U), (float*)(p.ws + WS_USC), item);
    else fp8_rows_item(p.in[18], (unsigned char*)(p.ws + WS_V), (float*)(p.ws + WS_VSC), item - 4096);
  }
}
DI void phase2(const Params& p, char* smem) {
  const u16* H = (const u16*)(p.ws + WS_H); const u16* W = (const u16*)(p.ws + WS_WINT); u16* P = (u16*)(p.ws + WS_P); float* SSQ = (float*)(p.ws + WS_SSQ);
  unsigned* ctr = (unsigned*)(p.ws + WS_BAR);
  if (blockIdx.x & 1) {
#pragma unroll 1
    for (int q = 0; q < 4; ++q) { const int c = grab(ctr + CTR_CHUNK, smem); if (c < 2048) uv_chunk(p, c); }
  }
  for (;;) {
    const int it = grab(ctr + CTR_TILE, smem);
    if (it >= 64 * 33) break;
    const int tn = it / 64, tm = it % 64;
    gemm_tile<true>(H, D_, W, D_, D_, tm * 128, tn * 128, smem, [&](f32x16 (&acc)[2][2], int mb, int nb, int r, int hi) __attribute__((always_inline)) {
      if (nb >= INC) return;
#pragma unroll
      for (int mi = 0; mi < 2; ++mi)
#pragma unroll
        for (int ni = 0; ni < 2; ++ni)
#pragma unroll
          for (int g = 0; g < 4; ++g) {
            const int row = mb + mi * 32 + r, col = nb + ni * 32 + hi * 4 + 8 * g;
            *(uint2*)(P + (size_t)row * INC + col) = make_uint2(pk2(acc[mi][ni][4 * g], acc[mi][ni][4 * g + 1]), pk2(acc[mi][ni][4 * g + 2], acc[mi][ni][4 * g + 3]));
          }
      if (nb >= 3072 && nb < 4096) {
#pragma unroll
        for (int mi = 0; mi < 2; ++mi) {
          float ss = 0.f;
#pragma unroll
          for (int ni = 0; ni < 2; ++ni)
#pragma unroll
            for (int i = 0; i < 16; ++i) ss += acc[mi][ni][i] * acc[mi][ni][i];
          ss += __shfl_xor(ss, 32);
          if (hi == 0) SSQ[(size_t)(mb + mi * 32 + r) * 16 + ((nb - 3072) >> 6)] = ss;
        }
      }
    });
  }
  for (;;) {
    const int c = grab(ctr + CTR_CHUNK, smem);
    if (c >= 2048) break;
    uv_chunk(p, c);
  }
}

DI void phase3(const Params& p, char* smem) {
  const u16* P = (const u16*)(p.ws + WS_P);
  u16* Q = (u16*)(p.ws + WS_Q); u16* Kb = (u16*)(p.ws + WS_K); u16* VT = (u16*)(p.ws + WS_VT); u16* MG = (u16*)(p.ws + WS_MG);
  const float2* rope = (const float2*)(p.ws + WS_ROPE); const float* SSQ = (const float*)(p.ws + WS_SSQ);
  float* rs = (float*)(smem + 16 + 2 * 2 * 128 * 72 * 2);
  constexpr int NQ = 64 * 12, NKV = 64 * 16, NKR = 1024, NCV = 1024;
  const float qscale = 0.07216878364870322f * 1.4426950408889634f;
  for (int it = blockIdx.x; it < NQ + NKV + NKR + NCV; it += gridDim.x) {
    if (it < NQ) {
      const int tn = it / 64, tm = it % 64;
      __syncthreads();
      if (threadIdx.x < 128) { const float4* sp = (const float4*)(SSQ + (size_t)(tm * 128 + threadIdx.x) * 16); const float4 a = sp[0], b = sp[1]; rs[threadIdx.x] = rsqrtf((((a.x + a.y) + (a.z + a.w)) + ((b.x + b.y) + (b.z + b.w))) * (1.f / 512.f) + EPS); }
      gemm_tile<true>(P + 3072, INC, (const u16*)(p.ws + WS_WUQT), 512, 512, tm * 128, tn * 128, smem, [&](f32x16 (&acc)[2][2], int mb, int nb, int r, int hi) __attribute__((always_inline)) {
        const bool is_rope = ((nb >> 6) % 3) == 2;
#pragma unroll
        for (int mi = 0; mi < 2; ++mi) {
          const int row = mb + mi * 32 + r;
          const float sc = rs[row - tm * 128] * qscale;
          const int pos = row & (S_ - 1);
#pragma unroll
          for (int g = 0; g < 4; ++g) {
            const int j = hi * 4 + 8 * g;
            float a0[4], a1[4];
#pragma unroll
            for (int e = 0; e < 4; ++e) { a0[e] = acc[mi][0][4 * g + e] * sc; a1[e] = acc[mi][1][4 * g + e] * sc; }
            if (is_rope) {
#pragma unroll
              for (int e = 0; e < 4; ++e) {
                const float2 cs = rope[pos * 32 + j + e];
                const float x1 = a0[e], x2 = a1[e];
                a0[e] = x1 * cs.x - x2 * cs.y; a1[e] = x2 * cs.x + x1 * cs.y;
              }
            }
            *(uint2*)(Q + (size_t)row * 1536 + nb + j) = make_uint2(pk2(a0[0], a0[1]), pk2(a0[2], a0[3]));
            *(uint2*)(Q + (size_t)row * 1536 + nb + 32 + j) = make_uint2(pk2(a1[0], a1[1]), pk2(a1[2], a1[3]));
          }
        }
      });
    } else if (it < NQ + NKV) {
      const int j2 = it - NQ, tn = j2 / 64, tm = j2 % 64;
      __syncthreads();
      if (threadIdx.x < 128) { const float4* sp = (const float4*)(SSQ + (size_t)(tm * 128 + threadIdx.x) * 16 + 8); const float4 a = sp[0], b = sp[1]; rs[threadIdx.x] = rsqrtf((((a.x + a.y) + (a.z + a.w)) + ((b.x + b.y) + (b.z + b.w))) * (1.f / 512.f) + EPS); }
      const int head = tn >> 1;
      if ((tn & 1) == 0) {
        gemm_tile<true>(P + 3584, INC, (const u16*)(p.ws + WS_WUKVT), 512, 512, tm * 128, tn * 128, smem, [&](f32x16 (&acc)[2][2], int mb, int nb, int r, int hi) __attribute__((always_inline)) {
#pragma unroll
          for (int mi = 0; mi < 2; ++mi) {
            const int row = mb + mi * 32 + r;
            const float sc = rs[row - tm * 128];
#pragma unroll
            for (int ni = 0; ni < 2; ++ni)
#pragma unroll
              for (int g = 0; g < 4; ++g) {
                const int d = (nb & 127) + ni * 32 + hi * 4 + 8 * g;
                *(uint2*)(Kb + (size_t)row * 1536 + head * 192 + d) = make_uint2(pk2(acc[mi][ni][4 * g] * sc, acc[mi][ni][4 * g + 1] * sc), pk2(acc[mi][ni][4 * g + 2] * sc, acc[mi][ni][4 * g + 3] * sc));
              }
          }
        });
      } else {
        gemm_tile<false>(P + 3584, INC, (const u16*)(p.ws + WS_WUKVT), 512, 512, tm * 128, tn * 128, smem, [&](f32x16 (&acc)[2][2], int mb, int nb, int r, int hi) __attribute__((always_inline)) {
#pragma unroll
          for (int mi = 0; mi < 2; ++mi)
#pragma unroll
            for (int g = 0; g < 4; ++g) {
              const int row0 = mb + mi * 32 + hi * 4 + 8 * g;
              const float s0 = rs[row0 - tm * 128], s1 = rs[row0 + 1 - tm * 128], s2 = rs[row0 + 2 - tm * 128], s3 = rs[row0 + 3 - tm * 128];
              const int b = row0 >> 11, t = row0 & (S_ - 1);
#pragma unroll
              for (int ni = 0; ni < 2; ++ni) {
                const int d = (nb & 127) + ni * 32 + r;
                *(uint2*)(VT + ((size_t)((b * 8 + head) * 128 + d)) * S_ + t) = make_uint2(pk2(acc[mi][ni][4 * g] * s0, acc[mi][ni][4 * g + 1] * s1), pk2(acc[mi][ni][4 * g + 2] * s2, acc[mi][ni][4 * g + 3] * s3));
              }
            }
        });
      }
    } else if (it < NQ + NKV + NKR) {
      const int j2 = it - NQ - NKV;
      const int row = j2 * 8 + (threadIdx.x >> 5), j = threadIdx.x & 31, pos = row & (S_ - 1);
      const float x1 = bflo((unsigned)P[(size_t)row * INC + 4096 + j]), x2 = bflo((unsigned)P[(size_t)row * INC + 4096 + 32 + j]);
      const float2 cs = rope[pos * 32 + j];
      const float o1 = x1 * cs.x - x2 * cs.y, o2 = x2 * cs.x + x1 * cs.y;
      const u16 b1 = (u16)(pk2(o1, 0.f) & 0xffffu), b2 = (u16)(pk2(o2, 0.f) & 0xffffu);
#pragma unroll
      for (int h = 0; h < 8; ++h) { Kb[(size_t)row * 1536 + h * 192 + 128 + j] = b1; Kb[(size_t)row * 1536 + h * 192 + 160 + j] = b2; }
    } else {
      const int j2 = it - NQ - NKV - NKR;
      const int wi = j2 * 4 + (threadIdx.x >> 6), lane = threadIdx.x & 63;
      const int g = wi & 7, run = wi >> 3;
      const int row0 = run * 16, t0 = row0 & (S_ - 1);
      const int ch = g * 128 + lane * 2;
      const float* cw = p.in[6];
      const float w00 = cw[ch], w01 = cw[ch + 1], w10 = cw[1024 + ch], w11 = cw[1024 + ch + 1], w20 = cw[2048 + ch], w21 = cw[2048 + ch + 1];
      float zm1a = 0.f, zm1b = 0.f, zm2a = 0.f, zm2b = 0.f;
      if (t0 > 0) {
        const unsigned c1 = *(const unsigned*)(P + (size_t)(row0 - 1) * INC + 1024 + ch), h1 = *(const unsigned*)(P + (size_t)(row0 - 1) * INC + 2048 + ch);
        const unsigned c2 = *(const unsigned*)(P + (size_t)(row0 - 2) * INC + 1024 + ch), h2 = *(const unsigned*)(P + (size_t)(row0 - 2) * INC + 2048 + ch);
        zm1a = bflo(c1) * bflo(h1); zm1b = bfhi(c1) * bfhi(h1); zm2a = bflo(c2) * bflo(h2); zm2b = bfhi(c2) * bfhi(h2);
      }
#pragma unroll 4
      for (int tt = 0; tt < 16; ++tt) {
        const size_t ro = (size_t)(row0 + tt) * INC;
        const unsigned bb = *(const unsigned*)(P + ro + ch), cc = *(const unsigned*)(P + ro + 1024 + ch), hh = *(const unsigned*)(P + ro + 2048 + ch);
        const float za = bflo(cc) * bflo(hh), zb = bfhi(cc) * bfhi(hh);
        const float ya = bflo(bb) * (w00 * zm2a + w10 * zm1a + w20 * za), yb = bfhi(bb) * (w01 * zm2b + w11 * zm1b + w21 * zb);
        zm2a = zm1a; zm2b = zm1b; zm1a = za; zm1b = zb;
        const float ss = wave_sum(ya * ya + yb * yb);
        const float rstd = rsqrtf(ss * (1.f / 128.f) + EPS);
        *(unsigned*)(MG + (size_t)(row0 + tt) * D_ + ch) = pk2(ya * rstd, yb * rstd);
      }
    }
  }
}

DI void phase4(const Params& p, char* smem) {
  const u16* Q = (const u16*)(p.ws + WS_Q); const u16* Kb = (const u16*)(p.ws + WS_K); const u16* VT = (const u16*)(p.ws + WS_VT);
  u16* MG = (u16*)(p.ws + WS_MG);
  u16* Ks = (u16*)(smem + 16);
  u16* Vs = Ks + 64 * 200;
  float* mrg = (float*)(smem + 16);
  const int tid = threadIdx.x, lane = tid & 63, w = tid >> 6, qh = w & 1, kh = w >> 1, r = lane & 31, hi = lane >> 5;
  for (int it = blockIdx.x; it < 512; it += gridDim.x) {
    const int pi = it & 15, h = (it >> 4) & 7, b = it >> 7;
    for (int sub = 0; sub < 2; ++sub) {
      const int c = sub ? (31 - pi) : pi;
      const size_t qrow = (size_t)b * S_ + c * 64 + qh * 32 + r;
      bf16x8 qf[12];
#pragma unroll
      for (int ks = 0; ks < 12; ++ks) qf[ks] = *(const bf16x8*)(Q + qrow * 1536 + h * 192 + ks * 16 + hi * 8);
      f32x16 O[4];
#pragma unroll
      for (int dt = 0; dt < 4; ++dt)
#pragma unroll
        for (int i = 0; i < 16; ++i) O[dt][i] = 0.f;
      float m = -1e30f, l = 0.f;
      u32x4 kr[6]; u32x4 vr[4];
      const u16* kg = Kb + ((size_t)b * S_ + (tid >> 2)) * 1536 + h * 192 + (tid & 3) * 8;
      const u16* vg = VT + ((size_t)((b * 8 + h) * 128 + (tid >> 1))) * S_ + (tid & 1) * 8;
      u16* ksw = Ks + (tid >> 2) * 200 + (tid & 3) * 8;
      u16* vsw = Vs + (tid >> 1) * 68 + (tid & 1) * 8;
      auto load_tile = [&]() __attribute__((always_inline)) {
#pragma unroll
        for (int i = 0; i < 6; ++i) kr[i] = *(const u32x4*)(kg + i * 32);
#pragma unroll
        for (int i = 0; i < 4; ++i) vr[i] = *(const u32x4*)(vg + i * 16);
        kg += 64 * 1536; vg += 64;
      };
      load_tile();
      for (int kt = 0; kt <= c; ++kt) {
        __syncthreads();
#pragma unroll
        for (int i = 0; i < 6; ++i) *(u32x4*)(ksw + i * 32) = kr[i];
#pragma unroll
        for (int i = 0; i < 4; ++i) { u32x2 lo2 = {vr[i][0], vr[i][1]}, hi2 = {vr[i][2], vr[i][3]}; *(u32x2*)(vsw + i * 16) = lo2; *(u32x2*)(vsw + i * 16 + 4) = hi2; }
        __syncthreads();
        if (kt < c) load_tile();
        f32x16 s;
#pragma unroll
        for (int i = 0; i < 16; ++i) s[i] = 0.f;
        const u16* kp = Ks + (kh * 32 + r) * 200 + hi * 8;
#pragma unroll
        for (int ks = 0; ks < 12; ++ks) { bf16x8 kf = *(const bf16x8*)(kp + ks * 16); s = MFMA(kf, qf[ks], s); }
        float mx = s[0];
#pragma unroll
        for (int i = 1; i < 16; ++i) mx = fmaxf(mx, s[i]);
        mx = fmaxf(mx, __shfl_xor(mx, 32));
        const float mn = fmaxf(m, mx);
        const float alpha = __builtin_amdgcn_exp2f(m - mn);
        const bool resc = __builtin_amdgcn_ballot_w64(mn > m) != 0ull;
        m = mn;
        float rsum = 0.f;
#pragma unroll
        for (int i = 0; i < 16; ++i) { s[i] = __builtin_amdgcn_exp2f(s[i] - mn); rsum += s[i]; }
        l = l * alpha + rsum;
        if (resc) {
#pragma unroll
          for (int dt = 0; dt < 4; ++dt)
#pragma unroll
            for (int i = 0; i < 16; ++i) O[dt][i] *= alpha;
        }
#pragma unroll
        for (int st = 0; st < 2; ++st) {
          uint4 pu = make_uint4(pk2(s[8 * st], s[8 * st + 1]), pk2(s[8 * st + 2], s[8 * st + 3]), pk2(s[8 * st + 4], s[8 * st + 5]), pk2(s[8 * st + 6], s[8 * st + 7]));
          const bf16x8 pf = __builtin_bit_cast(bf16x8, pu);
#pragma unroll
          for (int dt = 0; dt < 4; ++dt) {
            const u16* vp = Vs + (dt * 32 + r) * 68 + kh * 32 + 16 * st + 4 * hi;
            uint2 v0 = *(const uint2*)vp, v1 = *(const uint2*)(vp + 8);
            const bf16x8 vf = __builtin_bit_cast(bf16x8, make_uint4(v0.x, v0.y, v1.x, v1.y));
            O[dt] = MFMA(vf, pf, O[dt]);
          }
        }
      }
      l += __shfl_xor(l, 32);
      __syncthreads();
      float* mq = mrg + qh * 66 * 64;
      if (kh == 1) {
#pragma unroll
        for (int dt = 0; dt < 4; ++dt)
#pragma unroll
          for (int i = 0; i < 16; ++i) mq[(dt * 16 + i) * 64 + lane] = O[dt][i];
        mq[64 * 64 + lane] = m; mq[65 * 64 + lane] = l;
      }
      __syncthreads();
      if (kh == 0) {
        const float m1 = mq[64 * 64 + lane], l1 = mq[65 * 64 + lane];
        const float mt = fmaxf(m, m1), a0 = exp2f(m - mt), a1 = exp2f(m1 - mt);
        const float inv = 1.f / (l * a0 + l1 * a1);
        float ss = 0.f;
#pragma unroll
        for (int dt = 0; dt < 4; ++dt)
#pragma unroll
          for (int i = 0; i < 16; ++i) { const float o = (O[dt][i] * a0 + mq[(dt * 16 + i) * 64 + lane] * a1) * inv; O[dt][i] = o; ss += o * o; }
        ss += __shfl_xor(ss, 32);
        const float rstd = rsqrtf(ss * (1.f / 128.f) + EPS);
#pragma unroll
        for (int dt = 0; dt < 4; ++dt)
#pragma unroll
          for (int g = 0; g < 4; ++g) {
            const int d = dt * 32 + hi * 4 + 8 * g;
            *(uint2*)(MG + qrow * D_ + 1024 + h * 128 + d) = make_uint2(pk2(O[dt][4 * g] * rstd, O[dt][4 * g + 1] * rstd), pk2(O[dt][4 * g + 2] * rstd, O[dt][4 * g + 3] * rstd));
          }
      }
    }
  }
}

DI void phase5(const Params& p, char* smem) {
  const u16* MG = (const u16*)(p.ws + WS_MG); const u16* W = (const u16*)(p.ws + WS_WOUTT);
  const float* X = p.in[0]; const float* mod = (const float*)(p.ws + WS_MOD); float* X1 = (float*)(p.ws + WS_X1);
  for (int it = blockIdx.x; it < 64 * 16; it += gridDim.x) {
    const int tn = it / 64, tm = it % 64;
    gemm_tile<true>(MG, D_, W, D_, D_, tm * 128, tn * 128, smem, [&](f32x16 (&acc)[2][2], int mb, int nb, int r, int hi) __attribute__((always_inline)) {
#pragma unroll
      for (int mi = 0; mi < 2; ++mi) {
        const int row = mb + mi * 32 + r, b = row >> 11;
        const float* gt = mod + b * 12288 + 2 * 2048;
#pragma unroll
        for (int ni = 0; ni < 2; ++ni)
#pragma unroll
          for (int g = 0; g < 4; ++g) {
            const int col = nb + ni * 32 + hi * 4 + 8 * g;
            const float4 xv = *(const float4*)(X + (size_t)row * D_ + col), gv = *(const float4*)(gt + col);
            float4 o;
            o.x = xv.x + gv.x * acc[mi][ni][4 * g]; o.y = xv.y + gv.y * acc[mi][ni][4 * g + 1]; o.z = xv.z + gv.z * acc[mi][ni][4 * g + 2]; o.w = xv.w + gv.w * acc[mi][ni][4 * g + 3];
            *(float4*)(X1 + (size_t)row * D_ + col) = o;
          }
      }
    });
  }
}

DI void phase7(const Params& p, char* smem) {
  const u16* H2 = (const u16*)(p.ws + WS_H); const u16* W = (const u16*)(p.ws + WS_WQT); u16* PQ = (u16*)(p.ws + WS_P);
  for (int it = blockIdx.x; it < 64 * 16; it += gridDim.x) {
    const int tn = it / 64, tm = it % 64;
    gemm_tile<true>(H2, D_, W, D_, D_, tm * 128, tn * 128, smem, [&](f32x16 (&acc)[2][2], int mb, int nb, int r, int hi) __attribute__((always_inline)) {
#pragma unroll
      for (int mi = 0; mi < 2; ++mi)
#pragma unroll
        for (int ni = 0; ni < 2; ++ni)
#pragma unroll
          for (int g = 0; g < 4; ++g) {
            const int row = mb + mi * 32 + r, col = nb + ni * 32 + hi * 4 + 8 * g;
            *(uint2*)(PQ + (size_t)row * D_ + col) = make_uint2(pk2(acc[mi][ni][4 * g], acc[mi][ni][4 * g + 1]), pk2(acc[mi][ni][4 * g + 2], acc[mi][ni][4 * g + 3]));
          }
    });
  }
}

DI unsigned f2ord(float v) { unsigned u = __float_as_uint(v); return u ^ ((unsigned)((int)u >> 31) | 0x80000000u); }
#define TOPK_INSERT(keys, x) { _Pragma("unroll") for (int _j = 0; _j < 16; ++_j) { const unsigned _h = max(keys[_j], x); x = min(keys[_j], x); keys[_j] = _h; } }
DI void phase8(const Params& p, char* smem) {
  const u16* PQ = (const u16*)(p.ws + WS_P); const u16* SK = (const u16*)(p.ws + WS_SK);
  int* IDS = (int*)(p.ws + WS_IDS); float* GATE = (float*)(p.ws + WS_GATE);
  float* sc = (float*)(smem + 16);
  const int tid = threadIdx.x, lane = tid & 63, w = tid >> 6, r = lane & 31, hi = lane >> 5;
  for (int it = blockIdx.x; it < 128 * 8; it += gridDim.x) {
    const int h = it & 7, tile = it >> 3;
    const int pp = w >> 1, rh = w & 1;
    __syncthreads();
    {
      f32x16 acc[4];
#pragma unroll
      for (int nt = 0; nt < 4; ++nt)
#pragma unroll
        for (int i = 0; i < 16; ++i) acc[nt][i] = 0.f;
      const u16* ap = PQ + (size_t)(tile * 64 + rh * 32 + r) * D_ + h * 256 + pp * 128 + hi * 8;
      const u16* bp = SK + ((size_t)(h * 2 + pp) * 128 + r) * 128 + hi * 8;
#pragma unroll
      for (int ks = 0; ks < 8; ++ks) {
        const bf16x8 af = *(const bf16x8*)(ap + ks * 16);
#pragma unroll
        for (int nt = 0; nt < 4; ++nt) { const bf16x8 bf = *(const bf16x8*)(bp + nt * 32 * 128 + ks * 16); acc[nt] = MFMA(af, bf, acc[nt]); }
      }
#pragma unroll
      for (int nt = 0; nt < 4; ++nt)
#pragma unroll
        for (int i = 0; i < 16; ++i) sc[(pp * 64 + rh * 32 + hi * 4 + (i & 3) + 8 * (i >> 2)) * 129 + nt * 32 + r] = acc[nt][i];
    }
    __syncthreads();
    if (tid < 128) {
      float* row = sc + tid * 129;
      unsigned keys[16];
#pragma unroll
      for (int j = 0; j < 16; ++j) keys[j] = 0u;
#pragma unroll 4
      for (int n = 0; n < 128; ++n) {
        unsigned x = (f2ord(row[n]) & 0xFFFFFF80u) | (unsigned)(127 - n);
        TOPK_INSERT(keys, x);
      }
      float vals[16];
#pragma unroll
      for (int j = 0; j < 16; ++j) vals[j] = row[127 - (keys[j] & 127u)];
#pragma unroll
      for (int j = 0; j < 16; ++j) { row[j] = vals[j]; row[16 + j] = __int_as_float((int)(127 - (keys[j] & 127u))); }
    }
    __syncthreads();
    if (tid < 64) {
      const float* ra = sc + tid * 129; const float* rb = sc + (64 + tid) * 129;
      float a[16], bq[16];
#pragma unroll
      for (int j = 0; j < 16; ++j) { a[j] = ra[j]; bq[j] = rb[j]; }
      unsigned keys[16];
#pragma unroll
      for (int j = 0; j < 16; ++j) keys[j] = 0u;
#pragma unroll
      for (int i = 0; i < 16; ++i)
#pragma unroll
        for (int j = 0; j < 16; ++j)
          if ((i + 1) * (j + 1) <= 16) {
            unsigned x = (f2ord(a[i] + bq[j]) & 0xFFFFFF00u) | (unsigned)(255 - (i * 16 + j));
            TOPK_INSERT(keys, x);
          }
      float bv[16]; int ex[16];
      float mx = -1e30f;
#pragma unroll
      for (int q = 0; q < 16; ++q) {
        const int flat = 255 - (int)(keys[q] & 255u), i = flat >> 4, j = flat & 15;
        bv[q] = ra[i] + rb[j];
        ex[q] = __float_as_int(ra[16 + i]) * 128 + __float_as_int(rb[16 + j]);
        mx = fmaxf(mx, bv[q]);
      }
      float sum = 0.f;
#pragma unroll
      for (int q = 0; q < 16; ++q) { bv[q] = __expf(bv[q] - mx); sum += bv[q]; }
      const float inv = 1.f / sum;
      const size_t o = (size_t)(tile * 64 + tid) * 128 + h * 16;
#pragma unroll
      for (int q = 0; q < 16; q += 4) {
        *(int4*)(IDS + o + q) = make_int4(ex[q], ex[q + 1], ex[q + 2], ex[q + 3]);
        *(float4*)(GATE + o + q) = make_float4(bv[q] * inv, bv[q + 1] * inv, bv[q + 2] * inv, bv[q + 3] * inv);
      }
    }
  }
}

constexpr int CTR_UQ = 4096, CTR_VQ = 4608;
DI f2_t cvt8lo(unsigned w) { return __builtin_amdgcn_cvt_pk_f32_fp8(w, false); }
DI f2_t cvt8hi(unsigned w) { return __builtin_amdgcn_cvt_pk_f32_fp8(w, true); }
template <class F>
DI void xcd_queue(unsigned* ctrs, int nchunks, char* smem, F&& f) {
  const int x0 = (int)(xb_xcc_id() & 7u);
#pragma unroll 1
  for (int k = 0; k < 8; ++k) {
    const int s = (x0 + k) & 7;
    for (;;) { const int c = grab(ctrs + 64 * s, smem); if (c >= nchunks) break; f(s, c); }
  }
}
DI void wave_lds_sync() { asm volatile("s_waitcnt lgkmcnt(0)" ::: "memory"); __builtin_amdgcn_wave_barrier(); }

DI void phase9(const Params& p, char* smem, int rep) {
  const unsigned char* H2Q = (const unsigned char*)(p.ws + WS_H2Q); const unsigned char* U8 = (const unsigned char*)(p.ws + WS_U);
  const int* IDS = (const int*)(p.ws + WS_IDS); int* PA = (int*)(p.ws + WS_PA);
  const int lane = threadIdx.x & 63, w = threadIdx.x >> 6, g = lane >> 4, l15 = lane & 15;
  const int b3 = (lane >> 3) & 1, b2 = (lane >> 2) & 1, b1 = (lane >> 1) & 1, b0 = lane & 1;
  int* lw = (int*)(smem + 16) + w * 256;
  xcd_queue((unsigned*)(p.ws + WS_BAR) + CTR_UQ + rep * 8, 512, smem, [&](int s, int c) __attribute__((always_inline)) {
#pragma unroll 1
    for (int t = 0; t < 4; ++t) {
      const int tok = __builtin_amdgcn_readfirstlane(c * 16 + w * 4 + t);
      const int i0 = IDS[(size_t)tok * 128 + lane], i1 = IDS[(size_t)tok * 128 + 64 + lane];
      const u32x4 hq = *(const u32x4*)(H2Q + (size_t)tok * D_ + s * 256 + l15 * 16);
      wave_lds_sync();
      lw[(lane & 3) * 32 + (lane >> 2)] = i0;
      lw[(lane & 3) * 32 + 16 + (lane >> 2)] = i1;
      wave_lds_sync();
      const unsigned char* ub = U8 + s * 256 + l15 * 16;
#pragma unroll
      for (int batch = 0; batch < 2; ++batch) {
        int ida[16];
#pragma unroll
        for (int q = 0; q < 4; ++q) { const int4 v = *(const int4*)(lw + g * 32 + batch * 16 + q * 4); ida[q * 4] = v.x; ida[q * 4 + 1] = v.y; ida[q * 4 + 2] = v.z; ida[q * 4 + 3] = v.w; }
        u32x4 rows[16];
#pragma unroll
        for (int k = 0; k < 16; ++k) rows[k] = *(const u32x4*)(ub + (size_t)ida[k] * 2048);
        int part[16];
#pragma unroll
        for (int k = 0; k < 16; ++k) {
          int acc = 0;
#pragma unroll
          for (int d = 0; d < 4; ++d) acc = __builtin_amdgcn_sdot4((int)rows[k][d], (int)hq[d], acc, false);
          part[k] = acc;
        }
        int q8[8], q4[4], q2[2];
#pragma unroll
        for (int k = 0; k < 8; ++k) q8[k] = (b3 ? part[8 + k] : part[k]) + __shfl_xor(b3 ? part[k] : part[8 + k], 8);
#pragma unroll
        for (int k = 0; k < 4; ++k) q4[k] = (b2 ? q8[4 + k] : q8[k]) + __shfl_xor(b2 ? q8[k] : q8[4 + k], 4);
#pragma unroll
        for (int k = 0; k < 2; ++k) q2[k] = (b1 ? q4[2 + k] : q4[k]) + __shfl_xor(b1 ? q4[k] : q4[2 + k], 2);
        const int rr = (b0 ? q2[1] : q2[0]) + __shfl_xor(b0 ? q2[0] : q2[1], 1);
        PA[((size_t)s * T_ + tok) * 128 + 4 * (batch * 16 + l15) + g] = rr;
      }
    }
  });
}

DI void phase10(const Params& p) {
  const int* PA = (const int*)(p.ws + WS_PA); float* ACT = (float*)(p.ws + WS_ACT); const float* HSC = (const float*)(p.ws + WS_HSC);
  const int* IDS = (const int*)(p.ws + WS_IDS); const float* GATE = (const float*)(p.ws + WS_GATE);
  const float* USC = (const float*)(p.ws + WS_USC); const float* VSC = (const float*)(p.ws + WS_VSC);
  for (int i = blockIdx.x * 256 + threadIdx.x; i < T_ * 128; i += gridDim.x * 256) {
    int ai = 0;
#pragma unroll
    for (int s = 0; s < 8; ++s) ai += PA[(size_t)s * T_ * 128 + i];
    const int id = IDS[i];
    const float a = (float)ai * USC[id] * HSC[i >> 7];
    ACT[i] = 0.5f * a * (1.f + erff(a * 0.70710678118654752f)) * GATE[i] * VSC[id];
  }
}

DI void phase11(const Params& p, char* smem, int rep) {
  const unsigned char* V8 = (const unsigned char*)(p.ws + WS_V);
  const int* IDS = (const int*)(p.ws + WS_IDS); const float* ACT = (const float*)(p.ws + WS_ACT); u16* OUTP = (u16*)(p.ws + WS_OUTP);
  const int lane = threadIdx.x & 63, w = threadIdx.x >> 6, g = lane >> 4, l15 = lane & 15;
  const int b5 = (lane >> 5) & 1, b4 = (lane >> 4) & 1;
  int* lw = (int*)(smem + 16) + w * 256;
  float* lf = (float*)(lw + 128);
  xcd_queue((unsigned*)(p.ws + WS_BAR) + CTR_VQ + rep * 8, 512, smem, [&](int s, int c) __attribute__((always_inline)) {
#pragma unroll 1
    for (int t = 0; t < 4; ++t) {
      const int tok = __builtin_amdgcn_readfirstlane(c * 16 + w * 4 + t);
      const int i0 = IDS[(size_t)tok * 128 + lane], i1 = IDS[(size_t)tok * 128 + 64 + lane];
      const float a0 = ACT[(size_t)tok * 128 + lane], a1 = ACT[(size_t)tok * 128 + 64 + lane];
      wave_lds_sync();
      lw[(lane & 3) * 32 + (lane >> 2)] = i0; lw[(lane & 3) * 32 + 16 + (lane >> 2)] = i1;
      lf[(lane & 3) * 32 + (lane >> 2)] = a0; lf[(lane & 3) * 32 + 16 + (lane >> 2)] = a1;
      wave_lds_sync();
      f2_t o[8];
#pragma unroll
      for (int i = 0; i < 8; ++i) o[i] = f2_t{0.f, 0.f};
      const unsigned char* vb = V8 + s * 256 + l15 * 16;
#pragma unroll
      for (int batch = 0; batch < 2; ++batch) {
        int ida[16]; float aa[16];
#pragma unroll
        for (int q = 0; q < 4; ++q) {
          const int4 v = *(const int4*)(lw + g * 32 + batch * 16 + q * 4); ida[q * 4] = v.x; ida[q * 4 + 1] = v.y; ida[q * 4 + 2] = v.z; ida[q * 4 + 3] = v.w;
          const float4 f = *(const float4*)(lf + g * 32 + batch * 16 + q * 4); aa[q * 4] = f.x; aa[q * 4 + 1] = f.y; aa[q * 4 + 2] = f.z; aa[q * 4 + 3] = f.w;
        }
        u32x4 rows[16];
#pragma unroll
        for (int k = 0; k < 16; ++k) rows[k] = *(const u32x4*)(vb + (size_t)ida[k] * 2048);
#pragma unroll
        for (int k = 0; k < 16; ++k) {
          const f2_t a2 = {aa[k], aa[k]};
#pragma unroll
          for (int d = 0; d < 4; ++d) { const unsigned ww = rows[k][d]; o[2 * d] += a2 * cvt8lo(ww); o[2 * d + 1] += a2 * cvt8hi(ww); }
        }
      }
      float ov[16];
#pragma unroll
      for (int d = 0; d < 4; ++d) { ov[4 * d] = o[2 * d].x; ov[4 * d + 1] = o[2 * d].y; ov[4 * d + 2] = o[2 * d + 1].x; ov[4 * d + 3] = o[2 * d + 1].y; }
      float q8[8], q4[4];
#pragma unroll
      for (int k = 0; k < 8; ++k) q8[k] = (b5 ? ov[8 + k] : ov[k]) + __shfl_xor(b5 ? ov[k] : ov[8 + k], 32);
#pragma unroll
      for (int k = 0; k < 4; ++k) q4[k] = (b4 ? q8[4 + k] : q8[k]) + __shfl_xor(b4 ? q8[k] : q8[4 + k], 16);
      *(uint2*)(OUTP + (size_t)tok * D_ + s * 256 + l15 * 16 + 8 * b5 + 4 * b4) = make_uint2(pk2(q4[0], q4[1]), pk2(q4[2], q4[3]));
    }
  });
}

DI void phase12(const Params& p) {
  const float* X1 = (const float*)(p.ws + WS_X1); const u16* OUTP = (const u16*)(p.ws + WS_OUTP);
  const float* mod = (const float*)(p.ws + WS_MOD); const float* gfin = p.in[19];
  const int lane = threadIdx.x & 63, w = threadIdx.x >> 6;
  for (int row = blockIdx.x * 4 + w; row < T_; row += gridDim.x * 4) {
    const float* gt = mod + (row >> 11) * 12288 + 5 * 2048;
    float4 v[8];
    float ss = 0.f;
#pragma unroll
    for (int j = 0; j < 8; ++j) {
      const int d = j * 256 + lane * 4;
      const float4 xv = *(const float4*)(X1 + (size_t)row * D_ + d), gv = *(const float4*)(gt + d);
      const uint2 ob = *(const uint2*)(OUTP + (size_t)row * D_ + d);
      const float4 ov = make_float4(bflo(ob.x), bfhi(ob.x), bflo(ob.y), bfhi(ob.y));
      v[j] = make_float4(xv.x + gv.x * ov.x, xv.y + gv.y * ov.y, xv.z + gv.z * ov.z, xv.w + gv.w * ov.w);
      ss += v[j].x * v[j].x + v[j].y * v[j].y + v[j].z * v[j].z + v[j].w * v[j].w;
    }
    ss = wave_sum(ss);
    const float rstd = rsqrtf(ss * (1.f / D_) + EPS);
#pragma unroll
    for (int j = 0; j < 8; ++j) {
      const int d = j * 256 + lane * 4;
      const float4 gv = *(const float4*)(gfin + d);
      *(float4*)(p.out + (size_t)row * D_ + d) = make_float4(v[j].x * rstd * gv.x, v[j].y * rstd * gv.y, v[j].z * rstd * gv.z, v[j].w * rstd * gv.w);
    }
  }
}

__global__ void __launch_bounds__(256, 2) mega(Params p) {
  extern __shared__ __attribute__((aligned(16))) char smem[];
  XcdBarrier xb;
  const bool multi = (p.ph_hi - p.ph_lo) > 1;
  if (multi) {
    if (threadIdx.x == 0) *(uint4*)smem = make_uint4(0u, 0u, 0u, 0u);
    __syncthreads();
    xb = xcd_barrier_post((unsigned*)(p.ws + WS_BAR), (volatile LAS unsigned*)smem);
  }
#ifndef PHMASK
#define PHMASK 0x1fff
#endif
#ifndef REPMASK
#define REPMASK 0
#endif
  int rep = 0;
#define RUN_PHASE(n, call) if (p.ph_lo <= (n) && (n) < p.ph_hi) { \
    if ((n) > p.ph_lo) { xcd_barrier(xb); } \
    if (PHMASK & (1 << (n))) { call; if (REPMASK & (1 << (n))) { xcd_barrier(xb); rep = 1; call; rep = 0; } } }
  RUN_PHASE(0, phase0(p, smem))
  RUN_PHASE(1, phase1(p, smem))
#ifdef BARX
  for (int i = 0; i < BARX; ++i) xcd_barrier(xb);
#endif
  RUN_PHASE(2, phase2(p, smem))
  RUN_PHASE(3, phase3(p, smem))
  RUN_PHASE(4, phase4(p, smem))
  RUN_PHASE(5, phase5(p, smem))
  RUN_PHASE(6, norm_rows<true>((const float*)(p.ws + WS_X1), p.in[14], (const float*)(p.ws + WS_MOD) + 3 * 2048, 12288, (u16*)(p.ws + WS_H), (unsigned char*)(p.ws + WS_H2Q), (float*)(p.ws + WS_HSC)))
  RUN_PHASE(7, phase7(p, smem))
  RUN_PHASE(8, phase8(p, smem))
  RUN_PHASE(9, phase9(p, smem, rep))
  RUN_PHASE(10, phase10(p))
  RUN_PHASE(11, phase11(p, smem, rep))
  RUN_PHASE(12, phase12(p))
}

extern "C" void kernel_launch(void* const* d_in, const int* in_sizes, int n_in, void* d_out, int out_size, void* d_ws, size_t ws_size, hipStream_t stream) {
  static int grid = 0;
  if (grid == 0) {
    if (n_in != 20 || ws_size < WS_END) { fprintf(stderr, "kernel_launch: unexpected n_in %d / ws_size %zu (need %zu)\n", n_in, ws_size, (size_t)WS_END); grid = -1; return; }
    int dev = 0, cus = 0, per_cu = 0;
    hipGetDevice(&dev);
    hipDeviceGetAttribute(&cus, hipDeviceAttributeMultiprocessorCount, dev);
    hipFuncSetAttribute((const void*)mega, hipFuncAttributeMaxDynamicSharedMemorySize, LDS_BYTES);
    hipOccupancyMaxActiveBlocksPerMultiprocessor(&per_cu, (const void*)mega, 256, LDS_BYTES);
    if (per_cu < 1) { fprintf(stderr, "kernel_launch: occupancy query says %d\n", per_cu); per_cu = 1; }
    if (per_cu > 2) per_cu = 2;
    grid = cus * per_cu;
    fprintf(stderr, "kernel_launch: grid %d (%d per CU)\n", grid, per_cu);
  }
  if (grid < 0) return;
  Params p{};
  for (int i = 0; i < 20; ++i) p.in[i] = (const float*)d_in[i];
  p.out = (float*)d_out; p.ws = (char*)d_ws;
#if N_LAUNCH_PER_PHASE
  p.coop = 0;
  for (int ph = 0; ph < NPH; ++ph) {
    p.ph_lo = ph; p.ph_hi = ph + 1;
    hipLaunchKernelGGL(mega, dim3(grid), dim3(256), LDS_BYTES, stream, p);
  }
#else
  hipMemsetAsync((char*)d_ws + WS_BAR, 0, WS_MOD, stream);
  p.coop = 0; p.ph_lo = 0; p.ph_hi = NPH;
  void* args[] = {&p};
  hipError_t e = hipLaunchCooperativeKernel((const void*)mega, dim3(grid), dim3(256), args, LDS_BYTES, stream);
  if (e != hipSuccess) fprintf(stderr, "cooperative launch failed: %s (grid %d)\n", hipGetErrorString(e), grid);
#endif
}
```

```cpp
#include <hip/hip_runtime.h>
#include <cstdio>
#include <cstdint>

#ifndef N_LAUNCH_PER_PHASE
#define N_LAUNCH_PER_PHASE 0
#endif

#define DI __device__ __forceinline__
typedef unsigned short u16;
typedef __attribute__((ext_vector_type(8))) short bf16x8;
typedef __attribute__((ext_vector_type(16))) float f32x16;
typedef __attribute__((ext_vector_type(2))) __bf16 bf2_t;
typedef __attribute__((ext_vector_type(2))) float f2_t;
typedef __attribute__((ext_vector_type(4))) unsigned u32x4;
typedef __attribute__((ext_vector_type(2))) unsigned u32x2;
#define MFMA(a, b, c) __builtin_amdgcn_mfma_f32_32x32x16_bf16((a), (b), (c), 0, 0, 0)

constexpr int T_ = 8192, D_ = 2048, S_ = 2048;
constexpr int INC = 4160;
constexpr float EPS = 1e-6f;
constexpr int NPH = 13;

constexpr size_t al256(size_t x) { return (x + 255) & ~(size_t)255; }
constexpr size_t WS_BAR = 0;
constexpr size_t WS_MOD = 32768;
constexpr size_t WS_ROPE = WS_MOD + al256(4 * 12288 * 4);
constexpr size_t WS_WINT = WS_ROPE + al256(2048 * 32 * 8);
constexpr size_t WS_WUQT = WS_WINT + al256((size_t)4224 * 2048 * 2);
constexpr size_t WS_WUKVT = WS_WUQT + al256((size_t)1536 * 512 * 2);
constexpr size_t WS_WOUTT = WS_WUKVT + al256((size_t)2048 * 512 * 2);
constexpr size_t WS_WQT = WS_WOUTT + al256((size_t)2048 * 2048 * 2);
constexpr size_t WS_SK = WS_WQT + al256((size_t)2048 * 2048 * 2);
constexpr size_t WS_U = WS_SK + al256((size_t)262144 * 2);
constexpr size_t WS_V = WS_U + al256((size_t)16384 * 2048);
constexpr size_t WS_H = WS_V + al256((size_t)16384 * 2048);
constexpr size_t WS_P = WS_H + al256((size_t)T_ * D_ * 2);
constexpr size_t WS_Q = WS_P + al256((size_t)T_ * INC * 2);
constexpr size_t WS_K = WS_Q + al256((size_t)T_ * 1536 * 2);
constexpr size_t WS_VT = WS_K + al256((size_t)T_ * 1536 * 2);
constexpr size_t WS_MG = WS_VT + al256((size_t)T_ * 1024 * 2);
constexpr size_t WS_X1 = WS_MG + al256((size_t)T_ * D_ * 2);
constexpr size_t WS_IDS = WS_X1 + al256((size_t)T_ * D_ * 4);
constexpr size_t WS_GATE = WS_IDS + al256((size_t)T_ * 128 * 4);
constexpr size_t WS_USC = WS_GATE + al256((size_t)T_ * 128 * 4);
constexpr size_t WS_VSC = WS_USC + 65536;
constexpr size_t WS_MODP = WS_VSC + 65536;
constexpr size_t WS_ACT = WS_MODP + al256((size_t)4 * 4 * 12288 * 4);
constexpr size_t WS_H2Q = WS_ACT + al256((size_t)T_ * 128 * 4);
constexpr size_t WS_HSC = WS_H2Q + al256((size_t)T_ * D_);
constexpr size_t WS_SSQ = WS_HSC + al256((size_t)T_ * 4);
constexpr size_t WS_END = WS_SSQ + al256((size_t)T_ * 16 * 4);
constexpr size_t WS_PA = WS_MG;
constexpr size_t WS_OUTP = WS_Q;
static_assert(WS_VT + (size_t)T_ * 1024 * 2 - WS_Q >= (size_t)T_ * D_ * 4, "OUTP alias");
static_assert((size_t)8 * T_ * 128 * 4 <= (size_t)T_ * D_ * 2, "PA alias");

constexpr int LDS_BYTES = 16 + 2 * 2 * 128 * 72 * 2 + 512;

struct Params {
  const float* in[20];
  float* out;
  char* ws;
  int ph_lo, ph_hi, coop, pad;
};

DI unsigned pk2(float a, float b) { f2_t v = {a, b}; bf2_t r = __builtin_convertvector(v, bf2_t); return __builtin_bit_cast(unsigned, r); }
DI float bflo(unsigned u) { return __uint_as_float(u << 16); }
DI float bfhi(unsigned u) { return __uint_as_float(u & 0xffff0000u); }
DI float dot2(unsigned a, unsigned b, float c) { return __builtin_amdgcn_fdot2_f32_bf16(__builtin_bit_cast(bf2_t, a), __builtin_bit_cast(bf2_t, b), c, false); }
DI float wave_sum(float v) {
#pragma unroll
  for (int o = 32; o >= 1; o >>= 1) v += __shfl_xor(v, o);
  return v;
}

#define XB_TMO      128
#define XB_XCNT(j)  (256  + 64 * (j))
#define XB_XSUB(j)  (1280 + 64 * (j))
#define XB_XGEN(j)  (2304 + 64 * (j))
#define XB_TOP      3328
#define XB_TOPGEN   3392
#define XCD_BAR_WORDS 3456
#define XB_SPIN_CAP (1u << 22)
#define LAS __attribute__((address_space(3)))
DI unsigned xb_ld(unsigned* p) { return __hip_atomic_load(p, __ATOMIC_RELAXED, __HIP_MEMORY_SCOPE_AGENT); }
DI unsigned xb_add(unsigned* p, unsigned v) { return __hip_atomic_fetch_add(p, v, __ATOMIC_RELAXED, __HIP_MEMORY_SCOPE_AGENT); }
DI unsigned xb_xcc_id() { return (unsigned)__builtin_amdgcn_s_getreg((3 << 11) | 20) & 0xFu; }
#define XB_SPIN(cond, bar) do { unsigned _sp = 0; while (cond) { __builtin_amdgcn_s_sleep(1); \
    if ((++_sp & 255u) == 0u) { if (xb_ld(&(bar)[XB_TMO])) break; if (_sp > XB_SPIN_CAP) { atomicAdd(&(bar)[XB_TMO], 1u); break; } } } } while (0)
struct XcdBarrier { unsigned* bar; unsigned x; volatile LAS unsigned* st; };
DI XcdBarrier xcd_barrier_post(unsigned* bar, volatile LAS unsigned* st) {
  XcdBarrier b; b.bar = bar; b.x = xb_xcc_id(); b.st = st;
  if (threadIdx.x == 0) (void)xb_add(&bar[XB_XCNT(b.x)], 1u);
  return b;
}
DI void xcd_barrier_complete(unsigned* bar, unsigned x, unsigned& nloc, unsigned& nx) {
  const unsigned G = gridDim.x * gridDim.y * gridDim.z;
  unsigned sum, cnt, mine, sp = 0u;
  for (;;) {
    sum = 0u; cnt = 0u; mine = 0u;
#pragma unroll
    for (unsigned j = 0; j < 16; ++j) { const unsigned c = xb_ld(&bar[XB_XCNT(j)]); sum += c; cnt += (c > 0u) ? 1u : 0u; mine = (j == x) ? c : mine; }
    if (sum == G) break;
    __builtin_amdgcn_s_sleep(1);
    if ((++sp & 255u) == 0u) { if (xb_ld(&bar[XB_TMO])) break; if (sp > XB_SPIN_CAP) { atomicAdd(&bar[XB_TMO], 1u); break; } }
  }
  nloc = mine > 0u ? mine : 1u; nx = cnt > 0u ? cnt : 1u;
}
DI void xcd_barrier(const XcdBarrier& b) {
  asm volatile("s_waitcnt vmcnt(0)" ::: "memory");
  __syncthreads();
  if (threadIdx.x == 0) {
    unsigned* bar = b.bar;
    __builtin_amdgcn_s_waitcnt(0);
    unsigned nloc = b.st[0], nx = b.st[1];
    if (nloc == 0u) { xcd_barrier_complete(bar, b.x, nloc, nx); b.st[0] = nloc; b.st[1] = nx; }
    const unsigned old = xb_add(&bar[XB_XSUB(b.x)], 1u);
    const unsigned gen = old / nloc;
    if (old + 1u == (gen + 1u) * nloc) {
      __builtin_amdgcn_fence(__ATOMIC_RELEASE, "agent");
      asm volatile("s_waitcnt vmcnt(0)" ::: "memory");
      const unsigned og = xb_add(&bar[XB_TOP], 1u);
      const unsigned tg = og / nx;
      if (og + 1u == (tg + 1u) * nx) xb_add(&bar[XB_TOPGEN], 1u);
      else XB_SPIN(xb_ld(&bar[XB_TOPGEN]) == tg, bar);
      __builtin_amdgcn_fence(__ATOMIC_ACQUIRE, "agent");
      xb_add(&bar[XB_XGEN(b.x)], 1u);
      asm volatile("s_waitcnt vmcnt(0)" ::: "memory");
    } else {
      XB_SPIN(xb_ld(&bar[XB_XGEN(b.x)]) == gen, bar);
      __builtin_amdgcn_fence(__ATOMIC_ACQUIRE, "agent");
      asm volatile("s_waitcnt vmcnt(0)" ::: "memory");
    }
  }
  __syncthreads();
}

template <bool SWAP, class Epi>
DI void gemm_tile(const u16* __restrict__ A, int lda, const u16* __restrict__ Bt, int ldb, int K, int m0, int n0, char* smem, Epi&& epi) {
  u16* As = (u16*)(smem + 16);
  u16* Bs = As + 2 * 128 * 72;
  const int tid = threadIdx.x, lane = tid & 63, w = tid >> 6, wm = w >> 1, wn = w & 1;
  const int r = lane & 31, hi = lane >> 5;
  f32x16 acc[2][2];
#pragma unroll
  for (int a = 0; a < 2; ++a)
#pragma unroll
    for (int b = 0; b < 2; ++b)
#pragma unroll
      for (int i = 0; i < 16; ++i) acc[a][b][i] = 0.f;
  const int srow = tid >> 3, skc = tid & 7;
  const u16* ag = A + (size_t)(m0 + srow) * lda + skc * 8;
  const u16* bg = Bt + (size_t)(n0 + srow) * ldb + skc * 8;
  u32x4 ra[4], rb[4];
#pragma unroll
  for (int i = 0; i < 4; ++i) { ra[i] = *(const u32x4*)(ag + (size_t)i * 32 * lda); rb[i] = *(const u32x4*)(bg + (size_t)i * 32 * ldb); }
  __syncthreads();
#pragma unroll
  for (int i = 0; i < 4; ++i) { *(u32x4*)(As + (srow + 32 * i) * 72 + skc * 8) = ra[i]; *(u32x4*)(Bs + (srow + 32 * i) * 72 + skc * 8) = rb[i]; }
  __syncthreads();
  const int KT = K >> 6;
  for (int kt = 0; kt < KT; ++kt) {
    const int buf = kt & 1;
    if (kt + 1 < KT) {
      const int k0 = (kt + 1) << 6;
#pragma unroll
      for (int i = 0; i < 4; ++i) { ra[i] = *(const u32x4*)(ag + (size_t)i * 32 * lda + k0); rb[i] = *(const u32x4*)(bg + (size_t)i * 32 * ldb + k0); }
    }
    const u16* Asb = As + buf * 128 * 72 + (wm * 64 + r) * 72 + hi * 8;
    const u16* Bsb = Bs + buf * 128 * 72 + (wn * 64 + r) * 72 + hi * 8;
#pragma unroll
    for (int ks = 0; ks < 4; ++ks) {
      bf16x8 af[2], bfr[2];
      af[0] = *(const bf16x8*)(Asb + ks * 16);
      af[1] = *(const bf16x8*)(Asb + 32 * 72 + ks * 16);
      bfr[0] = *(const bf16x8*)(Bsb + ks * 16);
      bfr[1] = *(const bf16x8*)(Bsb + 32 * 72 + ks * 16);
#pragma unroll
      for (int mi = 0; mi < 2; ++mi)
#pragma unroll
        for (int ni = 0; ni < 2; ++ni) {
          if (SWAP) acc[mi][ni] = MFMA(bfr[ni], af[mi], acc[mi][ni]);
          else acc[mi][ni] = MFMA(af[mi], bfr[ni], acc[mi][ni]);
        }
    }
    if (kt + 1 < KT) {
      const int nb = buf ^ 1;
#pragma unroll
      for (int i = 0; i < 4; ++i) { *(u32x4*)(As + nb * 128 * 72 + (srow + 32 * i) * 72 + skc * 8) = ra[i]; *(u32x4*)(Bs + nb * 128 * 72 + (srow + 32 * i) * 72 + skc * 8) = rb[i]; }
    }
    __syncthreads();
  }
  epi(acc, m0 + wm * 64, n0 + wn * 64, r, hi);
}

DI void tile_rstd512(const u16* __restrict__ A, int lda, int m0, float* rs) {
  const int tid = threadIdx.x, row = tid >> 1, half = tid & 1;
  const uint4* p = (const uint4*)(A + (size_t)(m0 + row) * lda + half * 256);
  float ss = 0.f;
#pragma unroll 8
  for (int i = 0; i < 32; ++i) {
    uint4 v = p[i];
    ss = dot2(v.x, v.x, ss); ss = dot2(v.y, v.y, ss); ss = dot2(v.z, v.z, ss); ss = dot2(v.w, v.w, ss);
  }
  ss += __shfl_xor(ss, 1);
  if (half == 0) rs[row] = rsqrtf(ss * (1.f / 512.f) + EPS);
}

DI void transpose_item(const float* __restrict__ src, int N, int K, const float* __restrict__ scale, u16* __restrict__ dst, int tk, int tn, char* smem) {
  float* tile = (float*)(smem + 16);
  const int t = threadIdx.x;
  __syncthreads();
  {
    const int rr = t >> 4, c4 = (t & 15) * 4;
#pragma unroll
    for (int ps = 0; ps < 4; ++ps) {
      const int kk = ps * 16 + rr, k = tk * 64 + kk;
      float4 v = *(const float4*)(src + (size_t)k * N + tn * 64 + c4);
      const float sc = scale ? scale[k] : 1.f;
      tile[kk * 65 + c4 + 0] = v.x * sc; tile[kk * 65 + c4 + 1] = v.y * sc; tile[kk * 65 + c4 + 2] = v.z * sc; tile[kk * 65 + c4 + 3] = v.w * sc;
    }
  }
  __syncthreads();
  {
    const int n = t & 63, kc = (t >> 6) * 16;
    unsigned o[8];
#pragma unroll
    for (int j = 0; j < 8; ++j) o[j] = pk2(tile[(kc + 2 * j) * 65 + n], tile[(kc + 2 * j + 1) * 65 + n]);
    uint4* d = (uint4*)(dst + (size_t)(tn * 64 + n) * K + tk * 64 + kc);
    d[0] = make_uint4(o[0], o[1], o[2], o[3]); d[1] = make_uint4(o[4], o[5], o[6], o[7]);
  }
}

DI void convert_item(const float* __restrict__ src, u16* __restrict__ dst, size_t base) {
  const int t = threadIdx.x;
#pragma unroll
  for (int st = 0; st < 4; ++st) {
    const size_t idx = base + st * 2048 + t * 8;
    float4 a = *(const float4*)(src + idx), b = *(const float4*)(src + idx + 4);
    *(uint4*)(dst + idx) = make_uint4(pk2(a.x, a.y), pk2(a.z, a.w), pk2(b.x, b.y), pk2(b.z, b.w));
  }
}

DI float wave_max(float v) {
#pragma unroll
  for (int o = 32; o >= 1; o >>= 1) v = fmaxf(v, __shfl_xor(v, o));
  return v;
}
DI void fp8_rows_item(const float* __restrict__ src, unsigned char* __restrict__ dst, float* __restrict__ scales, int item) {
  const int lane = threadIdx.x & 63, w = threadIdx.x >> 6;
  const int row = item * 4 + w;
  const float* sr = src + (size_t)row * 2048 + lane * 16;
  float4 v[8];
  float amax = 0.f;
#pragma unroll
  for (int j = 0; j < 2; ++j)
#pragma unroll
    for (int q = 0; q < 4; ++q) {
      const float4 t = *(const float4*)(sr + 1024 * j + q * 4);
      v[j * 4 + q] = t;
      amax = fmaxf(amax, fmaxf(fmaxf(fabsf(t.x), fabsf(t.y)), fmaxf(fabsf(t.z), fabsf(t.w))));
    }
  amax = wave_max(amax);
  int e = 0;
  if (amax > 0.f) e = (int)floorf(log2f(384.f / amax));
  e = e < -100 ? -100 : (e > 100 ? 100 : e);
  const float sc = ldexpf(1.f, e);
  if (lane == 0) scales[row] = ldexpf(1.f, -e);
#pragma unroll
  for (int j = 0; j < 2; ++j) {
    unsigned d[4];
#pragma unroll
    for (int q = 0; q < 4; ++q) {
      const float4 t = v[j * 4 + q];
      unsigned pk = __builtin_amdgcn_cvt_pk_fp8_f32(t.x * sc, t.y * sc, 0, false);
      pk = __builtin_amdgcn_cvt_pk_fp8_f32(t.z * sc, t.w * sc, pk, true);
      d[q] = pk;
    }
    *(uint4*)(dst + (size_t)row * 2048 + 1024 * j + lane * 16) = make_uint4(d[0], d[1], d[2], d[3]);
  }
}

DI unsigned pack_i8x4(float a, float b, float c, float d) {
  const int ia = __float2int_rn(a), ib = __float2int_rn(b), ic = __float2int_rn(c), id = __float2int_rn(d);
  return (unsigned)(ia & 0xff) | ((unsigned)(ib & 0xff) << 8) | ((unsigned)(ic & 0xff) << 16) | ((unsigned)id << 24);
}
DI void i8_rows_item(const float* __restrict__ src, unsigned char* __restrict__ dst, float* __restrict__ scales, int item) {
  const int lane = threadIdx.x & 63, w = threadIdx.x >> 6;
  const int row = item * 4 + w;
  const float* sr = src + (size_t)row * 2048 + lane * 16;
  float4 v[8];
  float amax = 0.f;
#pragma unroll
  for (int j = 0; j < 2; ++j)
#pragma unroll
    for (int q = 0; q < 4; ++q) {
      const float4 t = *(const float4*)(sr + 1024 * j + q * 4);
      v[j * 4 + q] = t;
      amax = fmaxf(amax, fmaxf(fmaxf(fabsf(t.x), fabsf(t.y)), fmaxf(fabsf(t.z), fabsf(t.w))));
    }
  amax = wave_max(amax);
  const float sc = amax > 0.f ? 127.f / amax : 0.f;
  if (lane == 0) scales[row] = amax * (1.f / 127.f);
#pragma unroll
  for (int j = 0; j < 2; ++j) {
    unsigned d[4];
#pragma unroll
    for (int q = 0; q < 4; ++q) { const float4 t = v[j * 4 + q]; d[q] = pack_i8x4(t.x * sc, t.y * sc, t.z * sc, t.w * sc); }
    *(uint4*)(dst + (size_t)row * 2048 + 1024 * j + lane * 16) = make_uint4(d[0], d[1], d[2], d[3]);
  }
}

DI void mod_item(const Params& p, int item, char* smem) {
  float* cact = (float*)(smem + 16);
  float* red = cact + 4 * 512;
  const int t = threadIdx.x;
  const int cgi = item % 192, ksp = item / 192, kbase = ksp * 512;
  const float* c = p.in[1]; const float* W = p.in[2];
  float* mod = (float*)(p.ws + WS_MODP);
  __syncthreads();
  for (int i = t; i < 4 * 512; i += 256) { float v = c[(i >> 9) * 2048 + kbase + (i & 511)]; cact[i] = v / (1.f + __expf(-v)); }
  __syncthreads();
  const int cq = t & 15, kl = t >> 4, c0 = cgi * 64;
  float acc[4][4];
#pragma unroll
  for (int b = 0; b < 4; ++b)
#pragma unroll
    for (int j = 0; j < 4; ++j) acc[b][j] = 0.f;
  const float* wp = W + (size_t)(kbase + kl) * 12288 + c0 + cq * 4;
#pragma unroll 8
  for (int i = 0; i < 32; ++i) {
    const int k = kl + 16 * i;
    float4 w4 = *(const float4*)(wp + (size_t)i * 16 * 12288);
#pragma unroll
    for (int b = 0; b < 4; ++b) {
      const float a = cact[b * 512 + k];
      acc[b][0] += a * w4.x; acc[b][1] += a * w4.y; acc[b][2] += a * w4.z; acc[b][3] += a * w4.w;
    }
  }
#pragma unroll
  for (int b = 0; b < 4; ++b)
#pragma unroll
    for (int j = 0; j < 4; ++j) red[(kl * 16 + cq) * 17 + b * 4 + j] = acc[b][j];
  __syncthreads();
  {
    const int b = t >> 6, col = t & 63, q = col >> 2, j = col & 3;
    float s = 0.f;
#pragma unroll
    for (int k2 = 0; k2 < 16; ++k2) s += red[(k2 * 16 + q) * 17 + b * 4 + j];
    mod[(size_t)ksp * 49152 + b * 12288 + c0 + col] = s;
  }
}

constexpr int P0_MOD = 768;
constexpr int P0_TIN = 32 * 65, P0_TUQ = 8 * 24, P0_TUKV = 8 * 32, P0_TOUT = 32 * 32, P0_TWQ = 32 * 32;
constexpr int P0_SK = 32, P0_UV = 0, P0_ROPE = 32;
DI void phase0(const Params& p, char* smem) {
  constexpr int o1 = P0_MOD, o2 = o1 + P0_TIN, o3 = o2 + P0_TUQ, o4 = o3 + P0_TUKV, o5 = o4 + P0_TOUT, o6 = o5 + P0_TWQ, o7 = o6 + P0_SK, o8 = o7 + P0_UV, o9 = o8 + P0_UV, o10 = o9 + P0_ROPE;
  for (int it = blockIdx.x; it < o10; it += gridDim.x) {
    if (it < o1) mod_item(p, it, smem);
    else if (it < o2) { int j = it - o1; transpose_item(p.in[5], INC, 2048, nullptr, (u16*)(p.ws + WS_WINT), j / 65, j % 65, smem); }
    else if (it < o3) { int j = it - o2; transpose_item(p.in[8], 1536, 512, p.in[7], (u16*)(p.ws + WS_WUQT), j / 24, j % 24, smem); }
    else if (it < o4) { int j = it - o3; transpose_item(p.in[10], 2048, 512, p.in[9], (u16*)(p.ws + WS_WUKVT), j / 32, j % 32, smem); }
    else if (it < o5) { int j = it - o4; int tk = j / 32; transpose_item(p.in[13], 2048, 2048, tk < 16 ? p.in[11] : p.in[12] - 1024, (u16*)(p.ws + WS_WOUTT), tk, j % 32, smem); }
    else if (it < o6) { int j = it - o5; transpose_item(p.in[15], 2048, 2048, nullptr, (u16*)(p.ws + WS_WQT), j / 32, j % 32, smem); }
    else if (it < o7) convert_item(p.in[16], (u16*)(p.ws + WS_SK), (size_t)(it - o6) * 8192);
    else if (it < o8) fp8_rows_item(p.in[17], (unsigned char*)(p.ws + WS_U), (float*)(p.ws + WS_USC), it - o7);
    else if (it < o9) fp8_rows_item(p.in[18], (unsigned char*)(p.ws + WS_V), (float*)(p.ws + WS_VSC), it - o8);
    else {
      float2* rope = (float2*)(p.ws + WS_ROPE);
      const int base = (it - o9) * 2048;
      for (int e = threadIdx.x; e < 2048; e += 256) {
        const int idx = base + e, pos = idx >> 5, j = idx & 31;
        const float inv = 1.0f / powf(10000.0f, (float)(2 * j) / 64.0f);
        const float ang = (float)pos * inv;
        rope[idx] = make_float2(cosf(ang), sinf(ang));
      }
    }
  }
}

template <bool Q8>
DI void norm_rows(const float* __restrict__ X, const float* __restrict__ g, const float* mod, int bstride, u16* __restrict__ out, unsigned char* __restrict__ outq, float* __restrict__ qscale,
                  int row_start, int row_step, int row_end) {
  const int lane = threadIdx.x & 63, w = threadIdx.x >> 6;
  for (int row = row_start + w; row < row_end; row += row_step) {
    const float* xr = X + (size_t)row * D_;
    float4 v[8];
    float ss = 0.f;
#pragma unroll
    for (int j = 0; j < 8; ++j) { v[j] = *(const float4*)(xr + j * 256 + lane * 4); ss += v[j].x * v[j].x + v[j].y * v[j].y + v[j].z * v[j].z + v[j].w * v[j].w; }
    ss = wave_sum(ss);
    const float rstd = rsqrtf(ss * (1.f / D_) + EPS);
    const int b = row >> 11;
    const float* sh = mod + b * bstride;
    const float* sc = sh + 2048;
    float amax = 0.f;
#pragma unroll
    for (int j = 0; j < 8; ++j) {
      const int d = j * 256 + lane * 4;
      const float4 gg = *(const float4*)(g + d), s4 = *(const float4*)(sc + d), h4 = *(const float4*)(sh + d);
      const float o0 = v[j].x * rstd * gg.x * (1.f + s4.x) + h4.x;
      const float o1 = v[j].y * rstd * gg.y * (1.f + s4.y) + h4.y;
      const float o2 = v[j].z * rstd * gg.z * (1.f + s4.z) + h4.z;
      const float o3 = v[j].w * rstd * gg.w * (1.f + s4.w) + h4.w;
      *(uint2*)(out + (size_t)row * D_ + d) = make_uint2(pk2(o0, o1), pk2(o2, o3));
      if (Q8) { v[j] = make_float4(o0, o1, o2, o3); amax = fmaxf(amax, fmaxf(fmaxf(fabsf(o0), fabsf(o1)), fmaxf(fabsf(o2), fabsf(o3)))); }
    }
    if (Q8) {
      amax = wave_max(amax);
      const float qs = amax > 0.f ? 127.f / amax : 0.f;
      if (lane == 0) qscale[row] = amax * (1.f / 127.f);
#pragma unroll
      for (int j = 0; j < 8; ++j) *(unsigned*)(outq + (size_t)row * D_ + j * 256 + lane * 4) = pack_i8x4(v[j].x * qs, v[j].y * qs, v[j].z * qs, v[j].w * qs);
    }
  }
}
DI void phase1(const Params& p, char* smem) {
  const float* mp = (const float*)(p.ws + WS_MODP); float* mod = (float*)(p.ws + WS_MOD); const float* bias = p.in[3];
  for (int i = blockIdx.x * 256 + threadIdx.x; i < 49152; i += gridDim.x * 256)
    mod[i] = ((mp[i] + mp[49152 + i]) + mp[2 * 49152 + i]) + mp[3 * 49152 + i] + bias[i % 12288];
  const int rpb = T_ / (int)gridDim.x, row0 = (int)blockIdx.x * rpb, bb = row0 >> 11;
  float* lm = (float*)(smem + 16);
  __syncthreads();
  for (int c = threadIdx.x; c < 4096; c += 256) {
    const int src = bb * 12288 + c;
    lm[c] = ((mp[src] + mp[49152 + src]) + mp[2 * 49152 + src]) + mp[3 * 49152 + src] + bias[c];
  }
  __syncthreads();
  norm_rows<false>(p.in[0], p.in[4], lm, 0, (u16*)(p.ws + WS_H), nullptr, nullptr, row0, 4, row0 + rpb);
}

constexpr int CTR_TILE = 3520, CTR_CHUNK = 3584;
DI int grab(unsigned* ctr, char* smem) {
  __syncthreads();
  if (threadIdx.x == 0) *(volatile unsigned*)(smem + 8) = atomicAdd(ctr, 1u);
  __syncthreads();
  return (int)*(volatile unsigned*)(smem + 8);
}
DI void uv_chunk(const Params& p, int c) {
#pragma unroll 1
  for (int i = 0; i < 4; ++i) {
    const int item = c * 4 + i;
    if (item < 4096) i8_rows_item(p.in[17], (unsigned char*)(p.ws + WS_U), (float*)(p.ws + WS_USC), item);
    else fp8_rows_item(p.in[18], (unsigned char*)(p.ws + WS_V), (float*)(p.ws + WS_VSC), item - 4096);
  }
}
DI void phase2(const Params& p, char* smem, int rep) {
  const u16* H = (const u16*)(p.ws + WS_H); const u16* W = (const u16*)(p.ws + WS_WINT); u16* P = (u16*)(p.ws + WS_P); float* SSQ = (float*)(p.ws + WS_SSQ);
  (void)rep;
  const bool odd = (blockIdx.x & 1) != 0;
  if (odd) for (int c = blockIdx.x; c < 2048; c += gridDim.x) uv_chunk(p, c);
  for (int it = blockIdx.x; it < 64 * 32; it += gridDim.x) {
    const int tn = it / 64, tm = it % 64;
    gemm_tile<true>(H, D_, W, D_, D_, tm * 128, tn * 128, smem, [&](f32x16 (&acc)[2][2], int mb, int nb, int r, int hi) __attribute__((always_inline)) {
#pragma unroll
      for (int mi = 0; mi < 2; ++mi)
#pragma unroll
        for (int ni = 0; ni < 2; ++ni)
#pragma unroll
          for (int g = 0; g < 4; ++g) {
            const int row = mb + mi * 32 + r, col = nb + ni * 32 + hi * 4 + 8 * g;
            *(uint2*)(P + (size_t)row * INC + col) = make_uint2(pk2(acc[mi][ni][4 * g], acc[mi][ni][4 * g + 1]), pk2(acc[mi][ni][4 * g + 2], acc[mi][ni][4 * g + 3]));
          }
      if (nb >= 3072) {
#pragma unroll
        for (int mi = 0; mi < 2; ++mi) {
          float ss = 0.f;
#pragma unroll
          for (int ni = 0; ni < 2; ++ni)
#pragma unroll
            for (int i = 0; i < 16; ++i) ss += acc[mi][ni][i] * acc[mi][ni][i];
          ss += __shfl_xor(ss, 32);
          if (hi == 0) SSQ[(size_t)(mb + mi * 32 + r) * 16 + ((nb - 3072) >> 6)] = ss;
        }
      }
    });
  }
  if (!odd) for (int c = blockIdx.x; c < 2048; c += gridDim.x) uv_chunk(p, c);
}

DI void phase3(const Params& p, char* smem) {
  const u16* P = (const u16*)(p.ws + WS_P);
  u16* Q = (u16*)(p.ws + WS_Q); u16* Kb = (u16*)(p.ws + WS_K); u16* VT = (u16*)(p.ws + WS_VT); u16* MG = (u16*)(p.ws + WS_MG);
  const float2* rope = (const float2*)(p.ws + WS_ROPE); const float* SSQ = (const float*)(p.ws + WS_SSQ);
  float* rs = (float*)(smem + 16 + 2 * 2 * 128 * 72 * 2);
  constexpr int NQ = 64 * 12, NKV = 64 * 16, NKR = 1024, NCV = 1024;
  const float qscale = 0.07216878364870322f * 1.4426950408889634f;
  const int G = (int)gridDim.x, bid = (int)blockIdx.x;
  if (bid < 64) {
    for (int tm = bid; tm < 64; tm += 64) {
      gemm_tile<true>((const u16*)(p.ws + WS_H), D_, (const u16*)(p.ws + WS_WINT), D_, D_, tm * 128, 4096, smem, [&](f32x16 (&acc)[2][2], int mb, int nb, int r, int hi) __attribute__((always_inline)) {
        if (nb != 4096) return;
#pragma unroll
        for (int mi = 0; mi < 2; ++mi) {
          const int row = mb + mi * 32 + r, pos = row & (S_ - 1);
#pragma unroll
          for (int g = 0; g < 4; ++g) {
            const int j = hi * 4 + 8 * g;
            float a0[4], a1[4];
#pragma unroll
            for (int e = 0; e < 4; ++e) {
              const float2 cs = rope[pos * 32 + j + e];
              const float x1 = acc[mi][0][4 * g + e], x2 = acc[mi][1][4 * g + e];
              a0[e] = x1 * cs.x - x2 * cs.y; a1[e] = x2 * cs.x + x1 * cs.y;
            }
            const uint2 lo = make_uint2(pk2(a0[0], a0[1]), pk2(a0[2], a0[3])), hi2 = make_uint2(pk2(a1[0], a1[1]), pk2(a1[2], a1[3]));
#pragma unroll
            for (int h = 0; h < 8; ++h) { *(uint2*)(Kb + (size_t)row * 1536 + h * 192 + 128 + j) = lo; *(uint2*)(Kb + (size_t)row * 1536 + h * 192 + 160 + j) = hi2; }
          }
        }
      });
    }
  }
  const int t_begin = bid < 64 ? NQ + NKV : bid - 64, t_step = G - 64;
  for (int itx = 0; itx < 2; ++itx)
  for (int it = (itx == 0 ? t_begin : NQ + NKV + NKR + bid); it < (itx == 0 ? NQ + NKV : NQ + NKV + NKR + NCV); it += (itx == 0 ? t_step : G)) {
    if (it < NQ) {
      const int tn = it / 64, tm = it % 64;
      __syncthreads();
      if (threadIdx.x < 128) { const float4* sp = (const float4*)(SSQ + (size_t)(tm * 128 + threadIdx.x) * 16); const float4 a = sp[0], b = sp[1]; rs[threadIdx.x] = rsqrtf((((a.x + a.y) + (a.z + a.w)) + ((b.x + b.y) + (b.z + b.w))) * (1.f / 512.f) + EPS); }
      gemm_tile<true>(P + 3072, INC, (const u16*)(p.ws + WS_WUQT), 512, 512, tm * 128, tn * 128, smem, [&](f32x16 (&acc)[2][2], int mb, int nb, int r, int hi) __attribute__((always_inline)) {
        const bool is_rope = ((nb >> 6) % 3) == 2;
#pragma unroll
        for (int mi = 0; mi < 2; ++mi) {
          const int row = mb + mi * 32 + r;
          const float sc = rs[row - tm * 128] * qscale;
          const int pos = row & (S_ - 1);
#pragma unroll
          for (int g = 0; g < 4; ++g) {
            const int j = hi * 4 + 8 * g;
            float a0[4], a1[4];
#pragma unroll
            for (int e = 0; e < 4; ++e) { a0[e] = acc[mi][0][4 * g + e] * sc; a1[e] = acc[mi][1][4 * g + e] * sc; }
            if (is_rope) {
#pragma unroll
              for (int e = 0; e < 4; ++e) {
                const float2 cs = rope[pos * 32 + j + e];
                const float x1 = a0[e], x2 = a1[e];
                a0[e] = x1 * cs.x - x2 * cs.y; a1[e] = x2 * cs.x + x1 * cs.y;
              }
            }
            *(uint2*)(Q + (size_t)row * 1536 + nb + j) = make_uint2(pk2(a0[0], a0[1]), pk2(a0[2], a0[3]));
            *(uint2*)(Q + (size_t)row * 1536 + nb + 32 + j) = make_uint2(pk2(a1[0], a1[1]), pk2(a1[2], a1[3]));
          }
        }
      });
    } else if (it < NQ + NKV) {
      const int j2 = it - NQ, tn = j2 / 64, tm = j2 % 64;
      __syncthreads();
      if (threadIdx.x < 128) { const float4* sp = (const float4*)(SSQ + (size_t)(tm * 128 + threadIdx.x) * 16 + 8); const float4 a = sp[0], b = sp[1]; rs[threadIdx.x] = rsqrtf((((a.x + a.y) + (a.z + a.w)) + ((b.x + b.y) + (b.z + b.w))) * (1.f / 512.f) + EPS); }
      const int head = tn >> 1;
      if ((tn & 1) == 0) {
        gemm_tile<true>(P + 3584, INC, (const u16*)(p.ws + WS_WUKVT), 512, 512, tm * 128, tn * 128, smem, [&](f32x16 (&acc)[2][2], int mb, int nb, int r, int hi) __attribute__((always_inline)) {
#pragma unroll
          for (int mi = 0; mi < 2; ++mi) {
            const int row = mb + mi * 32 + r;
            const float sc = rs[row - tm * 128];
#pragma unroll
            for (int ni = 0; ni < 2; ++ni)
#pragma unroll
              for (int g = 0; g < 4; ++g) {
                const int d = (nb & 127) + ni * 32 + hi * 4 + 8 * g;
                *(uint2*)(Kb + (size_t)row * 1536 + head * 192 + d) = make_uint2(pk2(acc[mi][ni][4 * g] * sc, acc[mi][ni][4 * g + 1] * sc), pk2(acc[mi][ni][4 * g + 2] * sc, acc[mi][ni][4 * g + 3] * sc));
              }
          }
        });
      } else {
        gemm_tile<false>(P + 3584, INC, (const u16*)(p.ws + WS_WUKVT), 512, 512, tm * 128, tn * 128, smem, [&](f32x16 (&acc)[2][2], int mb, int nb, int r, int hi) __attribute__((always_inline)) {
#pragma unroll
          for (int mi = 0; mi < 2; ++mi)
#pragma unroll
            for (int g = 0; g < 4; ++g) {
              const int row0 = mb + mi * 32 + hi * 4 + 8 * g;
              const float s0 = rs[row0 - tm * 128], s1 = rs[row0 + 1 - tm * 128], s2 = rs[row0 + 2 - tm * 128], s3 = rs[row0 + 3 - tm * 128];
              const int b = row0 >> 11, t = row0 & (S_ - 1);
#pragma unroll
              for (int ni = 0; ni < 2; ++ni) {
                const int d = (nb & 127) + ni * 32 + r;
                *(uint2*)(VT + ((size_t)((b * 8 + head) * 128 + d)) * S_ + t) = make_uint2(pk2(acc[mi][ni][4 * g] * s0, acc[mi][ni][4 * g + 1] * s1), pk2(acc[mi][ni][4 * g + 2] * s2, acc[mi][ni][4 * g + 3] * s3));
              }
            }
        });
      }
    } else if (it < NQ + NKV + NKR) {
      const int j2 = it - NQ - NKV;
      const int row = j2 * 8 + (threadIdx.x >> 5), j = threadIdx.x & 31, pos = row & (S_ - 1);
      const float x1 = bflo((unsigned)P[(size_t)row * INC + 4096 + j]), x2 = bflo((unsigned)P[(size_t)row * INC + 4096 + 32 + j]);
      const float2 cs = rope[pos * 32 + j];
      const float o1 = x1 * cs.x - x2 * cs.y, o2 = x2 * cs.x + x1 * cs.y;
      const u16 b1 = (u16)(pk2(o1, 0.f) & 0xffffu), b2 = (u16)(pk2(o2, 0.f) & 0xffffu);
#pragma unroll
      for (int h = 0; h < 8; ++h) { Kb[(size_t)row * 1536 + h * 192 + 128 + j] = b1; Kb[(size_t)row * 1536 + h * 192 + 160 + j] = b2; }
    } else {
      const int j2 = it - NQ - NKV - NKR;
      const int wi = j2 * 4 + (threadIdx.x >> 6), lane = threadIdx.x & 63;
      const int g = wi & 7, run = wi >> 3;
      const int row0 = run * 16, t0 = row0 & (S_ - 1);
      const int ch = g * 128 + lane * 2;
      const float* cw = p.in[6];
      const float w00 = cw[ch], w01 = cw[ch + 1], w10 = cw[1024 + ch], w11 = cw[1024 + ch + 1], w20 = cw[2048 + ch], w21 = cw[2048 + ch + 1];
      float zm1a = 0.f, zm1b = 0.f, zm2a = 0.f, zm2b = 0.f;
      if (t0 > 0) {
        const unsigned c1 = *(const unsigned*)(P + (size_t)(row0 - 1) * INC + 1024 + ch), h1 = *(const unsigned*)(P + (size_t)(row0 - 1) * INC + 2048 + ch);
        const unsigned c2 = *(const unsigned*)(P + (size_t)(row0 - 2) * INC + 1024 + ch), h2 = *(const unsigned*)(P + (size_t)(row0 - 2) * INC + 2048 + ch);
        zm1a = bflo(c1) * bflo(h1); zm1b = bfhi(c1) * bfhi(h1); zm2a = bflo(c2) * bflo(h2); zm2b = bfhi(c2) * bfhi(h2);
      }
#pragma unroll 4
      for (int tt = 0; tt < 16; ++tt) {
        const size_t ro = (size_t)(row0 + tt) * INC;
        const unsigned bb = *(const unsigned*)(P + ro + ch), cc = *(const unsigned*)(P + ro + 1024 + ch), hh = *(const unsigned*)(P + ro + 2048 + ch);
        const float za = bflo(cc) * bflo(hh), zb = bfhi(cc) * bfhi(hh);
        const float ya = bflo(bb) * (w00 * zm2a + w10 * zm1a + w20 * za), yb = bfhi(bb) * (w01 * zm2b + w11 * zm1b + w21 * zb);
        zm2a = zm1a; zm2b = zm1b; zm1a = za; zm1b = zb;
        const float ss = wave_sum(ya * ya + yb * yb);
        const float rstd = rsqrtf(ss * (1.f / 128.f) + EPS);
        *(unsigned*)(MG + (size_t)(row0 + tt) * D_ + ch) = pk2(ya * rstd, yb * rstd);
      }
    }
  }
}

DI void phase4(const Params& p, char* smem) {
  const u16* Q = (const u16*)(p.ws + WS_Q); const u16* Kb = (const u16*)(p.ws + WS_K); const u16* VT = (const u16*)(p.ws + WS_VT);
  u16* MG = (u16*)(p.ws + WS_MG);
  u16* Ks = (u16*)(smem + 16);
  u16* Vs = Ks + 64 * 200;
  float* mrg = (float*)(smem + 16);
  const int tid = threadIdx.x, lane = tid & 63, w = tid >> 6, qh = w & 1, kh = w >> 1, r = lane & 31, hi = lane >> 5;
  for (int it = blockIdx.x; it < 512; it += gridDim.x) {
    const int pi = it & 15, h = (it >> 4) & 7, b = it >> 7;
    for (int sub = 0; sub < 2; ++sub) {
      const int c = sub ? (31 - pi) : pi;
      const size_t qrow = (size_t)b * S_ + c * 64 + qh * 32 + r;
      bf16x8 qf[12];
#pragma unroll
      for (int ks = 0; ks < 12; ++ks) qf[ks] = *(const bf16x8*)(Q + qrow * 1536 + h * 192 + ks * 16 + hi * 8);
      f32x16 O[4];
#pragma unroll
      for (int dt = 0; dt < 4; ++dt)
#pragma unroll
        for (int i = 0; i < 16; ++i) O[dt][i] = 0.f;
      float m = -1e30f, l = 0.f;
      u32x4 kr[6]; u32x4 vr[4];
      const u16* kg = Kb + ((size_t)b * S_ + (tid >> 2)) * 1536 + h * 192 + (tid & 3) * 8;
      const u16* vg = VT + ((size_t)((b * 8 + h) * 128 + (tid >> 1))) * S_ + (tid & 1) * 8;
      u16* ksw = Ks + (tid >> 2) * 200 + (tid & 3) * 8;
      u16* vsw = Vs + (tid >> 1) * 68 + (tid & 1) * 8;
      auto load_tile = [&]() __attribute__((always_inline)) {
#pragma unroll
        for (int i = 0; i < 6; ++i) kr[i] = *(const u32x4*)(kg + i * 32);
#pragma unroll
        for (int i = 0; i < 4; ++i) vr[i] = *(const u32x4*)(vg + i * 16);
        kg += 64 * 1536; vg += 64;
      };
      load_tile();
      for (int kt = 0; kt <= c; ++kt) {
        __syncthreads();
#pragma unroll
        for (int i = 0; i < 6; ++i) *(u32x4*)(ksw + i * 32) = kr[i];
#pragma unroll
        for (int i = 0; i < 4; ++i) { u32x2 lo2 = {vr[i][0], vr[i][1]}, hi2 = {vr[i][2], vr[i][3]}; *(u32x2*)(vsw + i * 16) = lo2; *(u32x2*)(vsw + i * 16 + 4) = hi2; }
        __syncthreads();
        if (kt < c) load_tile();
        f32x16 s;
#pragma unroll
        for (int i = 0; i < 16; ++i) s[i] = 0.f;
        const u16* kp = Ks + (kh * 32 + r) * 200 + hi * 8;
#pragma unroll
        for (int ks = 0; ks < 12; ++ks) { bf16x8 kf = *(const bf16x8*)(kp + ks * 16); s = MFMA(kf, qf[ks], s); }
        float mx = s[0];
#pragma unroll
        for (int i = 1; i < 16; ++i) mx = fmaxf(mx, s[i]);
        mx = fmaxf(mx, __shfl_xor(mx, 32));
        const float mn = fmaxf(m, mx);
        const float alpha = __builtin_amdgcn_exp2f(m - mn);
        const bool resc = __builtin_amdgcn_ballot_w64(mn > m) != 0ull;
        m = mn;
        float rsum = 0.f;
#pragma unroll
        for (int i = 0; i < 16; ++i) { s[i] = __builtin_amdgcn_exp2f(s[i] - mn); rsum += s[i]; }
        l = l * alpha + rsum;
        if (resc) {
#pragma unroll
          for (int dt = 0; dt < 4; ++dt)
#pragma unroll
            for (int i = 0; i < 16; ++i) O[dt][i] *= alpha;
        }
#pragma unroll
        for (int st = 0; st < 2; ++st) {
          uint4 pu = make_uint4(pk2(s[8 * st], s[8 * st + 1]), pk2(s[8 * st + 2], s[8 * st + 3]), pk2(s[8 * st + 4], s[8 * st + 5]), pk2(s[8 * st + 6], s[8 * st + 7]));
          const bf16x8 pf = __builtin_bit_cast(bf16x8, pu);
#pragma unroll
          for (int dt = 0; dt < 4; ++dt) {
            const u16* vp = Vs + (dt * 32 + r) * 68 + kh * 32 + 16 * st + 4 * hi;
            uint2 v0 = *(const uint2*)vp, v1 = *(const uint2*)(vp + 8);
            const bf16x8 vf = __builtin_bit_cast(bf16x8, make_uint4(v0.x, v0.y, v1.x, v1.y));
            O[dt] = MFMA(vf, pf, O[dt]);
          }
        }
      }
      l += __shfl_xor(l, 32);
      __syncthreads();
      float* mq = mrg + qh * 66 * 64;
      if (kh == 1) {
#pragma unroll
        for (int dt = 0; dt < 4; ++dt)
#pragma unroll
          for (int i = 0; i < 16; ++i) mq[(dt * 16 + i) * 64 + lane] = O[dt][i];
        mq[64 * 64 + lane] = m; mq[65 * 64 + lane] = l;
      }
      __syncthreads();
      if (kh == 0) {
        const float m1 = mq[64 * 64 + lane], l1 = mq[65 * 64 + lane];
        const float mt = fmaxf(m, m1), a0 = exp2f(m - mt), a1 = exp2f(m1 - mt);
        const float inv = 1.f / (l * a0 + l1 * a1);
        float ss = 0.f;
#pragma unroll
        for (int dt = 0; dt < 4; ++dt)
#pragma unroll
          for (int i = 0; i < 16; ++i) { const float o = (O[dt][i] * a0 + mq[(dt * 16 + i) * 64 + lane] * a1) * inv; O[dt][i] = o; ss += o * o; }
        ss += __shfl_xor(ss, 32);
        const float rstd = rsqrtf(ss * (1.f / 128.f) + EPS);
#pragma unroll
        for (int dt = 0; dt < 4; ++dt)
#pragma unroll
          for (int g = 0; g < 4; ++g) {
            const int d = dt * 32 + hi * 4 + 8 * g;
            *(uint2*)(MG + qrow * D_ + 1024 + h * 128 + d) = make_uint2(pk2(O[dt][4 * g] * rstd, O[dt][4 * g + 1] * rstd), pk2(O[dt][4 * g + 2] * rstd, O[dt][4 * g + 3] * rstd));
          }
      }
    }
  }
}

DI void phase5(const Params& p, char* smem) {
  const u16* MG = (const u16*)(p.ws + WS_MG); const u16* W = (const u16*)(p.ws + WS_WOUTT);
  const float* X = p.in[0]; const float* mod = (const float*)(p.ws + WS_MOD); float* X1 = (float*)(p.ws + WS_X1);
  for (int it = blockIdx.x; it < 64 * 16; it += gridDim.x) {
    const int tn = it / 64, tm = it % 64;
    gemm_tile<true>(MG, D_, W, D_, D_, tm * 128, tn * 128, smem, [&](f32x16 (&acc)[2][2], int mb, int nb, int r, int hi) __attribute__((always_inline)) {
#pragma unroll
      for (int mi = 0; mi < 2; ++mi) {
        const int row = mb + mi * 32 + r, b = row >> 11;
        const float* gt = mod + b * 12288 + 2 * 2048;
#pragma unroll
        for (int ni = 0; ni < 2; ++ni)
#pragma unroll
          for (int g = 0; g < 4; ++g) {
            const int col = nb + ni * 32 + hi * 4 + 8 * g;
            const float4 xv = *(const float4*)(X + (size_t)row * D_ + col), gv = *(const float4*)(gt + col);
            float4 o;
            o.x = xv.x + gv.x * acc[mi][ni][4 * g]; o.y = xv.y + gv.y * acc[mi][ni][4 * g + 1]; o.z = xv.z + gv.z * acc[mi][ni][4 * g + 2]; o.w = xv.w + gv.w * acc[mi][ni][4 * g + 3];
            *(float4*)(X1 + (size_t)row * D_ + col) = o;
          }
      }
    });
  }
}

DI void phase7(const Params& p, char* smem) {
  const u16* H2 = (const u16*)(p.ws + WS_H); const u16* W = (const u16*)(p.ws + WS_WQT); u16* PQ = (u16*)(p.ws + WS_P);
  for (int it = blockIdx.x; it < 64 * 16; it += gridDim.x) {
    const int tn = it / 64, tm = it % 64;
    gemm_tile<true>(H2, D_, W, D_, D_, tm * 128, tn * 128, smem, [&](f32x16 (&acc)[2][2], int mb, int nb, int r, int hi) __attribute__((always_inline)) {
#pragma unroll
      for (int mi = 0; mi < 2; ++mi)
#pragma unroll
        for (int ni = 0; ni < 2; ++ni)
#pragma unroll
          for (int g = 0; g < 4; ++g) {
            const int row = mb + mi * 32 + r, col = nb + ni * 32 + hi * 4 + 8 * g;
            *(uint2*)(PQ + (size_t)row * D_ + col) = make_uint2(pk2(acc[mi][ni][4 * g], acc[mi][ni][4 * g + 1]), pk2(acc[mi][ni][4 * g + 2], acc[mi][ni][4 * g + 3]));
          }
    });
  }
}

DI unsigned f2ord(float v) { unsigned u = __float_as_uint(v); return u ^ ((unsigned)((int)u >> 31) | 0x80000000u); }
#define TOPK_INSERT(keys, x) { _Pragma("unroll") for (int _j = 0; _j < 16; ++_j) { const unsigned _h = max(keys[_j], x); x = min(keys[_j], x); keys[_j] = _h; } }
DI void phase8(const Params& p, char* smem) {
  const u16* PQ = (const u16*)(p.ws + WS_P); const u16* SK = (const u16*)(p.ws + WS_SK);
  int* IDS = (int*)(p.ws + WS_IDS); float* GATE = (float*)(p.ws + WS_GATE);
  float* sc = (float*)(smem + 16);
  const int tid = threadIdx.x, lane = tid & 63, w = tid >> 6, r = lane & 31, hi = lane >> 5;
  for (int it = blockIdx.x; it < 128 * 8; it += gridDim.x) {
    const int h = it & 7, tile = it >> 3;
    const int pp = w >> 1, rh = w & 1;
    __syncthreads();
    {
      f32x16 acc[4];
#pragma unroll
      for (int nt = 0; nt < 4; ++nt)
#pragma unroll
        for (int i = 0; i < 16; ++i) acc[nt][i] = 0.f;
      const u16* ap = PQ + (size_t)(tile * 64 + rh * 32 + r) * D_ + h * 256 + pp * 128 + hi * 8;
      const u16* bp = SK + ((size_t)(h * 2 + pp) * 128 + r) * 128 + hi * 8;
#pragma unroll
      for (int ks = 0; ks < 8; ++ks) {
        const bf16x8 af = *(const bf16x8*)(ap + ks * 16);
#pragma unroll
        for (int nt = 0; nt < 4; ++nt) { const bf16x8 bf = *(const bf16x8*)(bp + nt * 32 * 128 + ks * 16); acc[nt] = MFMA(af, bf, acc[nt]); }
      }
#pragma unroll
      for (int nt = 0; nt < 4; ++nt)
#pragma unroll
        for (int i = 0; i < 16; ++i) sc[(pp * 64 + rh * 32 + hi * 4 + (i & 3) + 8 * (i >> 2)) * 129 + nt * 32 + r] = acc[nt][i];
    }
    __syncthreads();
    {
      const int rowi = tid & 127, half = tid >> 7;
      float* row = sc + rowi * 129;
      unsigned* mk = (unsigned*)(smem + 16 + 128 * 129 * 4);
      unsigned keys[16];
#pragma unroll
      for (int j = 0; j < 16; ++j) keys[j] = 0u;
#pragma unroll 4
      for (int n2 = 0; n2 < 64; ++n2) {
        const int n = half * 64 + n2;
        unsigned x = (f2ord(row[n]) & 0xFFFFFF80u) | (unsigned)(127 - n);
        TOPK_INSERT(keys, x);
      }
      if (half == 1) {
#pragma unroll
        for (int j = 0; j < 16; ++j) mk[j * 128 + rowi] = keys[j];
      }
      __syncthreads();
      if (half == 0) {
#pragma unroll
        for (int j = 0; j < 16; ++j) { unsigned x = mk[j * 128 + rowi]; TOPK_INSERT(keys, x); }
        float vals[16];
#pragma unroll
        for (int j = 0; j < 16; ++j) vals[j] = row[127 - (keys[j] & 127u)];
#pragma unroll
        for (int j = 0; j < 16; ++j) { row[j] = vals[j]; row[16 + j] = __int_as_float((int)(127 - (keys[j] & 127u))); }
      }
    }
    __syncthreads();
    if (tid < 64) {
      const float* ra = sc + tid * 129; const float* rb = sc + (64 + tid) * 129;
      float a[16], bq[16];
#pragma unroll
      for (int j = 0; j < 16; ++j) { a[j] = ra[j]; bq[j] = rb[j]; }
      unsigned keys[16];
#pragma unroll
      for (int j = 0; j < 16; ++j) keys[j] = 0u;
#pragma unroll
      for (int i = 0; i < 16; ++i)
#pragma unroll
        for (int j = 0; j < 16; ++j)
          if ((i + 1) * (j + 1) <= 16) {
            unsigned x = (f2ord(a[i] + bq[j]) & 0xFFFFFF00u) | (unsigned)(255 - (i * 16 + j));
            TOPK_INSERT(keys, x);
          }
      float bv[16]; int ex[16];
      float mx = -1e30f;
#pragma unroll
      for (int q = 0; q < 16; ++q) {
        const int flat = 255 - (int)(keys[q] & 255u), i = flat >> 4, j = flat & 15;
        bv[q] = ra[i] + rb[j];
        ex[q] = __float_as_int(ra[16 + i]) * 128 + __float_as_int(rb[16 + j]);
        mx = fmaxf(mx, bv[q]);
      }
      float sum = 0.f;
#pragma unroll
      for (int q = 0; q < 16; ++q) { bv[q] = __expf(bv[q] - mx); sum += bv[q]; }
      const float inv = 1.f / sum;
      const size_t o = (size_t)(tile * 64 + tid) * 128 + h * 16;
#pragma unroll
      for (int q = 0; q < 16; q += 4) {
        *(int4*)(IDS + o + q) = make_int4(ex[q], ex[q + 1], ex[q + 2], ex[q + 3]);
        *(float4*)(GATE + o + q) = make_float4(bv[q] * inv, bv[q + 1] * inv, bv[q + 2] * inv, bv[q + 3] * inv);
      }
    }
  }
}

constexpr int CTR_UQ = 4096, CTR_VQ = 4608;
DI f2_t cvt8lo(unsigned w) { return __builtin_amdgcn_cvt_pk_f32_fp8(w, false); }
DI f2_t cvt8hi(unsigned w) { return __builtin_amdgcn_cvt_pk_f32_fp8(w, true); }
template <class F>
DI void xcd_queue(unsigned* ctrs, int nchunks, char* smem, F&& f) {
  const int x0 = (int)(xb_xcc_id() & 7u);
#pragma unroll 1
  for (int k = 0; k < 8; ++k) {
    const int s = (x0 + k) & 7;
    for (;;) { const int c = grab(ctrs + 64 * s, smem); if (c >= nchunks) break; f(s, c); }
  }
}
DI void wave_lds_sync() { asm volatile("s_waitcnt lgkmcnt(0)" ::: "memory"); __builtin_amdgcn_wave_barrier(); }

DI void phase9(const Params& p, char* smem, int rep) {
  const unsigned char* H2Q = (const unsigned char*)(p.ws + WS_H2Q); const unsigned char* U8 = (const unsigned char*)(p.ws + WS_U);
  const int* IDS = (const int*)(p.ws + WS_IDS); int* PA = (int*)(p.ws + WS_PA);
  const int lane = threadIdx.x & 63, w = threadIdx.x >> 6, g = lane >> 4, l15 = lane & 15;
  const int b3 = (lane >> 3) & 1, b2 = (lane >> 2) & 1, b1 = (lane >> 1) & 1, b0 = lane & 1;
  int* lw = (int*)(smem + 16) + w * 256;
  xcd_queue((unsigned*)(p.ws + WS_BAR) + CTR_UQ + rep * 8, 512, smem, [&](int s, int c) __attribute__((always_inline)) {
#pragma unroll 1
    for (int t = 0; t < 4; ++t) {
      const int tok = __builtin_amdgcn_readfirstlane(c * 16 + w * 4 + t);
      const int i0 = IDS[(size_t)tok * 128 + lane], i1 = IDS[(size_t)tok * 128 + 64 + lane];
      const u32x4 hq = *(const u32x4*)(H2Q + (size_t)tok * D_ + s * 256 + l15 * 16);
      wave_lds_sync();
      lw[(lane & 3) * 32 + (lane >> 2)] = i0;
      lw[(lane & 3) * 32 + 16 + (lane >> 2)] = i1;
      wave_lds_sync();
      const unsigned char* ub = U8 + s * 256 + l15 * 16;
#pragma unroll
      for (int batch = 0; batch < 2; ++batch) {
        int ida[16];
#pragma unroll
        for (int q = 0; q < 4; ++q) { const int4 v = *(const int4*)(lw + g * 32 + batch * 16 + q * 4); ida[q * 4] = v.x; ida[q * 4 + 1] = v.y; ida[q * 4 + 2] = v.z; ida[q * 4 + 3] = v.w; }
        u32x4 rows[16];
#pragma unroll
        for (int k = 0; k < 16; ++k) rows[k] = *(const u32x4*)(ub + (size_t)ida[k] * 2048);
        int part[16];
#pragma unroll
        for (int k = 0; k < 16; ++k) {
          int acc = 0;
#pragma unroll
          for (int d = 0; d < 4; ++d) acc = __builtin_amdgcn_sdot4((int)rows[k][d], (int)hq[d], acc, false);
          part[k] = acc;
        }
        int q8[8], q4[4], q2[2];
#pragma unroll
        for (int k = 0; k < 8; ++k) q8[k] = (b3 ? part[8 + k] : part[k]) + __shfl_xor(b3 ? part[k] : part[8 + k], 8);
#pragma unroll
        for (int k = 0; k < 4; ++k) q4[k] = (b2 ? q8[4 + k] : q8[k]) + __shfl_xor(b2 ? q8[k] : q8[4 + k], 4);
#pragma unroll
        for (int k = 0; k < 2; ++k) q2[k] = (b1 ? q4[2 + k] : q4[k]) + __shfl_xor(b1 ? q4[k] : q4[2 + k], 2);
        const int rr = (b0 ? q2[1] : q2[0]) + __shfl_xor(b0 ? q2[0] : q2[1], 1);
        PA[((size_t)s * T_ + tok) * 128 + 4 * (batch * 16 + l15) + g] = rr;
      }
    }
  });
}

DI void phase10(const Params& p) {
  const int* PA = (const int*)(p.ws + WS_PA); float* ACT = (float*)(p.ws + WS_ACT); const float* HSC = (const float*)(p.ws + WS_HSC);
  const int* IDS = (const int*)(p.ws + WS_IDS); const float* GATE = (const float*)(p.ws + WS_GATE);
  const float* USC = (const float*)(p.ws + WS_USC); const float* VSC = (const float*)(p.ws + WS_VSC);
  for (int i = blockIdx.x * 256 + threadIdx.x; i < T_ * 128; i += gridDim.x * 256) {
    int ai = 0;
#pragma unroll
    for (int s = 0; s < 8; ++s) ai += PA[(size_t)s * T_ * 128 + i];
    const int id = IDS[i];
    const float a = (float)ai * USC[id] * HSC[i >> 7];
    ACT[i] = 0.5f * a * (1.f + erff(a * 0.70710678118654752f)) * GATE[i] * VSC[id];
  }
}

DI void phase11(const Params& p, char* smem, int rep) {
  const unsigned char* V8 = (const unsigned char*)(p.ws + WS_V);
  const int* IDS = (const int*)(p.ws + WS_IDS); const float* ACT = (const float*)(p.ws + WS_ACT); u16* OUTP = (u16*)(p.ws + WS_OUTP);
  const int lane = threadIdx.x & 63, w = threadIdx.x >> 6, g = lane >> 4, l15 = lane & 15;
  const int b5 = (lane >> 5) & 1, b4 = (lane >> 4) & 1;
  int* lw = (int*)(smem + 16) + w * 256;
  float* lf = (float*)(lw + 128);
  xcd_queue((unsigned*)(p.ws + WS_BAR) + CTR_VQ + rep * 8, 512, smem, [&](int s, int c) __attribute__((always_inline)) {
#pragma unroll 1
    for (int t = 0; t < 4; ++t) {
      const int tok = __builtin_amdgcn_readfirstlane(c * 16 + w * 4 + t);
      const int i0 = IDS[(size_t)tok * 128 + lane], i1 = IDS[(size_t)tok * 128 + 64 + lane];
      const float a0 = ACT[(size_t)tok * 128 + lane], a1 = ACT[(size_t)tok * 128 + 64 + lane];
      wave_lds_sync();
      lw[(lane & 3) * 32 + (lane >> 2)] = i0; lw[(lane & 3) * 32 + 16 + (lane >> 2)] = i1;
      lf[(lane & 3) * 32 + (lane >> 2)] = a0; lf[(lane & 3) * 32 + 16 + (lane >> 2)] = a1;
      wave_lds_sync();
      f2_t o[8];
#pragma unroll
      for (int i = 0; i < 8; ++i) o[i] = f2_t{0.f, 0.f};
      const unsigned char* vb = V8 + s * 256 + l15 * 16;
#pragma unroll
      for (int batch = 0; batch < 2; ++batch) {
        int ida[16]; float aa[16];
#pragma unroll
        for (int q = 0; q < 4; ++q) {
          const int4 v = *(const int4*)(lw + g * 32 + batch * 16 + q * 4); ida[q * 4] = v.x; ida[q * 4 + 1] = v.y; ida[q * 4 + 2] = v.z; ida[q * 4 + 3] = v.w;
          const float4 f = *(const float4*)(lf + g * 32 + batch * 16 + q * 4); aa[q * 4] = f.x; aa[q * 4 + 1] = f.y; aa[q * 4 + 2] = f.z; aa[q * 4 + 3] = f.w;
        }
        u32x4 rows[16];
#pragma unroll
        for (int k = 0; k < 16; ++k) rows[k] = *(const u32x4*)(vb + (size_t)ida[k] * 2048);
#pragma unroll
        for (int k = 0; k < 16; ++k) {
          const f2_t a2 = {aa[k], aa[k]};
#pragma unroll
          for (int d = 0; d < 4; ++d) { const unsigned ww = rows[k][d]; o[2 * d] += a2 * cvt8lo(ww); o[2 * d + 1] += a2 * cvt8hi(ww); }
        }
      }
      float ov[16];
#pragma unroll
      for (int d = 0; d < 4; ++d) { ov[4 * d] = o[2 * d].x; ov[4 * d + 1] = o[2 * d].y; ov[4 * d + 2] = o[2 * d + 1].x; ov[4 * d + 3] = o[2 * d + 1].y; }
      float q8[8], q4[4];
#pragma unroll
      for (int k = 0; k < 8; ++k) q8[k] = (b5 ? ov[8 + k] : ov[k]) + __shfl_xor(b5 ? ov[k] : ov[8 + k], 32);
#pragma unroll
      for (int k = 0; k < 4; ++k) q4[k] = (b4 ? q8[4 + k] : q8[k]) + __shfl_xor(b4 ? q8[k] : q8[4 + k], 16);
      *(uint2*)(OUTP + (size_t)tok * D_ + s * 256 + l15 * 16 + 8 * b5 + 4 * b4) = make_uint2(pk2(q4[0], q4[1]), pk2(q4[2], q4[3]));
    }
  });
}

DI void phase12(const Params& p) {
  const float* X1 = (const float*)(p.ws + WS_X1); const u16* OUTP = (const u16*)(p.ws + WS_OUTP);
  const float* mod = (const float*)(p.ws + WS_MOD); const float* gfin = p.in[19];
  const int lane = threadIdx.x & 63, w = threadIdx.x >> 6;
  for (int row = blockIdx.x * 4 + w; row < T_; row += gridDim.x * 4) {
    const float* gt = mod + (row >> 11) * 12288 + 5 * 2048;
    float4 v[8];
    float ss = 0.f;
#pragma unroll
    for (int j = 0; j < 8; ++j) {
      const int d = j * 256 + lane * 4;
      const float4 xv = *(const float4*)(X1 + (size_t)row * D_ + d), gv = *(const float4*)(gt + d);
      const uint2 ob = *(const uint2*)(OUTP + (size_t)row * D_ + d);
      const float4 ov = make_float4(bflo(ob.x), bfhi(ob.x), bflo(ob.y), bfhi(ob.y));
      v[j] = make_float4(xv.x + gv.x * ov.x, xv.y + gv.y * ov.y, xv.z + gv.z * ov.z, xv.w + gv.w * ov.w);
      ss += v[j].x * v[j].x + v[j].y * v[j].y + v[j].z * v[j].z + v[j].w * v[j].w;
    }
    ss = wave_sum(ss);
    const float rstd = rsqrtf(ss * (1.f / D_) + EPS);
#pragma unroll
    for (int j = 0; j < 8; ++j) {
      const int d = j * 256 + lane * 4;
      const float4 gv = *(const float4*)(gfin + d);
      *(float4*)(p.out + (size_t)row * D_ + d) = make_float4(v[j].x * rstd * gv.x, v[j].y * rstd * gv.y, v[j].z * rstd * gv.z, v[j].w * rstd * gv.w);
    }
  }
}

__global__ void __launch_bounds__(256, 2) mega(Params p) {
  extern __shared__ __attribute__((aligned(16))) char smem[];
  XcdBarrier xb;
  const bool multi = (p.ph_hi - p.ph_lo) > 1;
  if (multi) {
    if (threadIdx.x == 0) *(uint4*)smem = make_uint4(0u, 0u, 0u, 0u);
    __syncthreads();
    xb = xcd_barrier_post((unsigned*)(p.ws + WS_BAR), (volatile LAS unsigned*)smem);
  }
#ifndef PHMASK
#define PHMASK 0x1fff
#endif
#ifndef REPMASK
#define REPMASK 0
#endif
  int rep = 0;
#define RUN_PHASE(n, call) if (p.ph_lo <= (n) && (n) < p.ph_hi) { \
    if ((n) > p.ph_lo) { xcd_barrier(xb); } \
    if (PHMASK & (1 << (n))) { call; if (REPMASK & (1 << (n))) { xcd_barrier(xb); rep = 1; call; rep = 0; } } }
  RUN_PHASE(0, phase0(p, smem))
  RUN_PHASE(1, phase1(p, smem))
#ifdef BARX
  for (int i = 0; i < BARX; ++i) xcd_barrier(xb);
#endif
  RUN_PHASE(2, phase2(p, smem, rep))
  RUN_PHASE(3, phase3(p, smem))
  RUN_PHASE(4, phase4(p, smem))
  RUN_PHASE(5, phase5(p, smem))
  RUN_PHASE(6, norm_rows<true>((const float*)(p.ws + WS_X1), p.in[14], (const float*)(p.ws + WS_MOD) + 3 * 2048, 12288, (u16*)(p.ws + WS_H), (unsigned char*)(p.ws + WS_H2Q), (float*)(p.ws + WS_HSC), (int)blockIdx.x * 4, (int)gridDim.x * 4, T_))
  RUN_PHASE(7, phase7(p, smem))
  RUN_PHASE(8, phase8(p, smem))
  RUN_PHASE(9, phase9(p, smem, rep))
  RUN_PHASE(10, phase10(p))
  RUN_PHASE(11, phase11(p, smem, rep))
  RUN_PHASE(12, phase12(p))
}

extern "C" void kernel_launch(void* const* d_in, const int* in_sizes, int n_in, void* d_out, int out_size, void* d_ws, size_t ws_size, hipStream_t stream) {
  static int grid = 0;
  if (grid == 0) {
    if (n_in != 20 || ws_size < WS_END) { fprintf(stderr, "kernel_launch: unexpected n_in %d / ws_size %zu (need %zu)\n", n_in, ws_size, (size_t)WS_END); grid = -1; return; }
    int dev = 0, cus = 0, per_cu = 0;
    hipGetDevice(&dev);
    hipDeviceGetAttribute(&cus, hipDeviceAttributeMultiprocessorCount, dev);
    hipFuncSetAttribute((const void*)mega, hipFuncAttributeMaxDynamicSharedMemorySize, LDS_BYTES);
    hipOccupancyMaxActiveBlocksPerMultiprocessor(&per_cu, (const void*)mega, 256, LDS_BYTES);
    if (per_cu < 1) { fprintf(stderr, "kernel_launch: occupancy query says %d\n", per_cu); per_cu = 1; }
    if (per_cu > 2) per_cu = 2;
    grid = cus * per_cu;
    fprintf(stderr, "kernel_launch: grid %d (%d per CU)\n", grid, per_cu);
  }
  if (grid < 0) return;
  Params p{};
  for (int i = 0; i < 20; ++i) p.in[i] = (const float*)d_in[i];
  p.out = (float*)d_out; p.ws = (char*)d_ws;
#if N_LAUNCH_PER_PHASE
  p.coop = 0;
  for (int ph = 0; ph < NPH; ++ph) {
    p.ph_lo = ph; p.ph_hi = ph + 1;
    hipLaunchKernelGGL(mega, dim3(grid), dim3(256), LDS_BYTES, stream, p);
  }
#else
  hipMemsetAsync((char*)d_ws + WS_BAR, 0, WS_MOD, stream);
  p.coop = 0; p.ph_lo = 0; p.ph_hi = NPH;
  void* args[] = {&p};
  hipError_t e = hipLaunchCooperativeKernel((const void*)mega, dim3(grid), dim3(256), args, LDS_BYTES, stream);
  if (e != hipSuccess) fprintf(stderr, "cooperative launch failed: %s (grid %d)\n", hipGetErrorString(e), grid);
#endif
}
```

```cpp
#include <hip/hip_runtime.h>
#include <cstdio>
#include <cstdint>

#ifndef N_LAUNCH_PER_PHASE
#define N_LAUNCH_PER_PHASE 0
#endif

#define DI __device__ __forceinline__
typedef unsigned short u16;
typedef __attribute__((ext_vector_type(8))) short bf16x8;
typedef __attribute__((ext_vector_type(16))) float f32x16;
typedef __attribute__((ext_vector_type(2))) __bf16 bf2_t;
typedef __attribute__((ext_vector_type(2))) float f2_t;
typedef __attribute__((ext_vector_type(4))) unsigned u32x4;
typedef __attribute__((ext_vector_type(2))) unsigned u32x2;
#define MFMA(a, b, c) __builtin_amdgcn_mfma_f32_32x32x16_bf16((a), (b), (c), 0, 0, 0)

constexpr int T_ = 8192, D_ = 2048, S_ = 2048;
constexpr int INC = 4160;
constexpr float EPS = 1e-6f;
constexpr int NPH = 13;

constexpr size_t al256(size_t x) { return (x + 255) & ~(size_t)255; }
constexpr size_t WS_BAR = 0;
constexpr size_t WS_MOD = 32768;
constexpr size_t WS_ROPE = WS_MOD + al256(4 * 12288 * 4);
constexpr size_t WS_WINT = WS_ROPE + al256(2048 * 32 * 8);
constexpr size_t WS_WUQT = WS_WINT + al256((size_t)4224 * 2048 * 2);
constexpr size_t WS_WUKVT = WS_WUQT + al256((size_t)1536 * 512 * 2);
constexpr size_t WS_WOUTT = WS_WUKVT + al256((size_t)2048 * 512 * 2);
constexpr size_t WS_WQT = WS_WOUTT + al256((size_t)2048 * 2048 * 2);
constexpr size_t WS_SK = WS_WQT + al256((size_t)2048 * 2048 * 2);
constexpr size_t WS_U = WS_SK + al256((size_t)262144 * 2);
constexpr size_t WS_V = WS_U + al256((size_t)16384 * 2048);
constexpr size_t WS_H = WS_V + al256((size_t)16384 * 2048);
constexpr size_t WS_P = WS_H + al256((size_t)T_ * D_ * 2);
constexpr size_t WS_Q = WS_P + al256((size_t)T_ * INC * 2);
constexpr size_t WS_K = WS_Q + al256((size_t)T_ * 1536 * 2);
constexpr size_t WS_VT = WS_K + al256((size_t)T_ * 1536 * 2);
constexpr size_t WS_MG = WS_VT + al256((size_t)T_ * 1024 * 2);
constexpr size_t WS_X1 = WS_MG + al256((size_t)T_ * D_ * 2);
constexpr size_t WS_IDS = WS_X1 + al256((size_t)T_ * D_ * 4);
constexpr size_t WS_GATE = WS_IDS + al256((size_t)T_ * 128 * 4);
constexpr size_t WS_USC = WS_GATE + al256((size_t)T_ * 128 * 4);
constexpr size_t WS_VSC = WS_USC + 65536;
constexpr size_t WS_MODP = WS_VSC + 65536;
constexpr size_t WS_ACT = WS_MODP + al256((size_t)4 * 4 * 12288 * 4);
constexpr size_t WS_H2Q = WS_ACT + al256((size_t)T_ * 128 * 4);
constexpr size_t WS_HSC = WS_H2Q + al256((size_t)T_ * D_);
constexpr size_t WS_SSQ = WS_HSC + al256((size_t)T_ * 4);
constexpr size_t WS_END = WS_SSQ + al256((size_t)T_ * 16 * 4);
constexpr size_t WS_PA = WS_MG;
constexpr size_t WS_OUTP = WS_Q;
static_assert(WS_VT + (size_t)T_ * 1024 * 2 - WS_Q >= (size_t)T_ * D_ * 4, "OUTP alias");
static_assert((size_t)8 * T_ * 128 * 4 <= (size_t)T_ * D_ * 2, "PA alias");

constexpr int LDS_BYTES = 16 + 2 * 2 * 128 * 72 * 2 + 512;

struct Params {
  const float* in[20];
  float* out;
  char* ws;
  int ph_lo, ph_hi, coop, pad;
};

DI unsigned pk2(float a, float b) { f2_t v = {a, b}; bf2_t r = __builtin_convertvector(v, bf2_t); return __builtin_bit_cast(unsigned, r); }
DI float bflo(unsigned u) { return __uint_as_float(u << 16); }
DI float bfhi(unsigned u) { return __uint_as_float(u & 0xffff0000u); }
DI float dot2(unsigned a, unsigned b, float c) { return __builtin_amdgcn_fdot2_f32_bf16(__builtin_bit_cast(bf2_t, a), __builtin_bit_cast(bf2_t, b), c, false); }
DI float wave_sum(float v) {
#pragma unroll
  for (int o = 32; o >= 1; o >>= 1) v += __shfl_xor(v, o);
  return v;
}

#define XB_TMO      128
#define XB_XCNT(j)  (256  + 64 * (j))
#define XB_XSUB(j)  (1280 + 64 * (j))
#define XB_XGEN(j)  (2304 + 64 * (j))
#define XB_TOP      3328
#define XB_TOPGEN   3392
#define XCD_BAR_WORDS 3456
#define XB_SPIN_CAP (1u << 22)
#define LAS __attribute__((address_space(3)))
DI unsigned xb_ld(unsigned* p) { return __hip_atomic_load(p, __ATOMIC_RELAXED, __HIP_MEMORY_SCOPE_AGENT); }
DI unsigned xb_add(unsigned* p, unsigned v) { return __hip_atomic_fetch_add(p, v, __ATOMIC_RELAXED, __HIP_MEMORY_SCOPE_AGENT); }
DI unsigned xb_xcc_id() { return (unsigned)__builtin_amdgcn_s_getreg((3 << 11) | 20) & 0xFu; }
#define XB_SPIN(cond, bar) do { unsigned _sp = 0; while (cond) { __builtin_amdgcn_s_sleep(1); \
    if ((++_sp & 255u) == 0u) { if (xb_ld(&(bar)[XB_TMO])) break; if (_sp > XB_SPIN_CAP) { atomicAdd(&(bar)[XB_TMO], 1u); break; } } } } while (0)
struct XcdBarrier { unsigned* bar; unsigned x; volatile LAS unsigned* st; };
DI XcdBarrier xcd_barrier_post(unsigned* bar, volatile LAS unsigned* st) {
  XcdBarrier b; b.bar = bar; b.x = xb_xcc_id(); b.st = st;
  if (threadIdx.x == 0) (void)xb_add(&bar[XB_XCNT(b.x)], 1u);
  return b;
}
DI void xcd_barrier_complete(unsigned* bar, unsigned x, unsigned& nloc, unsigned& nx) {
  const unsigned G = gridDim.x * gridDim.y * gridDim.z;
  unsigned sum, cnt, mine, sp = 0u;
  for (;;) {
    sum = 0u; cnt = 0u; mine = 0u;
#pragma unroll
    for (unsigned j = 0; j < 16; ++j) { const unsigned c = xb_ld(&bar[XB_XCNT(j)]); sum += c; cnt += (c > 0u) ? 1u : 0u; mine = (j == x) ? c : mine; }
    if (sum == G) break;
    __builtin_amdgcn_s_sleep(1);
    if ((++sp & 255u) == 0u) { if (xb_ld(&bar[XB_TMO])) break; if (sp > XB_SPIN_CAP) { atomicAdd(&bar[XB_TMO], 1u); break; } }
  }
  nloc = mine > 0u ? mine : 1u; nx = cnt > 0u ? cnt : 1u;
}
DI void xcd_barrier(const XcdBarrier& b) {
  asm volatile("s_waitcnt vmcnt(0)" ::: "memory");
  __syncthreads();
  if (threadIdx.x == 0) {
    unsigned* bar = b.bar;
    __builtin_amdgcn_s_waitcnt(0);
    unsigned nloc = b.st[0], nx = b.st[1];
    if (nloc == 0u) { xcd_barrier_complete(bar, b.x, nloc, nx); b.st[0] = nloc; b.st[1] = nx; }
    const unsigned old = xb_add(&bar[XB_XSUB(b.x)], 1u);
    const unsigned gen = old / nloc;
    if (old + 1u == (gen + 1u) * nloc) {
      __builtin_amdgcn_fence(__ATOMIC_RELEASE, "agent");
      asm volatile("s_waitcnt vmcnt(0)" ::: "memory");
      const unsigned og = xb_add(&bar[XB_TOP], 1u);
      const unsigned tg = og / nx;
      if (og + 1u == (tg + 1u) * nx) xb_add(&bar[XB_TOPGEN], 1u);
      else XB_SPIN(xb_ld(&bar[XB_TOPGEN]) == tg, bar);
      __builtin_amdgcn_fence(__ATOMIC_ACQUIRE, "agent");
      xb_add(&bar[XB_XGEN(b.x)], 1u);
      asm volatile("s_waitcnt vmcnt(0)" ::: "memory");
    } else {
      XB_SPIN(xb_ld(&bar[XB_XGEN(b.x)]) == gen, bar);
      __builtin_amdgcn_fence(__ATOMIC_ACQUIRE, "agent");
      asm volatile("s_waitcnt vmcnt(0)" ::: "memory");
    }
  }
  __syncthreads();
}

template <bool SWAP, class Epi>
DI void gemm_tile(const u16* __restrict__ A, int lda, const u16* __restrict__ Bt, int ldb, int K, int m0, int n0, char* smem, Epi&& epi) {
  u16* As = (u16*)(smem + 16);
  u16* Bs = As + 2 * 128 * 72;
  const int tid = threadIdx.x, lane = tid & 63, w = tid >> 6, wm = w >> 1, wn = w & 1;
  const int r = lane & 31, hi = lane >> 5;
  f32x16 acc[2][2];
#pragma unroll
  for (int a = 0; a < 2; ++a)
#pragma unroll
    for (int b = 0; b < 2; ++b)
#pragma unroll
      for (int i = 0; i < 16; ++i) acc[a][b][i] = 0.f;
  const int srow = tid >> 3, skc = tid & 7;
  const u16* ag = A + (size_t)(m0 + srow) * lda + skc * 8;
  const u16* bg = Bt + (size_t)(n0 + srow) * ldb + skc * 8;
  u32x4 ra[4], rb[4];
#pragma unroll
  for (int i = 0; i < 4; ++i) { ra[i] = *(const u32x4*)(ag + (size_t)i * 32 * lda); rb[i] = *(const u32x4*)(bg + (size_t)i * 32 * ldb); }
  __syncthreads();
#pragma unroll
  for (int i = 0; i < 4; ++i) { *(u32x4*)(As + (srow + 32 * i) * 72 + skc * 8) = ra[i]; *(u32x4*)(Bs + (srow + 32 * i) * 72 + skc * 8) = rb[i]; }
  __syncthreads();
  const int KT = K >> 6;
  for (int kt = 0; kt < KT; ++kt) {
    const int buf = kt & 1;
    if (kt + 1 < KT) {
      const int k0 = (kt + 1) << 6;
#pragma unroll
      for (int i = 0; i < 4; ++i) { ra[i] = *(const u32x4*)(ag + (size_t)i * 32 * lda + k0); rb[i] = *(const u32x4*)(bg + (size_t)i * 32 * ldb + k0); }
    }
    const u16* Asb = As + buf * 128 * 72 + (wm * 64 + r) * 72 + hi * 8;
    const u16* Bsb = Bs + buf * 128 * 72 + (wn * 64 + r) * 72 + hi * 8;
#pragma unroll
    for (int ks = 0; ks < 4; ++ks) {
      bf16x8 af[2], bfr[2];
      af[0] = *(const bf16x8*)(Asb + ks * 16);
      af[1] = *(const bf16x8*)(Asb + 32 * 72 + ks * 16);
      bfr[0] = *(const bf16x8*)(Bsb + ks * 16);
      bfr[1] = *(const bf16x8*)(Bsb + 32 * 72 + ks * 16);
#pragma unroll
      for (int mi = 0; mi < 2; ++mi)
#pragma unroll
        for (int ni = 0; ni < 2; ++ni) {
          if (SWAP) acc[mi][ni] = MFMA(bfr[ni], af[mi], acc[mi][ni]);
          else acc[mi][ni] = MFMA(af[mi], bfr[ni], acc[mi][ni]);
        }
    }
    if (kt + 1 < KT) {
      const int nb = buf ^ 1;
#pragma unroll
      for (int i = 0; i < 4; ++i) { *(u32x4*)(As + nb * 128 * 72 + (srow + 32 * i) * 72 + skc * 8) = ra[i]; *(u32x4*)(Bs + nb * 128 * 72 + (srow + 32 * i) * 72 + skc * 8) = rb[i]; }
    }
    __syncthreads();
  }
  epi(acc, m0 + wm * 64, n0 + wn * 64, r, hi);
}

DI void tile_rstd512(const u16* __restrict__ A, int lda, int m0, float* rs) {
  const int tid = threadIdx.x, row = tid >> 1, half = tid & 1;
  const uint4* p = (const uint4*)(A + (size_t)(m0 + row) * lda + half * 256);
  float ss = 0.f;
#pragma unroll 8
  for (int i = 0; i < 32; ++i) {
    uint4 v = p[i];
    ss = dot2(v.x, v.x, ss); ss = dot2(v.y, v.y, ss); ss = dot2(v.z, v.z, ss); ss = dot2(v.w, v.w, ss);
  }
  ss += __shfl_xor(ss, 1);
  if (half == 0) rs[row] = rsqrtf(ss * (1.f / 512.f) + EPS);
}

DI void transpose_item(const float* __restrict__ src, int N, int K, const float* __restrict__ scale, u16* __restrict__ dst, int tk, int tn, char* smem) {
  float* tile = (float*)(smem + 16);
  const int t = threadIdx.x;
  __syncthreads();
  {
    const int rr = t >> 4, c4 = (t & 15) * 4;
#pragma unroll
    for (int ps = 0; ps < 4; ++ps) {
      const int kk = ps * 16 + rr, k = tk * 64 + kk;
      float4 v = *(const float4*)(src + (size_t)k * N + tn * 64 + c4);
      const float sc = scale ? scale[k] : 1.f;
      tile[kk * 65 + c4 + 0] = v.x * sc; tile[kk * 65 + c4 + 1] = v.y * sc; tile[kk * 65 + c4 + 2] = v.z * sc; tile[kk * 65 + c4 + 3] = v.w * sc;
    }
  }
  __syncthreads();
  {
    const int n = t & 63, kc = (t >> 6) * 16;
    unsigned o[8];
#pragma unroll
    for (int j = 0; j < 8; ++j) o[j] = pk2(tile[(kc + 2 * j) * 65 + n], tile[(kc + 2 * j + 1) * 65 + n]);
    uint4* d = (uint4*)(dst + (size_t)(tn * 64 + n) * K + tk * 64 + kc);
    d[0] = make_uint4(o[0], o[1], o[2], o[3]); d[1] = make_uint4(o[4], o[5], o[6], o[7]);
  }
}

DI void convert_item(const float* __restrict__ src, u16* __restrict__ dst, size_t base) {
  const int t = threadIdx.x;
#pragma unroll
  for (int st = 0; st < 4; ++st) {
    const size_t idx = base + st * 2048 + t * 8;
    float4 a = *(const float4*)(src + idx), b = *(const float4*)(src + idx + 4);
    *(uint4*)(dst + idx) = make_uint4(pk2(a.x, a.y), pk2(a.z, a.w), pk2(b.x, b.y), pk2(b.z, b.w));
  }
}

DI float wave_max(float v) {
#pragma unroll
  for (int o = 32; o >= 1; o >>= 1) v = fmaxf(v, __shfl_xor(v, o));
  return v;
}
DI void fp8_rows_item(const float* __restrict__ src, unsigned char* __restrict__ dst, float* __restrict__ scales, int item) {
  const int lane = threadIdx.x & 63, w = threadIdx.x >> 6;
  const int row = item * 4 + w;
  const float* sr = src + (size_t)row * 2048 + lane * 16;
  float4 v[8];
  float amax = 0.f;
#pragma unroll
  for (int j = 0; j < 2; ++j)
#pragma unroll
    for (int q = 0; q < 4; ++q) {
      const float4 t = *(const float4*)(sr + 1024 * j + q * 4);
      v[j * 4 + q] = t;
      amax = fmaxf(amax, fmaxf(fmaxf(fabsf(t.x), fabsf(t.y)), fmaxf(fabsf(t.z), fabsf(t.w))));
    }
  amax = wave_max(amax);
  int e = 0;
  if (amax > 0.f) e = (int)floorf(log2f(384.f / amax));
  e = e < -100 ? -100 : (e > 100 ? 100 : e);
  const float sc = ldexpf(1.f, e);
  if (lane == 0) scales[row] = ldexpf(1.f, -e);
#pragma unroll
  for (int j = 0; j < 2; ++j) {
    unsigned d[4];
#pragma unroll
    for (int q = 0; q < 4; ++q) {
      const float4 t = v[j * 4 + q];
      unsigned pk = __builtin_amdgcn_cvt_pk_fp8_f32(t.x * sc, t.y * sc, 0, false);
      pk = __builtin_amdgcn_cvt_pk_fp8_f32(t.z * sc, t.w * sc, pk, true);
      d[q] = pk;
    }
    *(uint4*)(dst + (size_t)row * 2048 + 1024 * j + lane * 16) = make_uint4(d[0], d[1], d[2], d[3]);
  }
}

DI unsigned pack_i8x4(float a, float b, float c, float d) {
  const int ia = __float2int_rn(a), ib = __float2int_rn(b), ic = __float2int_rn(c), id = __float2int_rn(d);
  return (unsigned)(ia & 0xff) | ((unsigned)(ib & 0xff) << 8) | ((unsigned)(ic & 0xff) << 16) | ((unsigned)id << 24);
}
DI void i8_rows_item(const float* __restrict__ src, unsigned char* __restrict__ dst, float* __restrict__ scales, int item) {
  const int lane = threadIdx.x & 63, w = threadIdx.x >> 6;
  const int row = item * 4 + w;
  const float* sr = src + (size_t)row * 2048 + lane * 16;
  float4 v[8];
  float amax = 0.f;
#pragma unroll
  for (int j = 0; j < 2; ++j)
#pragma unroll
    for (int q = 0; q < 4; ++q) {
      const float4 t = *(const float4*)(sr + 1024 * j + q * 4);
      v[j * 4 + q] = t;
      amax = fmaxf(amax, fmaxf(fmaxf(fabsf(t.x), fabsf(t.y)), fmaxf(fabsf(t.z), fabsf(t.w))));
    }
  amax = wave_max(amax);
  const float sc = amax > 0.f ? 127.f / amax : 0.f;
  if (lane == 0) scales[row] = amax * (1.f / 127.f);
#pragma unroll
  for (int j = 0; j < 2; ++j) {
    unsigned d[4];
#pragma unroll
    for (int q = 0; q < 4; ++q) { const float4 t = v[j * 4 + q]; d[q] = pack_i8x4(t.x * sc, t.y * sc, t.z * sc, t.w * sc); }
    *(uint4*)(dst + (size_t)row * 2048 + 1024 * j + lane * 16) = make_uint4(d[0], d[1], d[2], d[3]);
  }
}

DI void mod_item(const Params& p, int item, char* smem) {
  float* cact = (float*)(smem + 16);
  float* red = cact + 4 * 512;
  const int t = threadIdx.x;
  const int cgi = item % 192, ksp = item / 192, kbase = ksp * 512;
  const float* c = p.in[1]; const float* W = p.in[2];
  float* mod = (float*)(p.ws + WS_MODP);
  __syncthreads();
  for (int i = t; i < 4 * 512; i += 256) { float v = c[(i >> 9) * 2048 + kbase + (i & 511)]; cact[i] = v / (1.f + __expf(-v)); }
  __syncthreads();
  const int cq = t & 15, kl = t >> 4, c0 = cgi * 64;
  float acc[4][4];
#pragma unroll
  for (int b = 0; b < 4; ++b)
#pragma unroll
    for (int j = 0; j < 4; ++j) acc[b][j] = 0.f;
  const float* wp = W + (size_t)(kbase + kl) * 12288 + c0 + cq * 4;
#pragma unroll 8
  for (int i = 0; i < 32; ++i) {
    const int k = kl + 16 * i;
    float4 w4 = *(const float4*)(wp + (size_t)i * 16 * 12288);
#pragma unroll
    for (int b = 0; b < 4; ++b) {
      const float a = cact[b * 512 + k];
      acc[b][0] += a * w4.x; acc[b][1] += a * w4.y; acc[b][2] += a * w4.z; acc[b][3] += a * w4.w;
    }
  }
#pragma unroll
  for (int b = 0; b < 4; ++b)
#pragma unroll
    for (int j = 0; j < 4; ++j) red[(kl * 16 + cq) * 17 + b * 4 + j] = acc[b][j];
  __syncthreads();
  {
    const int b = t >> 6, col = t & 63, q = col >> 2, j = col & 3;
    float s = 0.f;
#pragma unroll
    for (int k2 = 0; k2 < 16; ++k2) s += red[(k2 * 16 + q) * 17 + b * 4 + j];
    mod[(size_t)ksp * 49152 + b * 12288 + c0 + col] = s;
  }
}

constexpr int P0_MOD = 768;
constexpr int P0_TIN = 32 * 65, P0_TUQ = 8 * 24, P0_TUKV = 8 * 32, P0_TOUT = 32 * 32, P0_TWQ = 32 * 32;
constexpr int P0_SK = 32, P0_UV = 0, P0_ROPE = 32;
DI void phase0(const Params& p, char* smem) {
  constexpr int o1 = P0_MOD, o2 = o1 + P0_TIN, o3 = o2 + P0_TUQ, o4 = o3 + P0_TUKV, o5 = o4 + P0_TOUT, o6 = o5 + P0_TWQ, o7 = o6 + P0_SK, o8 = o7 + P0_UV, o9 = o8 + P0_UV, o10 = o9 + P0_ROPE;
  for (int it = blockIdx.x; it < o10; it += gridDim.x) {
    if (it < o1) mod_item(p, it, smem);
    else if (it < o2) { int j = it - o1; transpose_item(p.in[5], INC, 2048, nullptr, (u16*)(p.ws + WS_WINT), j / 65, j % 65, smem); }
    else if (it < o3) { int j = it - o2; transpose_item(p.in[8], 1536, 512, p.in[7], (u16*)(p.ws + WS_WUQT), j / 24, j % 24, smem); }
    else if (it < o4) { int j = it - o3; transpose_item(p.in[10], 2048, 512, p.in[9], (u16*)(p.ws + WS_WUKVT), j / 32, j % 32, smem); }
    else if (it < o5) { int j = it - o4; int tk = j / 32; transpose_item(p.in[13], 2048, 2048, tk < 16 ? p.in[11] : p.in[12] - 1024, (u16*)(p.ws + WS_WOUTT), tk, j % 32, smem); }
    else if (it < o6) { int j = it - o5; transpose_item(p.in[15], 2048, 2048, nullptr, (u16*)(p.ws + WS_WQT), j / 32, j % 32, smem); }
    else if (it < o7) convert_item(p.in[16], (u16*)(p.ws + WS_SK), (size_t)(it - o6) * 8192);
    else if (it < o8) fp8_rows_item(p.in[17], (unsigned char*)(p.ws + WS_U), (float*)(p.ws + WS_USC), it - o7);
    else if (it < o9) fp8_rows_item(p.in[18], (unsigned char*)(p.ws + WS_V), (float*)(p.ws + WS_VSC), it - o8);
    else {
      float2* rope = (float2*)(p.ws + WS_ROPE);
      const int base = (it - o9) * 2048;
      for (int e = threadIdx.x; e < 2048; e += 256) {
        const int idx = base + e, pos = idx >> 5, j = idx & 31;
        const float inv = 1.0f / powf(10000.0f, (float)(2 * j) / 64.0f);
        const float ang = (float)pos * inv;
        rope[idx] = make_float2(cosf(ang), sinf(ang));
      }
    }
  }
}

template <bool Q8>
DI void norm_rows(const float* __restrict__ X, const float* __restrict__ g, const float* mod, int bstride, u16* __restrict__ out, unsigned char* __restrict__ outq, float* __restrict__ qscale,
                  int row_start, int row_step, int row_end) {
  const int lane = threadIdx.x & 63, w = threadIdx.x >> 6;
  for (int row = row_start + w; row < row_end; row += row_step) {
    const float* xr = X + (size_t)row * D_;
    float4 v[8];
    float ss = 0.f;
#pragma unroll
    for (int j = 0; j < 8; ++j) { v[j] = *(const float4*)(xr + j * 256 + lane * 4); ss += v[j].x * v[j].x + v[j].y * v[j].y + v[j].z * v[j].z + v[j].w * v[j].w; }
    ss = wave_sum(ss);
    const float rstd = rsqrtf(ss * (1.f / D_) + EPS);
    const int b = row >> 11;
    const float* sh = mod + b * bstride;
    const float* sc = sh + 2048;
    float amax = 0.f;
#pragma unroll
    for (int j = 0; j < 8; ++j) {
      const int d = j * 256 + lane * 4;
      const float4 gg = *(const float4*)(g + d), s4 = *(const float4*)(sc + d), h4 = *(const float4*)(sh + d);
      const float o0 = v[j].x * rstd * gg.x * (1.f + s4.x) + h4.x;
      const float o1 = v[j].y * rstd * gg.y * (1.f + s4.y) + h4.y;
      const float o2 = v[j].z * rstd * gg.z * (1.f + s4.z) + h4.z;
      const float o3 = v[j].w * rstd * gg.w * (1.f + s4.w) + h4.w;
      *(uint2*)(out + (size_t)row * D_ + d) = make_uint2(pk2(o0, o1), pk2(o2, o3));
      if (Q8) { v[j] = make_float4(o0, o1, o2, o3); amax = fmaxf(amax, fmaxf(fmaxf(fabsf(o0), fabsf(o1)), fmaxf(fabsf(o2), fabsf(o3)))); }
    }
    if (Q8) {
      amax = wave_max(amax);
      const float qs = amax > 0.f ? 127.f / amax : 0.f;
      if (lane == 0) qscale[row] = amax * (1.f / 127.f);
#pragma unroll
      for (int j = 0; j < 8; ++j) *(unsigned*)(outq + (size_t)row * D_ + j * 256 + lane * 4) = pack_i8x4(v[j].x * qs, v[j].y * qs, v[j].z * qs, v[j].w * qs);
    }
  }
}
DI void phase1(const Params& p, char* smem) {
  const float* mp = (const float*)(p.ws + WS_MODP); float* mod = (float*)(p.ws + WS_MOD); const float* bias = p.in[3];
  for (int i = blockIdx.x * 256 + threadIdx.x; i < 49152; i += gridDim.x * 256)
    mod[i] = ((mp[i] + mp[49152 + i]) + mp[2 * 49152 + i]) + mp[3 * 49152 + i] + bias[i % 12288];
  const int rpb = T_ / (int)gridDim.x, row0 = (int)blockIdx.x * rpb, bb = row0 >> 11;
  float* lm = (float*)(smem + 16);
  __syncthreads();
  for (int c = threadIdx.x; c < 4096; c += 256) {
    const int src = bb * 12288 + c;
    lm[c] = ((mp[src] + mp[49152 + src]) + mp[2 * 49152 + src]) + mp[3 * 49152 + src] + bias[c];
  }
  __syncthreads();
  norm_rows<false>(p.in[0], p.in[4], lm, 0, (u16*)(p.ws + WS_H), nullptr, nullptr, row0, 4, row0 + rpb);
}

constexpr int CTR_TILE = 3520, CTR_CHUNK = 3584;
DI int grab(unsigned* ctr, char* smem) {
  __syncthreads();
  if (threadIdx.x == 0) *(volatile unsigned*)(smem + 8) = atomicAdd(ctr, 1u);
  __syncthreads();
  return (int)*(volatile unsigned*)(smem + 8);
}
DI void uv_chunk(const Params& p, int c) {
#pragma unroll 1
  for (int i = 0; i < 4; ++i) {
    const int item = c * 4 + i;
    if (item < 4096) i8_rows_item(p.in[17], (unsigned char*)(p.ws + WS_U), (float*)(p.ws + WS_USC), item);
    else fp8_rows_item(p.in[18], (unsigned char*)(p.ws + WS_V), (float*)(p.ws + WS_VSC), item - 4096);
  }
}
DI void phase2(const Params& p, char* smem, int rep) {
  const u16* H = (const u16*)(p.ws + WS_H); const u16* W = (const u16*)(p.ws + WS_WINT); u16* P = (u16*)(p.ws + WS_P); float* SSQ = (float*)(p.ws + WS_SSQ);
  (void)rep;
  const bool odd = (blockIdx.x & 1) != 0;
  if (odd) for (int c = blockIdx.x; c < 2048; c += gridDim.x) uv_chunk(p, c);
  for (int it = blockIdx.x; it < 64 * 32; it += gridDim.x) {
    const int tn = it / 64, tm = it % 64;
    gemm_tile<true>(H, D_, W, D_, D_, tm * 128, tn * 128, smem, [&](f32x16 (&acc)[2][2], int mb, int nb, int r, int hi) __attribute__((always_inline)) {
#pragma unroll
      for (int mi = 0; mi < 2; ++mi)
#pragma unroll
        for (int ni = 0; ni < 2; ++ni)
#pragma unroll
          for (int g = 0; g < 4; ++g) {
            const int row = mb + mi * 32 + r, col = nb + ni * 32 + hi * 4 + 8 * g;
            *(uint2*)(P + (size_t)row * INC + col) = make_uint2(pk2(acc[mi][ni][4 * g], acc[mi][ni][4 * g + 1]), pk2(acc[mi][ni][4 * g + 2], acc[mi][ni][4 * g + 3]));
          }
      if (nb >= 3072) {
#pragma unroll
        for (int mi = 0; mi < 2; ++mi) {
          float ss = 0.f;
#pragma unroll
          for (int ni = 0; ni < 2; ++ni)
#pragma unroll
            for (int i = 0; i < 16; ++i) ss += acc[mi][ni][i] * acc[mi][ni][i];
          ss += __shfl_xor(ss, 32);
          if (hi == 0) SSQ[(size_t)(mb + mi * 32 + r) * 16 + ((nb - 3072) >> 6)] = ss;
        }
      }
    });
  }
  if (!odd) for (int c = blockIdx.x; c < 2048; c += gridDim.x) uv_chunk(p, c);
}

DI void phase3(const Params& p, char* smem) {
  const u16* P = (const u16*)(p.ws + WS_P);
  u16* Q = (u16*)(p.ws + WS_Q); u16* Kb = (u16*)(p.ws + WS_K); u16* VT = (u16*)(p.ws + WS_VT); u16* MG = (u16*)(p.ws + WS_MG);
  const float2* rope = (const float2*)(p.ws + WS_ROPE); const float* SSQ = (const float*)(p.ws + WS_SSQ);
  float* rs = (float*)(smem + 16 + 2 * 2 * 128 * 72 * 2);
  constexpr int NQ = 64 * 12, NKV = 64 * 16, NKR = 1024, NCV = 1024;
  const float qscale = 0.07216878364870322f * 1.4426950408889634f;
  const int G = (int)gridDim.x, bid = (int)blockIdx.x;
  if (bid < 64) {
    for (int tm = bid; tm < 64; tm += 64) {
      gemm_tile<true>((const u16*)(p.ws + WS_H), D_, (const u16*)(p.ws + WS_WINT), D_, D_, tm * 128, 4096, smem, [&](f32x16 (&acc)[2][2], int mb, int nb, int r, int hi) __attribute__((always_inline)) {
        if (nb != 4096) return;
#pragma unroll
        for (int mi = 0; mi < 2; ++mi) {
          const int row = mb + mi * 32 + r, pos = row & (S_ - 1);
#pragma unroll
          for (int g = 0; g < 4; ++g) {
            const int j = hi * 4 + 8 * g;
            float a0[4], a1[4];
#pragma unroll
            for (int e = 0; e < 4; ++e) {
              const float2 cs = rope[pos * 32 + j + e];
              const float x1 = acc[mi][0][4 * g + e], x2 = acc[mi][1][4 * g + e];
              a0[e] = x1 * cs.x - x2 * cs.y; a1[e] = x2 * cs.x + x1 * cs.y;
            }
            const uint2 lo = make_uint2(pk2(a0[0], a0[1]), pk2(a0[2], a0[3])), hi2 = make_uint2(pk2(a1[0], a1[1]), pk2(a1[2], a1[3]));
#pragma unroll
            for (int h = 0; h < 8; ++h) { *(uint2*)(Kb + (size_t)row * 1536 + h * 192 + 128 + j) = lo; *(uint2*)(Kb + (size_t)row * 1536 + h * 192 + 160 + j) = hi2; }
          }
        }
      });
    }
  }
  const int t_begin = bid < 64 ? NQ + NKV : bid - 64, t_step = G - 64;
  for (int itx = 0; itx < 2; ++itx)
  for (int it = (itx == 0 ? t_begin : NQ + NKV + NKR + bid); it < (itx == 0 ? NQ + NKV : NQ + NKV + NKR + NCV); it += (itx == 0 ? t_step : G)) {
    if (it < NQ) {
      const int tn = it / 64, tm = it % 64;
      __syncthreads();
      if (threadIdx.x < 128) { const float4* sp = (const float4*)(SSQ + (size_t)(tm * 128 + threadIdx.x) * 16); const float4 a = sp[0], b = sp[1]; rs[threadIdx.x] = rsqrtf((((a.x + a.y) + (a.z + a.w)) + ((b.x + b.y) + (b.z + b.w))) * (1.f / 512.f) + EPS); }
      gemm_tile<true>(P + 3072, INC, (const u16*)(p.ws + WS_WUQT), 512, 512, tm * 128, tn * 128, smem, [&](f32x16 (&acc)[2][2], int mb, int nb, int r, int hi) __attribute__((always_inline)) {
        const bool is_rope = ((nb >> 6) % 3) == 2;
#pragma unroll
        for (int mi = 0; mi < 2; ++mi) {
          const int row = mb + mi * 32 + r;
          const float sc = rs[row - tm * 128] * qscale;
          const int pos = row & (S_ - 1);
#pragma unroll
          for (int g = 0; g < 4; ++g) {
            const int j = hi * 4 + 8 * g;
            float a0[4], a1[4];
#pragma unroll
            for (int e = 0; e < 4; ++e) { a0[e] = acc[mi][0][4 * g + e] * sc; a1[e] = acc[mi][1][4 * g + e] * sc; }
            if (is_rope) {
#pragma unroll
              for (int e = 0; e < 4; ++e) {
                const float2 cs = rope[pos * 32 + j + e];
                const float x1 = a0[e], x2 = a1[e];
                a0[e] = x1 * cs.x - x2 * cs.y; a1[e] = x2 * cs.x + x1 * cs.y;
              }
            }
            *(uint2*)(Q + (size_t)row * 1536 + nb + j) = make_uint2(pk2(a0[0], a0[1]), pk2(a0[2], a0[3]));
            *(uint2*)(Q + (size_t)row * 1536 + nb + 32 + j) = make_uint2(pk2(a1[0], a1[1]), pk2(a1[2], a1[3]));
          }
        }
      });
    } else if (it < NQ + NKV) {
      const int j2 = it - NQ, tn = j2 / 64, tm = j2 % 64;
      __syncthreads();
      if (threadIdx.x < 128) { const float4* sp = (const float4*)(SSQ + (size_t)(tm * 128 + threadIdx.x) * 16 + 8); const float4 a = sp[0], b = sp[1]; rs[threadIdx.x] = rsqrtf((((a.x + a.y) + (a.z + a.w)) + ((b.x + b.y) + (b.z + b.w))) * (1.f / 512.f) + EPS); }
      const int head = tn >> 1;
      if ((tn & 1) == 0) {
        gemm_tile<true>(P + 3584, INC, (const u16*)(p.ws + WS_WUKVT), 512, 512, tm * 128, tn * 128, smem, [&](f32x16 (&acc)[2][2], int mb, int nb, int r, int hi) __attribute__((always_inline)) {
#pragma unroll
          for (int mi = 0; mi < 2; ++mi) {
            const int row = mb + mi * 32 + r;
            const float sc = rs[row - tm * 128];
#pragma unroll
            for (int ni = 0; ni < 2; ++ni)
#pragma unroll
              for (int g = 0; g < 4; ++g) {
                const int d = (nb & 127) + ni * 32 + hi * 4 + 8 * g;
                *(uint2*)(Kb + (size_t)row * 1536 + head * 192 + d) = make_uint2(pk2(acc[mi][ni][4 * g] * sc, acc[mi][ni][4 * g + 1] * sc), pk2(acc[mi][ni][4 * g + 2] * sc, acc[mi][ni][4 * g + 3] * sc));
              }
          }
        });
      } else {
        gemm_tile<false>(P + 3584, INC, (const u16*)(p.ws + WS_WUKVT), 512, 512, tm * 128, tn * 128, smem, [&](f32x16 (&acc)[2][2], int mb, int nb, int r, int hi) __attribute__((always_inline)) {
#pragma unroll
          for (int mi = 0; mi < 2; ++mi)
#pragma unroll
            for (int g = 0; g < 4; ++g) {
              const int row0 = mb + mi * 32 + hi * 4 + 8 * g;
              const float s0 = rs[row0 - tm * 128], s1 = rs[row0 + 1 - tm * 128], s2 = rs[row0 + 2 - tm * 128], s3 = rs[row0 + 3 - tm * 128];
              const int b = row0 >> 11, t = row0 & (S_ - 1);
#pragma unroll
              for (int ni = 0; ni < 2; ++ni) {
                const int d = (nb & 127) + ni * 32 + r;
                *(uint2*)(VT + ((size_t)((b * 8 + head) * 128 + d)) * S_ + t) = make_uint2(pk2(acc[mi][ni][4 * g] * s0, acc[mi][ni][4 * g + 1] * s1), pk2(acc[mi][ni][4 * g + 2] * s2, acc[mi][ni][4 * g + 3] * s3));
              }
            }
        });
      }
    } else if (it < NQ + NKV + NKR) {
      const int j2 = it - NQ - NKV;
      const int row = j2 * 8 + (threadIdx.x >> 5), j = threadIdx.x & 31, pos = row & (S_ - 1);
      const float x1 = bflo((unsigned)P[(size_t)row * INC + 4096 + j]), x2 = bflo((unsigned)P[(size_t)row * INC + 4096 + 32 + j]);
      const float2 cs = rope[pos * 32 + j];
      const float o1 = x1 * cs.x - x2 * cs.y, o2 = x2 * cs.x + x1 * cs.y;
      const u16 b1 = (u16)(pk2(o1, 0.f) & 0xffffu), b2 = (u16)(pk2(o2, 0.f) & 0xffffu);
#pragma unroll
      for (int h = 0; h < 8; ++h) { Kb[(size_t)row * 1536 + h * 192 + 128 + j] = b1; Kb[(size_t)row * 1536 + h * 192 + 160 + j] = b2; }
    } else {
      const int j2 = it - NQ - NKV - NKR;
      const int wi = j2 * 4 + (threadIdx.x >> 6), lane = threadIdx.x & 63;
      const int g = wi & 7, run = wi >> 3;
      const int row0 = run * 16, t0 = row0 & (S_ - 1);
      const int ch = g * 128 + lane * 2;
      const float* cw = p.in[6];
      const float w00 = cw[ch], w01 = cw[ch + 1], w10 = cw[1024 + ch], w11 = cw[1024 + ch + 1], w20 = cw[2048 + ch], w21 = cw[2048 + ch + 1];
      float zm1a = 0.f, zm1b = 0.f, zm2a = 0.f, zm2b = 0.f;
      if (t0 > 0) {
        const unsigned c1 = *(const unsigned*)(P + (size_t)(row0 - 1) * INC + 1024 + ch), h1 = *(const unsigned*)(P + (size_t)(row0 - 1) * INC + 2048 + ch);
        const unsigned c2 = *(const unsigned*)(P + (size_t)(row0 - 2) * INC + 1024 + ch), h2 = *(const unsigned*)(P + (size_t)(row0 - 2) * INC + 2048 + ch);
        zm1a = bflo(c1) * bflo(h1); zm1b = bfhi(c1) * bfhi(h1); zm2a = bflo(c2) * bflo(h2); zm2b = bfhi(c2) * bfhi(h2);
      }
#pragma unroll 4
      for (int tt = 0; tt < 16; ++tt) {
        const size_t ro = (size_t)(row0 + tt) * INC;
        const unsigned bb = *(const unsigned*)(P + ro + ch), cc = *(const unsigned*)(P + ro + 1024 + ch), hh = *(const unsigned*)(P + ro + 2048 + ch);
        const float za = bflo(cc) * bflo(hh), zb = bfhi(cc) * bfhi(hh);
        const float ya = bflo(bb) * (w00 * zm2a + w10 * zm1a + w20 * za), yb = bfhi(bb) * (w01 * zm2b + w11 * zm1b + w21 * zb);
        zm2a = zm1a; zm2b = zm1b; zm1a = za; zm1b = zb;
        const float ss = wave_sum(ya * ya + yb * yb);
        const float rstd = rsqrtf(ss * (1.f / 128.f) + EPS);
        *(unsigned*)(MG + (size_t)(row0 + tt) * D_ + ch) = pk2(ya * rstd, yb * rstd);
      }
    }
  }
}

DI void phase4(const Params& p, char* smem) {
  const u16* Q = (const u16*)(p.ws + WS_Q); const u16* Kb = (const u16*)(p.ws + WS_K); const u16* VT = (const u16*)(p.ws + WS_VT);
  u16* MG = (u16*)(p.ws + WS_MG);
  u16* Ks = (u16*)(smem + 16);
  u16* Vs = Ks + 64 * 200;
  float* mrg = (float*)(smem + 16);
  const int tid = threadIdx.x, lane = tid & 63, w = tid >> 6, qh = w & 1, kh = w >> 1, r = lane & 31, hi = lane >> 5;
  for (int it = blockIdx.x; it < 512; it += gridDim.x) {
    const int xq = it & 7, jq = it >> 3, bh = xq + 8 * (jq >> 4);
    const int pi = jq & 15, h = bh & 7, b = bh >> 3;
    for (int sub = 0; sub < 2; ++sub) {
      const int c = sub ? (31 - pi) : pi;
      const size_t qrow = (size_t)b * S_ + c * 64 + qh * 32 + r;
      bf16x8 qf[12];
#pragma unroll
      for (int ks = 0; ks < 12; ++ks) qf[ks] = *(const bf16x8*)(Q + qrow * 1536 + h * 192 + ks * 16 + hi * 8);
      f32x16 O[4];
#pragma unroll
      for (int dt = 0; dt < 4; ++dt)
#pragma unroll
        for (int i = 0; i < 16; ++i) O[dt][i] = 0.f;
      float m = -1e30f, l = 0.f;
      u32x4 kr[6]; u32x4 vr[4];
      const u16* kg = Kb + ((size_t)b * S_ + (tid >> 2)) * 1536 + h * 192 + (tid & 3) * 8;
      const u16* vg = VT + ((size_t)((b * 8 + h) * 128 + (tid >> 1))) * S_ + (tid & 1) * 8;
      u16* ksw = Ks + (tid >> 2) * 200 + (tid & 3) * 8;
      u16* vsw = Vs + (tid >> 1) * 68 + (tid & 1) * 8;
      auto load_tile = [&]() __attribute__((always_inline)) {
#pragma unroll
        for (int i = 0; i < 6; ++i) kr[i] = *(const u32x4*)(kg + i * 32);
#pragma unroll
        for (int i = 0; i < 4; ++i) vr[i] = *(const u32x4*)(vg + i * 16);
        kg += 64 * 1536; vg += 64;
      };
      load_tile();
      for (int kt = 0; kt <= c; ++kt) {
        __syncthreads();
#pragma unroll
        for (int i = 0; i < 6; ++i) *(u32x4*)(ksw + i * 32) = kr[i];
#pragma unroll
        for (int i = 0; i < 4; ++i) { u32x2 lo2 = {vr[i][0], vr[i][1]}, hi2 = {vr[i][2], vr[i][3]}; *(u32x2*)(vsw + i * 16) = lo2; *(u32x2*)(vsw + i * 16 + 4) = hi2; }
        __syncthreads();
        if (kt < c) load_tile();
        f32x16 s;
#pragma unroll
        for (int i = 0; i < 16; ++i) s[i] = 0.f;
        const u16* kp = Ks + (kh * 32 + r) * 200 + hi * 8;
#pragma unroll
        for (int ks = 0; ks < 12; ++ks) { bf16x8 kf = *(const bf16x8*)(kp + ks * 16); s = MFMA(kf, qf[ks], s); }
        float mx = s[0];
#pragma unroll
        for (int i = 1; i < 16; ++i) mx = fmaxf(mx, s[i]);
        mx = fmaxf(mx, __shfl_xor(mx, 32));
        const float mn = fmaxf(m, mx);
        const float alpha = __builtin_amdgcn_exp2f(m - mn);
        const bool resc = __builtin_amdgcn_ballot_w64(mn > m) != 0ull;
        m = mn;
        float rsum = 0.f;
#pragma unroll
        for (int i = 0; i < 16; ++i) { s[i] = __builtin_amdgcn_exp2f(s[i] - mn); rsum += s[i]; }
        l = l * alpha + rsum;
        if (resc) {
#pragma unroll
          for (int dt = 0; dt < 4; ++dt)
#pragma unroll
            for (int i = 0; i < 16; ++i) O[dt][i] *= alpha;
        }
#pragma unroll
        for (int st = 0; st < 2; ++st) {
          uint4 pu = make_uint4(pk2(s[8 * st], s[8 * st + 1]), pk2(s[8 * st + 2], s[8 * st + 3]), pk2(s[8 * st + 4], s[8 * st + 5]), pk2(s[8 * st + 6], s[8 * st + 7]));
          const bf16x8 pf = __builtin_bit_cast(bf16x8, pu);
#pragma unroll
          for (int dt = 0; dt < 4; ++dt) {
            const u16* vp = Vs + (dt * 32 + r) * 68 + kh * 32 + 16 * st + 4 * hi;
            uint2 v0 = *(const uint2*)vp, v1 = *(const uint2*)(vp + 8);
            const bf16x8 vf = __builtin_bit_cast(bf16x8, make_uint4(v0.x, v0.y, v1.x, v1.y));
            O[dt] = MFMA(vf, pf, O[dt]);
          }
        }
      }
      l += __shfl_xor(l, 32);
      __syncthreads();
      float* mq = mrg + qh * 66 * 64;
      if (kh == 1) {
#pragma unroll
        for (int dt = 0; dt < 4; ++dt)
#pragma unroll
          for (int i = 0; i < 16; ++i) mq[(dt * 16 + i) * 64 + lane] = O[dt][i];
        mq[64 * 64 + lane] = m; mq[65 * 64 + lane] = l;
      }
      __syncthreads();
      if (kh == 0) {
        const float m1 = mq[64 * 64 + lane], l1 = mq[65 * 64 + lane];
        const float mt = fmaxf(m, m1), a0 = exp2f(m - mt), a1 = exp2f(m1 - mt);
        const float inv = 1.f / (l * a0 + l1 * a1);
        float ss = 0.f;
#pragma unroll
        for (int dt = 0; dt < 4; ++dt)
#pragma unroll
          for (int i = 0; i < 16; ++i) { const float o = (O[dt][i] * a0 + mq[(dt * 16 + i) * 64 + lane] * a1) * inv; O[dt][i] = o; ss += o * o; }
        ss += __shfl_xor(ss, 32);
        const float rstd = rsqrtf(ss * (1.f / 128.f) + EPS);
#pragma unroll
        for (int dt = 0; dt < 4; ++dt)
#pragma unroll
          for (int g = 0; g < 4; ++g) {
            const int d = dt * 32 + hi * 4 + 8 * g;
            *(uint2*)(MG + qrow * D_ + 1024 + h * 128 + d) = make_uint2(pk2(O[dt][4 * g] * rstd, O[dt][4 * g + 1] * rstd), pk2(O[dt][4 * g + 2] * rstd, O[dt][4 * g + 3] * rstd));
          }
      }
    }
  }
}

DI void phase5(const Params& p, char* smem) {
  const u16* MG = (const u16*)(p.ws + WS_MG); const u16* W = (const u16*)(p.ws + WS_WOUTT);
  const float* X = p.in[0]; const float* mod = (const float*)(p.ws + WS_MOD); float* X1 = (float*)(p.ws + WS_X1);
  for (int it = blockIdx.x; it < 64 * 16; it += gridDim.x) {
    const int tn = it / 64, tm = it % 64;
    gemm_tile<true>(MG, D_, W, D_, D_, tm * 128, tn * 128, smem, [&](f32x16 (&acc)[2][2], int mb, int nb, int r, int hi) __attribute__((always_inline)) {
#pragma unroll
      for (int mi = 0; mi < 2; ++mi) {
        const int row = mb + mi * 32 + r, b = row >> 11;
        const float* gt = mod + b * 12288 + 2 * 2048;
#pragma unroll
        for (int ni = 0; ni < 2; ++ni)
#pragma unroll
          for (int g = 0; g < 4; ++g) {
            const int col = nb + ni * 32 + hi * 4 + 8 * g;
            const float4 xv = *(const float4*)(X + (size_t)row * D_ + col), gv = *(const float4*)(gt + col);
            float4 o;
            o.x = xv.x + gv.x * acc[mi][ni][4 * g]; o.y = xv.y + gv.y * acc[mi][ni][4 * g + 1]; o.z = xv.z + gv.z * acc[mi][ni][4 * g + 2]; o.w = xv.w + gv.w * acc[mi][ni][4 * g + 3];
            *(float4*)(X1 + (size_t)row * D_ + col) = o;
          }
      }
    });
  }
}

DI void phase7(const Params& p, char* smem) {
  const u16* H2 = (const u16*)(p.ws + WS_H); const u16* W = (const u16*)(p.ws + WS_WQT); u16* PQ = (u16*)(p.ws + WS_P);
  for (int it = blockIdx.x; it < 64 * 16; it += gridDim.x) {
    const int tn = it / 64, tm = it % 64;
    gemm_tile<true>(H2, D_, W, D_, D_, tm * 128, tn * 128, smem, [&](f32x16 (&acc)[2][2], int mb, int nb, int r, int hi) __attribute__((always_inline)) {
#pragma unroll
      for (int mi = 0; mi < 2; ++mi)
#pragma unroll
        for (int ni = 0; ni < 2; ++ni)
#pragma unroll
          for (int g = 0; g < 4; ++g) {
            const int row = mb + mi * 32 + r, col = nb + ni * 32 + hi * 4 + 8 * g;
            *(uint2*)(PQ + (size_t)row * D_ + col) = make_uint2(pk2(acc[mi][ni][4 * g], acc[mi][ni][4 * g + 1]), pk2(acc[mi][ni][4 * g + 2], acc[mi][ni][4 * g + 3]));
          }
    });
  }
}

DI unsigned f2ord(float v) { unsigned u = __float_as_uint(v); return u ^ ((unsigned)((int)u >> 31) | 0x80000000u); }
#define TOPK_INSERT(keys, x) { _Pragma("unroll") for (int _j = 0; _j < 16; ++_j) { const unsigned _h = max(keys[_j], x); x = min(keys[_j], x); keys[_j] = _h; } }
DI void phase8(const Params& p, char* smem) {
  const u16* PQ = (const u16*)(p.ws + WS_P); const u16* SK = (const u16*)(p.ws + WS_SK);
  int* IDS = (int*)(p.ws + WS_IDS); float* GATE = (float*)(p.ws + WS_GATE);
  float* sc = (float*)(smem + 16);
  const int tid = threadIdx.x, lane = tid & 63, w = tid >> 6, r = lane & 31, hi = lane >> 5;
  for (int it = blockIdx.x; it < 128 * 8; it += gridDim.x) {
    const int h = it & 7, tile = it >> 3;
    const int pp = w >> 1, rh = w & 1;
    __syncthreads();
    {
      f32x16 acc[4];
#pragma unroll
      for (int nt = 0; nt < 4; ++nt)
#pragma unroll
        for (int i = 0; i < 16; ++i) acc[nt][i] = 0.f;
      const u16* ap = PQ + (size_t)(tile * 64 + rh * 32 + r) * D_ + h * 256 + pp * 128 + hi * 8;
      const u16* bp = SK + ((size_t)(h * 2 + pp) * 128 + r) * 128 + hi * 8;
#pragma unroll
      for (int ks = 0; ks < 8; ++ks) {
        const bf16x8 af = *(const bf16x8*)(ap + ks * 16);
#pragma unroll
        for (int nt = 0; nt < 4; ++nt) { const bf16x8 bf = *(const bf16x8*)(bp + nt * 32 * 128 + ks * 16); acc[nt] = MFMA(af, bf, acc[nt]); }
      }
#pragma unroll
      for (int nt = 0; nt < 4; ++nt)
#pragma unroll
        for (int i = 0; i < 16; ++i) sc[(pp * 64 + rh * 32 + hi * 4 + (i & 3) + 8 * (i >> 2)) * 129 + nt * 32 + r] = acc[nt][i];
    }
    __syncthreads();
    {
      const int rowi = tid & 127, half = tid >> 7;
      float* row = sc + rowi * 129;
      unsigned* mk = (unsigned*)(smem + 16 + 128 * 129 * 4);
      unsigned keys[16];
#pragma unroll
      for (int j = 0; j < 16; ++j) keys[j] = 0u;
#pragma unroll 4
      for (int n2 = 0; n2 < 64; ++n2) {
        const int n = half * 64 + n2;
        unsigned x = (f2ord(row[n]) & 0xFFFFFF80u) | (unsigned)(127 - n);
        TOPK_INSERT(keys, x);
      }
      if (half == 1) {
#pragma unroll
        for (int j = 0; j < 16; ++j) mk[j * 128 + rowi] = keys[j];
      }
      __syncthreads();
      if (half == 0) {
#pragma unroll
        for (int j = 0; j < 16; ++j) { unsigned x = mk[j * 128 + rowi]; TOPK_INSERT(keys, x); }
        float vals[16];
#pragma unroll
        for (int j = 0; j < 16; ++j) vals[j] = row[127 - (keys[j] & 127u)];
#pragma unroll
        for (int j = 0; j < 16; ++j) { row[j] = vals[j]; row[16 + j] = __int_as_float((int)(127 - (keys[j] & 127u))); }
      }
    }
    __syncthreads();
    if (tid < 64) {
      const float* ra = sc + tid * 129; const float* rb = sc + (64 + tid) * 129;
      float a[16], bq[16];
#pragma unroll
      for (int j = 0; j < 16; ++j) { a[j] = ra[j]; bq[j] = rb[j]; }
      unsigned keys[16];
#pragma unroll
      for (int j = 0; j < 16; ++j) keys[j] = 0u;
#pragma unroll
      for (int i = 0; i < 16; ++i)
#pragma unroll
        for (int j = 0; j < 16; ++j)
          if ((i + 1) * (j + 1) <= 16) {
            unsigned x = (f2ord(a[i] + bq[j]) & 0xFFFFFF00u) | (unsigned)(255 - (i * 16 + j));
            TOPK_INSERT(keys, x);
          }
      float bv[16]; int ex[16];
      float mx = -1e30f;
#pragma unroll
      for (int q = 0; q < 16; ++q) {
        const int flat = 255 - (int)(keys[q] & 255u), i = flat >> 4, j = flat & 15;
        bv[q] = ra[i] + rb[j];
        ex[q] = __float_as_int(ra[16 + i]) * 128 + __float_as_int(rb[16 + j]);
        mx = fmaxf(mx, bv[q]);
      }
      float sum = 0.f;
#pragma unroll
      for (int q = 0; q < 16; ++q) { bv[q] = __expf(bv[q] - mx); sum += bv[q]; }
      const float inv = 1.f / sum;
      const size_t o = (size_t)(tile * 64 + tid) * 128 + h * 16;
#pragma unroll
      for (int q = 0; q < 16; q += 4) {
        *(int4*)(IDS + o + q) = make_int4(ex[q], ex[q + 1], ex[q + 2], ex[q + 3]);
        *(float4*)(GATE + o + q) = make_float4(bv[q] * inv, bv[q + 1] * inv, bv[q + 2] * inv, bv[q + 3] * inv);
      }
    }
  }
}

constexpr int CTR_UQ = 4096, CTR_VQ = 4608;
DI f2_t cvt8lo(unsigned w) { return __builtin_amdgcn_cvt_pk_f32_fp8(w, false); }
DI f2_t cvt8hi(unsigned w) { return __builtin_amdgcn_cvt_pk_f32_fp8(w, true); }
template <class F>
DI void xcd_queue(unsigned* ctrs, int nchunks, char* smem, F&& f) {
  const int x0 = (int)(xb_xcc_id() & 7u);
#pragma unroll 1
  for (int k = 0; k < 8; ++k) {
    const int s = (x0 + k) & 7;
    for (;;) { const int c = grab(ctrs + 64 * s, smem); if (c >= nchunks) break; f(s, c); }
  }
}
DI void wave_lds_sync() { asm volatile("s_waitcnt lgkmcnt(0)" ::: "memory"); __builtin_amdgcn_wave_barrier(); }

DI void phase9(const Params& p, char* smem, int rep) {
  const unsigned char* H2Q = (const unsigned char*)(p.ws + WS_H2Q); const unsigned char* U8 = (const unsigned char*)(p.ws + WS_U);
  const int* IDS = (const int*)(p.ws + WS_IDS); int* PA = (int*)(p.ws + WS_PA);
  const int lane = threadIdx.x & 63, w = threadIdx.x >> 6, g = lane >> 4, l15 = lane & 15;
  const int b3 = (lane >> 3) & 1, b2 = (lane >> 2) & 1, b1 = (lane >> 1) & 1, b0 = lane & 1;
  int* lw = (int*)(smem + 16) + w * 256;
  xcd_queue((unsigned*)(p.ws + WS_BAR) + CTR_UQ + rep * 8, 512, smem, [&](int s, int c) __attribute__((always_inline)) {
#pragma unroll 1
    for (int t = 0; t < 4; ++t) {
      const int tok = __builtin_amdgcn_readfirstlane(c * 16 + w * 4 + t);
      const int i0 = IDS[(size_t)tok * 128 + lane], i1 = IDS[(size_t)tok * 128 + 64 + lane];
      const u32x4 hq = *(const u32x4*)(H2Q + (size_t)tok * D_ + s * 256 + l15 * 16);
      wave_lds_sync();
      lw[(lane & 3) * 32 + (lane >> 2)] = i0;
      lw[(lane & 3) * 32 + 16 + (lane >> 2)] = i1;
      wave_lds_sync();
      const unsigned char* ub = U8 + s * 256 + l15 * 16;
#pragma unroll
      for (int batch = 0; batch < 2; ++batch) {
        int ida[16];
#pragma unroll
        for (int q = 0; q < 4; ++q) { const int4 v = *(const int4*)(lw + g * 32 + batch * 16 + q * 4); ida[q * 4] = v.x; ida[q * 4 + 1] = v.y; ida[q * 4 + 2] = v.z; ida[q * 4 + 3] = v.w; }
        u32x4 rows[16];
#pragma unroll
        for (int k = 0; k < 16; ++k) rows[k] = *(const u32x4*)(ub + (size_t)ida[k] * 2048);
        int part[16];
#pragma unroll
        for (int k = 0; k < 16; ++k) {
          int acc = 0;
#pragma unroll
          for (int d = 0; d < 4; ++d) acc = __builtin_amdgcn_sdot4((int)rows[k][d], (int)hq[d], acc, false);
          part[k] = acc;
        }
        int q8[8], q4[4], q2[2];
#pragma unroll
        for (int k = 0; k < 8; ++k) q8[k] = (b3 ? part[8 + k] : part[k]) + __shfl_xor(b3 ? part[k] : part[8 + k], 8);
#pragma unroll
        for (int k = 0; k < 4; ++k) q4[k] = (b2 ? q8[4 + k] : q8[k]) + __shfl_xor(b2 ? q8[k] : q8[4 + k], 4);
#pragma unroll
        for (int k = 0; k < 2; ++k) q2[k] = (b1 ? q4[2 + k] : q4[k]) + __shfl_xor(b1 ? q4[k] : q4[2 + k], 2);
        const int rr = (b0 ? q2[1] : q2[0]) + __shfl_xor(b0 ? q2[0] : q2[1], 1);
        PA[((size_t)s * T_ + tok) * 128 + 4 * (batch * 16 + l15) + g] = rr;
      }
    }
  });
}

DI void phase10(const Params& p) {
  const int* PA = (const int*)(p.ws + WS_PA); float* ACT = (float*)(p.ws + WS_ACT); const float* HSC = (const float*)(p.ws + WS_HSC);
  const int* IDS = (const int*)(p.ws + WS_IDS); const float* GATE = (const float*)(p.ws + WS_GATE);
  const float* USC = (const float*)(p.ws + WS_USC); const float* VSC = (const float*)(p.ws + WS_VSC);
  for (int i = blockIdx.x * 256 + threadIdx.x; i < T_ * 128; i += gridDim.x * 256) {
    int ai = 0;
#pragma unroll
    for (int s = 0; s < 8; ++s) ai += PA[(size_t)s * T_ * 128 + i];
    const int id = IDS[i];
    const float a = (float)ai * USC[id] * HSC[i >> 7];
    ACT[i] = 0.5f * a * (1.f + erff(a * 0.70710678118654752f)) * GATE[i] * VSC[id];
  }
}

DI void phase11(const Params& p, char* smem, int rep) {
  const unsigned char* V8 = (const unsigned char*)(p.ws + WS_V);
  const int* IDS = (const int*)(p.ws + WS_IDS); const float* ACT = (const float*)(p.ws + WS_ACT); u16* OUTP = (u16*)(p.ws + WS_OUTP);
  const int lane = threadIdx.x & 63, w = threadIdx.x >> 6, g = lane >> 4, l15 = lane & 15;
  const int b5 = (lane >> 5) & 1, b4 = (lane >> 4) & 1;
  int* lw = (int*)(smem + 16) + w * 256;
  float* lf = (float*)(lw + 128);
  xcd_queue((unsigned*)(p.ws + WS_BAR) + CTR_VQ + rep * 8, 512, smem, [&](int s, int c) __attribute__((always_inline)) {
#pragma unroll 1
    for (int t = 0; t < 4; ++t) {
      const int tok = __builtin_amdgcn_readfirstlane(c * 16 + w * 4 + t);
      const int i0 = IDS[(size_t)tok * 128 + lane], i1 = IDS[(size_t)tok * 128 + 64 + lane];
      const float a0 = ACT[(size_t)tok * 128 + lane], a1 = ACT[(size_t)tok * 128 + 64 + lane];
      wave_lds_sync();
      lw[(lane & 3) * 32 + (lane >> 2)] = i0; lw[(lane & 3) * 32 + 16 + (lane >> 2)] = i1;
      lf[(lane & 3) * 32 + (lane >> 2)] = a0; lf[(lane & 3) * 32 + 16 + (lane >> 2)] = a1;
      wave_lds_sync();
      f2_t o[8];
#pragma unroll
      for (int i = 0; i < 8; ++i) o[i] = f2_t{0.f, 0.f};
      const unsigned char* vb = V8 + s * 256 + l15 * 16;
#pragma unroll
      for (int batch = 0; batch < 2; ++batch) {
        int ida[16]; float aa[16];
#pragma unroll
        for (int q = 0; q < 4; ++q) {
          const int4 v = *(const int4*)(lw + g * 32 + batch * 16 + q * 4); ida[q * 4] = v.x; ida[q * 4 + 1] = v.y; ida[q * 4 + 2] = v.z; ida[q * 4 + 3] = v.w;
          const float4 f = *(const float4*)(lf + g * 32 + batch * 16 + q * 4); aa[q * 4] = f.x; aa[q * 4 + 1] = f.y; aa[q * 4 + 2] = f.z; aa[q * 4 + 3] = f.w;
        }
        u32x4 rows[16];
#pragma unroll
        for (int k = 0; k < 16; ++k) rows[k] = *(const u32x4*)(vb + (size_t)ida[k] * 2048);
#pragma unroll
        for (int k = 0; k < 16; ++k) {
          const f2_t a2 = {aa[k], aa[k]};
#pragma unroll
          for (int d = 0; d < 4; ++d) { const unsigned ww = rows[k][d]; o[2 * d] += a2 * cvt8lo(ww); o[2 * d + 1] += a2 * cvt8hi(ww); }
        }
      }
      float ov[16];
#pragma unroll
      for (int d = 0; d < 4; ++d) { ov[4 * d] = o[2 * d].x; ov[4 * d + 1] = o[2 * d].y; ov[4 * d + 2] = o[2 * d + 1].x; ov[4 * d + 3] = o[2 * d + 1].y; }
      float q8[8], q4[4];
#pragma unroll
      for (int k = 0; k < 8; ++k) q8[k] = (b5 ? ov[8 + k] : ov[k]) + __shfl_xor(b5 ? ov[k] : ov[8 + k], 32);
#pragma unroll
      for (int k = 0; k < 4; ++k) q4[k] = (b4 ? q8[4 + k] : q8[k]) + __shfl_xor(b4 ? q8[k] : q8[4 + k], 16);
      *(uint2*)(OUTP + (size_t)tok * D_ + s * 256 + l15 * 16 + 8 * b5 + 4 * b4) = make_uint2(pk2(q4[0], q4[1]), pk2(q4[2], q4[3]));
    }
  });
}

DI void phase12(const Params& p) {
  const float* X1 = (const float*)(p.ws + WS_X1); const u16* OUTP = (const u16*)(p.ws + WS_OUTP);
  const float* mod = (const float*)(p.ws + WS_MOD); const float* gfin = p.in[19];
  const int lane = threadIdx.x & 63, w = threadIdx.x >> 6;
  for (int row = blockIdx.x * 4 + w; row < T_; row += gridDim.x * 4) {
    const float* gt = mod + (row >> 11) * 12288 + 5 * 2048;
    float4 v[8];
    float ss = 0.f;
#pragma unroll
    for (int j = 0; j < 8; ++j) {
      const int d = j * 256 + lane * 4;
      const float4 xv = *(const float4*)(X1 + (size_t)row * D_ + d), gv = *(const float4*)(gt + d);
      const uint2 ob = *(const uint2*)(OUTP + (size_t)row * D_ + d);
      const float4 ov = make_float4(bflo(ob.x), bfhi(ob.x), bflo(ob.y), bfhi(ob.y));
      v[j] = make_float4(xv.x + gv.x * ov.x, xv.y + gv.y * ov.y, xv.z + gv.z * ov.z, xv.w + gv.w * ov.w);
      ss += v[j].x * v[j].x + v[j].y * v[j].y + v[j].z * v[j].z + v[j].w * v[j].w;
    }
    ss = wave_sum(ss);
    const float rstd = rsqrtf(ss * (1.f / D_) + EPS);
#pragma unroll
    for (int j = 0; j < 8; ++j) {
      const int d = j * 256 + lane * 4;
      const float4 gv = *(const float4*)(gfin + d);
      *(float4*)(p.out + (size_t)row * D_ + d) = make_float4(v[j].x * rstd * gv.x, v[j].y * rstd * gv.y, v[j].z * rstd * gv.z, v[j].w * rstd * gv.w);
    }
  }
}

__global__ void __launch_bounds__(256, 2) mega(Params p) {
  extern __shared__ __attribute__((aligned(16))) char smem[];
  XcdBarrier xb;
  const bool multi = (p.ph_hi - p.ph_lo) > 1;
  if (multi) {
    if (threadIdx.x == 0) *(uint4*)smem = make_uint4(0u, 0u, 0u, 0u);
    __syncthreads();
    xb = xcd_barrier_post((unsigned*)(p.ws + WS_BAR), (volatile LAS unsigned*)smem);
  }
#ifndef PHMASK
#define PHMASK 0x1fff
#endif
#ifndef REPMASK
#define REPMASK 0
#endif
  int rep = 0;
#define RUN_PHASE(n, call) if (p.ph_lo <= (n) && (n) < p.ph_hi) { \
    if ((n) > p.ph_lo) { xcd_barrier(xb); } \
    if (PHMASK & (1 << (n))) { call; if (REPMASK & (1 << (n))) { xcd_barrier(xb); rep = 1; call; rep = 0; } } }
  RUN_PHASE(0, phase0(p, smem))
  RUN_PHASE(1, phase1(p, smem))
#ifdef BARX
  for (int i = 0; i < BARX; ++i) xcd_barrier(xb);
#endif
  RUN_PHASE(2, phase2(p, smem, rep))
  RUN_PHASE(3, phase3(p, smem))
  RUN_PHASE(4, phase4(p, smem))
  RUN_PHASE(5, phase5(p, smem))
  RUN_PHASE(6, norm_rows<true>((const float*)(p.ws + WS_X1), p.in[14], (const float*)(p.ws + WS_MOD) + 3 * 2048, 12288, (u16*)(p.ws + WS_H), (unsigned char*)(p.ws + WS_H2Q), (float*)(p.ws + WS_HSC), (int)blockIdx.x * 4, (int)gridDim.x * 4, T_))
  RUN_PHASE(7, phase7(p, smem))
  RUN_PHASE(8, phase8(p, smem))
  RUN_PHASE(9, phase9(p, smem, rep))
  RUN_PHASE(10, phase10(p))
  RUN_PHASE(11, phase11(p, smem, rep))
  RUN_PHASE(12, phase12(p))
}

extern "C" void kernel_launch(void* const* d_in, const int* in_sizes, int n_in, void* d_out, int out_size, void* d_ws, size_t ws_size, hipStream_t stream) {
  static int grid = 0;
  if (grid == 0) {
    if (n_in != 20 || ws_size < WS_END) { fprintf(stderr, "kernel_launch: unexpected n_in %d / ws_size %zu (need %zu)\n", n_in, ws_size, (size_t)WS_END); grid = -1; return; }
    int dev = 0, cus = 0, per_cu = 0;
    hipGetDevice(&dev);
    hipDeviceGetAttribute(&cus, hipDeviceAttributeMultiprocessorCount, dev);
    hipFuncSetAttribute((const void*)mega, hipFuncAttributeMaxDynamicSharedMemorySize, LDS_BYTES);
    hipOccupancyMaxActiveBlocksPerMultiprocessor(&per_cu, (const void*)mega, 256, LDS_BYTES);
    if (per_cu < 1) { fprintf(stderr, "kernel_launch: occupancy query says %d\n", per_cu); per_cu = 1; }
    if (per_cu > 2) per_cu = 2;
    grid = cus * per_cu;
    fprintf(stderr, "kernel_launch: grid %d (%d per CU)\n", grid, per_cu);
  }
  if (grid < 0) return;
  Params p{};
  for (int i = 0; i < 20; ++i) p.in[i] = (const float*)d_in[i];
  p.out = (float*)d_out; p.ws = (char*)d_ws;
#if N_LAUNCH_PER_PHASE
  p.coop = 0;
  for (int ph = 0; ph < NPH; ++ph) {
    p.ph_lo = ph; p.ph_hi = ph + 1;
    hipLaunchKernelGGL(mega, dim3(grid), dim3(256), LDS_BYTES, stream, p);
  }
#else
  hipMemsetAsync((char*)d_ws + WS_BAR, 0, WS_MOD, stream);
  p.coop = 0; p.ph_lo = 0; p.ph_hi = NPH;
  void* args[] = {&p};
  hipError_t e = hipLaunchCooperativeKernel((const void*)mega, dim3(grid), dim3(256), args, LDS_BYTES, stream);
  if (e != hipSuccess) fprintf(stderr, "cooperative launch failed: %s (grid %d)\n", hipGetErrorString(e), grid);
#endif
}
```

```cpp
#include <hip/hip_runtime.h>
#include <cstdio>
#include <cstdint>

#ifndef N_LAUNCH_PER_PHASE
#define N_LAUNCH_PER_PHASE 0
#endif

#define DI __device__ __forceinline__
typedef unsigned short u16;
typedef __attribute__((ext_vector_type(8))) short bf16x8;
typedef __attribute__((ext_vector_type(16))) float f32x16;
typedef __attribute__((ext_vector_type(2))) __bf16 bf2_t;
typedef __attribute__((ext_vector_type(2))) float f2_t;
typedef __attribute__((ext_vector_type(4))) unsigned u32x4;
typedef __attribute__((ext_vector_type(2))) unsigned u32x2;
typedef __attribute__((ext_vector_type(4))) float f32x4v;
DI float4 nt_load4(const float* p) { const f32x4v t = __builtin_nontemporal_load((const f32x4v*)p); return make_float4(t[0], t[1], t[2], t[3]); }
DI void nt_store4(void* p, unsigned a, unsigned b, unsigned c, unsigned d) { const u32x4 t = {a, b, c, d}; __builtin_nontemporal_store(t, (u32x4*)p); }
#define MFMA(a, b, c) __builtin_amdgcn_mfma_f32_32x32x16_bf16((a), (b), (c), 0, 0, 0)

constexpr int T_ = 8192, D_ = 2048, S_ = 2048;
constexpr int INC = 4160;
constexpr float EPS = 1e-6f;
constexpr int NPH = 13;

constexpr size_t al256(size_t x) { return (x + 255) & ~(size_t)255; }
constexpr size_t WS_BAR = 0;
constexpr size_t WS_MOD = 32768;
constexpr size_t WS_ROPE = WS_MOD + al256(4 * 12288 * 4);
constexpr size_t WS_WINT = WS_ROPE + al256(2048 * 32 * 8);
constexpr size_t WS_WUQT = WS_WINT + al256((size_t)4224 * 2048 * 2);
constexpr size_t WS_WUKVT = WS_WUQT + al256((size_t)1536 * 512 * 2);
constexpr size_t WS_WOUTT = WS_WUKVT + al256((size_t)2048 * 512 * 2);
constexpr size_t WS_WQT = WS_WOUTT + al256((size_t)2048 * 2048 * 2);
constexpr size_t WS_SK = WS_WQT + al256((size_t)2048 * 2048 * 2);
constexpr size_t WS_U = WS_SK + al256((size_t)262144 * 2);
constexpr size_t WS_V = WS_U + al256((size_t)16384 * 2048);
constexpr size_t WS_H = WS_V + al256((size_t)16384 * 2048);
constexpr size_t WS_P = WS_H + al256((size_t)T_ * D_ * 2);
constexpr size_t WS_Q = WS_P + al256((size_t)T_ * INC * 2);
constexpr size_t WS_K = WS_Q + al256((size_t)T_ * 1536 * 2);
constexpr size_t WS_VT = WS_K + al256((size_t)T_ * 1536 * 2);
constexpr size_t WS_MG = WS_VT + al256((size_t)T_ * 1024 * 2);
constexpr size_t WS_X1 = WS_MG + al256((size_t)T_ * D_ * 2);
constexpr size_t WS_IDS = WS_X1 + al256((size_t)T_ * D_ * 4);
constexpr size_t WS_GATE = WS_IDS + al256((size_t)T_ * 128 * 4);
constexpr size_t WS_USC = WS_GATE + al256((size_t)T_ * 128 * 4);
constexpr size_t WS_VSC = WS_USC + 65536;
constexpr size_t WS_MODP = WS_VSC + 65536;
constexpr size_t WS_ACT = WS_MODP + al256((size_t)4 * 4 * 12288 * 4);
constexpr size_t WS_H2Q = WS_ACT + al256((size_t)T_ * 128 * 4);
constexpr size_t WS_HSC = WS_H2Q + al256((size_t)T_ * D_);
constexpr size_t WS_SSQ = WS_HSC + al256((size_t)T_ * 4);
constexpr size_t WS_END = WS_SSQ + al256((size_t)T_ * 16 * 4);
constexpr size_t WS_PA = WS_MG;
constexpr size_t WS_OUTP = WS_Q;
static_assert(WS_VT + (size_t)T_ * 1024 * 2 - WS_Q >= (size_t)T_ * D_ * 4, "OUTP alias");
static_assert((size_t)8 * T_ * 128 * 4 <= (size_t)T_ * D_ * 2, "PA alias");

constexpr int LDS_BYTES = 16 + 2 * 2 * 128 * 72 * 2 + 512;

struct Params {
  const float* in[20];
  float* out;
  char* ws;
  int ph_lo, ph_hi, coop, pad;
};

DI unsigned pk2(float a, float b) { f2_t v = {a, b}; bf2_t r = __builtin_convertvector(v, bf2_t); return __builtin_bit_cast(unsigned, r); }
DI float bflo(unsigned u) { return __uint_as_float(u << 16); }
DI float bfhi(unsigned u) { return __uint_as_float(u & 0xffff0000u); }
DI float dot2(unsigned a, unsigned b, float c) { return __builtin_amdgcn_fdot2_f32_bf16(__builtin_bit_cast(bf2_t, a), __builtin_bit_cast(bf2_t, b), c, false); }
DI float wave_sum(float v) {
#pragma unroll
  for (int o = 32; o >= 1; o >>= 1) v += __shfl_xor(v, o);
  return v;
}

#define XB_TMO      128
#define XB_XCNT(j)  (256  + 64 * (j))
#define XB_XSUB(j)  (1280 + 64 * (j))
#define XB_XGEN(j)  (2304 + 64 * (j))
#define XB_TOP      3328
#define XB_TOPGEN   3392
#define XCD_BAR_WORDS 3456
#define XB_SPIN_CAP (1u << 22)
#define LAS __attribute__((address_space(3)))
DI unsigned xb_ld(unsigned* p) { return __hip_atomic_load(p, __ATOMIC_RELAXED, __HIP_MEMORY_SCOPE_AGENT); }
DI unsigned xb_add(unsigned* p, unsigned v) { return __hip_atomic_fetch_add(p, v, __ATOMIC_RELAXED, __HIP_MEMORY_SCOPE_AGENT); }
DI unsigned xb_xcc_id() { return (unsigned)__builtin_amdgcn_s_getreg((3 << 11) | 20) & 0xFu; }
#define XB_SPIN(cond, bar) do { unsigned _sp = 0; while (cond) { __builtin_amdgcn_s_sleep(1); \
    if ((++_sp & 255u) == 0u) { if (xb_ld(&(bar)[XB_TMO])) break; if (_sp > XB_SPIN_CAP) { atomicAdd(&(bar)[XB_TMO], 1u); break; } } } } while (0)
struct XcdBarrier { unsigned* bar; unsigned x; volatile LAS unsigned* st; };
DI XcdBarrier xcd_barrier_post(unsigned* bar, volatile LAS unsigned* st) {
  XcdBarrier b; b.bar = bar; b.x = xb_xcc_id(); b.st = st;
  if (threadIdx.x == 0) (void)xb_add(&bar[XB_XCNT(b.x)], 1u);
  return b;
}
DI void xcd_barrier_complete(unsigned* bar, unsigned x, unsigned& nloc, unsigned& nx) {
  const unsigned G = gridDim.x * gridDim.y * gridDim.z;
  unsigned sum, cnt, mine, sp = 0u;
  for (;;) {
    sum = 0u; cnt = 0u; mine = 0u;
#pragma unroll
    for (unsigned j = 0; j < 16; ++j) { const unsigned c = xb_ld(&bar[XB_XCNT(j)]); sum += c; cnt += (c > 0u) ? 1u : 0u; mine = (j == x) ? c : mine; }
    if (sum == G) break;
    __builtin_amdgcn_s_sleep(1);
    if ((++sp & 255u) == 0u) { if (xb_ld(&bar[XB_TMO])) break; if (sp > XB_SPIN_CAP) { atomicAdd(&bar[XB_TMO], 1u); break; } }
  }
  nloc = mine > 0u ? mine : 1u; nx = cnt > 0u ? cnt : 1u;
}
DI void xcd_barrier(const XcdBarrier& b) {
  asm volatile("s_waitcnt vmcnt(0)" ::: "memory");
  __syncthreads();
  if (threadIdx.x == 0) {
    unsigned* bar = b.bar;
    __builtin_amdgcn_s_waitcnt(0);
    unsigned nloc = b.st[0], nx = b.st[1];
    if (nloc == 0u) { xcd_barrier_complete(bar, b.x, nloc, nx); b.st[0] = nloc; b.st[1] = nx; }
    const unsigned old = xb_add(&bar[XB_XSUB(b.x)], 1u);
    const unsigned gen = old / nloc;
    if (old + 1u == (gen + 1u) * nloc) {
      __builtin_amdgcn_fence(__ATOMIC_RELEASE, "agent");
      asm volatile("s_waitcnt vmcnt(0)" ::: "memory");
      const unsigned og = xb_add(&bar[XB_TOP], 1u);
      const unsigned tg = og / nx;
      if (og + 1u == (tg + 1u) * nx) xb_add(&bar[XB_TOPGEN], 1u);
      else XB_SPIN(xb_ld(&bar[XB_TOPGEN]) == tg, bar);
      __builtin_amdgcn_fence(__ATOMIC_ACQUIRE, "agent");
      xb_add(&bar[XB_XGEN(b.x)], 1u);
      asm volatile("s_waitcnt vmcnt(0)" ::: "memory");
    } else {
      XB_SPIN(xb_ld(&bar[XB_XGEN(b.x)]) == gen, bar);
      __builtin_amdgcn_fence(__ATOMIC_ACQUIRE, "agent");
      asm volatile("s_waitcnt vmcnt(0)" ::: "memory");
    }
  }
  __syncthreads();
}

template <bool SWAP, class Epi>
DI void gemm_tile(const u16* __restrict__ A, int lda, const u16* __restrict__ Bt, int ldb, int K, int m0, int n0, char* smem, Epi&& epi) {
  u16* As = (u16*)(smem + 16);
  u16* Bs = As + 2 * 128 * 72;
  const int tid = threadIdx.x, lane = tid & 63, w = tid >> 6, wm = w >> 1, wn = w & 1;
  const int r = lane & 31, hi = lane >> 5;
  f32x16 acc[2][2];
#pragma unroll
  for (int a = 0; a < 2; ++a)
#pragma unroll
    for (int b = 0; b < 2; ++b)
#pragma unroll
      for (int i = 0; i < 16; ++i) acc[a][b][i] = 0.f;
  const int srow = tid >> 3, skc = tid & 7;
  const u16* ag = A + (size_t)(m0 + srow) * lda + skc * 8;
  const u16* bg = Bt + (size_t)(n0 + srow) * ldb + skc * 8;
  u32x4 ra[4], rb[4];
#pragma unroll
  for (int i = 0; i < 4; ++i) { ra[i] = *(const u32x4*)(ag + (size_t)i * 32 * lda); rb[i] = *(const u32x4*)(bg + (size_t)i * 32 * ldb); }
  __syncthreads();
#pragma unroll
  for (int i = 0; i < 4; ++i) { *(u32x4*)(As + (srow + 32 * i) * 72 + skc * 8) = ra[i]; *(u32x4*)(Bs + (srow + 32 * i) * 72 + skc * 8) = rb[i]; }
  __syncthreads();
  const int KT = K >> 6;
  for (int kt = 0; kt < KT; ++kt) {
    const int buf = kt & 1;
    if (kt + 1 < KT) {
      const int k0 = (kt + 1) << 6;
#pragma unroll
      for (int i = 0; i < 4; ++i) { ra[i] = *(const u32x4*)(ag + (size_t)i * 32 * lda + k0); rb[i] = *(const u32x4*)(bg + (size_t)i * 32 * ldb + k0); }
    }
    const u16* Asb = As + buf * 128 * 72 + (wm * 64 + r) * 72 + hi * 8;
    const u16* Bsb = Bs + buf * 128 * 72 + (wn * 64 + r) * 72 + hi * 8;
#pragma unroll
    for (int ks = 0; ks < 4; ++ks) {
      bf16x8 af[2], bfr[2];
      af[0] = *(const bf16x8*)(Asb + ks * 16);
      af[1] = *(const bf16x8*)(Asb + 32 * 72 + ks * 16);
      bfr[0] = *(const bf16x8*)(Bsb + ks * 16);
      bfr[1] = *(const bf16x8*)(Bsb + 32 * 72 + ks * 16);
#pragma unroll
      for (int mi = 0; mi < 2; ++mi)
#pragma unroll
        for (int ni = 0; ni < 2; ++ni) {
          if (SWAP) acc[mi][ni] = MFMA(bfr[ni], af[mi], acc[mi][ni]);
          else acc[mi][ni] = MFMA(af[mi], bfr[ni], acc[mi][ni]);
        }
    }
    if (kt + 1 < KT) {
      const int nb = buf ^ 1;
#pragma unroll
      for (int i = 0; i < 4; ++i) { *(u32x4*)(As + nb * 128 * 72 + (srow + 32 * i) * 72 + skc * 8) = ra[i]; *(u32x4*)(Bs + nb * 128 * 72 + (srow + 32 * i) * 72 + skc * 8) = rb[i]; }
    }
    __syncthreads();
  }
  epi(acc, m0 + wm * 64, n0 + wn * 64, r, hi);
}

DI void tile_rstd512(const u16* __restrict__ A, int lda, int m0, float* rs) {
  const int tid = threadIdx.x, row = tid >> 1, half = tid & 1;
  const uint4* p = (const uint4*)(A + (size_t)(m0 + row) * lda + half * 256);
  float ss = 0.f;
#pragma unroll 8
  for (int i = 0; i < 32; ++i) {
    uint4 v = p[i];
    ss = dot2(v.x, v.x, ss); ss = dot2(v.y, v.y, ss); ss = dot2(v.z, v.z, ss); ss = dot2(v.w, v.w, ss);
  }
  ss += __shfl_xor(ss, 1);
  if (half == 0) rs[row] = rsqrtf(ss * (1.f / 512.f) + EPS);
}

DI void transpose_item(const float* __restrict__ src, int N, int K, const float* __restrict__ scale, u16* __restrict__ dst, int tk, int tn, char* smem) {
  float* tile = (float*)(smem + 16);
  const int t = threadIdx.x;
  __syncthreads();
  {
    const int rr = t >> 4, c4 = (t & 15) * 4;
#pragma unroll
    for (int ps = 0; ps < 4; ++ps) {
      const int kk = ps * 16 + rr, k = tk * 64 + kk;
      float4 v = nt_load4(src + (size_t)k * N + tn * 64 + c4);
      const float sc = scale ? scale[k] : 1.f;
      tile[kk * 65 + c4 + 0] = v.x * sc; tile[kk * 65 + c4 + 1] = v.y * sc; tile[kk * 65 + c4 + 2] = v.z * sc; tile[kk * 65 + c4 + 3] = v.w * sc;
    }
  }
  __syncthreads();
  {
    const int n = t & 63, kc = (t >> 6) * 16;
    unsigned o[8];
#pragma unroll
    for (int j = 0; j < 8; ++j) o[j] = pk2(tile[(kc + 2 * j) * 65 + n], tile[(kc + 2 * j + 1) * 65 + n]);
    uint4* d = (uint4*)(dst + (size_t)(tn * 64 + n) * K + tk * 64 + kc);
    d[0] = make_uint4(o[0], o[1], o[2], o[3]); d[1] = make_uint4(o[4], o[5], o[6], o[7]);
  }
}

DI void convert_item(const float* __restrict__ src, u16* __restrict__ dst, size_t base) {
  const int t = threadIdx.x;
#pragma unroll
  for (int st = 0; st < 4; ++st) {
    const size_t idx = base + st * 2048 + t * 8;
    float4 a = *(const float4*)(src + idx), b = *(const float4*)(src + idx + 4);
    *(uint4*)(dst + idx) = make_uint4(pk2(a.x, a.y), pk2(a.z, a.w), pk2(b.x, b.y), pk2(b.z, b.w));
  }
}

DI float wave_max(float v) {
#pragma unroll
  for (int o = 32; o >= 1; o >>= 1) v = fmaxf(v, __shfl_xor(v, o));
  return v;
}
DI void fp8_rows_item(const float* __restrict__ src, unsigned char* __restrict__ dst, float* __restrict__ scales, int item) {
  const int lane = threadIdx.x & 63, w = threadIdx.x >> 6;
  const int row = item * 4 + w;
  const float* sr = src + (size_t)row * 2048 + lane * 16;
  float4 v[8];
  float amax = 0.f;
#pragma unroll
  for (int j = 0; j < 2; ++j)
#pragma unroll
    for (int q = 0; q < 4; ++q) {
      const float4 t = nt_load4(sr + 1024 * j + q * 4);
      v[j * 4 + q] = t;
      amax = fmaxf(amax, fmaxf(fmaxf(fabsf(t.x), fabsf(t.y)), fmaxf(fabsf(t.z), fabsf(t.w))));
    }
  amax = wave_max(amax);
  int e = 0;
  if (amax > 0.f) e = (int)floorf(log2f(384.f / amax));
  e = e < -100 ? -100 : (e > 100 ? 100 : e);
  const float sc = ldexpf(1.f, e);
  if (lane == 0) scales[row] = ldexpf(1.f, -e);
#pragma unroll
  for (int j = 0; j < 2; ++j) {
    unsigned d[4];
#pragma unroll
    for (int q = 0; q < 4; ++q) {
      const float4 t = v[j * 4 + q];
      unsigned pk = __builtin_amdgcn_cvt_pk_fp8_f32(t.x * sc, t.y * sc, 0, false);
      pk = __builtin_amdgcn_cvt_pk_fp8_f32(t.z * sc, t.w * sc, pk, true);
      d[q] = pk;
    }
    nt_store4(dst + (size_t)row * 2048 + 1024 * j + lane * 16, d[0], d[1], d[2], d[3]);
  }
}

DI unsigned pack_i8x4(float a, float b, float c, float d) {
  const int ia = __float2int_rn(a), ib = __float2int_rn(b), ic = __float2int_rn(c), id = __float2int_rn(d);
  return (unsigned)(ia & 0xff) | ((unsigned)(ib & 0xff) << 8) | ((unsigned)(ic & 0xff) << 16) | ((unsigned)id << 24);
}
DI void i8_rows_item(const float* __restrict__ src, unsigned char* __restrict__ dst, float* __restrict__ scales, int item) {
  const int lane = threadIdx.x & 63, w = threadIdx.x >> 6;
  const int row = item * 4 + w;
  const float* sr = src + (size_t)row * 2048 + lane * 16;
  float4 v[8];
  float amax = 0.f;
#pragma unroll
  for (int j = 0; j < 2; ++j)
#pragma unroll
    for (int q = 0; q < 4; ++q) {
      const float4 t = nt_load4(sr + 1024 * j + q * 4);
      v[j * 4 + q] = t;
      amax = fmaxf(amax, fmaxf(fmaxf(fabsf(t.x), fabsf(t.y)), fmaxf(fabsf(t.z), fabsf(t.w))));
    }
  amax = wave_max(amax);
  const float sc = amax > 0.f ? 127.f / amax : 0.f;
  if (lane == 0) scales[row] = amax * (1.f / 127.f);
#pragma unroll
  for (int j = 0; j < 2; ++j) {
    unsigned d[4];
#pragma unroll
    for (int q = 0; q < 4; ++q) { const float4 t = v[j * 4 + q]; d[q] = pack_i8x4(t.x * sc, t.y * sc, t.z * sc, t.w * sc); }
    nt_store4(dst + (size_t)row * 2048 + 1024 * j + lane * 16, d[0], d[1], d[2], d[3]);
  }
}

DI void mod_item(const Params& p, int item, char* smem) {
  float* cact = (float*)(smem + 16);
  float* red = cact + 4 * 512;
  const int t = threadIdx.x;
  const int cgi = item % 192, ksp = item / 192, kbase = ksp * 512;
  const float* c = p.in[1]; const float* W = p.in[2];
  float* mod = (float*)(p.ws + WS_MODP);
  __syncthreads();
  for (int i = t; i < 4 * 512; i += 256) { float v = c[(i >> 9) * 2048 + kbase + (i & 511)]; cact[i] = v / (1.f + __expf(-v)); }
  __syncthreads();
  const int cq = t & 15, kl = t >> 4, c0 = cgi * 64;
  float acc[4][4];
#pragma unroll
  for (int b = 0; b < 4; ++b)
#pragma unroll
    for (int j = 0; j < 4; ++j) acc[b][j] = 0.f;
  const float* wp = W + (size_t)(kbase + kl) * 12288 + c0 + cq * 4;
#pragma unroll 8
  for (int i = 0; i < 32; ++i) {
    const int k = kl + 16 * i;
    float4 w4 = nt_load4(wp + (size_t)i * 16 * 12288);
#pragma unroll
    for (int b = 0; b < 4; ++b) {
      const float a = cact[b * 512 + k];
      acc[b][0] += a * w4.x; acc[b][1] += a * w4.y; acc[b][2] += a * w4.z; acc[b][3] += a * w4.w;
    }
  }
#pragma unroll
  for (int b = 0; b < 4; ++b)
#pragma unroll
    for (int j = 0; j < 4; ++j) red[(kl * 16 + cq) * 17 + b * 4 + j] = acc[b][j];
  __syncthreads();
  {
    const int b = t >> 6, col = t & 63, q = col >> 2, j = col & 3;
    float s = 0.f;
#pragma unroll
    for (int k2 = 0; k2 < 16; ++k2) s += red[(k2 * 16 + q) * 17 + b * 4 + j];
    mod[(size_t)ksp * 49152 + b * 12288 + c0 + col] = s;
  }
}

constexpr int P0_MOD = 768;
constexpr int P0_TIN = 32 * 65, P0_TUQ = 8 * 24, P0_TUKV = 8 * 32, P0_TOUT = 32 * 32, P0_TWQ = 32 * 32;
constexpr int P0_SK = 32, P0_UV = 0, P0_ROPE = 32;
DI void phase0(const Params& p, char* smem) {
  constexpr int o1 = P0_MOD, o2 = o1 + P0_TIN, o3 = o2 + P0_TUQ, o4 = o3 + P0_TUKV, o5 = o4 + P0_TOUT, o6 = o5 + P0_TWQ, o7 = o6 + P0_SK, o8 = o7 + P0_UV, o9 = o8 + P0_UV, o10 = o9 + P0_ROPE;
  for (int it = blockIdx.x; it < o10; it += gridDim.x) {
    if (it < o1) mod_item(p, it, smem);
    else if (it < o2) { int j = it - o1; transpose_item(p.in[5], INC, 2048, nullptr, (u16*)(p.ws + WS_WINT), j / 65, j % 65, smem); }
    else if (it < o3) { int j = it - o2; transpose_item(p.in[8], 1536, 512, p.in[7], (u16*)(p.ws + WS_WUQT), j / 24, j % 24, smem); }
    else if (it < o4) { int j = it - o3; transpose_item(p.in[10], 2048, 512, p.in[9], (u16*)(p.ws + WS_WUKVT), j / 32, j % 32, smem); }
    else if (it < o5) { int j = it - o4; int tk = j / 32; transpose_item(p.in[13], 2048, 2048, tk < 16 ? p.in[11] : p.in[12] - 1024, (u16*)(p.ws + WS_WOUTT), tk, j % 32, smem); }
    else if (it < o6) { int j = it - o5; transpose_item(p.in[15], 2048, 2048, nullptr, (u16*)(p.ws + WS_WQT), j / 32, j % 32, smem); }
    else if (it < o7) convert_item(p.in[16], (u16*)(p.ws + WS_SK), (size_t)(it - o6) * 8192);
    else if (it < o8) fp8_rows_item(p.in[17], (unsigned char*)(p.ws + WS_U), (float*)(p.ws + WS_USC), it - o7);
    else if (it < o9) fp8_rows_item(p.in[18], (unsigned char*)(p.ws + WS_V), (float*)(p.ws + WS_VSC), it - o8);
    else {
      float2* rope = (float2*)(p.ws + WS_ROPE);
      const int base = (it - o9) * 2048;
      for (int e = threadIdx.x; e < 2048; e += 256) {
        const int idx = base + e, pos = idx >> 5, j = idx & 31;
        const float inv = 1.0f / powf(10000.0f, (float)(2 * j) / 64.0f);
        const float ang = (float)pos * inv;
        rope[idx] = make_float2(cosf(ang), sinf(ang));
      }
    }
  }
}

template <bool Q8, bool XBF>
DI void norm_rows(const float* __restrict__ X, const float* __restrict__ g, const float* mod, int bstride, u16* __restrict__ out, unsigned char* __restrict__ outq, float* __restrict__ qscale,
                  int row_start, int row_step, int row_end) {
  const int lane = threadIdx.x & 63, w = threadIdx.x >> 6;
  for (int row = row_start + w; row < row_end; row += row_step) {
    const float* xr = X + (size_t)row * D_;
    float4 v[8];
    float ss = 0.f;
#pragma unroll
    for (int j = 0; j < 8; ++j) {
      if (XBF) { const uint2 t = *(const uint2*)((const u16*)X + (size_t)row * D_ + j * 256 + lane * 4); v[j] = make_float4(bflo(t.x), bfhi(t.x), bflo(t.y), bfhi(t.y)); }
      else v[j] = *(const float4*)(xr + j * 256 + lane * 4);
      ss += v[j].x * v[j].x + v[j].y * v[j].y + v[j].z * v[j].z + v[j].w * v[j].w;
    }
    ss = wave_sum(ss);
    const float rstd = rsqrtf(ss * (1.f / D_) + EPS);
    const int b = row >> 11;
    const float* sh = mod + b * bstride;
    const float* sc = sh + 2048;
    float amax = 0.f;
#pragma unroll
    for (int j = 0; j < 8; ++j) {
      const int d = j * 256 + lane * 4;
      const float4 gg = *(const float4*)(g + d), s4 = *(const float4*)(sc + d), h4 = *(const float4*)(sh + d);
      const float o0 = v[j].x * rstd * gg.x * (1.f + s4.x) + h4.x;
      const float o1 = v[j].y * rstd * gg.y * (1.f + s4.y) + h4.y;
      const float o2 = v[j].z * rstd * gg.z * (1.f + s4.z) + h4.z;
      const float o3 = v[j].w * rstd * gg.w * (1.f + s4.w) + h4.w;
      *(uint2*)(out + (size_t)row * D_ + d) = make_uint2(pk2(o0, o1), pk2(o2, o3));
      if (Q8) { v[j] = make_float4(o0, o1, o2, o3); amax = fmaxf(amax, fmaxf(fmaxf(fabsf(o0), fabsf(o1)), fmaxf(fabsf(o2), fabsf(o3)))); }
    }
    if (Q8) {
      amax = wave_max(amax);
      const float qs = amax > 0.f ? 127.f / amax : 0.f;
      if (lane == 0) qscale[row] = amax * (1.f / 127.f);
#pragma unroll
      for (int j = 0; j < 8; ++j) *(unsigned*)(outq + (size_t)row * D_ + j * 256 + lane * 4) = pack_i8x4(v[j].x * qs, v[j].y * qs, v[j].z * qs, v[j].w * qs);
    }
  }
}
DI void phase1(const Params& p, char* smem) {
  const float* mp = (const float*)(p.ws + WS_MODP); float* mod = (float*)(p.ws + WS_MOD); const float* bias = p.in[3];
  for (int i = blockIdx.x * 256 + threadIdx.x; i < 49152; i += gridDim.x * 256)
    mod[i] = ((mp[i] + mp[49152 + i]) + mp[2 * 49152 + i]) + mp[3 * 49152 + i] + bias[i % 12288];
  const int rpb = T_ / (int)gridDim.x, row0 = (int)blockIdx.x * rpb, bb = row0 >> 11;
  float* lm = (float*)(smem + 16);
  __syncthreads();
  for (int c = threadIdx.x; c < 4096; c += 256) {
    const int src = bb * 12288 + c;
    lm[c] = ((mp[src] + mp[49152 + src]) + mp[2 * 49152 + src]) + mp[3 * 49152 + src] + bias[c];
  }
  __syncthreads();
  norm_rows<false, false>(p.in[0], p.in[4], lm, 0, (u16*)(p.ws + WS_H), nullptr, nullptr, row0, 4, row0 + rpb);
}

constexpr int CTR_TILE = 3520, CTR_CHUNK = 3584;
DI int grab(unsigned* ctr, char* smem) {
  __syncthreads();
  if (threadIdx.x == 0) *(volatile unsigned*)(smem + 8) = atomicAdd(ctr, 1u);
  __syncthreads();
  return (int)*(volatile unsigned*)(smem + 8);
}
DI void uv_chunk(const Params& p, int c) {
#pragma unroll 1
  for (int i = 0; i < 4; ++i) {
    const int item = c * 4 + i;
    if (item < 4096) i8_rows_item(p.in[17], (unsigned char*)(p.ws + WS_U), (float*)(p.ws + WS_USC), item);
    else fp8_rows_item(p.in[18], (unsigned char*)(p.ws + WS_V), (float*)(p.ws + WS_VSC), item - 4096);
  }
}
DI void phase2(const Params& p, char* smem, int rep) {
  const u16* H = (const u16*)(p.ws + WS_H); const u16* W = (const u16*)(p.ws + WS_WINT); u16* P = (u16*)(p.ws + WS_P); float* SSQ = (float*)(p.ws + WS_SSQ);
  (void)rep;
  const bool odd = (blockIdx.x & 1) != 0;
  if (odd) for (int c = blockIdx.x; c < 2048; c += gridDim.x) uv_chunk(p, c);
  for (int it = blockIdx.x; it < 64 * 32; it += gridDim.x) {
    const int tn = it / 64, tm = it % 64;
    gemm_tile<true>(H, D_, W, D_, D_, tm * 128, tn * 128, smem, [&](f32x16 (&acc)[2][2], int mb, int nb, int r, int hi) __attribute__((always_inline)) {
#pragma unroll
      for (int mi = 0; mi < 2; ++mi)
#pragma unroll
        for (int ni = 0; ni < 2; ++ni)
#pragma unroll
          for (int g = 0; g < 4; ++g) {
            const int row = mb + mi * 32 + r, col = nb + ni * 32 + hi * 4 + 8 * g;
            *(uint2*)(P + (size_t)row * INC + col) = make_uint2(pk2(acc[mi][ni][4 * g], acc[mi][ni][4 * g + 1]), pk2(acc[mi][ni][4 * g + 2], acc[mi][ni][4 * g + 3]));
          }
      if (nb >= 3072) {
#pragma unroll
        for (int mi = 0; mi < 2; ++mi) {
          float ss = 0.f;
#pragma unroll
          for (int ni = 0; ni < 2; ++ni)
#pragma unroll
            for (int i = 0; i < 16; ++i) ss += acc[mi][ni][i] * acc[mi][ni][i];
          ss += __shfl_xor(ss, 32);
          if (hi == 0) SSQ[(size_t)(mb + mi * 32 + r) * 16 + ((nb - 3072) >> 6)] = ss;
        }
      }
    });
  }
  if (!odd) for (int c = blockIdx.x; c < 2048; c += gridDim.x) uv_chunk(p, c);
}

DI void phase3(const Params& p, char* smem) {
  const u16* P = (const u16*)(p.ws + WS_P);
  u16* Q = (u16*)(p.ws + WS_Q); u16* Kb = (u16*)(p.ws + WS_K); u16* VT = (u16*)(p.ws + WS_VT); u16* MG = (u16*)(p.ws + WS_MG);
  const float2* rope = (const float2*)(p.ws + WS_ROPE); const float* SSQ = (const float*)(p.ws + WS_SSQ);
  float* rs = (float*)(smem + 16 + 2 * 2 * 128 * 72 * 2);
  constexpr int NQ = 64 * 12, NKV = 64 * 16, NKR = 1024, NCV = 1024;
  const float qscale = 0.07216878364870322f * 1.4426950408889634f;
  const int G = (int)gridDim.x, bid = (int)blockIdx.x;
  if (bid < 64) {
    for (int tm = bid; tm < 64; tm += 64) {
      gemm_tile<true>((const u16*)(p.ws + WS_H), D_, (const u16*)(p.ws + WS_WINT), D_, D_, tm * 128, 4096, smem, [&](f32x16 (&acc)[2][2], int mb, int nb, int r, int hi) __attribute__((always_inline)) {
        if (nb != 4096) return;
#pragma unroll
        for (int mi = 0; mi < 2; ++mi) {
          const int row = mb + mi * 32 + r, pos = row & (S_ - 1);
#pragma unroll
          for (int g = 0; g < 4; ++g) {
            const int j = hi * 4 + 8 * g;
            float a0[4], a1[4];
#pragma unroll
            for (int e = 0; e < 4; ++e) {
              const float2 cs = rope[pos * 32 + j + e];
              const float x1 = acc[mi][0][4 * g + e], x2 = acc[mi][1][4 * g + e];
              a0[e] = x1 * cs.x - x2 * cs.y; a1[e] = x2 * cs.x + x1 * cs.y;
            }
            const uint2 lo = make_uint2(pk2(a0[0], a0[1]), pk2(a0[2], a0[3])), hi2 = make_uint2(pk2(a1[0], a1[1]), pk2(a1[2], a1[3]));
#pragma unroll
            for (int h = 0; h < 8; ++h) { *(uint2*)(Kb + (size_t)row * 1536 + h * 192 + 128 + j) = lo; *(uint2*)(Kb + (size_t)row * 1536 + h * 192 + 160 + j) = hi2; }
          }
        }
      });
    }
  }
  const int t_begin = bid < 64 ? NQ + NKV : bid - 64, t_step = G - 64;
  for (int itx = 0; itx < 2; ++itx)
  for (int it = (itx == 0 ? t_begin : NQ + NKV + NKR + bid); it < (itx == 0 ? NQ + NKV : NQ + NKV + NKR + NCV); it += (itx == 0 ? t_step : G)) {
    if (it < NQ) {
      const int tn = it / 64, tm = it % 64;
      __syncthreads();
      if (threadIdx.x < 128) { const float4* sp = (const float4*)(SSQ + (size_t)(tm * 128 + threadIdx.x) * 16); const float4 a = sp[0], b = sp[1]; rs[threadIdx.x] = rsqrtf((((a.x + a.y) + (a.z + a.w)) + ((b.x + b.y) + (b.z + b.w))) * (1.f / 512.f) + EPS); }
      gemm_tile<true>(P + 3072, INC, (const u16*)(p.ws + WS_WUQT), 512, 512, tm * 128, tn * 128, smem, [&](f32x16 (&acc)[2][2], int mb, int nb, int r, int hi) __attribute__((always_inline)) {
        const bool is_rope = ((nb >> 6) % 3) == 2;
#pragma unroll
        for (int mi = 0; mi < 2; ++mi) {
          const int row = mb + mi * 32 + r;
          const float sc = rs[row - tm * 128] * qscale;
          const int pos = row & (S_ - 1);
#pragma unroll
          for (int g = 0; g < 4; ++g) {
            const int j = hi * 4 + 8 * g;
            float a0[4], a1[4];
#pragma unroll
            for (int e = 0; e < 4; ++e) { a0[e] = acc[mi][0][4 * g + e] * sc; a1[e] = acc[mi][1][4 * g + e] * sc; }
            if (is_rope) {
#pragma unroll
              for (int e = 0; e < 4; ++e) {
                const float2 cs = rope[pos * 32 + j + e];
                const float x1 = a0[e], x2 = a1[e];
                a0[e] = x1 * cs.x - x2 * cs.y; a1[e] = x2 * cs.x + x1 * cs.y;
              }
            }
            *(uint2*)(Q + (size_t)row * 1536 + nb + j) = make_uint2(pk2(a0[0], a0[1]), pk2(a0[2], a0[3]));
            *(uint2*)(Q + (size_t)row * 1536 + nb + 32 + j) = make_uint2(pk2(a1[0], a1[1]), pk2(a1[2], a1[3]));
          }
        }
      });
    } else if (it < NQ + NKV) {
      const int j2 = it - NQ, tn = j2 / 64, tm = j2 % 64;
      __syncthreads();
      if (threadIdx.x < 128) { const float4* sp = (const float4*)(SSQ + (size_t)(tm * 128 + threadIdx.x) * 16 + 8); const float4 a = sp[0], b = sp[1]; rs[threadIdx.x] = rsqrtf((((a.x + a.y) + (a.z + a.w)) + ((b.x + b.y) + (b.z + b.w))) * (1.f / 512.f) + EPS); }
      const int head = tn >> 1;
      if ((tn & 1) == 0) {
        gemm_tile<true>(P + 3584, INC, (const u16*)(p.ws + WS_WUKVT), 512, 512, tm * 128, tn * 128, smem, [&](f32x16 (&acc)[2][2], int mb, int nb, int r, int hi) __attribute__((always_inline)) {
#pragma unroll
          for (int mi = 0; mi < 2; ++mi) {
            const int row = mb + mi * 32 + r;
            const float sc = rs[row - tm * 128];
#pragma unroll
            for (int ni = 0; ni < 2; ++ni)
#pragma unroll
              for (int g = 0; g < 4; ++g) {
                const int d = (nb & 127) + ni * 32 + hi * 4 + 8 * g;
                *(uint2*)(Kb + (size_t)row * 1536 + head * 192 + d) = make_uint2(pk2(acc[mi][ni][4 * g] * sc, acc[mi][ni][4 * g + 1] * sc), pk2(acc[mi][ni][4 * g + 2] * sc, acc[mi][ni][4 * g + 3] * sc));
              }
          }
        });
      } else {
        gemm_tile<false>(P + 3584, INC, (const u16*)(p.ws + WS_WUKVT), 512, 512, tm * 128, tn * 128, smem, [&](f32x16 (&acc)[2][2], int mb, int nb, int r, int hi) __attribute__((always_inline)) {
#pragma unroll
          for (int mi = 0; mi < 2; ++mi)
#pragma unroll
            for (int g = 0; g < 4; ++g) {
              const int row0 = mb + mi * 32 + hi * 4 + 8 * g;
              const float s0 = rs[row0 - tm * 128], s1 = rs[row0 + 1 - tm * 128], s2 = rs[row0 + 2 - tm * 128], s3 = rs[row0 + 3 - tm * 128];
              const int b = row0 >> 11, t = row0 & (S_ - 1);
#pragma unroll
              for (int ni = 0; ni < 2; ++ni) {
                const int d = (nb & 127) + ni * 32 + r;
                *(uint2*)(VT + ((size_t)((b * 8 + head) * 128 + d)) * S_ + t) = make_uint2(pk2(acc[mi][ni][4 * g] * s0, acc[mi][ni][4 * g + 1] * s1), pk2(acc[mi][ni][4 * g + 2] * s2, acc[mi][ni][4 * g + 3] * s3));
              }
            }
        });
      }
    } else if (it < NQ + NKV + NKR) {
      const int j2 = it - NQ - NKV;
      const int row = j2 * 8 + (threadIdx.x >> 5), j = threadIdx.x & 31, pos = row & (S_ - 1);
      const float x1 = bflo((unsigned)P[(size_t)row * INC + 4096 + j]), x2 = bflo((unsigned)P[(size_t)row * INC + 4096 + 32 + j]);
      const float2 cs = rope[pos * 32 + j];
      const float o1 = x1 * cs.x - x2 * cs.y, o2 = x2 * cs.x + x1 * cs.y;
      const u16 b1 = (u16)(pk2(o1, 0.f) & 0xffffu), b2 = (u16)(pk2(o2, 0.f) & 0xffffu);
#pragma unroll
      for (int h = 0; h < 8; ++h) { Kb[(size_t)row * 1536 + h * 192 + 128 + j] = b1; Kb[(size_t)row * 1536 + h * 192 + 160 + j] = b2; }
    } else {
      const int j2 = it - NQ - NKV - NKR;
      const int wi = j2 * 4 + (threadIdx.x >> 6), lane = threadIdx.x & 63;
      const int g = wi & 7, run = wi >> 3;
      const int row0 = run * 16, t0 = row0 & (S_ - 1);
      const int ch = g * 128 + lane * 2;
      const float* cw = p.in[6];
      const float w00 = cw[ch], w01 = cw[ch + 1], w10 = cw[1024 + ch], w11 = cw[1024 + ch + 1], w20 = cw[2048 + ch], w21 = cw[2048 + ch + 1];
      float zm1a = 0.f, zm1b = 0.f, zm2a = 0.f, zm2b = 0.f;
      if (t0 > 0) {
        const unsigned c1 = *(const unsigned*)(P + (size_t)(row0 - 1) * INC + 1024 + ch), h1 = *(const unsigned*)(P + (size_t)(row0 - 1) * INC + 2048 + ch);
        const unsigned c2 = *(const unsigned*)(P + (size_t)(row0 - 2) * INC + 1024 + ch), h2 = *(const unsigned*)(P + (size_t)(row0 - 2) * INC + 2048 + ch);
        zm1a = bflo(c1) * bflo(h1); zm1b = bfhi(c1) * bfhi(h1); zm2a = bflo(c2) * bflo(h2); zm2b = bfhi(c2) * bfhi(h2);
      }
#pragma unroll 4
      for (int tt = 0; tt < 16; ++tt) {
        const size_t ro = (size_t)(row0 + tt) * INC;
        const unsigned bb = *(const unsigned*)(P + ro + ch), cc = *(const unsigned*)(P + ro + 1024 + ch), hh = *(const unsigned*)(P + ro + 2048 + ch);
        const float za = bflo(cc) * bflo(hh), zb = bfhi(cc) * bfhi(hh);
        const float ya = bflo(bb) * (w00 * zm2a + w10 * zm1a + w20 * za), yb = bfhi(bb) * (w01 * zm2b + w11 * zm1b + w21 * zb);
        zm2a = zm1a; zm2b = zm1b; zm1a = za; zm1b = zb;
        const float ss = wave_sum(ya * ya + yb * yb);
        const float rstd = rsqrtf(ss * (1.f / 128.f) + EPS);
        *(unsigned*)(MG + (size_t)(row0 + tt) * D_ + ch) = pk2(ya * rstd, yb * rstd);
      }
    }
  }
}

DI void phase4(const Params& p, char* smem) {
  const u16* Q = (const u16*)(p.ws + WS_Q); const u16* Kb = (const u16*)(p.ws + WS_K); const u16* VT = (const u16*)(p.ws + WS_VT);
  u16* MG = (u16*)(p.ws + WS_MG);
  u16* Ks = (u16*)(smem + 16);
  u16* Vs = Ks + 64 * 200;
  float* mrg = (float*)(smem + 16);
  const int tid = threadIdx.x, lane = tid & 63, w = tid >> 6, qh = w & 1, kh = w >> 1, r = lane & 31, hi = lane >> 5;
  for (int it = blockIdx.x; it < 512; it += gridDim.x) {
    const int xq = it & 7, jq = it >> 3, bh = xq + 8 * (jq >> 4);
    const int pi = jq & 15, h = bh & 7, b = bh >> 3;
    for (int sub = 0; sub < 2; ++sub) {
      const int c = sub ? (31 - pi) : pi;
      const size_t qrow = (size_t)b * S_ + c * 64 + qh * 32 + r;
      bf16x8 qf[12];
#pragma unroll
      for (int ks = 0; ks < 12; ++ks) qf[ks] = *(const bf16x8*)(Q + qrow * 1536 + h * 192 + ks * 16 + hi * 8);
      f32x16 O[4];
#pragma unroll
      for (int dt = 0; dt < 4; ++dt)
#pragma unroll
        for (int i = 0; i < 16; ++i) O[dt][i] = 0.f;
      float m = -1e30f, l = 0.f;
      u32x4 kr[6]; u32x4 vr[4];
      const u16* kg = Kb + ((size_t)b * S_ + (tid >> 2)) * 1536 + h * 192 + (tid & 3) * 8;
      const u16* vg = VT + ((size_t)((b * 8 + h) * 128 + (tid >> 1))) * S_ + (tid & 1) * 8;
      u16* ksw = Ks + (tid >> 2) * 200 + (tid & 3) * 8;
      u16* vsw = Vs + (tid >> 1) * 68 + (tid & 1) * 8;
      auto load_tile = [&]() __attribute__((always_inline)) {
#pragma unroll
        for (int i = 0; i < 6; ++i) kr[i] = *(const u32x4*)(kg + i * 32);
#pragma unroll
        for (int i = 0; i < 4; ++i) vr[i] = *(const u32x4*)(vg + i * 16);
        kg += 64 * 1536; vg += 64;
      };
      load_tile();
      for (int kt = 0; kt <= c; ++kt) {
        __syncthreads();
#pragma unroll
        for (int i = 0; i < 6; ++i) *(u32x4*)(ksw + i * 32) = kr[i];
#pragma unroll
        for (int i = 0; i < 4; ++i) { u32x2 lo2 = {vr[i][0], vr[i][1]}, hi2 = {vr[i][2], vr[i][3]}; *(u32x2*)(vsw + i * 16) = lo2; *(u32x2*)(vsw + i * 16 + 4) = hi2; }
        __syncthreads();
        if (kt < c) load_tile();
        f32x16 s;
#pragma unroll
        for (int i = 0; i < 16; ++i) s[i] = 0.f;
        const u16* kp = Ks + (kh * 32 + r) * 200 + hi * 8;
#pragma unroll
        for (int ks = 0; ks < 12; ++ks) { bf16x8 kf = *(const bf16x8*)(kp + ks * 16); s = MFMA(kf, qf[ks], s); }
        float mx = s[0];
#pragma unroll
        for (int i = 1; i < 16; ++i) mx = fmaxf(mx, s[i]);
        mx = fmaxf(mx, __shfl_xor(mx, 32));
        const float mn = fmaxf(m, mx);
        const float alpha = __builtin_amdgcn_exp2f(m - mn);
        const bool resc = __builtin_amdgcn_ballot_w64(mn > m) != 0ull;
        m = mn;
        float rsum = 0.f;
#pragma unroll
        for (int i = 0; i < 16; ++i) { s[i] = __builtin_amdgcn_exp2f(s[i] - mn); rsum += s[i]; }
        l = l * alpha + rsum;
        if (resc) {
#pragma unroll
          for (int dt = 0; dt < 4; ++dt)
#pragma unroll
            for (int i = 0; i < 16; ++i) O[dt][i] *= alpha;
        }
#pragma unroll
        for (int st = 0; st < 2; ++st) {
          uint4 pu = make_uint4(pk2(s[8 * st], s[8 * st + 1]), pk2(s[8 * st + 2], s[8 * st + 3]), pk2(s[8 * st + 4], s[8 * st + 5]), pk2(s[8 * st + 6], s[8 * st + 7]));
          const bf16x8 pf = __builtin_bit_cast(bf16x8, pu);
#pragma unroll
          for (int dt = 0; dt < 4; ++dt) {
            const u16* vp = Vs + (dt * 32 + r) * 68 + kh * 32 + 16 * st + 4 * hi;
            uint2 v0 = *(const uint2*)vp, v1 = *(const uint2*)(vp + 8);
            const bf16x8 vf = __builtin_bit_cast(bf16x8, make_uint4(v0.x, v0.y, v1.x, v1.y));
            O[dt] = MFMA(vf, pf, O[dt]);
          }
        }
      }
      l += __shfl_xor(l, 32);
      __syncthreads();
      float* mq = mrg + qh * 66 * 64;
      if (kh == 1) {
#pragma unroll
        for (int dt = 0; dt < 4; ++dt)
#pragma unroll
          for (int i = 0; i < 16; ++i) mq[(dt * 16 + i) * 64 + lane] = O[dt][i];
        mq[64 * 64 + lane] = m; mq[65 * 64 + lane] = l;
      }
      __syncthreads();
      if (kh == 0) {
        const float m1 = mq[64 * 64 + lane], l1 = mq[65 * 64 + lane];
        const float mt = fmaxf(m, m1), a0 = exp2f(m - mt), a1 = exp2f(m1 - mt);
        const float inv = 1.f / (l * a0 + l1 * a1);
        float ss = 0.f;
#pragma unroll
        for (int dt = 0; dt < 4; ++dt)
#pragma unroll
          for (int i = 0; i < 16; ++i) { const float o = (O[dt][i] * a0 + mq[(dt * 16 + i) * 64 + lane] * a1) * inv; O[dt][i] = o; ss += o * o; }
        ss += __shfl_xor(ss, 32);
        const float rstd = rsqrtf(ss * (1.f / 128.f) + EPS);
#pragma unroll
        for (int dt = 0; dt < 4; ++dt)
#pragma unroll
          for (int g = 0; g < 4; ++g) {
            const int d = dt * 32 + hi * 4 + 8 * g;
            *(uint2*)(MG + qrow * D_ + 1024 + h * 128 + d) = make_uint2(pk2(O[dt][4 * g] * rstd, O[dt][4 * g + 1] * rstd), pk2(O[dt][4 * g + 2] * rstd, O[dt][4 * g + 3] * rstd));
          }
      }
    }
  }
}

DI void phase5(const Params& p, char* smem) {
  const u16* MG = (const u16*)(p.ws + WS_MG); const u16* W = (const u16*)(p.ws + WS_WOUTT);
  const float* X = p.in[0]; const float* mod = (const float*)(p.ws + WS_MOD); u16* X1 = (u16*)(p.ws + WS_X1);
  for (int it = blockIdx.x; it < 64 * 16; it += gridDim.x) {
    const int tn = it / 64, tm = it % 64;
    gemm_tile<true>(MG, D_, W, D_, D_, tm * 128, tn * 128, smem, [&](f32x16 (&acc)[2][2], int mb, int nb, int r, int hi) __attribute__((always_inline)) {
#pragma unroll
      for (int mi = 0; mi < 2; ++mi) {
        const int row = mb + mi * 32 + r, b = row >> 11;
        const float* gt = mod + b * 12288 + 2 * 2048;
#pragma unroll
        for (int ni = 0; ni < 2; ++ni)
#pragma unroll
          for (int g = 0; g < 4; ++g) {
            const int col = nb + ni * 32 + hi * 4 + 8 * g;
            const float4 xv = *(const float4*)(X + (size_t)row * D_ + col), gv = *(const float4*)(gt + col);
            float4 o;
            o.x = xv.x + gv.x * acc[mi][ni][4 * g]; o.y = xv.y + gv.y * acc[mi][ni][4 * g + 1]; o.z = xv.z + gv.z * acc[mi][ni][4 * g + 2]; o.w = xv.w + gv.w * acc[mi][ni][4 * g + 3];
            *(uint2*)(X1 + (size_t)row * D_ + col) = make_uint2(pk2(o.x, o.y), pk2(o.z, o.w));
          }
      }
    });
  }
}

DI void phase7(const Params& p, char* smem) {
  const u16* H2 = (const u16*)(p.ws + WS_H); const u16* W = (const u16*)(p.ws + WS_WQT); u16* PQ = (u16*)(p.ws + WS_P);
  for (int it = blockIdx.x; it < 64 * 16; it += gridDim.x) {
    const int tn = it / 64, tm = it % 64;
    gemm_tile<true>(H2, D_, W, D_, D_, tm * 128, tn * 128, smem, [&](f32x16 (&acc)[2][2], int mb, int nb, int r, int hi) __attribute__((always_inline)) {
#pragma unroll
      for (int mi = 0; mi < 2; ++mi)
#pragma unroll
        for (int ni = 0; ni < 2; ++ni)
#pragma unroll
          for (int g = 0; g < 4; ++g) {
            const int row = mb + mi * 32 + r, col = nb + ni * 32 + hi * 4 + 8 * g;
            *(uint2*)(PQ + (size_t)row * D_ + col) = make_uint2(pk2(acc[mi][ni][4 * g], acc[mi][ni][4 * g + 1]), pk2(acc[mi][ni][4 * g + 2], acc[mi][ni][4 * g + 3]));
          }
    });
  }
}

DI unsigned f2ord(float v) { unsigned u = __float_as_uint(v); return u ^ ((unsigned)((int)u >> 31) | 0x80000000u); }
#define TOPK_INSERT(keys, x) { _Pragma("unroll") for (int _j = 0; _j < 16; ++_j) { const unsigned _h = max(keys[_j], x); x = min(keys[_j], x); keys[_j] = _h; } }
DI void phase8(const Params& p, char* smem) {
  const u16* PQ = (const u16*)(p.ws + WS_P); const u16* SK = (const u16*)(p.ws + WS_SK);
  int* IDS = (int*)(p.ws + WS_IDS); float* GATE = (float*)(p.ws + WS_GATE);
  float* sc = (float*)(smem + 16);
  const int tid = threadIdx.x, lane = tid & 63, w = tid >> 6, r = lane & 31, hi = lane >> 5;
  for (int it = blockIdx.x; it < 128 * 8; it += gridDim.x) {
    const int h = it & 7, tile = it >> 3;
    const int pp = w >> 1, rh = w & 1;
    __syncthreads();
    {
      f32x16 acc[4];
#pragma unroll
      for (int nt = 0; nt < 4; ++nt)
#pragma unroll
        for (int i = 0; i < 16; ++i) acc[nt][i] = 0.f;
      const u16* ap = PQ + (size_t)(tile * 64 + rh * 32 + r) * D_ + h * 256 + pp * 128 + hi * 8;
      const u16* bp = SK + ((size_t)(h * 2 + pp) * 128 + r) * 128 + hi * 8;
#pragma unroll
      for (int ks = 0; ks < 8; ++ks) {
        const bf16x8 af = *(const bf16x8*)(ap + ks * 16);
#pragma unroll
        for (int nt = 0; nt < 4; ++nt) { const bf16x8 bf = *(const bf16x8*)(bp + nt * 32 * 128 + ks * 16); acc[nt] = MFMA(af, bf, acc[nt]); }
      }
#pragma unroll
      for (int nt = 0; nt < 4; ++nt)
#pragma unroll
        for (int i = 0; i < 16; ++i) sc[(pp * 64 + rh * 32 + hi * 4 + (i & 3) + 8 * (i >> 2)) * 129 + nt * 32 + r] = acc[nt][i];
    }
    __syncthreads();
    {
      const int rowi = tid & 127, half = tid >> 7;
      float* row = sc + rowi * 129;
      unsigned* mk = (unsigned*)(smem + 16 + 128 * 129 * 4);
      unsigned keys[16];
#pragma unroll
      for (int j = 0; j < 16; ++j) keys[j] = 0u;
#pragma unroll 4
      for (int n2 = 0; n2 < 64; ++n2) {
        const int n = half * 64 + n2;
        unsigned x = (f2ord(row[n]) & 0xFFFFFF80u) | (unsigned)(127 - n);
        TOPK_INSERT(keys, x);
      }
      if (half == 1) {
#pragma unroll
        for (int j = 0; j < 16; ++j) mk[j * 128 + rowi] = keys[j];
      }
      __syncthreads();
      if (half == 0) {
#pragma unroll
        for (int j = 0; j < 16; ++j) { unsigned x = mk[j * 128 + rowi]; TOPK_INSERT(keys, x); }
        float vals[16];
#pragma unroll
        for (int j = 0; j < 16; ++j) vals[j] = row[127 - (keys[j] & 127u)];
#pragma unroll
        for (int j = 0; j < 16; ++j) { row[j] = vals[j]; row[16 + j] = __int_as_float((int)(127 - (keys[j] & 127u))); }
      }
    }
    __syncthreads();
    if (tid < 64) {
      const float* ra = sc + tid * 129; const float* rb = sc + (64 + tid) * 129;
      float a[16], bq[16];
#pragma unroll
      for (int j = 0; j < 16; ++j) { a[j] = ra[j]; bq[j] = rb[j]; }
      unsigned keys[16];
#pragma unroll
      for (int j = 0; j < 16; ++j) keys[j] = 0u;
#pragma unroll
      for (int i = 0; i < 16; ++i)
#pragma unroll
        for (int j = 0; j < 16; ++j)
          if ((i + 1) * (j + 1) <= 16) {
            unsigned x = (f2ord(a[i] + bq[j]) & 0xFFFFFF00u) | (unsigned)(255 - (i * 16 + j));
            TOPK_INSERT(keys, x);
          }
      float bv[16]; int ex[16];
      float mx = -1e30f;
#pragma unroll
      for (int q = 0; q < 16; ++q) {
        const int flat = 255 - (int)(keys[q] & 255u), i = flat >> 4, j = flat & 15;
        bv[q] = ra[i] + rb[j];
        ex[q] = __float_as_int(ra[16 + i]) * 128 + __float_as_int(rb[16 + j]);
        mx = fmaxf(mx, bv[q]);
      }
      float sum = 0.f;
#pragma unroll
      for (int q = 0; q < 16; ++q) { bv[q] = __expf(bv[q] - mx); sum += bv[q]; }
      const float inv = 1.f / sum;
      const size_t o = (size_t)(tile * 64 + tid) * 128 + h * 16;
#pragma unroll
      for (int q = 0; q < 16; q += 4) {
        *(int4*)(IDS + o + q) = make_int4(ex[q], ex[q + 1], ex[q + 2], ex[q + 3]);
        *(float4*)(GATE + o + q) = make_float4(bv[q] * inv, bv[q + 1] * inv, bv[q + 2] * inv, bv[q + 3] * inv);
      }
    }
  }
}

constexpr int CTR_UQ = 4096, CTR_VQ = 4608;
DI f2_t cvt8lo(unsigned w) { return __builtin_amdgcn_cvt_pk_f32_fp8(w, false); }
DI f2_t cvt8hi(unsigned w) { return __builtin_amdgcn_cvt_pk_f32_fp8(w, true); }
template <class F>
DI void xcd_queue(unsigned* ctrs, int nchunks, char* smem, F&& f) {
  const int x0 = (int)(xb_xcc_id() & 7u);
#pragma unroll 1
  for (int k = 0; k < 8; ++k) {
    const int s = (x0 + k) & 7;
    for (;;) { const int c = grab(ctrs + 64 * s, smem); if (c >= nchunks) break; f(s, c); }
  }
}
DI void wave_lds_sync() { asm volatile("s_waitcnt lgkmcnt(0)" ::: "memory"); __builtin_amdgcn_wave_barrier(); }

DI void phase9(const Params& p, char* smem, int rep) {
  const unsigned char* H2Q = (const unsigned char*)(p.ws + WS_H2Q); const unsigned char* U8 = (const unsigned char*)(p.ws + WS_U);
  const int* IDS = (const int*)(p.ws + WS_IDS); int* PA = (int*)(p.ws + WS_PA);
  const int lane = threadIdx.x & 63, w = threadIdx.x >> 6, g = lane >> 4, l15 = lane & 15;
  const int b3 = (lane >> 3) & 1, b2 = (lane >> 2) & 1, b1 = (lane >> 1) & 1, b0 = lane & 1;
  int* lw = (int*)(smem + 16) + w * 256;
  xcd_queue((unsigned*)(p.ws + WS_BAR) + CTR_UQ + rep * 8, 512, smem, [&](int s, int c) __attribute__((always_inline)) {
#pragma unroll 1
    for (int t = 0; t < 4; ++t) {
      const int tok = __builtin_amdgcn_readfirstlane(c * 16 + w * 4 + t);
      const int i0 = IDS[(size_t)tok * 128 + lane], i1 = IDS[(size_t)tok * 128 + 64 + lane];
      const u32x4 hq = *(const u32x4*)(H2Q + (size_t)tok * D_ + s * 256 + l15 * 16);
      wave_lds_sync();
      lw[(lane & 3) * 32 + (lane >> 2)] = i0;
      lw[(lane & 3) * 32 + 16 + (lane >> 2)] = i1;
      wave_lds_sync();
      const unsigned char* ub = U8 + s * 256 + l15 * 16;
#pragma unroll
      for (int batch = 0; batch < 2; ++batch) {
        int ida[16];
#pragma unroll
        for (int q = 0; q < 4; ++q) { const int4 v = *(const int4*)(lw + g * 32 + batch * 16 + q * 4); ida[q * 4] = v.x; ida[q * 4 + 1] = v.y; ida[q * 4 + 2] = v.z; ida[q * 4 + 3] = v.w; }
        u32x4 rows[16];
#pragma unroll
        for (int k = 0; k < 16; ++k) rows[k] = *(const u32x4*)(ub + (size_t)ida[k] * 2048);
        int part[16];
#pragma unroll
        for (int k = 0; k < 16; ++k) {
          int acc = 0;
#pragma unroll
          for (int d = 0; d < 4; ++d) acc = __builtin_amdgcn_sdot4((int)rows[k][d], (int)hq[d], acc, false);
          part[k] = acc;
        }
        int q8[8], q4[4], q2[2];
#pragma unroll
        for (int k = 0; k < 8; ++k) q8[k] = (b3 ? part[8 + k] : part[k]) + __shfl_xor(b3 ? part[k] : part[8 + k], 8);
#pragma unroll
        for (int k = 0; k < 4; ++k) q4[k] = (b2 ? q8[4 + k] : q8[k]) + __shfl_xor(b2 ? q8[k] : q8[4 + k], 4);
#pragma unroll
        for (int k = 0; k < 2; ++k) q2[k] = (b1 ? q4[2 + k] : q4[k]) + __shfl_xor(b1 ? q4[k] : q4[2 + k], 2);
        const int rr = (b0 ? q2[1] : q2[0]) + __shfl_xor(b0 ? q2[0] : q2[1], 1);
        PA[((size_t)s * T_ + tok) * 128 + 4 * (batch * 16 + l15) + g] = rr;
      }
    }
  });
}

DI void phase10(const Params& p) {
  const int* PA = (const int*)(p.ws + WS_PA); float* ACT = (float*)(p.ws + WS_ACT); const float* HSC = (const float*)(p.ws + WS_HSC);
  const int* IDS = (const int*)(p.ws + WS_IDS); const float* GATE = (const float*)(p.ws + WS_GATE);
  const float* USC = (const float*)(p.ws + WS_USC); const float* VSC = (const float*)(p.ws + WS_VSC);
  for (int i = blockIdx.x * 256 + threadIdx.x; i < T_ * 128; i += gridDim.x * 256) {
    int ai = 0;
#pragma unroll
    for (int s = 0; s < 8; ++s) ai += PA[(size_t)s * T_ * 128 + i];
    const int id = IDS[i];
    const float a = (float)ai * USC[id] * HSC[i >> 7];
    ACT[i] = 0.5f * a * (1.f + erff(a * 0.70710678118654752f)) * GATE[i] * VSC[id];
  }
}

DI void phase11(const Params& p, char* smem, int rep) {
  const unsigned char* V8 = (const unsigned char*)(p.ws + WS_V);
  const int* IDS = (const int*)(p.ws + WS_IDS); const float* ACT = (const float*)(p.ws + WS_ACT); u16* OUTP = (u16*)(p.ws + WS_OUTP);
  const int lane = threadIdx.x & 63, w = threadIdx.x >> 6, g = lane >> 4, l15 = lane & 15;
  const int b5 = (lane >> 5) & 1, b4 = (lane >> 4) & 1;
  int* lw = (int*)(smem + 16) + w * 256;
  float* lf = (float*)(lw + 128);
  xcd_queue((unsigned*)(p.ws + WS_BAR) + CTR_VQ + rep * 8, 512, smem, [&](int s, int c) __attribute__((always_inline)) {
#pragma unroll 1
    for (int t = 0; t < 4; ++t) {
      const int tok = __builtin_amdgcn_readfirstlane(c * 16 + w * 4 + t);
      const int i0 = IDS[(size_t)tok * 128 + lane], i1 = IDS[(size_t)tok * 128 + 64 + lane];
      const float a0 = ACT[(size_t)tok * 128 + lane], a1 = ACT[(size_t)tok * 128 + 64 + lane];
      wave_lds_sync();
      lw[(lane & 3) * 32 + (lane >> 2)] = i0; lw[(lane & 3) * 32 + 16 + (lane >> 2)] = i1;
      lf[(lane & 3) * 32 + (lane >> 2)] = a0; lf[(lane & 3) * 32 + 16 + (lane >> 2)] = a1;
      wave_lds_sync();
      f2_t o[8];
#pragma unroll
      for (int i = 0; i < 8; ++i) o[i] = f2_t{0.f, 0.f};
      const unsigned char* vb = V8 + s * 256 + l15 * 16;
#pragma unroll
      for (int batch = 0; batch < 2; ++batch) {
        int ida[16]; float aa[16];
#pragma unroll
        for (int q = 0; q < 4; ++q) {
          const int4 v = *(const int4*)(lw + g * 32 + batch * 16 + q * 4); ida[q * 4] = v.x; ida[q * 4 + 1] = v.y; ida[q * 4 + 2] = v.z; ida[q * 4 + 3] = v.w;
          const float4 f = *(const float4*)(lf + g * 32 + batch * 16 + q * 4); aa[q * 4] = f.x; aa[q * 4 + 1] = f.y; aa[q * 4 + 2] = f.z; aa[q * 4 + 3] = f.w;
        }
        u32x4 rows[16];
#pragma unroll
        for (int k = 0; k < 16; ++k) rows[k] = *(const u32x4*)(vb + (size_t)ida[k] * 2048);
#pragma unroll
        for (int k = 0; k < 16; ++k) {
          const f2_t a2 = {aa[k], aa[k]};
#pragma unroll
          for (int d = 0; d < 4; ++d) { const unsigned ww = rows[k][d]; o[2 * d] += a2 * cvt8lo(ww); o[2 * d + 1] += a2 * cvt8hi(ww); }
        }
      }
      float ov[16];
#pragma unroll
      for (int d = 0; d < 4; ++d) { ov[4 * d] = o[2 * d].x; ov[4 * d + 1] = o[2 * d].y; ov[4 * d + 2] = o[2 * d + 1].x; ov[4 * d + 3] = o[2 * d + 1].y; }
      float q8[8], q4[4];
#pragma unroll
      for (int k = 0; k < 8; ++k) q8[k] = (b5 ? ov[8 + k] : ov[k]) + __shfl_xor(b5 ? ov[k] : ov[8 + k], 32);
#pragma unroll
      for (int k = 0; k < 4; ++k) q4[k] = (b4 ? q8[4 + k] : q8[k]) + __shfl_xor(b4 ? q8[k] : q8[4 + k], 16);
      *(uint2*)(OUTP + (size_t)tok * D_ + s * 256 + l15 * 16 + 8 * b5 + 4 * b4) = make_uint2(pk2(q4[0], q4[1]), pk2(q4[2], q4[3]));
    }
  });
}

DI void phase12(const Params& p) {
  const u16* X1 = (const u16*)(p.ws + WS_X1); const u16* OUTP = (const u16*)(p.ws + WS_OUTP);
  const float* mod = (const float*)(p.ws + WS_MOD); const float* gfin = p.in[19];
  const int lane = threadIdx.x & 63, w = threadIdx.x >> 6;
  for (int row = blockIdx.x * 4 + w; row < T_; row += gridDim.x * 4) {
    const float* gt = mod + (row >> 11) * 12288 + 5 * 2048;
    float4 v[8];
    float ss = 0.f;
#pragma unroll
    for (int j = 0; j < 8; ++j) {
      const int d = j * 256 + lane * 4;
      const uint2 xb2 = *(const uint2*)(X1 + (size_t)row * D_ + d);
      const float4 xv = make_float4(bflo(xb2.x), bfhi(xb2.x), bflo(xb2.y), bfhi(xb2.y)), gv = *(const float4*)(gt + d);
      const uint2 ob = *(const uint2*)(OUTP + (size_t)row * D_ + d);
      const float4 ov = make_float4(bflo(ob.x), bfhi(ob.x), bflo(ob.y), bfhi(ob.y));
      v[j] = make_float4(xv.x + gv.x * ov.x, xv.y + gv.y * ov.y, xv.z + gv.z * ov.z, xv.w + gv.w * ov.w);
      ss += v[j].x * v[j].x + v[j].y * v[j].y + v[j].z * v[j].z + v[j].w * v[j].w;
    }
    ss = wave_sum(ss);
    const float rstd = rsqrtf(ss * (1.f / D_) + EPS);
#pragma unroll
    for (int j = 0; j < 8; ++j) {
      const int d = j * 256 + lane * 4;
      const float4 gv = *(const float4*)(gfin + d);
      { const f32x4v t = {v[j].x * rstd * gv.x, v[j].y * rstd * gv.y, v[j].z * rstd * gv.z, v[j].w * rstd * gv.w}; __builtin_nontemporal_store(t, (f32x4v*)(p.out + (size_t)row * D_ + d)); }
    }
  }
}

DI void phase6(const Params& p) {
  norm_rows<true, true>((const float*)(p.ws + WS_X1), p.in[14], (const float*)(p.ws + WS_MOD) + 3 * 2048, 12288, (u16*)(p.ws + WS_H), (unsigned char*)(p.ws + WS_H2Q), (float*)(p.ws + WS_HSC), (int)blockIdx.x * 4, (int)gridDim.x * 4, T_);
}

__global__ void __launch_bounds__(256, 2) mega(Params p) {
  extern __shared__ __attribute__((aligned(16))) char smem[];
  XcdBarrier xb;
  const bool multi = (p.ph_hi - p.ph_lo) > 1;
  if (multi) {
    if (threadIdx.x == 0) *(uint4*)smem = make_uint4(0u, 0u, 0u, 0u);
    __syncthreads();
    xb = xcd_barrier_post((unsigned*)(p.ws + WS_BAR), (volatile LAS unsigned*)smem);
  }
#ifndef PHMASK
#define PHMASK 0x1fff
#endif
#ifndef REPMASK
#define REPMASK 0
#endif
  int rep = 0;
#define RUN_PHASE(n, call) if (p.ph_lo <= (n) && (n) < p.ph_hi) { \
    if ((n) > p.ph_lo) { xcd_barrier(xb); } \
    if (PHMASK & (1 << (n))) { call; if (REPMASK & (1 << (n))) { xcd_barrier(xb); rep = 1; call; rep = 0; } } }
  RUN_PHASE(0, phase0(p, smem))
  RUN_PHASE(1, phase1(p, smem))
#ifdef BARX
  for (int i = 0; i < BARX; ++i) xcd_barrier(xb);
#endif
  RUN_PHASE(2, phase2(p, smem, rep))
  RUN_PHASE(3, phase3(p, smem))
  RUN_PHASE(4, phase4(p, smem))
  RUN_PHASE(5, phase5(p, smem))
  RUN_PHASE(6, phase6(p))
  RUN_PHASE(7, phase7(p, smem))
  RUN_PHASE(8, phase8(p, smem))
  RUN_PHASE(9, phase9(p, smem, rep))
  RUN_PHASE(10, phase10(p))
  RUN_PHASE(11, phase11(p, smem, rep))
  RUN_PHASE(12, phase12(p))
}

extern "C" void kernel_launch(void* const* d_in, const int* in_sizes, int n_in, void* d_out, int out_size, void* d_ws, size_t ws_size, hipStream_t stream) {
  static int grid = 0;
  if (grid == 0) {
    if (n_in != 20 || ws_size < WS_END) { fprintf(stderr, "kernel_launch: unexpected n_in %d / ws_size %zu (need %zu)\n", n_in, ws_size, (size_t)WS_END); grid = -1; return; }
    int dev = 0, cus = 0, per_cu = 0;
    hipGetDevice(&dev);
    hipDeviceGetAttribute(&cus, hipDeviceAttributeMultiprocessorCount, dev);
    hipFuncSetAttribute((const void*)mega, hipFuncAttributeMaxDynamicSharedMemorySize, LDS_BYTES);
    hipOccupancyMaxActiveBlocksPerMultiprocessor(&per_cu, (const void*)mega, 256, LDS_BYTES);
    if (per_cu < 1) { fprintf(stderr, "kernel_launch: occupancy query says %d\n", per_cu); per_cu = 1; }
    if (per_cu > 2) per_cu = 2;
    grid = cus * per_cu;
    fprintf(stderr, "kernel_launch: grid %d (%d per CU)\n", grid, per_cu);
  }
  if (grid < 0) return;
  Params p{};
  for (int i = 0; i < 20; ++i) p.in[i] = (const float*)d_in[i];
  p.out = (float*)d_out; p.ws = (char*)d_ws;
#if N_LAUNCH_PER_PHASE
  p.coop = 0;
  for (int ph = 0; ph < NPH; ++ph) {
    p.ph_lo = ph; p.ph_hi = ph + 1;
    hipLaunchKernelGGL(mega, dim3(grid), dim3(256), LDS_BYTES, stream, p);
  }
#else
  hipMemsetAsync((char*)d_ws + WS_BAR, 0, WS_MOD, stream);
  p.coop = 0; p.ph_lo = 0; p.ph_hi = NPH;
  void* args[] = {&p};
  hipError_t e = hipLaunchCooperativeKernel((const void*)mega, dim3(grid), dim3(256), args, LDS_BYTES, stream);
  if (e != hipSuccess) fprintf(stderr, "cooperative launch failed: %s (grid %d)\n", hipGetErrorString(e), grid);
#endif
}
```

```cpp
#include <hip/hip_runtime.h>
#include <cstdio>
#include <cstdint>

#ifndef N_LAUNCH_PER_PHASE
#define N_LAUNCH_PER_PHASE 0
#endif

#define DI __device__ __forceinline__
typedef unsigned short u16;
typedef __attribute__((ext_vector_type(8))) short bf16x8;
typedef __attribute__((ext_vector_type(16))) float f32x16;
typedef __attribute__((ext_vector_type(2))) __bf16 bf2_t;
typedef __attribute__((ext_vector_type(2))) float f2_t;
typedef __attribute__((ext_vector_type(4))) unsigned u32x4;
typedef __attribute__((ext_vector_type(2))) unsigned u32x2;
typedef __attribute__((ext_vector_type(4))) float f32x4v;
DI float4 nt_load4(const float* p) { const f32x4v t = __builtin_nontemporal_load((const f32x4v*)p); return make_float4(t[0], t[1], t[2], t[3]); }
DI void nt_store4(void* p, unsigned a, unsigned b, unsigned c, unsigned d) { const u32x4 t = {a, b, c, d}; __builtin_nontemporal_store(t, (u32x4*)p); }
#define MFMA(a, b, c) __builtin_amdgcn_mfma_f32_32x32x16_bf16((a), (b), (c), 0, 0, 0)

constexpr int T_ = 8192, D_ = 2048, S_ = 2048;
constexpr int INC = 4160;
constexpr float EPS = 1e-6f;
constexpr int NPH = 13;

constexpr size_t al256(size_t x) { return (x + 255) & ~(size_t)255; }
constexpr size_t WS_BAR = 0;
constexpr size_t WS_MOD = 32768;
constexpr size_t WS_ROPE = WS_MOD + al256(4 * 12288 * 4);
constexpr size_t WS_WINT = WS_ROPE + al256(2048 * 32 * 8);
constexpr size_t WS_WUQT = WS_WINT + al256((size_t)4224 * 2048 * 2);
constexpr size_t WS_WUKVT = WS_WUQT + al256((size_t)1536 * 512 * 2);
constexpr size_t WS_WOUTT = WS_WUKVT + al256((size_t)2048 * 512 * 2);
constexpr size_t WS_WQT = WS_WOUTT + al256((size_t)2048 * 2048 * 2);
constexpr size_t WS_SK = WS_WQT + al256((size_t)2048 * 2048 * 2);
constexpr size_t WS_U = WS_SK + al256((size_t)262144 * 2);
constexpr size_t WS_V = WS_U + al256((size_t)16384 * 2048);
constexpr size_t WS_H = WS_V + al256((size_t)16384 * 2048);
constexpr size_t WS_P = WS_H + al256((size_t)T_ * D_ * 2);
constexpr size_t WS_Q = WS_P + al256((size_t)T_ * INC * 2);
constexpr size_t WS_K = WS_Q + al256((size_t)T_ * 1536 * 2);
constexpr size_t WS_VT = WS_K + al256((size_t)T_ * 1536 * 2);
constexpr size_t WS_MG = WS_VT + al256((size_t)T_ * 1024 * 2);
constexpr size_t WS_X1 = WS_MG + al256((size_t)T_ * D_ * 2);
constexpr size_t WS_IDS = WS_X1 + al256((size_t)T_ * D_ * 4);
constexpr size_t WS_GATE = WS_IDS + al256((size_t)T_ * 128 * 4);
constexpr size_t WS_USC = WS_GATE + al256((size_t)T_ * 128 * 4);
constexpr size_t WS_VSC = WS_USC + 65536;
constexpr size_t WS_MODP = WS_VSC + 65536;
constexpr size_t WS_ACT = WS_MODP + al256((size_t)4 * 4 * 12288 * 4);
constexpr size_t WS_H2Q = WS_ACT + al256((size_t)T_ * 128 * 4);
constexpr size_t WS_HSC = WS_H2Q + al256((size_t)T_ * D_);
constexpr size_t WS_SSQ = WS_HSC + al256((size_t)T_ * 4);
constexpr size_t WS_END = WS_SSQ + al256((size_t)T_ * 16 * 4);
constexpr size_t WS_PA = WS_MG;
constexpr size_t WS_OUTP = WS_Q;
static_assert(WS_VT + (size_t)T_ * 1024 * 2 - WS_Q >= (size_t)T_ * D_ * 4, "OUTP alias");
static_assert((size_t)8 * T_ * 128 * 4 <= (size_t)T_ * D_ * 2, "PA alias");

constexpr int LDS_BYTES = 16 + 2 * 2 * 128 * 72 * 2 + 512;

struct Params {
  const float* in[20];
  float* out;
  char* ws;
  int ph_lo, ph_hi, coop, pad;
};

DI unsigned pk2(float a, float b) { f2_t v = {a, b}; bf2_t r = __builtin_convertvector(v, bf2_t); return __builtin_bit_cast(unsigned, r); }
DI float bflo(unsigned u) { return __uint_as_float(u << 16); }
DI float bfhi(unsigned u) { return __uint_as_float(u & 0xffff0000u); }
DI float dot2(unsigned a, unsigned b, float c) { return __builtin_amdgcn_fdot2_f32_bf16(__builtin_bit_cast(bf2_t, a), __builtin_bit_cast(bf2_t, b), c, false); }
DI float wave_sum(float v) {
#pragma unroll
  for (int o = 32; o >= 1; o >>= 1) v += __shfl_xor(v, o);
  return v;
}

#define XB_TMO      128
#define XB_XCNT(j)  (256  + 64 * (j))
#define XB_XSUB(j)  (1280 + 64 * (j))
#define XB_XGEN(j)  (2304 + 64 * (j))
#define XB_TOP      3328
#define XB_TOPGEN   3392
#define XCD_BAR_WORDS 3456
#define XB_SPIN_CAP (1u << 22)
#define LAS __attribute__((address_space(3)))
DI unsigned xb_ld(unsigned* p) { return __hip_atomic_load(p, __ATOMIC_RELAXED, __HIP_MEMORY_SCOPE_AGENT); }
DI unsigned xb_add(unsigned* p, unsigned v) { return __hip_atomic_fetch_add(p, v, __ATOMIC_RELAXED, __HIP_MEMORY_SCOPE_AGENT); }
DI unsigned xb_xcc_id() { return (unsigned)__builtin_amdgcn_s_getreg((3 << 11) | 20) & 0xFu; }
#define XB_SPIN(cond, bar) do { unsigned _sp = 0; while (cond) { __builtin_amdgcn_s_sleep(1); \
    if ((++_sp & 255u) == 0u) { if (xb_ld(&(bar)[XB_TMO])) break; if (_sp > XB_SPIN_CAP) { atomicAdd(&(bar)[XB_TMO], 1u); break; } } } } while (0)
struct XcdBarrier { unsigned* bar; unsigned x; volatile LAS unsigned* st; };
DI XcdBarrier xcd_barrier_post(unsigned* bar, volatile LAS unsigned* st) {
  XcdBarrier b; b.bar = bar; b.x = xb_xcc_id(); b.st = st;
  if (threadIdx.x == 0) (void)xb_add(&bar[XB_XCNT(b.x)], 1u);
  return b;
}
DI void xcd_barrier_complete(unsigned* bar, unsigned x, unsigned& nloc, unsigned& nx) {
  const unsigned G = gridDim.x * gridDim.y * gridDim.z;
  unsigned sum, cnt, mine, sp = 0u;
  for (;;) {
    sum = 0u; cnt = 0u; mine = 0u;
#pragma unroll
    for (unsigned j = 0; j < 16; ++j) { const unsigned c = xb_ld(&bar[XB_XCNT(j)]); sum += c; cnt += (c > 0u) ? 1u : 0u; mine = (j == x) ? c : mine; }
    if (sum == G) break;
    __builtin_amdgcn_s_sleep(1);
    if ((++sp & 255u) == 0u) { if (xb_ld(&bar[XB_TMO])) break; if (sp > XB_SPIN_CAP) { atomicAdd(&bar[XB_TMO], 1u); break; } }
  }
  nloc = mine > 0u ? mine : 1u; nx = cnt > 0u ? cnt : 1u;
}
DI void xcd_barrier(const XcdBarrier& b) {
  asm volatile("s_waitcnt vmcnt(0)" ::: "memory");
  __syncthreads();
  if (threadIdx.x == 0) {
    unsigned* bar = b.bar;
    __builtin_amdgcn_s_waitcnt(0);
    unsigned nloc = b.st[0], nx = b.st[1];
    if (nloc == 0u) { xcd_barrier_complete(bar, b.x, nloc, nx); b.st[0] = nloc; b.st[1] = nx; }
    const unsigned old = xb_add(&bar[XB_XSUB(b.x)], 1u);
    const unsigned gen = old / nloc;
    if (old + 1u == (gen + 1u) * nloc) {
      __builtin_amdgcn_fence(__ATOMIC_RELEASE, "agent");
      asm volatile("s_waitcnt vmcnt(0)" ::: "memory");
      const unsigned og = xb_add(&bar[XB_TOP], 1u);
      const unsigned tg = og / nx;
      if (og + 1u == (tg + 1u) * nx) xb_add(&bar[XB_TOPGEN], 1u);
      else XB_SPIN(xb_ld(&bar[XB_TOPGEN]) == tg, bar);
      __builtin_amdgcn_fence(__ATOMIC_ACQUIRE, "agent");
      xb_add(&bar[XB_XGEN(b.x)], 1u);
      asm volatile("s_waitcnt vmcnt(0)" ::: "memory");
    } else {
      XB_SPIN(xb_ld(&bar[XB_XGEN(b.x)]) == gen, bar);
      __builtin_amdgcn_fence(__ATOMIC_ACQUIRE, "agent");
      asm volatile("s_waitcnt vmcnt(0)" ::: "memory");
    }
  }
  __syncthreads();
}

template <bool SWAP, class Epi>
DI void gemm_tile(const u16* __restrict__ A, int lda, const u16* __restrict__ Bt, int ldb, int K, int m0, int n0, char* smem, Epi&& epi) {
  u16* As = (u16*)(smem + 16);
  u16* Bs = As + 2 * 128 * 72;
  const int tid = threadIdx.x, lane = tid & 63, w = tid >> 6, wm = w >> 1, wn = w & 1;
  const int r = lane & 31, hi = lane >> 5;
  f32x16 acc[2][2];
#pragma unroll
  for (int a = 0; a < 2; ++a)
#pragma unroll
    for (int b = 0; b < 2; ++b)
#pragma unroll
      for (int i = 0; i < 16; ++i) acc[a][b][i] = 0.f;
  const int srow = tid >> 3, skc = tid & 7;
  const u16* ag = A + (size_t)(m0 + srow) * lda + skc * 8;
  const u16* bg = Bt + (size_t)(n0 + srow) * ldb + skc * 8;
  u16* asw = As + srow * 72 + skc * 8;
  u16* bsw = Bs + srow * 72 + skc * 8;
  u32x4 ra0[4], rb0[4], ra1[4], rb1[4];
#pragma unroll
  for (int i = 0; i < 4; ++i) { ra0[i] = *(const u32x4*)(ag + (size_t)i * 32 * lda); rb0[i] = *(const u32x4*)(bg + (size_t)i * 32 * ldb); }
#pragma unroll
  for (int i = 0; i < 4; ++i) { ra1[i] = *(const u32x4*)(ag + (size_t)i * 32 * lda + 64); rb1[i] = *(const u32x4*)(bg + (size_t)i * 32 * ldb + 64); }
  __syncthreads();
#pragma unroll
  for (int i = 0; i < 4; ++i) { *(u32x4*)(asw + 32 * i * 72) = ra0[i]; *(u32x4*)(bsw + 32 * i * 72) = rb0[i]; }
  __syncthreads();
  const int KT = K >> 6;
  const u16* Asb = As + (wm * 64 + r) * 72 + hi * 8;
  const u16* Bsb = Bs + (wn * 64 + r) * 72 + hi * 8;
  auto compute = [&](int buf) __attribute__((always_inline)) {
    bf16x8 af[2][2], bfr[2][2];
    af[0][0] = *(const bf16x8*)(Asb + buf * 128 * 72);
    af[0][1] = *(const bf16x8*)(Asb + buf * 128 * 72 + 32 * 72);
    bfr[0][0] = *(const bf16x8*)(Bsb + buf * 128 * 72);
    bfr[0][1] = *(const bf16x8*)(Bsb + buf * 128 * 72 + 32 * 72);
#pragma unroll
    for (int ks = 0; ks < 4; ++ks) {
      const int c = ks & 1, n = c ^ 1;
      if (ks < 3) {
        af[n][0] = *(const bf16x8*)(Asb + buf * 128 * 72 + (ks + 1) * 16);
        af[n][1] = *(const bf16x8*)(Asb + buf * 128 * 72 + 32 * 72 + (ks + 1) * 16);
        bfr[n][0] = *(const bf16x8*)(Bsb + buf * 128 * 72 + (ks + 1) * 16);
        bfr[n][1] = *(const bf16x8*)(Bsb + buf * 128 * 72 + 32 * 72 + (ks + 1) * 16);
      }
      __builtin_amdgcn_sched_barrier(0);
#pragma unroll
      for (int mi = 0; mi < 2; ++mi)
#pragma unroll
        for (int ni = 0; ni < 2; ++ni) {
          if (SWAP) acc[mi][ni] = MFMA(bfr[c][ni], af[c][mi], acc[mi][ni]);
          else acc[mi][ni] = MFMA(af[c][mi], bfr[c][ni], acc[mi][ni]);
        }
      __builtin_amdgcn_sched_barrier(0);
    }
  };
  for (int kt = 0; kt < KT; kt += 2) {
    if (kt + 2 < KT) {
      const int k0 = (kt + 2) << 6;
#pragma unroll
      for (int i = 0; i < 4; ++i) { ra0[i] = *(const u32x4*)(ag + (size_t)i * 32 * lda + k0); rb0[i] = *(const u32x4*)(bg + (size_t)i * 32 * ldb + k0); }
    }
    compute(0);
#pragma unroll
    for (int i = 0; i < 4; ++i) { *(u32x4*)(asw + 128 * 72 + 32 * i * 72) = ra1[i]; *(u32x4*)(bsw + 128 * 72 + 32 * i * 72) = rb1[i]; }
    __syncthreads();
    if (kt + 3 < KT) {
      const int k0 = (kt + 3) << 6;
#pragma unroll
      for (int i = 0; i < 4; ++i) { ra1[i] = *(const u32x4*)(ag + (size_t)i * 32 * lda + k0); rb1[i] = *(const u32x4*)(bg + (size_t)i * 32 * ldb + k0); }
    }
    compute(1);
    if (kt + 2 < KT) {
#pragma unroll
      for (int i = 0; i < 4; ++i) { *(u32x4*)(asw + 32 * i * 72) = ra0[i]; *(u32x4*)(bsw + 32 * i * 72) = rb0[i]; }
    }
    __syncthreads();
  }
  epi(acc, m0 + wm * 64, n0 + wn * 64, r, hi);
}

DI void tile_rstd512(const u16* __restrict__ A, int lda, int m0, float* rs) {
  const int tid = threadIdx.x, row = tid >> 1, half = tid & 1;
  const uint4* p = (const uint4*)(A + (size_t)(m0 + row) * lda + half * 256);
  float ss = 0.f;
#pragma unroll 8
  for (int i = 0; i < 32; ++i) {
    uint4 v = p[i];
    ss = dot2(v.x, v.x, ss); ss = dot2(v.y, v.y, ss); ss = dot2(v.z, v.z, ss); ss = dot2(v.w, v.w, ss);
  }
  ss += __shfl_xor(ss, 1);
  if (half == 0) rs[row] = rsqrtf(ss * (1.f / 512.f) + EPS);
}

DI void transpose_item(const float* __restrict__ src, int N, int K, const float* __restrict__ scale, u16* __restrict__ dst, int tk, int tn, char* smem) {
  float* tile = (float*)(smem + 16);
  const int t = threadIdx.x;
  __syncthreads();
  {
    const int rr = t >> 4, c4 = (t & 15) * 4;
#pragma unroll
    for (int ps = 0; ps < 4; ++ps) {
      const int kk = ps * 16 + rr, k = tk * 64 + kk;
      float4 v = nt_load4(src + (size_t)k * N + tn * 64 + c4);
      const float sc = scale ? scale[k] : 1.f;
      tile[kk * 65 + c4 + 0] = v.x * sc; tile[kk * 65 + c4 + 1] = v.y * sc; tile[kk * 65 + c4 + 2] = v.z * sc; tile[kk * 65 + c4 + 3] = v.w * sc;
    }
  }
  __syncthreads();
  {
    const int n = t & 63, kc = (t >> 6) * 16;
    unsigned o[8];
#pragma unroll
    for (int j = 0; j < 8; ++j) o[j] = pk2(tile[(kc + 2 * j) * 65 + n], tile[(kc + 2 * j + 1) * 65 + n]);
    uint4* d = (uint4*)(dst + (size_t)(tn * 64 + n) * K + tk * 64 + kc);
    d[0] = make_uint4(o[0], o[1], o[2], o[3]); d[1] = make_uint4(o[4], o[5], o[6], o[7]);
  }
}

DI void convert_item(const float* __restrict__ src, u16* __restrict__ dst, size_t base) {
  const int t = threadIdx.x;
#pragma unroll
  for (int st = 0; st < 4; ++st) {
    const size_t idx = base + st * 2048 + t * 8;
    float4 a = *(const float4*)(src + idx), b = *(const float4*)(src + idx + 4);
    *(uint4*)(dst + idx) = make_uint4(pk2(a.x, a.y), pk2(a.z, a.w), pk2(b.x, b.y), pk2(b.z, b.w));
  }
}

DI float wave_max(float v) {
#pragma unroll
  for (int o = 32; o >= 1; o >>= 1) v = fmaxf(v, __shfl_xor(v, o));
  return v;
}
DI void fp8_rows_item(const float* __restrict__ src, unsigned char* __restrict__ dst, float* __restrict__ scales, int item) {
  const int lane = threadIdx.x & 63, w = threadIdx.x >> 6;
  const int row = item * 4 + w;
  const float* sr = src + (size_t)row * 2048 + lane * 16;
  float4 v[8];
  float amax = 0.f;
#pragma unroll
  for (int j = 0; j < 2; ++j)
#pragma unroll
    for (int q = 0; q < 4; ++q) {
      const float4 t = nt_load4(sr + 1024 * j + q * 4);
      v[j * 4 + q] = t;
      amax = fmaxf(amax, fmaxf(fmaxf(fabsf(t.x), fabsf(t.y)), fmaxf(fabsf(t.z), fabsf(t.w))));
    }
  amax = wave_max(amax);
  int e = 0;
  if (amax > 0.f) e = (int)floorf(log2f(384.f / amax));
  e = e < -100 ? -100 : (e > 100 ? 100 : e);
  const float sc = ldexpf(1.f, e);
  if (lane == 0) scales[row] = ldexpf(1.f, -e);
#pragma unroll
  for (int j = 0; j < 2; ++j) {
    unsigned d[4];
#pragma unroll
    for (int q = 0; q < 4; ++q) {
      const float4 t = v[j * 4 + q];
      unsigned pk = __builtin_amdgcn_cvt_pk_fp8_f32(t.x * sc, t.y * sc, 0, false);
      pk = __builtin_amdgcn_cvt_pk_fp8_f32(t.z * sc, t.w * sc, pk, true);
      d[q] = pk;
    }
    nt_store4(dst + (size_t)row * 2048 + 1024 * j + lane * 16, d[0], d[1], d[2], d[3]);
  }
}

DI unsigned pack_i8x4(float a, float b, float c, float d) {
  const int ia = __float2int_rn(a), ib = __float2int_rn(b), ic = __float2int_rn(c), id = __float2int_rn(d);
  return (unsigned)(ia & 0xff) | ((unsigned)(ib & 0xff) << 8) | ((unsigned)(ic & 0xff) << 16) | ((unsigned)id << 24);
}
DI void i8_rows_item(const float* __restrict__ src, unsigned char* __restrict__ dst, float* __restrict__ scales, int item) {
  const int lane = threadIdx.x & 63, w = threadIdx.x >> 6;
  const int row = item * 4 + w;
  const float* sr = src + (size_t)row * 2048 + lane * 16;
  float4 v[8];
  float amax = 0.f;
#pragma unroll
  for (int j = 0; j < 2; ++j)
#pragma unroll
    for (int q = 0; q < 4; ++q) {
      const float4 t = nt_load4(sr + 1024 * j + q * 4);
      v[j * 4 + q] = t;
      amax = fmaxf(amax, fmaxf(fmaxf(fabsf(t.x), fabsf(t.y)), fmaxf(fabsf(t.z), fabsf(t.w))));
    }
  amax = wave_max(amax);
  const float sc = amax > 0.f ? 127.f / amax : 0.f;
  if (lane == 0) scales[row] = amax * (1.f / 127.f);
#pragma unroll
  for (int j = 0; j < 2; ++j) {
    unsigned d[4];
#pragma unroll
    for (int q = 0; q < 4; ++q) { const float4 t = v[j * 4 + q]; d[q] = pack_i8x4(t.x * sc, t.y * sc, t.z * sc, t.w * sc); }
    nt_store4(dst + (size_t)row * 2048 + 1024 * j + lane * 16, d[0], d[1], d[2], d[3]);
  }
}

DI void mod_item(const Params& p, int item, char* smem) {
  float* cact = (float*)(smem + 16);
  float* red = cact + 4 * 512;
  const int t = threadIdx.x;
  const int cgi = item % 192, ksp = item / 192, kbase = ksp * 512;
  const float* c = p.in[1]; const float* W = p.in[2];
  float* mod = (float*)(p.ws + WS_MODP);
  __syncthreads();
  for (int i = t; i < 4 * 512; i += 256) { float v = c[(i >> 9) * 2048 + kbase + (i & 511)]; cact[i] = v / (1.f + __expf(-v)); }
  __syncthreads();
  const int cq = t & 15, kl = t >> 4, c0 = cgi * 64;
  float acc[4][4];
#pragma unroll
  for (int b = 0; b < 4; ++b)
#pragma unroll
    for (int j = 0; j < 4; ++j) acc[b][j] = 0.f;
  const float* wp = W + (size_t)(kbase + kl) * 12288 + c0 + cq * 4;
#pragma unroll 8
  for (int i = 0; i < 32; ++i) {
    const int k = kl + 16 * i;
    float4 w4 = nt_load4(wp + (size_t)i * 16 * 12288);
#pragma unroll
    for (int b = 0; b < 4; ++b) {
      const float a = cact[b * 512 + k];
      acc[b][0] += a * w4.x; acc[b][1] += a * w4.y; acc[b][2] += a * w4.z; acc[b][3] += a * w4.w;
    }
  }
#pragma unroll
  for (int b = 0; b < 4; ++b)
#pragma unroll
    for (int j = 0; j < 4; ++j) red[(kl * 16 + cq) * 17 + b * 4 + j] = acc[b][j];
  __syncthreads();
  {
    const int b = t >> 6, col = t & 63, q = col >> 2, j = col & 3;
    float s = 0.f;
#pragma unroll
    for (int k2 = 0; k2 < 16; ++k2) s += red[(k2 * 16 + q) * 17 + b * 4 + j];
    mod[(size_t)ksp * 49152 + b * 12288 + c0 + col] = s;
  }
}

constexpr int P0_MOD = 768;
constexpr int P0_TIN = 32 * 65, P0_TUQ = 8 * 24, P0_TUKV = 8 * 32, P0_TOUT = 32 * 32, P0_TWQ = 32 * 32;
constexpr int P0_SK = 32, P0_UV = 0, P0_ROPE = 32;
DI void phase0(const Params& p, char* smem) {
  constexpr int o1 = P0_MOD, o2 = o1 + P0_TIN, o3 = o2 + P0_TUQ, o4 = o3 + P0_TUKV, o5 = o4 + P0_TOUT, o6 = o5 + P0_TWQ, o7 = o6 + P0_SK, o8 = o7 + P0_UV, o9 = o8 + P0_UV, o10 = o9 + P0_ROPE;
  for (int it = blockIdx.x; it < o10; it += gridDim.x) {
    if (it < o1) mod_item(p, it, smem);
    else if (it < o2) { int j = it - o1; transpose_item(p.in[5], INC, 2048, nullptr, (u16*)(p.ws + WS_WINT), j / 65, j % 65, smem); }
    else if (it < o3) { int j = it - o2; transpose_item(p.in[8], 1536, 512, p.in[7], (u16*)(p.ws + WS_WUQT), j / 24, j % 24, smem); }
    else if (it < o4) { int j = it - o3; transpose_item(p.in[10], 2048, 512, p.in[9], (u16*)(p.ws + WS_WUKVT), j / 32, j % 32, smem); }
    else if (it < o5) { int j = it - o4; int tk = j / 32; transpose_item(p.in[13], 2048, 2048, tk < 16 ? p.in[11] : p.in[12] - 1024, (u16*)(p.ws + WS_WOUTT), tk, j % 32, smem); }
    else if (it < o6) { int j = it - o5; transpose_item(p.in[15], 2048, 2048, nullptr, (u16*)(p.ws + WS_WQT), j / 32, j % 32, smem); }
    else if (it < o7) convert_item(p.in[16], (u16*)(p.ws + WS_SK), (size_t)(it - o6) * 8192);
    else if (it < o8) fp8_rows_item(p.in[17], (unsigned char*)(p.ws + WS_U), (float*)(p.ws + WS_USC), it - o7);
    else if (it < o9) fp8_rows_item(p.in[18], (unsigned char*)(p.ws + WS_V), (float*)(p.ws + WS_VSC), it - o8);
    else {
      float2* rope = (float2*)(p.ws + WS_ROPE);
      const int base = (it - o9) * 2048;
      for (int e = threadIdx.x; e < 2048; e += 256) {
        const int idx = base + e, pos = idx >> 5, j = idx & 31;
        const float inv = 1.0f / powf(10000.0f, (float)(2 * j) / 64.0f);
        const float ang = (float)pos * inv;
        rope[idx] = make_float2(cosf(ang), sinf(ang));
      }
    }
  }
}

template <bool Q8, bool XBF>
DI void norm_rows(const float* __restrict__ X, const float* __restrict__ g, const float* mod, int bstride, u16* __restrict__ out, unsigned char* __restrict__ outq, float* __restrict__ qscale,
                  int row_start, int row_step, int row_end) {
  const int lane = threadIdx.x & 63, w = threadIdx.x >> 6;
  for (int row = row_start + w; row < row_end; row += row_step) {
    const float* xr = X + (size_t)row * D_;
    float4 v[8];
    float ss = 0.f;
#pragma unroll
    for (int j = 0; j < 8; ++j) {
      if (XBF) { const uint2 t = *(const uint2*)((const u16*)X + (size_t)row * D_ + j * 256 + lane * 4); v[j] = make_float4(bflo(t.x), bfhi(t.x), bflo(t.y), bfhi(t.y)); }
      else v[j] = *(const float4*)(xr + j * 256 + lane * 4);
      ss += v[j].x * v[j].x + v[j].y * v[j].y + v[j].z * v[j].z + v[j].w * v[j].w;
    }
    ss = wave_sum(ss);
    const float rstd = rsqrtf(ss * (1.f / D_) + EPS);
    const int b = row >> 11;
    const float* sh = mod + b * bstride;
    const float* sc = sh + 2048;
    float amax = 0.f;
#pragma unroll
    for (int j = 0; j < 8; ++j) {
      const int d = j * 256 + lane * 4;
      const float4 gg = *(const float4*)(g + d), s4 = *(const float4*)(sc + d), h4 = *(const float4*)(sh + d);
      const float o0 = v[j].x * rstd * gg.x * (1.f + s4.x) + h4.x;
      const float o1 = v[j].y * rstd * gg.y * (1.f + s4.y) + h4.y;
      const float o2 = v[j].z * rstd * gg.z * (1.f + s4.z) + h4.z;
      const float o3 = v[j].w * rstd * gg.w * (1.f + s4.w) + h4.w;
      *(uint2*)(out + (size_t)row * D_ + d) = make_uint2(pk2(o0, o1), pk2(o2, o3));
      if (Q8) { v[j] = make_float4(o0, o1, o2, o3); amax = fmaxf(amax, fmaxf(fmaxf(fabsf(o0), fabsf(o1)), fmaxf(fabsf(o2), fabsf(o3)))); }
    }
    if (Q8) {
      amax = wave_max(amax);
      const float qs = amax > 0.f ? 127.f / amax : 0.f;
      if (lane == 0) qscale[row] = amax * (1.f / 127.f);
#pragma unroll
      for (int j = 0; j < 8; ++j) *(unsigned*)(outq + (size_t)row * D_ + j * 256 + lane * 4) = pack_i8x4(v[j].x * qs, v[j].y * qs, v[j].z * qs, v[j].w * qs);
    }
  }
}
DI void phase1(const Params& p, char* smem) {
  const float* mp = (const float*)(p.ws + WS_MODP); float* mod = (float*)(p.ws + WS_MOD); const float* bias = p.in[3];
  for (int i = blockIdx.x * 256 + threadIdx.x; i < 49152; i += gridDim.x * 256)
    mod[i] = ((mp[i] + mp[49152 + i]) + mp[2 * 49152 + i]) + mp[3 * 49152 + i] + bias[i % 12288];
  const int rpb = T_ / (int)gridDim.x, row0 = (int)blockIdx.x * rpb, bb = row0 >> 11;
  float* lm = (float*)(smem + 16);
  __syncthreads();
  for (int c = threadIdx.x; c < 4096; c += 256) {
    const int src = bb * 12288 + c;
    lm[c] = ((mp[src] + mp[49152 + src]) + mp[2 * 49152 + src]) + mp[3 * 49152 + src] + bias[c];
  }
  __syncthreads();
  norm_rows<false, false>(p.in[0], p.in[4], lm, 0, (u16*)(p.ws + WS_H), nullptr, nullptr, row0, 4, row0 + rpb);
}

constexpr int CTR_TILE = 3520, CTR_CHUNK = 3584;
DI int grab(unsigned* ctr, char* smem) {
  __syncthreads();
  if (threadIdx.x == 0) *(volatile unsigned*)(smem + 8) = atomicAdd(ctr, 1u);
  __syncthreads();
  return (int)*(volatile unsigned*)(smem + 8);
}
DI void uv_chunk(const Params& p, int c) {
#pragma unroll 1
  for (int i = 0; i < 4; ++i) {
    const int item = c * 4 + i;
    if (item < 4096) i8_rows_item(p.in[17], (unsigned char*)(p.ws + WS_U), (float*)(p.ws + WS_USC), item);
    else fp8_rows_item(p.in[18], (unsigned char*)(p.ws + WS_V), (float*)(p.ws + WS_VSC), item - 4096);
  }
}
DI void phase2(const Params& p, char* smem, int rep) {
  const u16* H = (const u16*)(p.ws + WS_H); const u16* W = (const u16*)(p.ws + WS_WINT); u16* P = (u16*)(p.ws + WS_P); float* SSQ = (float*)(p.ws + WS_SSQ);
  (void)rep;
  const bool odd = (blockIdx.x & 1) != 0;
  if (odd) for (int c = blockIdx.x; c < 2048; c += gridDim.x) uv_chunk(p, c);
  for (int it = blockIdx.x; it < 64 * 32; it += gridDim.x) {
    const int tn = it / 64, tm = it % 64;
    gemm_tile<true>(H, D_, W, D_, D_, tm * 128, tn * 128, smem, [&](f32x16 (&acc)[2][2], int mb, int nb, int r, int hi) __attribute__((always_inline)) {
#pragma unroll
      for (int mi = 0; mi < 2; ++mi)
#pragma unroll
        for (int ni = 0; ni < 2; ++ni)
#pragma unroll
          for (int g = 0; g < 4; ++g) {
            const int row = mb + mi * 32 + r, col = nb + ni * 32 + hi * 4 + 8 * g;
            *(uint2*)(P + (size_t)row * INC + col) = make_uint2(pk2(acc[mi][ni][4 * g], acc[mi][ni][4 * g + 1]), pk2(acc[mi][ni][4 * g + 2], acc[mi][ni][4 * g + 3]));
          }
      if (nb >= 3072) {
#pragma unroll
        for (int mi = 0; mi < 2; ++mi) {
          float ss = 0.f;
#pragma unroll
          for (int ni = 0; ni < 2; ++ni)
#pragma unroll
            for (int i = 0; i < 16; ++i) ss += acc[mi][ni][i] * acc[mi][ni][i];
          ss += __shfl_xor(ss, 32);
          if (hi == 0) SSQ[(size_t)(mb + mi * 32 + r) * 16 + ((nb - 3072) >> 6)] = ss;
        }
      }
    });
  }
  if (!odd) for (int c = blockIdx.x; c < 2048; c += gridDim.x) uv_chunk(p, c);
}

DI void phase3(const Params& p, char* smem) {
  const u16* P = (const u16*)(p.ws + WS_P);
  u16* Q = (u16*)(p.ws + WS_Q); u16* Kb = (u16*)(p.ws + WS_K); u16* VT = (u16*)(p.ws + WS_VT); u16* MG = (u16*)(p.ws + WS_MG);
  const float2* rope = (const float2*)(p.ws + WS_ROPE); const float* SSQ = (const float*)(p.ws + WS_SSQ);
  float* rs = (float*)(smem + 16 + 2 * 2 * 128 * 72 * 2);
  constexpr int NQ = 64 * 12, NKV = 64 * 16, NKR = 1024, NCV = 1024;
  const float qscale = 0.07216878364870322f * 1.4426950408889634f;
  const int G = (int)gridDim.x, bid = (int)blockIdx.x;
  if (bid < 64) {
    for (int tm = bid; tm < 64; tm += 64) {
      gemm_tile<true>((const u16*)(p.ws + WS_H), D_, (const u16*)(p.ws + WS_WINT), D_, D_, tm * 128, 4096, smem, [&](f32x16 (&acc)[2][2], int mb, int nb, int r, int hi) __attribute__((always_inline)) {
        if (nb != 4096) return;
#pragma unroll
        for (int mi = 0; mi < 2; ++mi) {
          const int row = mb + mi * 32 + r, pos = row & (S_ - 1);
#pragma unroll
          for (int g = 0; g < 4; ++g) {
            const int j = hi * 4 + 8 * g;
            float a0[4], a1[4];
#pragma unroll
            for (int e = 0; e < 4; ++e) {
              const float2 cs = rope[pos * 32 + j + e];
              const float x1 = acc[mi][0][4 * g + e], x2 = acc[mi][1][4 * g + e];
              a0[e] = x1 * cs.x - x2 * cs.y; a1[e] = x2 * cs.x + x1 * cs.y;
            }
            const uint2 lo = make_uint2(pk2(a0[0], a0[1]), pk2(a0[2], a0[3])), hi2 = make_uint2(pk2(a1[0], a1[1]), pk2(a1[2], a1[3]));
#pragma unroll
            for (int h = 0; h < 8; ++h) { *(uint2*)(Kb + (size_t)row * 1536 + h * 192 + 128 + j) = lo; *(uint2*)(Kb + (size_t)row * 1536 + h * 192 + 160 + j) = hi2; }
          }
        }
      });
    }
  }
  const int t_begin = bid < 64 ? NQ + NKV : bid - 64, t_step = G - 64;
  for (int itx = 0; itx < 2; ++itx)
  for (int it = (itx == 0 ? t_begin : NQ + NKV + NKR + bid); it < (itx == 0 ? NQ + NKV : NQ + NKV + NKR + NCV); it += (itx == 0 ? t_step : G)) {
    if (it < NQ) {
      const int tn = it / 64, tm = it % 64;
      __syncthreads();
      if (threadIdx.x < 128) { const float4* sp = (const float4*)(SSQ + (size_t)(tm * 128 + threadIdx.x) * 16); const float4 a = sp[0], b = sp[1]; rs[threadIdx.x] = rsqrtf((((a.x + a.y) + (a.z + a.w)) + ((b.x + b.y) + (b.z + b.w))) * (1.f / 512.f) + EPS); }
      gemm_tile<true>(P + 3072, INC, (const u16*)(p.ws + WS_WUQT), 512, 512, tm * 128, tn * 128, smem, [&](f32x16 (&acc)[2][2], int mb, int nb, int r, int hi) __attribute__((always_inline)) {
        const bool is_rope = ((nb >> 6) % 3) == 2;
#pragma unroll
        for (int mi = 0; mi < 2; ++mi) {
          const int row = mb + mi * 32 + r;
          const float sc = rs[row - tm * 128] * qscale;
          const int pos = row & (S_ - 1);
#pragma unroll
          for (int g = 0; g < 4; ++g) {
            const int j = hi * 4 + 8 * g;
            float a0[4], a1[4];
#pragma unroll
            for (int e = 0; e < 4; ++e) { a0[e] = acc[mi][0][4 * g + e] * sc; a1[e] = acc[mi][1][4 * g + e] * sc; }
            if (is_rope) {
#pragma unroll
              for (int e = 0; e < 4; ++e) {
                const float2 cs = rope[pos * 32 + j + e];
                const float x1 = a0[e], x2 = a1[e];
                a0[e] = x1 * cs.x - x2 * cs.y; a1[e] = x2 * cs.x + x1 * cs.y;
              }
            }
            *(uint2*)(Q + (size_t)row * 1536 + nb + j) = make_uint2(pk2(a0[0], a0[1]), pk2(a0[2], a0[3]));
            *(uint2*)(Q + (size_t)row * 1536 + nb + 32 + j) = make_uint2(pk2(a1[0], a1[1]), pk2(a1[2], a1[3]));
          }
        }
      });
    } else if (it < NQ + NKV) {
      const int j2 = it - NQ, tn = j2 / 64, tm = j2 % 64;
      __syncthreads();
      if (threadIdx.x < 128) { const float4* sp = (const float4*)(SSQ + (size_t)(tm * 128 + threadIdx.x) * 16 + 8); const float4 a = sp[0], b = sp[1]; rs[threadIdx.x] = rsqrtf((((a.x + a.y) + (a.z + a.w)) + ((b.x + b.y) + (b.z + b.w))) * (1.f / 512.f) + EPS); }
      const int head = tn >> 1;
      if ((tn & 1) == 0) {
        gemm_tile<true>(P + 3584, INC, (const u16*)(p.ws + WS_WUKVT), 512, 512, tm * 128, tn * 128, smem, [&](f32x16 (&acc)[2][2], int mb, int nb, int r, int hi) __attribute__((always_inline)) {
#pragma unroll
          for (int mi = 0; mi < 2; ++mi) {
            const int row = mb + mi * 32 + r;
            const float sc = rs[row - tm * 128];
#pragma unroll
            for (int ni = 0; ni < 2; ++ni)
#pragma unroll
              for (int g = 0; g < 4; ++g) {
                const int d = (nb & 127) + ni * 32 + hi * 4 + 8 * g;
                *(uint2*)(Kb + (size_t)row * 1536 + head * 192 + d) = make_uint2(pk2(acc[mi][ni][4 * g] * sc, acc[mi][ni][4 * g + 1] * sc), pk2(acc[mi][ni][4 * g + 2] * sc, acc[mi][ni][4 * g + 3] * sc));
              }
          }
        });
      } else {
        gemm_tile<false>(P + 3584, INC, (const u16*)(p.ws + WS_WUKVT), 512, 512, tm * 128, tn * 128, smem, [&](f32x16 (&acc)[2][2], int mb, int nb, int r, int hi) __attribute__((always_inline)) {
#pragma unroll
          for (int mi = 0; mi < 2; ++mi)
#pragma unroll
            for (int g = 0; g < 4; ++g) {
              const int row0 = mb + mi * 32 + hi * 4 + 8 * g;
              const float s0 = rs[row0 - tm * 128], s1 = rs[row0 + 1 - tm * 128], s2 = rs[row0 + 2 - tm * 128], s3 = rs[row0 + 3 - tm * 128];
              const int b = row0 >> 11, t = row0 & (S_ - 1);
#pragma unroll
              for (int ni = 0; ni < 2; ++ni) {
                const int d = (nb & 127) + ni * 32 + r;
                *(uint2*)(VT + ((size_t)((b * 8 + head) * 128 + d)) * S_ + t) = make_uint2(pk2(acc[mi][ni][4 * g] * s0, acc[mi][ni][4 * g + 1] * s1), pk2(acc[mi][ni][4 * g + 2] * s2, acc[mi][ni][4 * g + 3] * s3));
              }
            }
        });
      }
    } else if (it < NQ + NKV + NKR) {
      const int j2 = it - NQ - NKV;
      const int row = j2 * 8 + (threadIdx.x >> 5), j = threadIdx.x & 31, pos = row & (S_ - 1);
      const float x1 = bflo((unsigned)P[(size_t)row * INC + 4096 + j]), x2 = bflo((unsigned)P[(size_t)row * INC + 4096 + 32 + j]);
      const float2 cs = rope[pos * 32 + j];
      const float o1 = x1 * cs.x - x2 * cs.y, o2 = x2 * cs.x + x1 * cs.y;
      const u16 b1 = (u16)(pk2(o1, 0.f) & 0xffffu), b2 = (u16)(pk2(o2, 0.f) & 0xffffu);
#pragma unroll
      for (int h = 0; h < 8; ++h) { Kb[(size_t)row * 1536 + h * 192 + 128 + j] = b1; Kb[(size_t)row * 1536 + h * 192 + 160 + j] = b2; }
    } else {
      const int j2 = it - NQ - NKV - NKR;
      const int wi = j2 * 4 + (threadIdx.x >> 6), lane = threadIdx.x & 63;
      const int g = wi & 7, run = wi >> 3;
      const int row0 = run * 16, t0 = row0 & (S_ - 1);
      const int ch = g * 128 + lane * 2;
      const float* cw = p.in[6];
      const float w00 = cw[ch], w01 = cw[ch + 1], w10 = cw[1024 + ch], w11 = cw[1024 + ch + 1], w20 = cw[2048 + ch], w21 = cw[2048 + ch + 1];
      float zm1a = 0.f, zm1b = 0.f, zm2a = 0.f, zm2b = 0.f;
      if (t0 > 0) {
        const unsigned c1 = *(const unsigned*)(P + (size_t)(row0 - 1) * INC + 1024 + ch), h1 = *(const unsigned*)(P + (size_t)(row0 - 1) * INC + 2048 + ch);
        const unsigned c2 = *(const unsigned*)(P + (size_t)(row0 - 2) * INC + 1024 + ch), h2 = *(const unsigned*)(P + (size_t)(row0 - 2) * INC + 2048 + ch);
        zm1a = bflo(c1) * bflo(h1); zm1b = bfhi(c1) * bfhi(h1); zm2a = bflo(c2) * bflo(h2); zm2b = bfhi(c2) * bfhi(h2);
      }
#pragma unroll 4
      for (int tt = 0; tt < 16; ++tt) {
        const size_t ro = (size_t)(row0 + tt) * INC;
        const unsigned bb = *(const unsigned*)(P + ro + ch), cc = *(const unsigned*)(P + ro + 1024 + ch), hh = *(const unsigned*)(P + ro + 2048 + ch);
        const float za = bflo(cc) * bflo(hh), zb = bfhi(cc) * bfhi(hh);
        const float ya = bflo(bb) * (w00 * zm2a + w10 * zm1a + w20 * za), yb = bfhi(bb) * (w01 * zm2b + w11 * zm1b + w21 * zb);
        zm2a = zm1a; zm2b = zm1b; zm1a = za; zm1b = zb;
        const float ss = wave_sum(ya * ya + yb * yb);
        const float rstd = rsqrtf(ss * (1.f / 128.f) + EPS);
        *(unsigned*)(MG + (size_t)(row0 + tt) * D_ + ch) = pk2(ya * rstd, yb * rstd);
      }
    }
  }
}

DI void phase4(const Params& p, char* smem) {
  const u16* Q = (const u16*)(p.ws + WS_Q); const u16* Kb = (const u16*)(p.ws + WS_K); const u16* VT = (const u16*)(p.ws + WS_VT);
  u16* MG = (u16*)(p.ws + WS_MG);
  u16* Ks = (u16*)(smem + 16);
  u16* Vs = Ks + 64 * 200;
  float* mrg = (float*)(smem + 16);
  const int tid = threadIdx.x, lane = tid & 63, w = tid >> 6, qh = w & 1, kh = w >> 1, r = lane & 31, hi = lane >> 5;
  for (int it = blockIdx.x; it < 512; it += gridDim.x) {
    const int xq = it & 7, jq = it >> 3, bh = xq + 8 * (jq >> 4);
    const int pi = jq & 15, h = bh & 7, b = bh >> 3;
    for (int sub = 0; sub < 2; ++sub) {
      const int c = sub ? (31 - pi) : pi;
      const size_t qrow = (size_t)b * S_ + c * 64 + qh * 32 + r;
      bf16x8 qf[12];
#pragma unroll
      for (int ks = 0; ks < 12; ++ks) qf[ks] = *(const bf16x8*)(Q + qrow * 1536 + h * 192 + ks * 16 + hi * 8);
      f32x16 O[4];
#pragma unroll
      for (int dt = 0; dt < 4; ++dt)
#pragma unroll
        for (int i = 0; i < 16; ++i) O[dt][i] = 0.f;
      float m = -1e30f, l = 0.f;
      u32x4 kr[6]; u32x4 vr[4];
      const u16* kg = Kb + ((size_t)b * S_ + (tid >> 2)) * 1536 + h * 192 + (tid & 3) * 8;
      const u16* vg = VT + ((size_t)((b * 8 + h) * 128 + (tid >> 1))) * S_ + (tid & 1) * 8;
      u16* ksw = Ks + (tid >> 2) * 200 + (tid & 3) * 8;
      u16* vsw = Vs + (tid >> 1) * 68 + (tid & 1) * 8;
      auto load_tile = [&]() __attribute__((always_inline)) {
#pragma unroll
        for (int i = 0; i < 6; ++i) kr[i] = *(const u32x4*)(kg + i * 32);
#pragma unroll
        for (int i = 0; i < 4; ++i) vr[i] = *(const u32x4*)(vg + i * 16);
        kg += 64 * 1536; vg += 64;
      };
      load_tile();
      for (int kt = 0; kt <= c; ++kt) {
        __syncthreads();
#pragma unroll
        for (int i = 0; i < 6; ++i) *(u32x4*)(ksw + i * 32) = kr[i];
#pragma unroll
        for (int i = 0; i < 4; ++i) { u32x2 lo2 = {vr[i][0], vr[i][1]}, hi2 = {vr[i][2], vr[i][3]}; *(u32x2*)(vsw + i * 16) = lo2; *(u32x2*)(vsw + i * 16 + 4) = hi2; }
        __syncthreads();
        if (kt < c) load_tile();
        f32x16 s;
#pragma unroll
        for (int i = 0; i < 16; ++i) s[i] = 0.f;
        const u16* kp = Ks + (kh * 32 + r) * 200 + hi * 8;
        {
          bf16x8 kf[4];
#pragma unroll
          for (int i = 0; i < 4; ++i) kf[i] = *(const bf16x8*)(kp + i * 16);
#pragma unroll
          for (int ks = 0; ks < 12; ++ks) {
            __builtin_amdgcn_sched_barrier(0);
            s = MFMA(kf[ks & 3], qf[ks], s);
            if (ks + 4 < 12) kf[ks & 3] = *(const bf16x8*)(kp + (ks + 4) * 16);
          }
          __builtin_amdgcn_sched_barrier(0);
        }
        bf16x8 vf0[4];
#pragma unroll
        for (int dt = 0; dt < 4; ++dt) {
          const u16* vp = Vs + (dt * 32 + r) * 68 + kh * 32 + 4 * hi;
          const u32x2 v0 = *(const u32x2*)vp, v1 = *(const u32x2*)(vp + 8);
          const u32x4 vv = {v0[0], v0[1], v1[0], v1[1]};
          vf0[dt] = __builtin_bit_cast(bf16x8, vv);
        }
        float mx = s[0];
#pragma unroll
        for (int i = 1; i < 16; ++i) mx = fmaxf(mx, s[i]);
        mx = fmaxf(mx, __shfl_xor(mx, 32));
        const float mn = fmaxf(m, mx);
        const float alpha = __builtin_amdgcn_exp2f(m - mn);
        const bool resc = __builtin_amdgcn_ballot_w64(mn > m) != 0ull;
        m = mn;
        float rsum = 0.f;
#pragma unroll
        for (int i = 0; i < 16; ++i) { s[i] = __builtin_amdgcn_exp2f(s[i] - mn); rsum += s[i]; }
        l = l * alpha + rsum;
        if (resc) {
#pragma unroll
          for (int dt = 0; dt < 4; ++dt)
#pragma unroll
            for (int i = 0; i < 16; ++i) O[dt][i] *= alpha;
        }
        {
          const u32x4 pu0 = {pk2(s[0], s[1]), pk2(s[2], s[3]), pk2(s[4], s[5]), pk2(s[6], s[7])};
          const u32x4 pu1 = {pk2(s[8], s[9]), pk2(s[10], s[11]), pk2(s[12], s[13]), pk2(s[14], s[15])};
          const bf16x8 pf0 = __builtin_bit_cast(bf16x8, pu0), pf1 = __builtin_bit_cast(bf16x8, pu1);
          bf16x8 vf1[4];
#pragma unroll
          for (int dt = 0; dt < 4; ++dt) {
            const u16* vp = Vs + (dt * 32 + r) * 68 + kh * 32 + 16 + 4 * hi;
            const u32x2 v0 = *(const u32x2*)vp, v1 = *(const u32x2*)(vp + 8);
            const u32x4 vv = {v0[0], v0[1], v1[0], v1[1]};
            vf1[dt] = __builtin_bit_cast(bf16x8, vv);
          }
          __builtin_amdgcn_sched_barrier(0);
#pragma unroll
          for (int dt = 0; dt < 4; ++dt) O[dt] = MFMA(vf0[dt], pf0, O[dt]);
#pragma unroll
          for (int dt = 0; dt < 4; ++dt) O[dt] = MFMA(vf1[dt], pf1, O[dt]);
        }
      }
      l += __shfl_xor(l, 32);
      __syncthreads();
      float* mq = mrg + qh * 66 * 64;
      if (kh == 1) {
#pragma unroll
        for (int dt = 0; dt < 4; ++dt)
#pragma unroll
          for (int i = 0; i < 16; ++i) mq[(dt * 16 + i) * 64 + lane] = O[dt][i];
        mq[64 * 64 + lane] = m; mq[65 * 64 + lane] = l;
      }
      __syncthreads();
      if (kh == 0) {
        const float m1 = mq[64 * 64 + lane], l1 = mq[65 * 64 + lane];
        const float mt = fmaxf(m, m1), a0 = exp2f(m - mt), a1 = exp2f(m1 - mt);
        const float inv = 1.f / (l * a0 + l1 * a1);
        float ss = 0.f;
#pragma unroll
        for (int dt = 0; dt < 4; ++dt)
#pragma unroll
          for (int i = 0; i < 16; ++i) { const float o = (O[dt][i] * a0 + mq[(dt * 16 + i) * 64 + lane] * a1) * inv; O[dt][i] = o; ss += o * o; }
        ss += __shfl_xor(ss, 32);
        const float rstd = rsqrtf(ss * (1.f / 128.f) + EPS);
#pragma unroll
        for (int dt = 0; dt < 4; ++dt)
#pragma unroll
          for (int g = 0; g < 4; ++g) {
            const int d = dt * 32 + hi * 4 + 8 * g;
            *(uint2*)(MG + qrow * D_ + 1024 + h * 128 + d) = make_uint2(pk2(O[dt][4 * g] * rstd, O[dt][4 * g + 1] * rstd), pk2(O[dt][4 * g + 2] * rstd, O[dt][4 * g + 3] * rstd));
          }
      }
    }
  }
}

DI void phase5(const Params& p, char* smem) {
  const u16* MG = (const u16*)(p.ws + WS_MG); const u16* W = (const u16*)(p.ws + WS_WOUTT);
  const float* X = p.in[0]; const float* mod = (const float*)(p.ws + WS_MOD); u16* X1 = (u16*)(p.ws + WS_X1);
  for (int it = blockIdx.x; it < 64 * 16; it += gridDim.x) {
    const int tn = it / 64, tm = it % 64;
    gemm_tile<true>(MG, D_, W, D_, D_, tm * 128, tn * 128, smem, [&](f32x16 (&acc)[2][2], int mb, int nb, int r, int hi) __attribute__((always_inline)) {
#pragma unroll
      for (int mi = 0; mi < 2; ++mi) {
        const int row = mb + mi * 32 + r, b = row >> 11;
        const float* gt = mod + b * 12288 + 2 * 2048;
#pragma unroll
        for (int ni = 0; ni < 2; ++ni)
#pragma unroll
          for (int g = 0; g < 4; ++g) {
            const int col = nb + ni * 32 + hi * 4 + 8 * g;
            const float4 xv = *(const float4*)(X + (size_t)row * D_ + col), gv = *(const float4*)(gt + col);
            float4 o;
            o.x = xv.x + gv.x * acc[mi][ni][4 * g]; o.y = xv.y + gv.y * acc[mi][ni][4 * g + 1]; o.z = xv.z + gv.z * acc[mi][ni][4 * g + 2]; o.w = xv.w + gv.w * acc[mi][ni][4 * g + 3];
            *(uint2*)(X1 + (size_t)row * D_ + col) = make_uint2(pk2(o.x, o.y), pk2(o.z, o.w));
          }
      }
    });
  }
}

DI void phase7(const Params& p, char* smem) {
  const u16* H2 = (const u16*)(p.ws + WS_H); const u16* W = (const u16*)(p.ws + WS_WQT); u16* PQ = (u16*)(p.ws + WS_P);
  for (int it = blockIdx.x; it < 64 * 16; it += gridDim.x) {
    const int tn = it / 64, tm = it % 64;
    gemm_tile<true>(H2, D_, W, D_, D_, tm * 128, tn * 128, smem, [&](f32x16 (&acc)[2][2], int mb, int nb, int r, int hi) __attribute__((always_inline)) {
#pragma unroll
      for (int mi = 0; mi < 2; ++mi)
#pragma unroll
        for (int ni = 0; ni < 2; ++ni)
#pragma unroll
          for (int g = 0; g < 4; ++g) {
            const int row = mb + mi * 32 + r, col = nb + ni * 32 + hi * 4 + 8 * g;
            *(uint2*)(PQ + (size_t)row * D_ + col) = make_uint2(pk2(acc[mi][ni][4 * g], acc[mi][ni][4 * g + 1]), pk2(acc[mi][ni][4 * g + 2], acc[mi][ni][4 * g + 3]));
          }
    });
  }
}

DI unsigned f2ord(float v) { unsigned u = __float_as_uint(v); return u ^ ((unsigned)((int)u >> 31) | 0x80000000u); }
#define TOPK_INSERT(keys, x) { _Pragma("unroll") for (int _j = 0; _j < 16; ++_j) { const unsigned _h = max(keys[_j], x); x = min(keys[_j], x); keys[_j] = _h; } }
DI void phase8(const Params& p, char* smem) {
  const u16* PQ = (const u16*)(p.ws + WS_P); const u16* SK = (const u16*)(p.ws + WS_SK);
  int* IDS = (int*)(p.ws + WS_IDS); float* GATE = (float*)(p.ws + WS_GATE);
  float* sc = (float*)(smem + 16);
  const int tid = threadIdx.x, lane = tid & 63, w = tid >> 6, r = lane & 31, hi = lane >> 5;
  for (int it = blockIdx.x; it < 128 * 8; it += gridDim.x) {
    const int h = it & 7, tile = it >> 3;
    const int pp = w >> 1, rh = w & 1;
    __syncthreads();
    {
      f32x16 acc[4];
#pragma unroll
      for (int nt = 0; nt < 4; ++nt)
#pragma unroll
        for (int i = 0; i < 16; ++i) acc[nt][i] = 0.f;
      const u16* ap = PQ + (size_t)(tile * 64 + rh * 32 + r) * D_ + h * 256 + pp * 128 + hi * 8;
      const u16* bp = SK + ((size_t)(h * 2 + pp) * 128 + r) * 128 + hi * 8;
#pragma unroll
      for (int ks = 0; ks < 8; ++ks) {
        const bf16x8 af = *(const bf16x8*)(ap + ks * 16);
#pragma unroll
        for (int nt = 0; nt < 4; ++nt) { const bf16x8 bf = *(const bf16x8*)(bp + nt * 32 * 128 + ks * 16); acc[nt] = MFMA(af, bf, acc[nt]); }
      }
#pragma unroll
      for (int nt = 0; nt < 4; ++nt)
#pragma unroll
        for (int i = 0; i < 16; ++i) sc[(pp * 64 + rh * 32 + hi * 4 + (i & 3) + 8 * (i >> 2)) * 129 + nt * 32 + r] = acc[nt][i];
    }
    __syncthreads();
    {
      const int rowi = tid & 127, half = tid >> 7;
      float* row = sc + rowi * 129;
      unsigned* mk = (unsigned*)(smem + 16 + 128 * 129 * 4);
      unsigned keys[16];
#pragma unroll
      for (int j = 0; j < 16; ++j) keys[j] = 0u;
#pragma unroll 4
      for (int n2 = 0; n2 < 64; ++n2) {
        const int n = half * 64 + n2;
        unsigned x = (f2ord(row[n]) & 0xFFFFFF80u) | (unsigned)(127 - n);
        TOPK_INSERT(keys, x);
      }
      if (half == 1) {
#pragma unroll
        for (int j = 0; j < 16; ++j) mk[j * 128 + rowi] = keys[j];
      }
      __syncthreads();
      if (half == 0) {
#pragma unroll
        for (int j = 0; j < 16; ++j) { unsigned x = mk[j * 128 + rowi]; TOPK_INSERT(keys, x); }
        float vals[16];
#pragma unroll
        for (int j = 0; j < 16; ++j) vals[j] = row[127 - (keys[j] & 127u)];
#pragma unroll
        for (int j = 0; j < 16; ++j) { row[j] = vals[j]; row[16 + j] = __int_as_float((int)(127 - (keys[j] & 127u))); }
      }
    }
    __syncthreads();
    if (tid < 64) {
      const float* ra = sc + tid * 129; const float* rb = sc + (64 + tid) * 129;
      float a[16], bq[16];
#pragma unroll
      for (int j = 0; j < 16; ++j) { a[j] = ra[j]; bq[j] = rb[j]; }
      unsigned keys[16];
#pragma unroll
      for (int j = 0; j < 16; ++j) keys[j] = 0u;
#pragma unroll
      for (int i = 0; i < 16; ++i)
#pragma unroll
        for (int j = 0; j < 16; ++j)
          if ((i + 1) * (j + 1) <= 16) {
            unsigned x = (f2ord(a[i] + bq[j]) & 0xFFFFFF00u) | (unsigned)(255 - (i * 16 + j));
            TOPK_INSERT(keys, x);
          }
      float bv[16]; int ex[16];
      float mx = -1e30f;
#pragma unroll
      for (int q = 0; q < 16; ++q) {
        const int flat = 255 - (int)(keys[q] & 255u), i = flat >> 4, j = flat & 15;
        bv[q] = ra[i] + rb[j];
        ex[q] = __float_as_int(ra[16 + i]) * 128 + __float_as_int(rb[16 + j]);
        mx = fmaxf(mx, bv[q]);
      }
      float sum = 0.f;
#pragma unroll
      for (int q = 0; q < 16; ++q) { bv[q] = __expf(bv[q] - mx); sum += bv[q]; }
      const float inv = 1.f / sum;
      const size_t o = (size_t)(tile * 64 + tid) * 128 + h * 16;
#pragma unroll
      for (int q = 0; q < 16; q += 4) {
        *(int4*)(IDS + o + q) = make_int4(ex[q], ex[q + 1], ex[q + 2], ex[q + 3]);
        *(float4*)(GATE + o + q) = make_float4(bv[q] * inv, bv[q + 1] * inv, bv[q + 2] * inv, bv[q + 3] * inv);
      }
    }
  }
}

constexpr int CTR_UQ = 4096, CTR_VQ = 4608;
DI f2_t cvt8lo(unsigned w) { return __builtin_amdgcn_cvt_pk_f32_fp8(w, false); }
DI f2_t cvt8hi(unsigned w) { return __builtin_amdgcn_cvt_pk_f32_fp8(w, true); }
template <class F>
DI void xcd_queue(unsigned* ctrs, int nchunks, char* smem, F&& f) {
  const int x0 = (int)(xb_xcc_id() & 7u);
#pragma unroll 1
  for (int k = 0; k < 8; ++k) {
    const int s = (x0 + k) & 7;
    for (;;) { const int c = grab(ctrs + 64 * s, smem); if (c >= nchunks) break; f(s, c); }
  }
}
DI void wave_lds_sync() { asm volatile("s_waitcnt lgkmcnt(0)" ::: "memory"); __builtin_amdgcn_wave_barrier(); }

DI void phase9(const Params& p, char* smem, int rep) {
  const unsigned char* H2Q = (const unsigned char*)(p.ws + WS_H2Q); const unsigned char* U8 = (const unsigned char*)(p.ws + WS_U);
  const int* IDS = (const int*)(p.ws + WS_IDS); int* PA = (int*)(p.ws + WS_PA);
  const int lane = threadIdx.x & 63, w = threadIdx.x >> 6, g = lane >> 4, l15 = lane & 15;
  const int b3 = (lane >> 3) & 1, b2 = (lane >> 2) & 1, b1 = (lane >> 1) & 1, b0 = lane & 1;
  int* lw = (int*)(smem + 16) + w * 256;
  xcd_queue((unsigned*)(p.ws + WS_BAR) + CTR_UQ + rep * 8, 512, smem, [&](int s, int c) __attribute__((always_inline)) {
#pragma unroll 1
    for (int t = 0; t < 4; ++t) {
      const int tok = __builtin_amdgcn_readfirstlane(c * 16 + w * 4 + t);
      const int i0 = IDS[(size_t)tok * 128 + lane], i1 = IDS[(size_t)tok * 128 + 64 + lane];
      const u32x4 hq = *(const u32x4*)(H2Q + (size_t)tok * D_ + s * 256 + l15 * 16);
      wave_lds_sync();
      lw[(lane & 3) * 32 + (lane >> 2)] = i0;
      lw[(lane & 3) * 32 + 16 + (lane >> 2)] = i1;
      wave_lds_sync();
      const unsigned char* ub = U8 + s * 256 + l15 * 16;
#pragma unroll
      for (int batch = 0; batch < 2; ++batch) {
        int ida[16];
#pragma unroll
        for (int q = 0; q < 4; ++q) { const int4 v = *(const int4*)(lw + g * 32 + batch * 16 + q * 4); ida[q * 4] = v.x; ida[q * 4 + 1] = v.y; ida[q * 4 + 2] = v.z; ida[q * 4 + 3] = v.w; }
        u32x4 rows[16];
#pragma unroll
        for (int k = 0; k < 16; ++k) rows[k] = *(const u32x4*)(ub + (size_t)ida[k] * 2048);
        int part[16];
#pragma unroll
        for (int k = 0; k < 16; ++k) {
          int acc = 0;
#pragma unroll
          for (int d = 0; d < 4; ++d) acc = __builtin_amdgcn_sdot4((int)rows[k][d], (int)hq[d], acc, false);
          part[k] = acc;
        }
        int q8[8], q4[4], q2[2];
#pragma unroll
        for (int k = 0; k < 8; ++k) q8[k] = (b3 ? part[8 + k] : part[k]) + __shfl_xor(b3 ? part[k] : part[8 + k], 8);
#pragma unroll
        for (int k = 0; k < 4; ++k) q4[k] = (b2 ? q8[4 + k] : q8[k]) + __shfl_xor(b2 ? q8[k] : q8[4 + k], 4);
#pragma unroll
        for (int k = 0; k < 2; ++k) q2[k] = (b1 ? q4[2 + k] : q4[k]) + __shfl_xor(b1 ? q4[k] : q4[2 + k], 2);
        const int rr = (b0 ? q2[1] : q2[0]) + __shfl_xor(b0 ? q2[0] : q2[1], 1);
        PA[((size_t)s * T_ + tok) * 128 + 4 * (batch * 16 + l15) + g] = rr;
      }
    }
  });
}

DI void phase10(const Params& p) {
  const int* PA = (const int*)(p.ws + WS_PA); float* ACT = (float*)(p.ws + WS_ACT); const float* HSC = (const float*)(p.ws + WS_HSC);
  const int* IDS = (const int*)(p.ws + WS_IDS); const float* GATE = (const float*)(p.ws + WS_GATE);
  const float* USC = (const float*)(p.ws + WS_USC); const float* VSC = (const float*)(p.ws + WS_VSC);
  for (int i = blockIdx.x * 256 + threadIdx.x; i < T_ * 128; i += gridDim.x * 256) {
    int ai = 0;
#pragma unroll
    for (int s = 0; s < 8; ++s) ai += PA[(size_t)s * T_ * 128 + i];
    const int id = IDS[i];
    const float a = (float)ai * USC[id] * HSC[i >> 7];
    ACT[i] = 0.5f * a * (1.f + erff(a * 0.70710678118654752f)) * GATE[i] * VSC[id];
  }
}

DI void phase11(const Params& p, char* smem, int rep) {
  const unsigned char* V8 = (const unsigned char*)(p.ws + WS_V);
  const int* IDS = (const int*)(p.ws + WS_IDS); const float* ACT = (const float*)(p.ws + WS_ACT); u16* OUTP = (u16*)(p.ws + WS_OUTP);
  const int lane = threadIdx.x & 63, w = threadIdx.x >> 6, g = lane >> 4, l15 = lane & 15;
  const int b5 = (lane >> 5) & 1, b4 = (lane >> 4) & 1;
  int* lw = (int*)(smem + 16) + w * 256;
  float* lf = (float*)(lw + 128);
  xcd_queue((unsigned*)(p.ws + WS_BAR) + CTR_VQ + rep * 8, 512, smem, [&](int s, int c) __attribute__((always_inline)) {
#pragma unroll 1
    for (int t = 0; t < 4; ++t) {
      const int tok = __builtin_amdgcn_readfirstlane(c * 16 + w * 4 + t);
      const int i0 = IDS[(size_t)tok * 128 + lane], i1 = IDS[(size_t)tok * 128 + 64 + lane];
      const float a0 = ACT[(size_t)tok * 128 + lane], a1 = ACT[(size_t)tok * 128 + 64 + lane];
      wave_lds_sync();
      lw[(lane & 3) * 32 + (lane >> 2)] = i0; lw[(lane & 3) * 32 + 16 + (lane >> 2)] = i1;
      lf[(lane & 3) * 32 + (lane >> 2)] = a0; lf[(lane & 3) * 32 + 16 + (lane >> 2)] = a1;
      wave_lds_sync();
      f2_t o[8];
#pragma unroll
      for (int i = 0; i < 8; ++i) o[i] = f2_t{0.f, 0.f};
      const unsigned char* vb = V8 + s * 256 + l15 * 16;
#pragma unroll
      for (int batch = 0; batch < 2; ++batch) {
        int ida[16]; float aa[16];
#pragma unroll
        for (int q = 0; q < 4; ++q) {
          const int4 v = *(const int4*)(lw + g * 32 + batch * 16 + q * 4); ida[q * 4] = v.x; ida[q * 4 + 1] = v.y; ida[q * 4 + 2] = v.z; ida[q * 4 + 3] = v.w;
          const float4 f = *(const float4*)(lf + g * 32 + batch * 16 + q * 4); aa[q * 4] = f.x; aa[q * 4 + 1] = f.y; aa[q * 4 + 2] = f.z; aa[q * 4 + 3] = f.w;
        }
        u32x4 rows[16];
#pragma unroll
        for (int k = 0; k < 16; ++k) rows[k] = *(const u32x4*)(vb + (size_t)ida[k] * 2048);
#pragma unroll
        for (int k = 0; k < 16; ++k) {
          const f2_t a2 = {aa[k], aa[k]};
#pragma unroll
          for (int d = 0; d < 4; ++d) { const unsigned ww = rows[k][d]; o[2 * d] += a2 * cvt8lo(ww); o[2 * d + 1] += a2 * cvt8hi(ww); }
        }
      }
      float ov[16];
#pragma unroll
      for (int d = 0; d < 4; ++d) { ov[4 * d] = o[2 * d].x; ov[4 * d + 1] = o[2 * d].y; ov[4 * d + 2] = o[2 * d + 1].x; ov[4 * d + 3] = o[2 * d + 1].y; }
      float q8[8], q4[4];
#pragma unroll
      for (int k = 0; k < 8; ++k) q8[k] = (b5 ? ov[8 + k] : ov[k]) + __shfl_xor(b5 ? ov[k] : ov[8 + k], 32);
#pragma unroll
      for (int k = 0; k < 4; ++k) q4[k] = (b4 ? q8[4 + k] : q8[k]) + __shfl_xor(b4 ? q8[k] : q8[4 + k], 16);
      *(uint2*)(OUTP + (size_t)tok * D_ + s * 256 + l15 * 16 + 8 * b5 + 4 * b4) = make_uint2(pk2(q4[0], q4[1]), pk2(q4[2], q4[3]));
    }
  });
}

DI void phase12(const Params& p) {
  const u16* X1 = (const u16*)(p.ws + WS_X1); const u16* OUTP = (const u16*)(p.ws + WS_OUTP);
  const float* mod = (const float*)(p.ws + WS_MOD); const float* gfin = p.in[19];
  const int lane = threadIdx.x & 63, w = threadIdx.x >> 6;
  for (int row = blockIdx.x * 4 + w; row < T_; row += gridDim.x * 4) {
    const float* gt = mod + (row >> 11) * 12288 + 5 * 2048;
    float4 v[8];
    float ss = 0.f;
#pragma unroll
    for (int j = 0; j < 8; ++j) {
      const int d = j * 256 + lane * 4;
      const uint2 xb2 = *(const uint2*)(X1 + (size_t)row * D_ + d);
      const float4 xv = make_float4(bflo(xb2.x), bfhi(xb2.x), bflo(xb2.y), bfhi(xb2.y)), gv = *(const float4*)(gt + d);
      const uint2 ob = *(const uint2*)(OUTP + (size_t)row * D_ + d);
      const float4 ov = make_float4(bflo(ob.x), bfhi(ob.x), bflo(ob.y), bfhi(ob.y));
      v[j] = make_float4(xv.x + gv.x * ov.x, xv.y + gv.y * ov.y, xv.z + gv.z * ov.z, xv.w + gv.w * ov.w);
      ss += v[j].x * v[j].x + v[j].y * v[j].y + v[j].z * v[j].z + v[j].w * v[j].w;
    }
    ss = wave_sum(ss);
    const float rstd = rsqrtf(ss * (1.f / D_) + EPS);
#pragma unroll
    for (int j = 0; j < 8; ++j) {
      const int d = j * 256 + lane * 4;
      const float4 gv = *(const float4*)(gfin + d);
      { const f32x4v t = {v[j].x * rstd * gv.x, v[j].y * rstd * gv.y, v[j].z * rstd * gv.z, v[j].w * rstd * gv.w}; __builtin_nontemporal_store(t, (f32x4v*)(p.out + (size_t)row * D_ + d)); }
    }
  }
}

DI void phase6(const Params& p) {
  norm_rows<true, true>((const float*)(p.ws + WS_X1), p.in[14], (const float*)(p.ws + WS_MOD) + 3 * 2048, 12288, (u16*)(p.ws + WS_H), (unsigned char*)(p.ws + WS_H2Q), (float*)(p.ws + WS_HSC), (int)blockIdx.x * 4, (int)gridDim.x * 4, T_);
}

__global__ void __launch_bounds__(256, 2) mega(Params p) {
  extern __shared__ __attribute__((aligned(16))) char smem[];
  XcdBarrier xb;
  const bool multi = (p.ph_hi - p.ph_lo) > 1;
  if (multi) {
    if (threadIdx.x == 0) *(uint4*)smem = make_uint4(0u, 0u, 0u, 0u);
    __syncthreads();
    xb = xcd_barrier_post((unsigned*)(p.ws + WS_BAR), (volatile LAS unsigned*)smem);
  }
#ifndef PHMASK
#define PHMASK 0x1fff
#endif
#ifndef REPMASK
#define REPMASK 0
#endif
  int rep = 0;
#define RUN_PHASE(n, call) if (p.ph_lo <= (n) && (n) < p.ph_hi) { \
    if ((n) > p.ph_lo) { xcd_barrier(xb); } \
    if (PHMASK & (1 << (n))) { call; if (REPMASK & (1 << (n))) { xcd_barrier(xb); rep = 1; call; rep = 0; } } }
  RUN_PHASE(0, phase0(p, smem))
  RUN_PHASE(1, phase1(p, smem))
#ifdef BARX
  for (int i = 0; i < BARX; ++i) xcd_barrier(xb);
#endif
  RUN_PHASE(2, phase2(p, smem, rep))
  RUN_PHASE(3, phase3(p, smem))
  RUN_PHASE(4, phase4(p, smem))
  RUN_PHASE(5, phase5(p, smem))
  RUN_PHASE(6, phase6(p))
  RUN_PHASE(7, phase7(p, smem))
  RUN_PHASE(8, phase8(p, smem))
  RUN_PHASE(9, phase9(p, smem, rep))
  RUN_PHASE(10, phase10(p))
  RUN_PHASE(11, phase11(p, smem, rep))
  RUN_PHASE(12, phase12(p))
}

extern "C" void kernel_launch(void* const* d_in, const int* in_sizes, int n_in, void* d_out, int out_size, void* d_ws, size_t ws_size, hipStream_t stream) {
  static int grid = 0;
  if (grid == 0) {
    if (n_in != 20 || ws_size < WS_END) { fprintf(stderr, "kernel_launch: unexpected n_in %d / ws_size %zu (need %zu)\n", n_in, ws_size, (size_t)WS_END); grid = -1; return; }
    int dev = 0, cus = 0, per_cu = 0;
    hipGetDevice(&dev);
    hipDeviceGetAttribute(&cus, hipDeviceAttributeMultiprocessorCount, dev);
    hipFuncSetAttribute((const void*)mega, hipFuncAttributeMaxDynamicSharedMemorySize, LDS_BYTES);
    hipOccupancyMaxActiveBlocksPerMultiprocessor(&per_cu, (const void*)mega, 256, LDS_BYTES);
    if (per_cu < 1) { fprintf(stderr, "kernel_launch: occupancy query says %d\n", per_cu); per_cu = 1; }
    if (per_cu > 2) per_cu = 2;
    grid = cus * per_cu;
    fprintf(stderr, "kernel_launch: grid %d (%d per CU)\n", grid, per_cu);
  }
  if (grid < 0) return;
  Params p{};
  for (int i = 0; i < 20; ++i) p.in[i] = (const float*)d_in[i];
  p.out = (float*)d_out; p.ws = (char*)d_ws;
#if N_LAUNCH_PER_PHASE
  p.coop = 0;
  for (int ph = 0; ph < NPH; ++ph) {
    p.ph_lo = ph; p.ph_hi = ph + 1;
    hipLaunchKernelGGL(mega, dim3(grid), dim3(256), LDS_BYTES, stream, p);
  }
#else
  hipMemsetAsync((char*)d_ws + WS_BAR, 0, WS_MOD, stream);
  p.coop = 0; p.ph_lo = 0; p.ph_hi = NPH;
  void* args[] = {&p};
  hipError_t e = hipLaunchCooperativeKernel((const void*)mega, dim3(grid), dim3(256), args, LDS_BYTES, stream);
  if (e != hipSuccess) fprintf(stderr, "cooperative launch failed: %s (grid %d)\n", hipGetErrorString(e), grid);
#endif
}
```

```cpp
#include <hip/hip_runtime.h>
#include <cstdio>
#include <cstdint>

#ifndef N_LAUNCH_PER_PHASE
#define N_LAUNCH_PER_PHASE 0
#endif

#define DI __device__ __forceinline__
typedef unsigned short u16;
typedef __attribute__((ext_vector_type(8))) short bf16x8;
typedef __attribute__((ext_vector_type(16))) float f32x16;
typedef __attribute__((ext_vector_type(2))) __bf16 bf2_t;
typedef __attribute__((ext_vector_type(2))) float f2_t;
typedef __attribute__((ext_vector_type(4))) unsigned u32x4;
typedef __attribute__((ext_vector_type(2))) unsigned u32x2;
typedef __attribute__((ext_vector_type(4))) float f32x4v;
DI float4 nt_load4(const float* p) { const f32x4v t = __builtin_nontemporal_load((const f32x4v*)p); return make_float4(t[0], t[1], t[2], t[3]); }
DI void nt_store4(void* p, unsigned a, unsigned b, unsigned c, unsigned d) { const u32x4 t = {a, b, c, d}; __builtin_nontemporal_store(t, (u32x4*)p); }
#define MFMA(a, b, c) __builtin_amdgcn_mfma_f32_32x32x16_bf16((a), (b), (c), 0, 0, 0)

constexpr int T_ = 8192, D_ = 2048, S_ = 2048;
constexpr int INC = 4160;
constexpr float EPS = 1e-6f;
constexpr int NPH = 13;

constexpr size_t al256(size_t x) { return (x + 255) & ~(size_t)255; }
constexpr size_t WS_BAR = 0;
constexpr size_t WS_MOD = 32768;
constexpr size_t WS_ROPE = WS_MOD + al256(4 * 12288 * 4);
constexpr size_t WS_WINT = WS_ROPE + al256(2048 * 32 * 8);
constexpr size_t WS_WUQT = WS_WINT + al256((size_t)4224 * 2048 * 2);
constexpr size_t WS_WUKVT = WS_WUQT + al256((size_t)1536 * 512 * 2);
constexpr size_t WS_WOUTT = WS_WUKVT + al256((size_t)2048 * 512 * 2);
constexpr size_t WS_WQT = WS_WOUTT + al256((size_t)2048 * 2048 * 2);
constexpr size_t WS_SK = WS_WQT + al256((size_t)2048 * 2048 * 2);
constexpr size_t WS_U = WS_SK + al256((size_t)262144 * 2);
constexpr size_t WS_V = WS_U + al256((size_t)16384 * 2048);
constexpr size_t WS_H = WS_V + al256((size_t)16384 * 2048);
constexpr size_t WS_P = WS_H + al256((size_t)T_ * D_ * 2);
constexpr size_t WS_Q = WS_P + al256((size_t)T_ * INC * 2);
constexpr size_t WS_K = WS_Q + al256((size_t)T_ * 1536 * 2);
constexpr size_t WS_VT = WS_K + al256((size_t)T_ * 1536 * 2);
constexpr size_t WS_MG = WS_VT + al256((size_t)T_ * 1024 * 2);
constexpr size_t WS_X1 = WS_MG + al256((size_t)T_ * D_ * 2);
constexpr size_t WS_IDS = WS_X1 + al256((size_t)T_ * D_ * 4);
constexpr size_t WS_GATE = WS_IDS + al256((size_t)T_ * 128 * 4);
constexpr size_t WS_USC = WS_GATE + al256((size_t)T_ * 128 * 4);
constexpr size_t WS_VSC = WS_USC + 65536;
constexpr size_t WS_MODP = WS_VSC + 65536;
constexpr size_t WS_ACT = WS_MODP + al256((size_t)4 * 4 * 12288 * 4);
constexpr size_t WS_H2Q = WS_ACT + al256((size_t)T_ * 128 * 4);
constexpr size_t WS_HSC = WS_H2Q + al256((size_t)T_ * D_);
constexpr size_t WS_SSQ = WS_HSC + al256((size_t)T_ * 4);
constexpr size_t WS_END = WS_SSQ + al256((size_t)T_ * 16 * 4);
constexpr size_t WS_PA = WS_MG;
constexpr size_t WS_OUTP = WS_Q;
static_assert(WS_VT + (size_t)T_ * 1024 * 2 - WS_Q >= (size_t)T_ * D_ * 4, "OUTP alias");
static_assert((size_t)8 * T_ * 128 * 4 <= (size_t)T_ * D_ * 2, "PA alias");

constexpr int LDS_BYTES = 16 + 2 * 2 * 128 * 72 * 2 + 512;

struct Params {
  const float* in[20];
  float* out;
  char* ws;
  int ph_lo, ph_hi, coop, pad;
};

DI unsigned pk2(float a, float b) { f2_t v = {a, b}; bf2_t r = __builtin_convertvector(v, bf2_t); return __builtin_bit_cast(unsigned, r); }
DI float bflo(unsigned u) { return __uint_as_float(u << 16); }
DI float bfhi(unsigned u) { return __uint_as_float(u & 0xffff0000u); }
DI float dot2(unsigned a, unsigned b, float c) { return __builtin_amdgcn_fdot2_f32_bf16(__builtin_bit_cast(bf2_t, a), __builtin_bit_cast(bf2_t, b), c, false); }
DI float wave_sum(float v) {
#pragma unroll
  for (int o = 32; o >= 1; o >>= 1) v += __shfl_xor(v, o);
  return v;
}

#define XB_TMO      128
#define XB_XCNT(j)  (256  + 64 * (j))
#define XB_XSUB(j)  (1280 + 64 * (j))
#define XB_XGEN(j)  (2304 + 64 * (j))
#define XB_TOP      3328
#define XB_TOPGEN   3392
#define XCD_BAR_WORDS 3456
#define XB_SPIN_CAP (1u << 22)
#define LAS __attribute__((address_space(3)))
DI unsigned xb_ld(unsigned* p) { return __hip_atomic_load(p, __ATOMIC_RELAXED, __HIP_MEMORY_SCOPE_AGENT); }
DI unsigned xb_add(unsigned* p, unsigned v) { return __hip_atomic_fetch_add(p, v, __ATOMIC_RELAXED, __HIP_MEMORY_SCOPE_AGENT); }
DI unsigned xb_xcc_id() { return (unsigned)__builtin_amdgcn_s_getreg((3 << 11) | 20) & 0xFu; }
#define XB_SPIN(cond, bar) do { unsigned _sp = 0; while (cond) { __builtin_amdgcn_s_sleep(1); \
    if ((++_sp & 255u) == 0u) { if (xb_ld(&(bar)[XB_TMO])) break; if (_sp > XB_SPIN_CAP) { atomicAdd(&(bar)[XB_TMO], 1u); break; } } } } while (0)
struct XcdBarrier { unsigned* bar; unsigned x; volatile LAS unsigned* st; };
DI XcdBarrier xcd_barrier_post(unsigned* bar, volatile LAS unsigned* st) {
  XcdBarrier b; b.bar = bar; b.x = xb_xcc_id(); b.st = st;
  if (threadIdx.x == 0) (void)xb_add(&bar[XB_XCNT(b.x)], 1u);
  return b;
}
DI void xcd_barrier_complete(unsigned* bar, unsigned x, unsigned& nloc, unsigned& nx) {
  const unsigned G = gridDim.x * gridDim.y * gridDim.z;
  unsigned sum, cnt, mine, sp = 0u;
  for (;;) {
    sum = 0u; cnt = 0u; mine = 0u;
#pragma unroll
    for (unsigned j = 0; j < 16; ++j) { const unsigned c = xb_ld(&bar[XB_XCNT(j)]); sum += c; cnt += (c > 0u) ? 1u : 0u; mine = (j == x) ? c : mine; }
    if (sum == G) break;
    __builtin_amdgcn_s_sleep(1);
    if ((++sp & 255u) == 0u) { if (xb_ld(&bar[XB_TMO])) break; if (sp > XB_SPIN_CAP) { atomicAdd(&bar[XB_TMO], 1u); break; } }
  }
  nloc = mine > 0u ? mine : 1u; nx = cnt > 0u ? cnt : 1u;
}
DI void xcd_barrier(const XcdBarrier& b) {
  asm volatile("s_waitcnt vmcnt(0)" ::: "memory");
  __syncthreads();
  if (threadIdx.x == 0) {
    unsigned* bar = b.bar;
    __builtin_amdgcn_s_waitcnt(0);
    unsigned nloc = b.st[0], nx = b.st[1];
    if (nloc == 0u) { xcd_barrier_complete(bar, b.x, nloc, nx); b.st[0] = nloc; b.st[1] = nx; }
    const unsigned old = xb_add(&bar[XB_XSUB(b.x)], 1u);
    const unsigned gen = old / nloc;
    if (old + 1u == (gen + 1u) * nloc) {
      __builtin_amdgcn_fence(__ATOMIC_RELEASE, "agent");
      asm volatile("s_waitcnt vmcnt(0)" ::: "memory");
      const unsigned og = xb_add(&bar[XB_TOP], 1u);
      const unsigned tg = og / nx;
      if (og + 1u == (tg + 1u) * nx) xb_add(&bar[XB_TOPGEN], 1u);
      else XB_SPIN(xb_ld(&bar[XB_TOPGEN]) == tg, bar);
      __builtin_amdgcn_fence(__ATOMIC_ACQUIRE, "agent");
      xb_add(&bar[XB_XGEN(b.x)], 1u);
      asm volatile("s_waitcnt vmcnt(0)" ::: "memory");
    } else {
      XB_SPIN(xb_ld(&bar[XB_XGEN(b.x)]) == gen, bar);
      __builtin_amdgcn_fence(__ATOMIC_ACQUIRE, "agent");
      asm volatile("s_waitcnt vmcnt(0)" ::: "memory");
    }
  }
  __syncthreads();
}

template <class BG>
DI void xcd_barrier_bg(const XcdBarrier b, char* smem, BG bg) {
  asm volatile("s_waitcnt vmcnt(0)" ::: "memory");
  __syncthreads();
  volatile unsigned* sst = (volatile unsigned*)(smem + 12);
  unsigned mygen = 0u;
  if (threadIdx.x == 0) {
    unsigned* bar = b.bar;
    __builtin_amdgcn_s_waitcnt(0);
    unsigned nloc = b.st[0], nx = b.st[1];
    if (nloc == 0u) { xcd_barrier_complete(bar, b.x, nloc, nx); b.st[0] = nloc; b.st[1] = nx; }
    const unsigned old = xb_add(&bar[XB_XSUB(b.x)], 1u);
    const unsigned gen = old / nloc;
    mygen = gen;
    if (old + 1u == (gen + 1u) * nloc) {
      __builtin_amdgcn_fence(__ATOMIC_RELEASE, "agent");
      asm volatile("s_waitcnt vmcnt(0)" ::: "memory");
      const unsigned og = xb_add(&bar[XB_TOP], 1u);
      const unsigned tg = og / nx;
      if (og + 1u == (tg + 1u) * nx) xb_add(&bar[XB_TOPGEN], 1u);
      else XB_SPIN(xb_ld(&bar[XB_TOPGEN]) == tg, bar);
      __builtin_amdgcn_fence(__ATOMIC_ACQUIRE, "agent");
      xb_add(&bar[XB_XGEN(b.x)], 1u);
      asm volatile("s_waitcnt vmcnt(0)" ::: "memory");
      *sst = 1u;
    } else {
      *sst = 0u;
    }
  }
  __syncthreads();
  if (*sst == 0u) {
    bool more = true;
    unsigned polls = 0u;
    for (;;) {
      if (threadIdx.x == 0) {
        bool rel = xb_ld(&b.bar[XB_XGEN(b.x)]) != mygen;
        if (!rel && (++polls & 1023u) == 0u) { if (xb_ld(&b.bar[XB_TMO])) rel = true; else if (polls > XB_SPIN_CAP) { atomicAdd(&b.bar[XB_TMO], 1u); rel = true; } }
        *sst = rel ? 2u : 0u;
      }
      __syncthreads();
      const unsigned stv = *sst;
      if (stv == 2u) break;
      if (more) more = bg(); else __builtin_amdgcn_s_sleep(2);
      __syncthreads();
    }
    if (threadIdx.x == 0) {
      __builtin_amdgcn_fence(__ATOMIC_ACQUIRE, "agent");
      asm volatile("s_waitcnt vmcnt(0)" ::: "memory");
    }
    __syncthreads();
  }
}

template <bool SWAP, class Epi>
DI void gemm_tile(const u16* __restrict__ A, int lda, const u16* __restrict__ Bt, int ldb, int K, int m0, int n0, char* smem, Epi&& epi) {
  u16* As = (u16*)(smem + 16);
  u16* Bs = As + 2 * 128 * 72;
  const int tid = threadIdx.x, lane = tid & 63, w = tid >> 6, wm = w >> 1, wn = w & 1;
  const int r = lane & 31, hi = lane >> 5;
  f32x16 acc[2][2];
#pragma unroll
  for (int a = 0; a < 2; ++a)
#pragma unroll
    for (int b = 0; b < 2; ++b)
#pragma unroll
      for (int i = 0; i < 16; ++i) acc[a][b][i] = 0.f;
  const int srow = tid >> 3, skc = tid & 7;
  const u16* ag = A + (size_t)(m0 + srow) * lda + skc * 8;
  const u16* bg = Bt + (size_t)(n0 + srow) * ldb + skc * 8;
  u16* asw = As + srow * 72 + skc * 8;
  u16* bsw = Bs + srow * 72 + skc * 8;
  u32x4 ra0[4], rb0[4], ra1[4], rb1[4];
#pragma unroll
  for (int i = 0; i < 4; ++i) { ra0[i] = *(const u32x4*)(ag + (size_t)i * 32 * lda); rb0[i] = *(const u32x4*)(bg + (size_t)i * 32 * ldb); }
#pragma unroll
  for (int i = 0; i < 4; ++i) { ra1[i] = *(const u32x4*)(ag + (size_t)i * 32 * lda + 64); rb1[i] = *(const u32x4*)(bg + (size_t)i * 32 * ldb + 64); }
  __syncthreads();
#pragma unroll
  for (int i = 0; i < 4; ++i) { *(u32x4*)(asw + 32 * i * 72) = ra0[i]; *(u32x4*)(bsw + 32 * i * 72) = rb0[i]; }
  __syncthreads();
  const int KT = K >> 6;
  const u16* Asb = As + (wm * 64 + r) * 72 + hi * 8;
  const u16* Bsb = Bs + (wn * 64 + r) * 72 + hi * 8;
  auto compute = [&](int buf) __attribute__((always_inline)) {
    bf16x8 af[2][2], bfr[2][2];
    af[0][0] = *(const bf16x8*)(Asb + buf * 128 * 72);
    af[0][1] = *(const bf16x8*)(Asb + buf * 128 * 72 + 32 * 72);
    bfr[0][0] = *(const bf16x8*)(Bsb + buf * 128 * 72);
    bfr[0][1] = *(const bf16x8*)(Bsb + buf * 128 * 72 + 32 * 72);
#pragma unroll
    for (int ks = 0; ks < 4; ++ks) {
      const int c = ks & 1, n = c ^ 1;
      if (ks < 3) {
        af[n][0] = *(const bf16x8*)(Asb + buf * 128 * 72 + (ks + 1) * 16);
        af[n][1] = *(const bf16x8*)(Asb + buf * 128 * 72 + 32 * 72 + (ks + 1) * 16);
        bfr[n][0] = *(const bf16x8*)(Bsb + buf * 128 * 72 + (ks + 1) * 16);
        bfr[n][1] = *(const bf16x8*)(Bsb + buf * 128 * 72 + 32 * 72 + (ks + 1) * 16);
      }
      __builtin_amdgcn_sched_barrier(0);
#pragma unroll
      for (int mi = 0; mi < 2; ++mi)
#pragma unroll
        for (int ni = 0; ni < 2; ++ni) {
          if (SWAP) acc[mi][ni] = MFMA(bfr[c][ni], af[c][mi], acc[mi][ni]);
          else acc[mi][ni] = MFMA(af[c][mi], bfr[c][ni], acc[mi][ni]);
        }
      __builtin_amdgcn_sched_barrier(0);
    }
  };
  for (int kt = 0; kt < KT; kt += 2) {
    if (kt + 2 < KT) {
      const int k0 = (kt + 2) << 6;
#pragma unroll
      for (int i = 0; i < 4; ++i) { ra0[i] = *(const u32x4*)(ag + (size_t)i * 32 * lda + k0); rb0[i] = *(const u32x4*)(bg + (size_t)i * 32 * ldb + k0); }
    }
    compute(0);
#pragma unroll
    for (int i = 0; i < 4; ++i) { *(u32x4*)(asw + 128 * 72 + 32 * i * 72) = ra1[i]; *(u32x4*)(bsw + 128 * 72 + 32 * i * 72) = rb1[i]; }
    __syncthreads();
    if (kt + 3 < KT) {
      const int k0 = (kt + 3) << 6;
#pragma unroll
      for (int i = 0; i < 4; ++i) { ra1[i] = *(const u32x4*)(ag + (size_t)i * 32 * lda + k0); rb1[i] = *(const u32x4*)(bg + (size_t)i * 32 * ldb + k0); }
    }
    compute(1);
    if (kt + 2 < KT) {
#pragma unroll
      for (int i = 0; i < 4; ++i) { *(u32x4*)(asw + 32 * i * 72) = ra0[i]; *(u32x4*)(bsw + 32 * i * 72) = rb0[i]; }
    }
    __syncthreads();
  }
  epi(acc, m0 + wm * 64, n0 + wn * 64, r, hi);
}

DI void tile_rstd512(const u16* __restrict__ A, int lda, int m0, float* rs) {
  const int tid = threadIdx.x, row = tid >> 1, half = tid & 1;
  const uint4* p = (const uint4*)(A + (size_t)(m0 + row) * lda + half * 256);
  float ss = 0.f;
#pragma unroll 8
  for (int i = 0; i < 32; ++i) {
    uint4 v = p[i];
    ss = dot2(v.x, v.x, ss); ss = dot2(v.y, v.y, ss); ss = dot2(v.z, v.z, ss); ss = dot2(v.w, v.w, ss);
  }
  ss += __shfl_xor(ss, 1);
  if (half == 0) rs[row] = rsqrtf(ss * (1.f / 512.f) + EPS);
}

DI void transpose_item(const float* __restrict__ src, int N, int K, const float* __restrict__ scale, u16* __restrict__ dst, int tk, int tn, char* smem) {
  float* tile = (float*)(smem + 16);
  const int t = threadIdx.x;
  __syncthreads();
  {
    const int rr = t >> 4, c4 = (t & 15) * 4;
#pragma unroll
    for (int ps = 0; ps < 4; ++ps) {
      const int kk = ps * 16 + rr, k = tk * 64 + kk;
      float4 v = nt_load4(src + (size_t)k * N + tn * 64 + c4);
      const float sc = scale ? scale[k] : 1.f;
      tile[kk * 65 + c4 + 0] = v.x * sc; tile[kk * 65 + c4 + 1] = v.y * sc; tile[kk * 65 + c4 + 2] = v.z * sc; tile[kk * 65 + c4 + 3] = v.w * sc;
    }
  }
  __syncthreads();
  {
    const int n = t & 63, kc = (t >> 6) * 16;
    unsigned o[8];
#pragma unroll
    for (int j = 0; j < 8; ++j) o[j] = pk2(tile[(kc + 2 * j) * 65 + n], tile[(kc + 2 * j + 1) * 65 + n]);
    uint4* d = (uint4*)(dst + (size_t)(tn * 64 + n) * K + tk * 64 + kc);
    d[0] = make_uint4(o[0], o[1], o[2], o[3]); d[1] = make_uint4(o[4], o[5], o[6], o[7]);
  }
}

DI void convert_item(const float* __restrict__ src, u16* __restrict__ dst, size_t base) {
  const int t = threadIdx.x;
#pragma unroll
  for (int st = 0; st < 4; ++st) {
    const size_t idx = base + st * 2048 + t * 8;
    float4 a = *(const float4*)(src + idx), b = *(const float4*)(src + idx + 4);
    *(uint4*)(dst + idx) = make_uint4(pk2(a.x, a.y), pk2(a.z, a.w), pk2(b.x, b.y), pk2(b.z, b.w));
  }
}

DI float wave_max(float v) {
#pragma unroll
  for (int o = 32; o >= 1; o >>= 1) v = fmaxf(v, __shfl_xor(v, o));
  return v;
}
DI void fp8_rows_item(const float* __restrict__ src, unsigned char* __restrict__ dst, float* __restrict__ scales, int item) {
  const int lane = threadIdx.x & 63, w = threadIdx.x >> 6;
  const int row = item * 4 + w;
  const float* sr = src + (size_t)row * 2048 + lane * 16;
  f32x4v v[8];
  float amax = 0.f;
#pragma unroll
  for (int j = 0; j < 2; ++j)
#pragma unroll
    for (int q = 0; q < 4; ++q) {
      const f32x4v t = __builtin_nontemporal_load((const f32x4v*)(sr + 1024 * j + q * 4));
      v[j * 4 + q] = t;
      amax = fmaxf(amax, fmaxf(fmaxf(fabsf(t[0]), fabsf(t[1])), fmaxf(fabsf(t[2]), fabsf(t[3]))));
    }
  amax = wave_max(amax);
  int e = 0;
  if (amax > 0.f) e = (int)floorf(log2f(384.f / amax));
  e = e < -100 ? -100 : (e > 100 ? 100 : e);
  const float sc = ldexpf(1.f, e);
  if (lane == 0) scales[row] = ldexpf(1.f, -e);
#pragma unroll
  for (int j = 0; j < 2; ++j) {
    unsigned d[4];
#pragma unroll
    for (int q = 0; q < 4; ++q) {
      const f32x4v t = v[j * 4 + q];
      unsigned pk = __builtin_amdgcn_cvt_pk_fp8_f32(t[0] * sc, t[1] * sc, 0, false);
      pk = __builtin_amdgcn_cvt_pk_fp8_f32(t[2] * sc, t[3] * sc, pk, true);
      d[q] = pk;
    }
    nt_store4(dst + (size_t)row * 2048 + 1024 * j + lane * 16, d[0], d[1], d[2], d[3]);
  }
}

DI unsigned pack_i8x4(float a, float b, float c, float d) {
  const int ia = __float2int_rn(a), ib = __float2int_rn(b), ic = __float2int_rn(c), id = __float2int_rn(d);
  return (unsigned)(ia & 0xff) | ((unsigned)(ib & 0xff) << 8) | ((unsigned)(ic & 0xff) << 16) | ((unsigned)id << 24);
}
DI void i8_rows_item(const float* __restrict__ src, unsigned char* __restrict__ dst, float* __restrict__ scales, int item) {
  const int lane = threadIdx.x & 63, w = threadIdx.x >> 6;
  const int row = item * 4 + w;
  const float* sr = src + (size_t)row * 2048 + lane * 16;
  f32x4v v[8];
  float amax = 0.f;
#pragma unroll
  for (int j = 0; j < 2; ++j)
#pragma unroll
    for (int q = 0; q < 4; ++q) {
      const f32x4v t = __builtin_nontemporal_load((const f32x4v*)(sr + 1024 * j + q * 4));
      v[j * 4 + q] = t;
      amax = fmaxf(amax, fmaxf(fmaxf(fabsf(t[0]), fabsf(t[1])), fmaxf(fabsf(t[2]), fabsf(t[3]))));
    }
  amax = wave_max(amax);
  const float sc = amax > 0.f ? 127.f / amax : 0.f;
  if (lane == 0) scales[row] = amax * (1.f / 127.f);
#pragma unroll
  for (int j = 0; j < 2; ++j) {
    unsigned d[4];
#pragma unroll
    for (int q = 0; q < 4; ++q) { const f32x4v t = v[j * 4 + q]; d[q] = pack_i8x4(t[0] * sc, t[1] * sc, t[2] * sc, t[3] * sc); }
    nt_store4(dst + (size_t)row * 2048 + 1024 * j + lane * 16, d[0], d[1], d[2], d[3]);
  }
}

DI void conv_rows_item(const float* __restrict__ src, unsigned char* __restrict__ dst, float* __restrict__ scales, int item, bool i8) {
  const int lane = threadIdx.x & 63, w = threadIdx.x >> 6;
  const int row = item * 4 + w;
  const float* sr = src + (size_t)row * 2048 + lane * 16;
  f32x4v v[8];
  float amax = 0.f;
#pragma unroll
  for (int j = 0; j < 2; ++j)
#pragma unroll
    for (int q = 0; q < 4; ++q) {
      const f32x4v t = __builtin_nontemporal_load((const f32x4v*)(sr + 1024 * j + q * 4));
      v[j * 4 + q] = t;
      amax = fmaxf(amax, fmaxf(fmaxf(fabsf(t[0]), fabsf(t[1])), fmaxf(fabsf(t[2]), fabsf(t[3]))));
    }
  amax = wave_max(amax);
  int e = 0;
  if (amax > 0.f) e = (int)floorf(log2f(384.f / amax));
  e = e < -100 ? -100 : (e > 100 ? 100 : e);
  const float sc = i8 ? (amax > 0.f ? 127.f / amax : 0.f) : ldexpf(1.f, e);
  const float inv = i8 ? amax * (1.f / 127.f) : ldexpf(1.f, -e);
  if (lane == 0) scales[row] = inv;
#pragma unroll
  for (int j = 0; j < 2; ++j) {
    unsigned d0, d1, d2, d3;
    {
      const f32x4v t0 = v[j * 4] * sc, t1 = v[j * 4 + 1] * sc, t2 = v[j * 4 + 2] * sc, t3 = v[j * 4 + 3] * sc;
      if (i8) { d0 = pack_i8x4(t0[0], t0[1], t0[2], t0[3]); d1 = pack_i8x4(t1[0], t1[1], t1[2], t1[3]); d2 = pack_i8x4(t2[0], t2[1], t2[2], t2[3]); d3 = pack_i8x4(t3[0], t3[1], t3[2], t3[3]); }
      else {
        d0 = __builtin_amdgcn_cvt_pk_fp8_f32(t0[2], t0[3], __builtin_amdgcn_cvt_pk_fp8_f32(t0[0], t0[1], 0, false), true);
        d1 = __builtin_amdgcn_cvt_pk_fp8_f32(t1[2], t1[3], __builtin_amdgcn_cvt_pk_fp8_f32(t1[0], t1[1], 0, false), true);
        d2 = __builtin_amdgcn_cvt_pk_fp8_f32(t2[2], t2[3], __builtin_amdgcn_cvt_pk_fp8_f32(t2[0], t2[1], 0, false), true);
        d3 = __builtin_amdgcn_cvt_pk_fp8_f32(t3[2], t3[3], __builtin_amdgcn_cvt_pk_fp8_f32(t3[0], t3[1], 0, false), true);
      }
    }
    nt_store4(dst + (size_t)row * 2048 + 1024 * j + lane * 16, d0, d1, d2, d3);
  }
}

DI void mod_item(const Params& p, int item, char* smem) {
  float* cact = (float*)(smem + 16);
  float* red = cact + 4 * 512;
  const int t = threadIdx.x;
  const int cgi = item % 192, ksp = item / 192, kbase = ksp * 512;
  const float* c = p.in[1]; const float* W = p.in[2];
  float* mod = (float*)(p.ws + WS_MODP);
  __syncthreads();
  for (int i = t; i < 4 * 512; i += 256) { float v = c[(i >> 9) * 2048 + kbase + (i & 511)]; cact[i] = v / (1.f + __expf(-v)); }
  __syncthreads();
  const int cq = t & 15, kl = t >> 4, c0 = cgi * 64;
  float acc[4][4];
#pragma unroll
  for (int b = 0; b < 4; ++b)
#pragma unroll
    for (int j = 0; j < 4; ++j) acc[b][j] = 0.f;
  const float* wp = W + (size_t)(kbase + kl) * 12288 + c0 + cq * 4;
#pragma unroll 8
  for (int i = 0; i < 32; ++i) {
    const int k = kl + 16 * i;
    float4 w4 = nt_load4(wp + (size_t)i * 16 * 12288);
#pragma unroll
    for (int b = 0; b < 4; ++b) {
      const float a = cact[b * 512 + k];
      acc[b][0] += a * w4.x; acc[b][1] += a * w4.y; acc[b][2] += a * w4.z; acc[b][3] += a * w4.w;
    }
  }
#pragma unroll
  for (int b = 0; b < 4; ++b)
#pragma unroll
    for (int j = 0; j < 4; ++j) red[(kl * 16 + cq) * 17 + b * 4 + j] = acc[b][j];
  __syncthreads();
  {
    const int b = t >> 6, col = t & 63, q = col >> 2, j = col & 3;
    float s = 0.f;
#pragma unroll
    for (int k2 = 0; k2 < 16; ++k2) s += red[(k2 * 16 + q) * 17 + b * 4 + j];
    mod[(size_t)ksp * 49152 + b * 12288 + c0 + col] = s;
  }
}

constexpr int P0_MOD = 768;
constexpr int P0_TIN = 32 * 65, P0_TUQ = 8 * 24, P0_TUKV = 8 * 32, P0_TOUT = 32 * 32, P0_TWQ = 32 * 32;
constexpr int P0_SK = 32, P0_UV = 0, P0_ROPE = 32;
DI void phase0(const Params& p, char* smem) {
  constexpr int o1 = P0_MOD, o2 = o1 + P0_TIN, o3 = o2 + P0_TUQ, o4 = o3 + P0_TUKV, o5 = o4 + P0_TOUT, o6 = o5 + P0_TWQ, o7 = o6 + P0_SK, o8 = o7 + P0_UV, o9 = o8 + P0_UV, o10 = o9 + P0_ROPE;
  for (int it = blockIdx.x; it < o10; it += gridDim.x) {
    if (it < o1) mod_item(p, it, smem);
    else if (it < o2) { int j = it - o1; transpose_item(p.in[5], INC, 2048, nullptr, (u16*)(p.ws + WS_WINT), j / 65, j % 65, smem); }
    else if (it < o3) { int j = it - o2; transpose_item(p.in[8], 1536, 512, p.in[7], (u16*)(p.ws + WS_WUQT), j / 24, j % 24, smem); }
    else if (it < o4) { int j = it - o3; transpose_item(p.in[10], 2048, 512, p.in[9], (u16*)(p.ws + WS_WUKVT), j / 32, j % 32, smem); }
    else if (it < o5) { int j = it - o4; int tk = j / 32; transpose_item(p.in[13], 2048, 2048, tk < 16 ? p.in[11] : p.in[12] - 1024, (u16*)(p.ws + WS_WOUTT), tk, j % 32, smem); }
    else if (it < o6) { int j = it - o5; transpose_item(p.in[15], 2048, 2048, nullptr, (u16*)(p.ws + WS_WQT), j / 32, j % 32, smem); }
    else if (it < o7) convert_item(p.in[16], (u16*)(p.ws + WS_SK), (size_t)(it - o6) * 8192);
    else if (it < o8) fp8_rows_item(p.in[17], (unsigned char*)(p.ws + WS_U), (float*)(p.ws + WS_USC), it - o7);
    else if (it < o9) fp8_rows_item(p.in[18], (unsigned char*)(p.ws + WS_V), (float*)(p.ws + WS_VSC), it - o8);
    else {
      float2* rope = (float2*)(p.ws + WS_ROPE);
      const int base = (it - o9) * 2048;
      for (int e = threadIdx.x; e < 2048; e += 256) {
        const int idx = base + e, pos = idx >> 5, j = idx & 31;
        const float inv = 1.0f / powf(10000.0f, (float)(2 * j) / 64.0f);
        const float ang = (float)pos * inv;
        rope[idx] = make_float2(cosf(ang), sinf(ang));
      }
    }
  }
}

template <bool Q8, bool XBF>
DI void norm_rows(const float* __restrict__ X, const float* __restrict__ g, const float* mod, int bstride, u16* __restrict__ out, unsigned char* __restrict__ outq, float* __restrict__ qscale,
                  int row_start, int row_step, int row_end) {
  const int lane = threadIdx.x & 63, w = threadIdx.x >> 6;
  for (int row = row_start + w; row < row_end; row += row_step) {
    const float* xr = X + (size_t)row * D_;
    float4 v[8];
    float ss = 0.f;
#pragma unroll
    for (int j = 0; j < 8; ++j) {
      if (XBF) { const uint2 t = *(const uint2*)((const u16*)X + (size_t)row * D_ + j * 256 + lane * 4); v[j] = make_float4(bflo(t.x), bfhi(t.x), bflo(t.y), bfhi(t.y)); }
      else v[j] = *(const float4*)(xr + j * 256 + lane * 4);
      ss += v[j].x * v[j].x + v[j].y * v[j].y + v[j].z * v[j].z + v[j].w * v[j].w;
    }
    ss = wave_sum(ss);
    const float rstd = rsqrtf(ss * (1.f / D_) + EPS);
    const int b = row >> 11;
    const float* sh = mod + b * bstride;
    const float* sc = sh + 2048;
    float amax = 0.f;
#pragma unroll
    for (int j = 0; j < 8; ++j) {
      const int d = j * 256 + lane * 4;
      const float4 gg = *(const float4*)(g + d), s4 = *(const float4*)(sc + d), h4 = *(const float4*)(sh + d);
      const float o0 = v[j].x * rstd * gg.x * (1.f + s4.x) + h4.x;
      const float o1 = v[j].y * rstd * gg.y * (1.f + s4.y) + h4.y;
      const float o2 = v[j].z * rstd * gg.z * (1.f + s4.z) + h4.z;
      const float o3 = v[j].w * rstd * gg.w * (1.f + s4.w) + h4.w;
      *(uint2*)(out + (size_t)row * D_ + d) = make_uint2(pk2(o0, o1), pk2(o2, o3));
      if (Q8) { v[j] = make_float4(o0, o1, o2, o3); amax = fmaxf(amax, fmaxf(fmaxf(fabsf(o0), fabsf(o1)), fmaxf(fabsf(o2), fabsf(o3)))); }
    }
    if (Q8) {
      amax = wave_max(amax);
      const float qs = amax > 0.f ? 127.f / amax : 0.f;
      if (lane == 0) qscale[row] = amax * (1.f / 127.f);
#pragma unroll
      for (int j = 0; j < 8; ++j) *(unsigned*)(outq + (size_t)row * D_ + j * 256 + lane * 4) = pack_i8x4(v[j].x * qs, v[j].y * qs, v[j].z * qs, v[j].w * qs);
    }
  }
}
DI void phase1(const Params& p, char* smem) {
  const float* mp = (const float*)(p.ws + WS_MODP); float* mod = (float*)(p.ws + WS_MOD); const float* bias = p.in[3];
  for (int i = blockIdx.x * 256 + threadIdx.x; i < 49152; i += gridDim.x * 256)
    mod[i] = ((mp[i] + mp[49152 + i]) + mp[2 * 49152 + i]) + mp[3 * 49152 + i] + bias[i % 12288];
  const int rpb = T_ / (int)gridDim.x, row0 = (int)blockIdx.x * rpb, bb = row0 >> 11;
  float* lm = (float*)(smem + 16);
  __syncthreads();
  for (int c = threadIdx.x; c < 4096; c += 256) {
    const int src = bb * 12288 + c;
    lm[c] = ((mp[src] + mp[49152 + src]) + mp[2 * 49152 + src]) + mp[3 * 49152 + src] + bias[c];
  }
  __syncthreads();
  norm_rows<false, false>(p.in[0], p.in[4], lm, 0, (u16*)(p.ws + WS_H), nullptr, nullptr, row0, 4, row0 + rpb);
}

constexpr int CTR_TILE = 3520, CTR_CHUNK = 3584;
DI int grab(unsigned* ctr, char* smem) {
  __syncthreads();
  if (threadIdx.x == 0) *(volatile unsigned*)(smem + 8) = atomicAdd(ctr, 1u);
  __syncthreads();
  return (int)*(volatile unsigned*)(smem + 8);
}
DI void uv_chunk(const Params& p, int c) {
#pragma unroll 1
  for (int i = 0; i < 4; ++i) {
    const int item = c * 4 + i;
    if (item < 4096) i8_rows_item(p.in[17], (unsigned char*)(p.ws + WS_U), (float*)(p.ws + WS_USC), item);
    else fp8_rows_item(p.in[18], (unsigned char*)(p.ws + WS_V), (float*)(p.ws + WS_VSC), item - 4096);
  }
}
DI void phase2(const Params& p, char* smem, int rep) {
  const u16* H = (const u16*)(p.ws + WS_H); const u16* W = (const u16*)(p.ws + WS_WINT); u16* P = (u16*)(p.ws + WS_P); float* SSQ = (float*)(p.ws + WS_SSQ);
  (void)rep;
  for (int it = blockIdx.x; it < 64 * 32; it += gridDim.x) {
    const int tn = it / 64, tm = it % 64;
    gemm_tile<true>(H, D_, W, D_, D_, tm * 128, tn * 128, smem, [&](f32x16 (&acc)[2][2], int mb, int nb, int r, int hi) __attribute__((always_inline)) {
#pragma unroll
      for (int mi = 0; mi < 2; ++mi)
#pragma unroll
        for (int ni = 0; ni < 2; ++ni)
#pragma unroll
          for (int g = 0; g < 4; ++g) {
            const int row = mb + mi * 32 + r, col = nb + ni * 32 + hi * 4 + 8 * g;
            *(uint2*)(P + (size_t)row * INC + col) = make_uint2(pk2(acc[mi][ni][4 * g], acc[mi][ni][4 * g + 1]), pk2(acc[mi][ni][4 * g + 2], acc[mi][ni][4 * g + 3]));
          }
      if (nb >= 3072) {
#pragma unroll
        for (int mi = 0; mi < 2; ++mi) {
          float ss = 0.f;
#pragma unroll
          for (int ni = 0; ni < 2; ++ni)
#pragma unroll
            for (int i = 0; i < 16; ++i) ss += acc[mi][ni][i] * acc[mi][ni][i];
          ss += __shfl_xor(ss, 32);
          if (hi == 0) SSQ[(size_t)(mb + mi * 32 + r) * 16 + ((nb - 3072) >> 6)] = ss;
        }
      }
    });
  }
}

DI void phase3(const Params& p, char* smem) {
  const u16* P = (const u16*)(p.ws + WS_P);
  u16* Q = (u16*)(p.ws + WS_Q); u16* Kb = (u16*)(p.ws + WS_K); u16* VT = (u16*)(p.ws + WS_VT); u16* MG = (u16*)(p.ws + WS_MG);
  const float2* rope = (const float2*)(p.ws + WS_ROPE); const float* SSQ = (const float*)(p.ws + WS_SSQ);
  float* rs = (float*)(smem + 16 + 2 * 2 * 128 * 72 * 2);
  constexpr int NQ = 64 * 12, NKV = 64 * 16, NKR = 1024, NCV = 1024;
  const float qscale = 0.07216878364870322f * 1.4426950408889634f;
  const int G = (int)gridDim.x, bid = (int)blockIdx.x;
  if (bid < 64) {
    for (int tm = bid; tm < 64; tm += 64) {
      gemm_tile<true>((const u16*)(p.ws + WS_H), D_, (const u16*)(p.ws + WS_WINT), D_, D_, tm * 128, 4096, smem, [&](f32x16 (&acc)[2][2], int mb, int nb, int r, int hi) __attribute__((always_inline)) {
        if (nb != 4096) return;
#pragma unroll
        for (int mi = 0; mi < 2; ++mi) {
          const int row = mb + mi * 32 + r, pos = row & (S_ - 1);
#pragma unroll
          for (int g = 0; g < 4; ++g) {
            const int j = hi * 4 + 8 * g;
            float a0[4], a1[4];
#pragma unroll
            for (int e = 0; e < 4; ++e) {
              const float2 cs = rope[pos * 32 + j + e];
              const float x1 = acc[mi][0][4 * g + e], x2 = acc[mi][1][4 * g + e];
              a0[e] = x1 * cs.x - x2 * cs.y; a1[e] = x2 * cs.x + x1 * cs.y;
            }
            const uint2 lo = make_uint2(pk2(a0[0], a0[1]), pk2(a0[2], a0[3])), hi2 = make_uint2(pk2(a1[0], a1[1]), pk2(a1[2], a1[3]));
#pragma unroll
            for (int h = 0; h < 8; ++h) { *(uint2*)(Kb + (size_t)row * 1536 + h * 192 + 128 + j) = lo; *(uint2*)(Kb + (size_t)row * 1536 + h * 192 + 160 + j) = hi2; }
          }
        }
      });
    }
  }
  const int t_begin = bid < 64 ? NQ + NKV : bid - 64, t_step = G - 64;
  for (int itx = 0; itx < 2; ++itx)
  for (int it = (itx == 0 ? t_begin : NQ + NKV + NKR + bid); it < (itx == 0 ? NQ + NKV : NQ + NKV + NKR + NCV); it += (itx == 0 ? t_step : G)) {
    if (it < NQ) {
      const int tn = it / 64, tm = it % 64;
      __syncthreads();
      if (threadIdx.x < 128) { const float4* sp = (const float4*)(SSQ + (size_t)(tm * 128 + threadIdx.x) * 16); const float4 a = sp[0], b = sp[1]; rs[threadIdx.x] = rsqrtf((((a.x + a.y) + (a.z + a.w)) + ((b.x + b.y) + (b.z + b.w))) * (1.f / 512.f) + EPS); }
      gemm_tile<true>(P + 3072, INC, (const u16*)(p.ws + WS_WUQT), 512, 512, tm * 128, tn * 128, smem, [&](f32x16 (&acc)[2][2], int mb, int nb, int r, int hi) __attribute__((always_inline)) {
        const bool is_rope = ((nb >> 6) % 3) == 2;
#pragma unroll
        for (int mi = 0; mi < 2; ++mi) {
          const int row = mb + mi * 32 + r;
          const float sc = rs[row - tm * 128] * qscale;
          const int pos = row & (S_ - 1);
#pragma unroll
          for (int g = 0; g < 4; ++g) {
            const int j = hi * 4 + 8 * g;
            float a0[4], a1[4];
#pragma unroll
            for (int e = 0; e < 4; ++e) { a0[e] = acc[mi][0][4 * g + e] * sc; a1[e] = acc[mi][1][4 * g + e] * sc; }
            if (is_rope) {
#pragma unroll
              for (int e = 0; e < 4; ++e) {
                const float2 cs = rope[pos * 32 + j + e];
                const float x1 = a0[e], x2 = a1[e];
                a0[e] = x1 * cs.x - x2 * cs.y; a1[e] = x2 * cs.x + x1 * cs.y;
              }
            }
            *(uint2*)(Q + (size_t)row * 1536 + nb + j) = make_uint2(pk2(a0[0], a0[1]), pk2(a0[2], a0[3]));
            *(uint2*)(Q + (size_t)row * 1536 + nb + 32 + j) = make_uint2(pk2(a1[0], a1[1]), pk2(a1[2], a1[3]));
          }
        }
      });
    } else if (it < NQ + NKV) {
      const int j2 = it - NQ, tn = j2 / 64, tm = j2 % 64;
      __syncthreads();
      if (threadIdx.x < 128) { const float4* sp = (const float4*)(SSQ + (size_t)(tm * 128 + threadIdx.x) * 16 + 8); const float4 a = sp[0], b = sp[1]; rs[threadIdx.x] = rsqrtf((((a.x + a.y) + (a.z + a.w)) + ((b.x + b.y) + (b.z + b.w))) * (1.f / 512.f) + EPS); }
      const int head = tn >> 1;
      if ((tn & 1) == 0) {
        gemm_tile<true>(P + 3584, INC, (const u16*)(p.ws + WS_WUKVT), 512, 512, tm * 128, tn * 128, smem, [&](f32x16 (&acc)[2][2], int mb, int nb, int r, int hi) __attribute__((always_inline)) {
#pragma unroll
          for (int mi = 0; mi < 2; ++mi) {
            const int row = mb + mi * 32 + r;
            const float sc = rs[row - tm * 128];
#pragma unroll
            for (int ni = 0; ni < 2; ++ni)
#pragma unroll
              for (int g = 0; g < 4; ++g) {
                const int d = (nb & 127) + ni * 32 + hi * 4 + 8 * g;
                *(uint2*)(Kb + (size_t)row * 1536 + head * 192 + d) = make_uint2(pk2(acc[mi][ni][4 * g] * sc, acc[mi][ni][4 * g + 1] * sc), pk2(acc[mi][ni][4 * g + 2] * sc, acc[mi][ni][4 * g + 3] * sc));
              }
          }
        });
      } else {
        gemm_tile<false>(P + 3584, INC, (const u16*)(p.ws + WS_WUKVT), 512, 512, tm * 128, tn * 128, smem, [&](f32x16 (&acc)[2][2], int mb, int nb, int r, int hi) __attribute__((always_inline)) {
#pragma unroll
          for (int mi = 0; mi < 2; ++mi)
#pragma unroll
            for (int g = 0; g < 4; ++g) {
              const int row0 = mb + mi * 32 + hi * 4 + 8 * g;
              const float s0 = rs[row0 - tm * 128], s1 = rs[row0 + 1 - tm * 128], s2 = rs[row0 + 2 - tm * 128], s3 = rs[row0 + 3 - tm * 128];
              const int b = row0 >> 11, t = row0 & (S_ - 1);
#pragma unroll
              for (int ni = 0; ni < 2; ++ni) {
                const int d = (nb & 127) + ni * 32 + r;
                *(uint2*)(VT + ((size_t)((b * 8 + head) * 128 + d)) * S_ + t) = make_uint2(pk2(acc[mi][ni][4 * g] * s0, acc[mi][ni][4 * g + 1] * s1), pk2(acc[mi][ni][4 * g + 2] * s2, acc[mi][ni][4 * g + 3] * s3));
              }
            }
        });
      }
    } else if (it < NQ + NKV + NKR) {
      const int j2 = it - NQ - NKV;
      const int row = j2 * 8 + (threadIdx.x >> 5), j = threadIdx.x & 31, pos = row & (S_ - 1);
      const float x1 = bflo((unsigned)P[(size_t)row * INC + 4096 + j]), x2 = bflo((unsigned)P[(size_t)row * INC + 4096 + 32 + j]);
      const float2 cs = rope[pos * 32 + j];
      const float o1 = x1 * cs.x - x2 * cs.y, o2 = x2 * cs.x + x1 * cs.y;
      const u16 b1 = (u16)(pk2(o1, 0.f) & 0xffffu), b2 = (u16)(pk2(o2, 0.f) & 0xffffu);
#pragma unroll
      for (int h = 0; h < 8; ++h) { Kb[(size_t)row * 1536 + h * 192 + 128 + j] = b1; Kb[(size_t)row * 1536 + h * 192 + 160 + j] = b2; }
    } else {
      const int j2 = it - NQ - NKV - NKR;
      const int wi = j2 * 4 + (threadIdx.x >> 6), lane = threadIdx.x & 63;
      const int g = wi & 7, run = wi >> 3;
      const int row0 = run * 16, t0 = row0 & (S_ - 1);
      const int ch = g * 128 + lane * 2;
      const float* cw = p.in[6];
      const float w00 = cw[ch], w01 = cw[ch + 1], w10 = cw[1024 + ch], w11 = cw[1024 + ch + 1], w20 = cw[2048 + ch], w21 = cw[2048 + ch + 1];
      float zm1a = 0.f, zm1b = 0.f, zm2a = 0.f, zm2b = 0.f;
      if (t0 > 0) {
        const unsigned c1 = *(const unsigned*)(P + (size_t)(row0 - 1) * INC + 1024 + ch), h1 = *(const unsigned*)(P + (size_t)(row0 - 1) * INC + 2048 + ch);
        const unsigned c2 = *(const unsigned*)(P + (size_t)(row0 - 2) * INC + 1024 + ch), h2 = *(const unsigned*)(P + (size_t)(row0 - 2) * INC + 2048 + ch);
        zm1a = bflo(c1) * bflo(h1); zm1b = bfhi(c1) * bfhi(h1); zm2a = bflo(c2) * bflo(h2); zm2b = bfhi(c2) * bfhi(h2);
      }
#pragma unroll 4
      for (int tt = 0; tt < 16; ++tt) {
        const size_t ro = (size_t)(row0 + tt) * INC;
        const unsigned bb = *(const unsigned*)(P + ro + ch), cc = *(const unsigned*)(P + ro + 1024 + ch), hh = *(const unsigned*)(P + ro + 2048 + ch);
        const float za = bflo(cc) * bflo(hh), zb = bfhi(cc) * bfhi(hh);
        const float ya = bflo(bb) * (w00 * zm2a + w10 * zm1a + w20 * za), yb = bfhi(bb) * (w01 * zm2b + w11 * zm1b + w21 * zb);
        zm2a = zm1a; zm2b = zm1b; zm1a = za; zm1b = zb;
        const float ss = wave_sum(ya * ya + yb * yb);
        const float rstd = rsqrtf(ss * (1.f / 128.f) + EPS);
        *(unsigned*)(MG + (size_t)(row0 + tt) * D_ + ch) = pk2(ya * rstd, yb * rstd);
      }
    }
  }
}

DI void phase4(const Params& p, char* smem) {
  const u16* Q = (const u16*)(p.ws + WS_Q); const u16* Kb = (const u16*)(p.ws + WS_K); const u16* VT = (const u16*)(p.ws + WS_VT);
  u16* MG = (u16*)(p.ws + WS_MG);
  u16* Ks = (u16*)(smem + 16);
  u16* Vs = Ks + 64 * 200;
  float* mrg = (float*)(smem + 16);
  const int tid = threadIdx.x, lane = tid & 63, w = tid >> 6, qh = w & 1, kh = w >> 1, r = lane & 31, hi = lane >> 5;
  for (int it = blockIdx.x; it < 512; it += gridDim.x) {
    const int xq = it & 7, jq = it >> 3, bh = xq + 8 * (jq >> 4);
    const int pi = jq & 15, h = bh & 7, b = bh >> 3;
    for (int sub = 0; sub < 2; ++sub) {
      const int c = sub ? (31 - pi) : pi;
      const size_t qrow = (size_t)b * S_ + c * 64 + qh * 32 + r;
      bf16x8 qf[12];
#pragma unroll
      for (int ks = 0; ks < 12; ++ks) qf[ks] = *(const bf16x8*)(Q + qrow * 1536 + h * 192 + ks * 16 + hi * 8);
      f32x16 O[4];
#pragma unroll
      for (int dt = 0; dt < 4; ++dt)
#pragma unroll
        for (int i = 0; i < 16; ++i) O[dt][i] = 0.f;
      float m = -1e30f, l = 0.f;
      u32x4 kr[6]; u32x4 vr[4];
      const u16* kg = Kb + ((size_t)b * S_ + (tid >> 2)) * 1536 + h * 192 + (tid & 3) * 8;
      const u16* vg = VT + ((size_t)((b * 8 + h) * 128 + (tid >> 1))) * S_ + (tid & 1) * 8;
      u16* ksw = Ks + (tid >> 2) * 200 + (tid & 3) * 8;
      u16* vsw = Vs + (tid >> 1) * 68 + (tid & 1) * 8;
      auto load_tile = [&]() __attribute__((always_inline)) {
#pragma unroll
        for (int i = 0; i < 6; ++i) kr[i] = *(const u32x4*)(kg + i * 32);
#pragma unroll
        for (int i = 0; i < 4; ++i) vr[i] = *(const u32x4*)(vg + i * 16);
        kg += 64 * 1536; vg += 64;
      };
      load_tile();
      for (int kt = 0; kt <= c; ++kt) {
        __syncthreads();
#pragma unroll
        for (int i = 0; i < 6; ++i) *(u32x4*)(ksw + i * 32) = kr[i];
#pragma unroll
        for (int i = 0; i < 4; ++i) { u32x2 lo2 = {vr[i][0], vr[i][1]}, hi2 = {vr[i][2], vr[i][3]}; *(u32x2*)(vsw + i * 16) = lo2; *(u32x2*)(vsw + i * 16 + 4) = hi2; }
        __syncthreads();
        if (kt < c) load_tile();
        f32x16 s;
#pragma unroll
        for (int i = 0; i < 16; ++i) s[i] = 0.f;
        const u16* kp = Ks + (kh * 32 + r) * 200 + hi * 8;
        {
          bf16x8 kf[4];
#pragma unroll
          for (int i = 0; i < 4; ++i) kf[i] = *(const bf16x8*)(kp + i * 16);
#pragma unroll
          for (int ks = 0; ks < 12; ++ks) {
            __builtin_amdgcn_sched_barrier(0);
            s = MFMA(kf[ks & 3], qf[ks], s);
            if (ks + 4 < 12) kf[ks & 3] = *(const bf16x8*)(kp + (ks + 4) * 16);
          }
          __builtin_amdgcn_sched_barrier(0);
        }
        bf16x8 vf0[4];
#pragma unroll
        for (int dt = 0; dt < 4; ++dt) {
          const u16* vp = Vs + (dt * 32 + r) * 68 + kh * 32 + 4 * hi;
          const u32x2 v0 = *(const u32x2*)vp, v1 = *(const u32x2*)(vp + 8);
          const u32x4 vv = {v0[0], v0[1], v1[0], v1[1]};
          vf0[dt] = __builtin_bit_cast(bf16x8, vv);
        }
        float mx = s[0];
#pragma unroll
        for (int i = 1; i < 16; ++i) mx = fmaxf(mx, s[i]);
        mx = fmaxf(mx, __shfl_xor(mx, 32));
        const float mn = fmaxf(m, mx);
        const float alpha = __builtin_amdgcn_exp2f(m - mn);
        const bool resc = __builtin_amdgcn_ballot_w64(mn > m) != 0ull;
        m = mn;
        float rsum = 0.f;
#pragma unroll
        for (int i = 0; i < 16; ++i) { s[i] = __builtin_amdgcn_exp2f(s[i] - mn); rsum += s[i]; }
        l = l * alpha + rsum;
        if (resc) {
#pragma unroll
          for (int dt = 0; dt < 4; ++dt)
#pragma unroll
            for (int i = 0; i < 16; ++i) O[dt][i] *= alpha;
        }
        {
          const u32x4 pu0 = {pk2(s[0], s[1]), pk2(s[2], s[3]), pk2(s[4], s[5]), pk2(s[6], s[7])};
          const u32x4 pu1 = {pk2(s[8], s[9]), pk2(s[10], s[11]), pk2(s[12], s[13]), pk2(s[14], s[15])};
          const bf16x8 pf0 = __builtin_bit_cast(bf16x8, pu0), pf1 = __builtin_bit_cast(bf16x8, pu1);
          bf16x8 vf1[4];
#pragma unroll
          for (int dt = 0; dt < 4; ++dt) {
            const u16* vp = Vs + (dt * 32 + r) * 68 + kh * 32 + 16 + 4 * hi;
            const u32x2 v0 = *(const u32x2*)vp, v1 = *(const u32x2*)(vp + 8);
            const u32x4 vv = {v0[0], v0[1], v1[0], v1[1]};
            vf1[dt] = __builtin_bit_cast(bf16x8, vv);
          }
          __builtin_amdgcn_sched_barrier(0);
#pragma unroll
          for (int dt = 0; dt < 4; ++dt) O[dt] = MFMA(vf0[dt], pf0, O[dt]);
#pragma unroll
          for (int dt = 0; dt < 4; ++dt) O[dt] = MFMA(vf1[dt], pf1, O[dt]);
        }
      }
      l += __shfl_xor(l, 32);
      __syncthreads();
      float* mq = mrg + qh * 66 * 64;
      if (kh == 1) {
#pragma unroll
        for (int dt = 0; dt < 4; ++dt)
#pragma unroll
          for (int i = 0; i < 16; ++i) mq[(dt * 16 + i) * 64 + lane] = O[dt][i];
        mq[64 * 64 + lane] = m; mq[65 * 64 + lane] = l;
      }
      __syncthreads();
      if (kh == 0) {
        const float m1 = mq[64 * 64 + lane], l1 = mq[65 * 64 + lane];
        const float mt = fmaxf(m, m1), a0 = exp2f(m - mt), a1 = exp2f(m1 - mt);
        const float inv = 1.f / (l * a0 + l1 * a1);
        float ss = 0.f;
#pragma unroll
        for (int dt = 0; dt < 4; ++dt)
#pragma unroll
          for (int i = 0; i < 16; ++i) { const float o = (O[dt][i] * a0 + mq[(dt * 16 + i) * 64 + lane] * a1) * inv; O[dt][i] = o; ss += o * o; }
        ss += __shfl_xor(ss, 32);
        const float rstd = rsqrtf(ss * (1.f / 128.f) + EPS);
#pragma unroll
        for (int dt = 0; dt < 4; ++dt)
#pragma unroll
          for (int g = 0; g < 4; ++g) {
            const int d = dt * 32 + hi * 4 + 8 * g;
            *(uint2*)(MG + qrow * D_ + 1024 + h * 128 + d) = make_uint2(pk2(O[dt][4 * g] * rstd, O[dt][4 * g + 1] * rstd), pk2(O[dt][4 * g + 2] * rstd, O[dt][4 * g + 3] * rstd));
          }
      }
    }
  }
}

DI void phase5(const Params& p, char* smem) {
  const u16* MG = (const u16*)(p.ws + WS_MG); const u16* W = (const u16*)(p.ws + WS_WOUTT);
  const float* X = p.in[0]; const float* mod = (const float*)(p.ws + WS_MOD); u16* X1 = (u16*)(p.ws + WS_X1);
  for (int it = blockIdx.x; it < 64 * 16; it += gridDim.x) {
    const int tn = it / 64, tm = it % 64;
    gemm_tile<true>(MG, D_, W, D_, D_, tm * 128, tn * 128, smem, [&](f32x16 (&acc)[2][2], int mb, int nb, int r, int hi) __attribute__((always_inline)) {
#pragma unroll
      for (int mi = 0; mi < 2; ++mi) {
        const int row = mb + mi * 32 + r, b = row >> 11;
        const float* gt = mod + b * 12288 + 2 * 2048;
#pragma unroll
        for (int ni = 0; ni < 2; ++ni)
#pragma unroll
          for (int g = 0; g < 4; ++g) {
            const int col = nb + ni * 32 + hi * 4 + 8 * g;
            const float4 xv = *(const float4*)(X + (size_t)row * D_ + col), gv = *(const float4*)(gt + col);
            float4 o;
            o.x = xv.x + gv.x * acc[mi][ni][4 * g]; o.y = xv.y + gv.y * acc[mi][ni][4 * g + 1]; o.z = xv.z + gv.z * acc[mi][ni][4 * g + 2]; o.w = xv.w + gv.w * acc[mi][ni][4 * g + 3];
            *(uint2*)(X1 + (size_t)row * D_ + col) = make_uint2(pk2(o.x, o.y), pk2(o.z, o.w));
          }
      }
    });
  }
}

DI void phase7(const Params& p, char* smem) {
  const u16* H2 = (const u16*)(p.ws + WS_H); const u16* W = (const u16*)(p.ws + WS_WQT); u16* PQ = (u16*)(p.ws + WS_P);
  for (int it = blockIdx.x; it < 64 * 16; it += gridDim.x) {
    const int tn = it / 64, tm = it % 64;
    gemm_tile<true>(H2, D_, W, D_, D_, tm * 128, tn * 128, smem, [&](f32x16 (&acc)[2][2], int mb, int nb, int r, int hi) __attribute__((always_inline)) {
#pragma unroll
      for (int mi = 0; mi < 2; ++mi)
#pragma unroll
        for (int ni = 0; ni < 2; ++ni)
#pragma unroll
          for (int g = 0; g < 4; ++g) {
            const int row = mb + mi * 32 + r, col = nb + ni * 32 + hi * 4 + 8 * g;
            *(uint2*)(PQ + (size_t)row * D_ + col) = make_uint2(pk2(acc[mi][ni][4 * g], acc[mi][ni][4 * g + 1]), pk2(acc[mi][ni][4 * g + 2], acc[mi][ni][4 * g + 3]));
          }
    });
  }
}

DI unsigned f2ord(float v) { unsigned u = __float_as_uint(v); return u ^ ((unsigned)((int)u >> 31) | 0x80000000u); }
#define TOPK_INSERT(keys, x) { _Pragma("unroll") for (int _j = 0; _j < 16; ++_j) { const unsigned _h = max(keys[_j], x); x = min(keys[_j], x); keys[_j] = _h; } }
DI void phase8(const Params& p, char* smem) {
  const u16* PQ = (const u16*)(p.ws + WS_P); const u16* SK = (const u16*)(p.ws + WS_SK);
  int* IDS = (int*)(p.ws + WS_IDS); float* GATE = (float*)(p.ws + WS_GATE);
  float* sc = (float*)(smem + 16);
  const int tid = threadIdx.x, lane = tid & 63, w = tid >> 6, r = lane & 31, hi = lane >> 5;
  for (int it = blockIdx.x; it < 128 * 8; it += gridDim.x) {
    const int h = it & 7, tile = it >> 3;
    const int pp = w >> 1, rh = w & 1;
    __syncthreads();
    {
      f32x16 acc[4];
#pragma unroll
      for (int nt = 0; nt < 4; ++nt)
#pragma unroll
        for (int i = 0; i < 16; ++i) acc[nt][i] = 0.f;
      const u16* ap = PQ + (size_t)(tile * 64 + rh * 32 + r) * D_ + h * 256 + pp * 128 + hi * 8;
      const u16* bp = SK + ((size_t)(h * 2 + pp) * 128 + r) * 128 + hi * 8;
#pragma unroll
      for (int ks = 0; ks < 8; ++ks) {
        const bf16x8 af = *(const bf16x8*)(ap + ks * 16);
#pragma unroll
        for (int nt = 0; nt < 4; ++nt) { const bf16x8 bf = *(const bf16x8*)(bp + nt * 32 * 128 + ks * 16); acc[nt] = MFMA(af, bf, acc[nt]); }
      }
#pragma unroll
      for (int nt = 0; nt < 4; ++nt)
#pragma unroll
        for (int i = 0; i < 16; ++i) sc[(pp * 64 + rh * 32 + hi * 4 + (i & 3) + 8 * (i >> 2)) * 129 + nt * 32 + r] = acc[nt][i];
    }
    __syncthreads();
    {
      const int rowi = tid & 127, half = tid >> 7;
      float* row = sc + rowi * 129;
      unsigned* mk = (unsigned*)(smem + 16 + 128 * 129 * 4);
      unsigned keys[16];
#pragma unroll
      for (int j = 0; j < 16; ++j) keys[j] = 0u;
#pragma unroll 4
      for (int n2 = 0; n2 < 64; ++n2) {
        const int n = half * 64 + n2;
        unsigned x = (f2ord(row[n]) & 0xFFFFFF80u) | (unsigned)(127 - n);
        TOPK_INSERT(keys, x);
      }
      if (half == 1) {
#pragma unroll
        for (int j = 0; j < 16; ++j) mk[j * 128 + rowi] = keys[j];
      }
      __syncthreads();
      if (half == 0) {
#pragma unroll
        for (int j = 0; j < 16; ++j) { unsigned x = mk[j * 128 + rowi]; TOPK_INSERT(keys, x); }
        float vals[16];
#pragma unroll
        for (int j = 0; j < 16; ++j) vals[j] = row[127 - (keys[j] & 127u)];
#pragma unroll
        for (int j = 0; j < 16; ++j) { row[j] = vals[j]; row[16 + j] = __int_as_float((int)(127 - (keys[j] & 127u))); }
      }
    }
    __syncthreads();
    if (tid < 64) {
      const float* ra = sc + tid * 129; const float* rb = sc + (64 + tid) * 129;
      float a[16], bq[16];
#pragma unroll
      for (int j = 0; j < 16; ++j) { a[j] = ra[j]; bq[j] = rb[j]; }
      unsigned keys[16];
#pragma unroll
      for (int j = 0; j < 16; ++j) keys[j] = 0u;
#pragma unroll
      for (int i = 0; i < 16; ++i)
#pragma unroll
        for (int j = 0; j < 16; ++j)
          if ((i + 1) * (j + 1) <= 16) {
            unsigned x = (f2ord(a[i] + bq[j]) & 0xFFFFFF00u) | (unsigned)(255 - (i * 16 + j));
            TOPK_INSERT(keys, x);
          }
      float bv[16]; int ex[16];
      float mx = -1e30f;
#pragma unroll
      for (int q = 0; q < 16; ++q) {
        const int flat = 255 - (int)(keys[q] & 255u), i = flat >> 4, j = flat & 15;
        bv[q] = ra[i] + rb[j];
        ex[q] = __float_as_int(ra[16 + i]) * 128 + __float_as_int(rb[16 + j]);
        mx = fmaxf(mx, bv[q]);
      }
      float sum = 0.f;
#pragma unroll
      for (int q = 0; q < 16; ++q) { bv[q] = __expf(bv[q] - mx); sum += bv[q]; }
      const float inv = 1.f / sum;
      const size_t o = (size_t)(tile * 64 + tid) * 128 + h * 16;
#pragma unroll
      for (int q = 0; q < 16; q += 4) {
        *(int4*)(IDS + o + q) = make_int4(ex[q], ex[q + 1], ex[q + 2], ex[q + 3]);
        *(float4*)(GATE + o + q) = make_float4(bv[q] * inv, bv[q + 1] * inv, bv[q + 2] * inv, bv[q + 3] * inv);
      }
    }
  }
}

constexpr int CTR_UQ = 4096, CTR_VQ = 4608;
DI f2_t cvt8lo(unsigned w) { return __builtin_amdgcn_cvt_pk_f32_fp8(w, false); }
DI f2_t cvt8hi(unsigned w) { return __builtin_amdgcn_cvt_pk_f32_fp8(w, true); }
template <class F>
DI void xcd_queue(unsigned* ctrs, int nchunks, char* smem, F&& f) {
  const int x0 = (int)(xb_xcc_id() & 7u);
#pragma unroll 1
  for (int k = 0; k < 8; ++k) {
    const int s = (x0 + k) & 7;
    for (;;) { const int c = grab(ctrs + 64 * s, smem); if (c >= nchunks) break; f(s, c); }
  }
}
DI void wave_lds_sync() { asm volatile("s_waitcnt lgkmcnt(0)" ::: "memory"); __builtin_amdgcn_wave_barrier(); }

DI void phase9(const Params& p, char* smem, int rep) {
  const unsigned char* H2Q = (const unsigned char*)(p.ws + WS_H2Q); const unsigned char* U8 = (const unsigned char*)(p.ws + WS_U);
  const int* IDS = (const int*)(p.ws + WS_IDS); int* PA = (int*)(p.ws + WS_PA);
  const int lane = threadIdx.x & 63, w = threadIdx.x >> 6, g = lane >> 4, l15 = lane & 15;
  const int b3 = (lane >> 3) & 1, b2 = (lane >> 2) & 1, b1 = (lane >> 1) & 1, b0 = lane & 1;
  int* lw = (int*)(smem + 16) + w * 256;
  xcd_queue((unsigned*)(p.ws + WS_BAR) + CTR_UQ + rep * 8, 512, smem, [&](int s, int c) __attribute__((always_inline)) {
#pragma unroll 1
    for (int t = 0; t < 4; ++t) {
      const int tok = __builtin_amdgcn_readfirstlane(c * 16 + w * 4 + t);
      const int i0 = IDS[(size_t)tok * 128 + lane], i1 = IDS[(size_t)tok * 128 + 64 + lane];
      const u32x4 hq = *(const u32x4*)(H2Q + (size_t)tok * D_ + s * 256 + l15 * 16);
      wave_lds_sync();
      lw[(lane & 3) * 32 + (lane >> 2)] = i0;
      lw[(lane & 3) * 32 + 16 + (lane >> 2)] = i1;
      wave_lds_sync();
      const unsigned char* ub = U8 + s * 256 + l15 * 16;
#pragma unroll
      for (int batch = 0; batch < 2; ++batch) {
        int ida[16];
#pragma unroll
        for (int q = 0; q < 4; ++q) { const int4 v = *(const int4*)(lw + g * 32 + batch * 16 + q * 4); ida[q * 4] = v.x; ida[q * 4 + 1] = v.y; ida[q * 4 + 2] = v.z; ida[q * 4 + 3] = v.w; }
        u32x4 rows[16];
#pragma unroll
        for (int k = 0; k < 16; ++k) rows[k] = *(const u32x4*)(ub + (size_t)ida[k] * 2048);
        int part[16];
#pragma unroll
        for (int k = 0; k < 16; ++k) {
          int acc = 0;
#pragma unroll
          for (int d = 0; d < 4; ++d) acc = __builtin_amdgcn_sdot4((int)rows[k][d], (int)hq[d], acc, false);
          part[k] = acc;
        }
        int q8[8], q4[4], q2[2];
#pragma unroll
        for (int k = 0; k < 8; ++k) q8[k] = (b3 ? part[8 + k] : part[k]) + __shfl_xor(b3 ? part[k] : part[8 + k], 8);
#pragma unroll
        for (int k = 0; k < 4; ++k) q4[k] = (b2 ? q8[4 + k] : q8[k]) + __shfl_xor(b2 ? q8[k] : q8[4 + k], 4);
#pragma unroll
        for (int k = 0; k < 2; ++k) q2[k] = (b1 ? q4[2 + k] : q4[k]) + __shfl_xor(b1 ? q4[k] : q4[2 + k], 2);
        const int rr = (b0 ? q2[1] : q2[0]) + __shfl_xor(b0 ? q2[0] : q2[1], 1);
        PA[((size_t)s * T_ + tok) * 128 + 4 * (batch * 16 + l15) + g] = rr;
      }
    }
  });
}

DI void phase10(const Params& p) {
  const int* PA = (const int*)(p.ws + WS_PA); float* ACT = (float*)(p.ws + WS_ACT); const float* HSC = (const float*)(p.ws + WS_HSC);
  const int* IDS = (const int*)(p.ws + WS_IDS); const float* GATE = (const float*)(p.ws + WS_GATE);
  const float* USC = (const float*)(p.ws + WS_USC); const float* VSC = (const float*)(p.ws + WS_VSC);
  for (int i = blockIdx.x * 256 + threadIdx.x; i < T_ * 128; i += gridDim.x * 256) {
    int ai = 0;
#pragma unroll
    for (int s = 0; s < 8; ++s) ai += PA[(size_t)s * T_ * 128 + i];
    const int id = IDS[i];
    const float a = (float)ai * USC[id] * HSC[i >> 7];
    ACT[i] = 0.5f * a * (1.f + erff(a * 0.70710678118654752f)) * GATE[i] * VSC[id];
  }
}

DI void phase11(const Params& p, char* smem, int rep) {
  const unsigned char* V8 = (const unsigned char*)(p.ws + WS_V);
  const int* IDS = (const int*)(p.ws + WS_IDS); const float* ACT = (const float*)(p.ws + WS_ACT); u16* OUTP = (u16*)(p.ws + WS_OUTP);
  const int lane = threadIdx.x & 63, w = threadIdx.x >> 6, g = lane >> 4, l15 = lane & 15;
  const int b5 = (lane >> 5) & 1, b4 = (lane >> 4) & 1;
  int* lw = (int*)(smem + 16) + w * 256;
  float* lf = (float*)(lw + 128);
  xcd_queue((unsigned*)(p.ws + WS_BAR) + CTR_VQ + rep * 8, 512, smem, [&](int s, int c) __attribute__((always_inline)) {
#pragma unroll 1
    for (int t = 0; t < 4; ++t) {
      const int tok = __builtin_amdgcn_readfirstlane(c * 16 + w * 4 + t);
      const int i0 = IDS[(size_t)tok * 128 + lane], i1 = IDS[(size_t)tok * 128 + 64 + lane];
      const float a0 = ACT[(size_t)tok * 128 + lane], a1 = ACT[(size_t)tok * 128 + 64 + lane];
      wave_lds_sync();
      lw[(lane & 3) * 32 + (lane >> 2)] = i0; lw[(lane & 3) * 32 + 16 + (lane >> 2)] = i1;
      lf[(lane & 3) * 32 + (lane >> 2)] = a0; lf[(lane & 3) * 32 + 16 + (lane >> 2)] = a1;
      wave_lds_sync();
      f2_t o[8];
#pragma unroll
      for (int i = 0; i < 8; ++i) o[i] = f2_t{0.f, 0.f};
      const unsigned char* vb = V8 + s * 256 + l15 * 16;
#pragma unroll
      for (int batch = 0; batch < 2; ++batch) {
        int ida[16]; float aa[16];
#pragma unroll
        for (int q = 0; q < 4; ++q) {
          const int4 v = *(const int4*)(lw + g * 32 + batch * 16 + q * 4); ida[q * 4] = v.x; ida[q * 4 + 1] = v.y; ida[q * 4 + 2] = v.z; ida[q * 4 + 3] = v.w;
          const float4 f = *(const float4*)(lf + g * 32 + batch * 16 + q * 4); aa[q * 4] = f.x; aa[q * 4 + 1] = f.y; aa[q * 4 + 2] = f.z; aa[q * 4 + 3] = f.w;
        }
        u32x4 rows[16];
#pragma unroll
        for (int k = 0; k < 16; ++k) rows[k] = *(const u32x4*)(vb + (size_t)ida[k] * 2048);
#pragma unroll
        for (int k = 0; k < 16; ++k) {
          const f2_t a2 = {aa[k], aa[k]};
#pragma unroll
          for (int d = 0; d < 4; ++d) { const unsigned ww = rows[k][d]; o[2 * d] += a2 * cvt8lo(ww); o[2 * d + 1] += a2 * cvt8hi(ww); }
        }
      }
      float ov[16];
#pragma unroll
      for (int d = 0; d < 4; ++d) { ov[4 * d] = o[2 * d].x; ov[4 * d + 1] = o[2 * d].y; ov[4 * d + 2] = o[2 * d + 1].x; ov[4 * d + 3] = o[2 * d + 1].y; }
      float q8[8], q4[4];
#pragma unroll
      for (int k = 0; k < 8; ++k) q8[k] = (b5 ? ov[8 + k] : ov[k]) + __shfl_xor(b5 ? ov[k] : ov[8 + k], 32);
#pragma unroll
      for (int k = 0; k < 4; ++k) q4[k] = (b4 ? q8[4 + k] : q8[k]) + __shfl_xor(b4 ? q8[k] : q8[4 + k], 16);
      *(uint2*)(OUTP + (size_t)tok * D_ + s * 256 + l15 * 16 + 8 * b5 + 4 * b4) = make_uint2(pk2(q4[0], q4[1]), pk2(q4[2], q4[3]));
    }
  });
}

DI void phase12(const Params& p) {
  const u16* X1 = (const u16*)(p.ws + WS_X1); const u16* OUTP = (const u16*)(p.ws + WS_OUTP);
  const float* mod = (const float*)(p.ws + WS_MOD); const float* gfin = p.in[19];
  const int lane = threadIdx.x & 63, w = threadIdx.x >> 6;
  for (int row = blockIdx.x * 4 + w; row < T_; row += gridDim.x * 4) {
    const float* gt = mod + (row >> 11) * 12288 + 5 * 2048;
    float4 v[8];
    float ss = 0.f;
#pragma unroll
    for (int j = 0; j < 8; ++j) {
      const int d = j * 256 + lane * 4;
      const uint2 xb2 = *(const uint2*)(X1 + (size_t)row * D_ + d);
      const float4 xv = make_float4(bflo(xb2.x), bfhi(xb2.x), bflo(xb2.y), bfhi(xb2.y)), gv = *(const float4*)(gt + d);
      const uint2 ob = *(const uint2*)(OUTP + (size_t)row * D_ + d);
      const float4 ov = make_float4(bflo(ob.x), bfhi(ob.x), bflo(ob.y), bfhi(ob.y));
      v[j] = make_float4(xv.x + gv.x * ov.x, xv.y + gv.y * ov.y, xv.z + gv.z * ov.z, xv.w + gv.w * ov.w);
      ss += v[j].x * v[j].x + v[j].y * v[j].y + v[j].z * v[j].z + v[j].w * v[j].w;
    }
    ss = wave_sum(ss);
    const float rstd = rsqrtf(ss * (1.f / D_) + EPS);
#pragma unroll
    for (int j = 0; j < 8; ++j) {
      const int d = j * 256 + lane * 4;
      const float4 gv = *(const float4*)(gfin + d);
      { const f32x4v t = {v[j].x * rstd * gv.x, v[j].y * rstd * gv.y, v[j].z * rstd * gv.z, v[j].w * rstd * gv.w}; __builtin_nontemporal_store(t, (f32x4v*)(p.out + (size_t)row * D_ + d)); }
    }
  }
}

DI void phase6(const Params& p) {
  norm_rows<true, true>((const float*)(p.ws + WS_X1), p.in[14], (const float*)(p.ws + WS_MOD) + 3 * 2048, 12288, (u16*)(p.ws + WS_H), (unsigned char*)(p.ws + WS_H2Q), (float*)(p.ws + WS_HSC), (int)blockIdx.x * 4, (int)gridDim.x * 4, T_);
}

__global__ void __launch_bounds__(256, 2) mega(Params p) {
  extern __shared__ __attribute__((aligned(16))) char smem[];
  XcdBarrier xb;
  const bool multi = (p.ph_hi - p.ph_lo) > 1;
  if (multi) {
    if (threadIdx.x == 0) *(uint4*)smem = make_uint4(0u, 0u, 0u, 0u);
    __syncthreads();
    xb = xcd_barrier_post((unsigned*)(p.ws + WS_BAR), (volatile LAS unsigned*)smem);
  }
#ifndef PHMASK
#define PHMASK 0x1fff
#endif
#ifndef REPMASK
#define REPMASK 0
#endif
  int rep = 0;
  constexpr int CTR_BG = 3776, BG_CHUNKS = 4096;
  auto bg_unit = [&]() __attribute__((always_inline)) -> bool {
    const int c = grab((unsigned*)(p.ws + WS_BAR) + CTR_BG, smem);
    if (c >= BG_CHUNKS) return false;
#pragma unroll 1
    for (int i = 0; i < 2; ++i) {
      const int item = c * 2 + i;
      const bool isu = item < 4096;
      conv_rows_item(isu ? p.in[17] : p.in[18], (unsigned char*)(p.ws + (isu ? WS_U : WS_V)), (float*)(p.ws + (isu ? WS_USC : WS_VSC)), isu ? item : item - 4096, isu);
    }
    return true;
  };
#define RUN_PHASE(n, call) if (p.ph_lo <= (n) && (n) < p.ph_hi) { \
    if ((n) > p.ph_lo) { if ((n) <= 7) xcd_barrier_bg(xb, smem, bg_unit); else xcd_barrier(xb); } \
    if (PHMASK & (1 << (n))) { call; if (REPMASK & (1 << (n))) { xcd_barrier(xb); rep = 1; call; rep = 0; } } \
    if ((n) == 7) { while (bg_unit()) {} } }
  RUN_PHASE(0, phase0(p, smem))
  RUN_PHASE(1, phase1(p, smem))
#ifdef BARX
  for (int i = 0; i < BARX; ++i) xcd_barrier(xb);
#endif
  RUN_PHASE(2, phase2(p, smem, rep))
  RUN_PHASE(3, phase3(p, smem))
  RUN_PHASE(4, phase4(p, smem))
  RUN_PHASE(5, phase5(p, smem))
  RUN_PHASE(6, phase6(p))
  RUN_PHASE(7, phase7(p, smem))
  RUN_PHASE(8, phase8(p, smem))
  RUN_PHASE(9, phase9(p, smem, rep))
  RUN_PHASE(10, phase10(p))
  RUN_PHASE(11, phase11(p, smem, rep))
  RUN_PHASE(12, phase12(p))
}

extern "C" void kernel_launch(void* const* d_in, const int* in_sizes, int n_in, void* d_out, int out_size, void* d_ws, size_t ws_size, hipStream_t stream) {
  static int grid = 0;
  if (grid == 0) {
    if (n_in != 20 || ws_size < WS_END) { fprintf(stderr, "kernel_launch: unexpected n_in %d / ws_size %zu (need %zu)\n", n_in, ws_size, (size_t)WS_END); grid = -1; return; }
    int dev = 0, cus = 0, per_cu = 0;
    hipGetDevice(&dev);
    hipDeviceGetAttribute(&cus, hipDeviceAttributeMultiprocessorCount, dev);
    hipFuncSetAttribute((const void*)mega, hipFuncAttributeMaxDynamicSharedMemorySize, LDS_BYTES);
    hipOccupancyMaxActiveBlocksPerMultiprocessor(&per_cu, (const void*)mega, 256, LDS_BYTES);
    if (per_cu < 1) { fprintf(stderr, "kernel_launch: occupancy query says %d\n", per_cu); per_cu = 1; }
    if (per_cu > 2) per_cu = 2;
    grid = cus * per_cu;
    fprintf(stderr, "kernel_launch: grid %d (%d per CU)\n", grid, per_cu);
  }
  if (grid < 0) return;
  Params p{};
  for (int i = 0; i < 20; ++i) p.in[i] = (const float*)d_in[i];
  p.out = (float*)d_out; p.ws = (char*)d_ws;
#if N_LAUNCH_PER_PHASE
  p.coop = 0;
  for (int ph = 0; ph < NPH; ++ph) {
    p.ph_lo = ph; p.ph_hi = ph + 1;
    hipLaunchKernelGGL(mega, dim3(grid), dim3(256), LDS_BYTES, stream, p);
  }
#else
  hipMemsetAsync((char*)d_ws + WS_BAR, 0, WS_MOD, stream);
  p.coop = 0; p.ph_lo = 0; p.ph_hi = NPH;
  void* args[] = {&p};
  hipError_t e = hipLaunchCooperativeKernel((const void*)mega, dim3(grid), dim3(256), args, LDS_BYTES, stream);
  if (e != hipSuccess) fprintf(stderr, "cooperative launch failed: %s (grid %d)\n", hipGetErrorString(e), grid);
#endif
}
```

```cpp
#include <hip/hip_runtime.h>
#include <cstdio>
#include <cstdint>

#ifndef N_LAUNCH_PER_PHASE
#define N_LAUNCH_PER_PHASE 0
#endif

#define DI __device__ __forceinline__
typedef unsigned short u16;
typedef __attribute__((ext_vector_type(8))) short bf16x8;
typedef __attribute__((ext_vector_type(16))) float f32x16;
typedef __attribute__((ext_vector_type(2))) __bf16 bf2_t;
typedef __attribute__((ext_vector_type(2))) float f2_t;
typedef __attribute__((ext_vector_type(4))) unsigned u32x4;
typedef __attribute__((ext_vector_type(2))) unsigned u32x2;
typedef __attribute__((ext_vector_type(4))) float f32x4v;
DI float4 nt_load4(const float* p) { const f32x4v t = __builtin_nontemporal_load((const f32x4v*)p); return make_float4(t[0], t[1], t[2], t[3]); }
DI void nt_store4(void* p, unsigned a, unsigned b, unsigned c, unsigned d) { const u32x4 t = {a, b, c, d}; __builtin_nontemporal_store(t, (u32x4*)p); }
#define MFMA(a, b, c) __builtin_amdgcn_mfma_f32_32x32x16_bf16((a), (b), (c), 0, 0, 0)

constexpr int T_ = 8192, D_ = 2048, S_ = 2048;
constexpr int INC = 4160;
constexpr float EPS = 1e-6f;
constexpr int NPH = 13;

constexpr size_t al256(size_t x) { return (x + 255) & ~(size_t)255; }
constexpr size_t WS_BAR = 0;
constexpr size_t WS_MOD = 32768;
constexpr size_t WS_ROPE = WS_MOD + al256(4 * 12288 * 4);
constexpr size_t WS_WINT = WS_ROPE + al256(2048 * 32 * 8);
constexpr size_t WS_WUQT = WS_WINT + al256((size_t)4224 * 2048 * 2);
constexpr size_t WS_WUKVT = WS_WUQT + al256((size_t)1536 * 512 * 2);
constexpr size_t WS_WOUTT = WS_WUKVT + al256((size_t)2048 * 512 * 2);
constexpr size_t WS_WQT = WS_WOUTT + al256((size_t)2048 * 2048 * 2);
constexpr size_t WS_SK = WS_WQT + al256((size_t)2048 * 2048 * 2);
constexpr size_t WS_U = WS_SK + al256((size_t)262144 * 2);
constexpr size_t WS_V = WS_U + al256((size_t)16384 * 2048);
constexpr size_t WS_H = WS_V + al256((size_t)16384 * 2048);
constexpr size_t WS_P = WS_H + al256((size_t)T_ * D_ * 2);
constexpr size_t WS_Q = WS_P + al256((size_t)T_ * INC * 2);
constexpr size_t WS_K = WS_Q + al256((size_t)T_ * 1536 * 2);
constexpr size_t WS_VT = WS_K + al256((size_t)T_ * 1536 * 2);
constexpr size_t WS_MG = WS_VT + al256((size_t)T_ * 1024 * 2);
constexpr size_t WS_X1 = WS_MG + al256((size_t)T_ * D_ * 2);
constexpr size_t WS_IDS = WS_X1 + al256((size_t)T_ * D_ * 4);
constexpr size_t WS_GATE = WS_IDS + al256((size_t)T_ * 128 * 4);
constexpr size_t WS_USC = WS_GATE + al256((size_t)T_ * 128 * 4);
constexpr size_t WS_VSC = WS_USC + 65536;
constexpr size_t WS_MODP = WS_VSC + 65536;
constexpr size_t WS_ACT = WS_MODP + al256((size_t)4 * 4 * 12288 * 4);
constexpr size_t WS_H2Q = WS_ACT + al256((size_t)T_ * 128 * 4);
constexpr size_t WS_HSC = WS_H2Q + al256((size_t)T_ * D_);
constexpr size_t WS_SSQ = WS_HSC + al256((size_t)T_ * 4);
constexpr size_t WS_END = WS_SSQ + al256((size_t)T_ * 16 * 4);
constexpr size_t WS_PA = WS_MG;
constexpr size_t WS_OUTP = WS_Q;
static_assert(WS_VT + (size_t)T_ * 1024 * 2 - WS_Q >= (size_t)T_ * D_ * 4, "OUTP alias");
static_assert((size_t)8 * T_ * 128 * 4 <= (size_t)T_ * D_ * 2, "PA alias");

constexpr int LDS_BYTES = 16 + 2 * 2 * 128 * 72 * 2 + 512;

struct Params {
  const float* in[20];
  float* out;
  char* ws;
  int ph_lo, ph_hi, coop, pad;
};

DI unsigned pk2(float a, float b) { f2_t v = {a, b}; bf2_t r = __builtin_convertvector(v, bf2_t); return __builtin_bit_cast(unsigned, r); }
DI float bflo(unsigned u) { return __uint_as_float(u << 16); }
DI float bfhi(unsigned u) { return __uint_as_float(u & 0xffff0000u); }
DI float dot2(unsigned a, unsigned b, float c) { return __builtin_amdgcn_fdot2_f32_bf16(__builtin_bit_cast(bf2_t, a), __builtin_bit_cast(bf2_t, b), c, false); }
DI float wave_sum(float v) {
#pragma unroll
  for (int o = 32; o >= 1; o >>= 1) v += __shfl_xor(v, o);
  return v;
}

#define XB_TMO      128
#define XB_XCNT(j)  (256  + 64 * (j))
#define XB_XSUB(j)  (1280 + 64 * (j))
#define XB_XGEN(j)  (2304 + 64 * (j))
#define XB_TOP      3328
#define XB_TOPGEN   3392
#define XCD_BAR_WORDS 3456
#define XB_SPIN_CAP (1u << 22)
#define LAS __attribute__((address_space(3)))
DI unsigned xb_ld(unsigned* p) { return __hip_atomic_load(p, __ATOMIC_RELAXED, __HIP_MEMORY_SCOPE_AGENT); }
DI unsigned xb_add(unsigned* p, unsigned v) { return __hip_atomic_fetch_add(p, v, __ATOMIC_RELAXED, __HIP_MEMORY_SCOPE_AGENT); }
DI unsigned xb_xcc_id() { return (unsigned)__builtin_amdgcn_s_getreg((3 << 11) | 20) & 0xFu; }
#define XB_SPIN(cond, bar) do { unsigned _sp = 0; while (cond) { __builtin_amdgcn_s_sleep(1); \
    if ((++_sp & 255u) == 0u) { if (xb_ld(&(bar)[XB_TMO])) break; if (_sp > XB_SPIN_CAP) { atomicAdd(&(bar)[XB_TMO], 1u); break; } } } } while (0)
struct XcdBarrier { unsigned* bar; unsigned x; volatile LAS unsigned* st; };
DI XcdBarrier xcd_barrier_post(unsigned* bar, volatile LAS unsigned* st) {
  XcdBarrier b; b.bar = bar; b.x = xb_xcc_id(); b.st = st;
  if (threadIdx.x == 0) (void)xb_add(&bar[XB_XCNT(b.x)], 1u);
  return b;
}
DI void xcd_barrier_complete(unsigned* bar, unsigned x, unsigned& nloc, unsigned& nx) {
  const unsigned G = gridDim.x * gridDim.y * gridDim.z;
  unsigned sum, cnt, mine, sp = 0u;
  for (;;) {
    sum = 0u; cnt = 0u; mine = 0u;
#pragma unroll
    for (unsigned j = 0; j < 16; ++j) { const unsigned c = xb_ld(&bar[XB_XCNT(j)]); sum += c; cnt += (c > 0u) ? 1u : 0u; mine = (j == x) ? c : mine; }
    if (sum == G) break;
    __builtin_amdgcn_s_sleep(1);
    if ((++sp & 255u) == 0u) { if (xb_ld(&bar[XB_TMO])) break; if (sp > XB_SPIN_CAP) { atomicAdd(&bar[XB_TMO], 1u); break; } }
  }
  nloc = mine > 0u ? mine : 1u; nx = cnt > 0u ? cnt : 1u;
}
DI void xcd_barrier(const XcdBarrier& b) {
  asm volatile("s_waitcnt vmcnt(0)" ::: "memory");
  __syncthreads();
  if (threadIdx.x == 0) {
    unsigned* bar = b.bar;
    __builtin_amdgcn_s_waitcnt(0);
    unsigned nloc = b.st[0], nx = b.st[1];
    if (nloc == 0u) { xcd_barrier_complete(bar, b.x, nloc, nx); b.st[0] = nloc; b.st[1] = nx; }
    const unsigned old = xb_add(&bar[XB_XSUB(b.x)], 1u);
    const unsigned gen = old / nloc;
    if (old + 1u == (gen + 1u) * nloc) {
      __builtin_amdgcn_fence(__ATOMIC_RELEASE, "agent");
      asm volatile("s_waitcnt vmcnt(0)" ::: "memory");
      const unsigned og = xb_add(&bar[XB_TOP], 1u);
      const unsigned tg = og / nx;
      if (og + 1u == (tg + 1u) * nx) xb_add(&bar[XB_TOPGEN], 1u);
      else XB_SPIN(xb_ld(&bar[XB_TOPGEN]) == tg, bar);
      __builtin_amdgcn_fence(__ATOMIC_ACQUIRE, "agent");
      xb_add(&bar[XB_XGEN(b.x)], 1u);
      asm volatile("s_waitcnt vmcnt(0)" ::: "memory");
    } else {
      XB_SPIN(xb_ld(&bar[XB_XGEN(b.x)]) == gen, bar);
      __builtin_amdgcn_fence(__ATOMIC_ACQUIRE, "agent");
      asm volatile("s_waitcnt vmcnt(0)" ::: "memory");
    }
  }
  __syncthreads();
}

template <class BG>
DI void xcd_barrier_bg(const XcdBarrier b, char* smem, BG bg) {
  asm volatile("s_waitcnt vmcnt(0)" ::: "memory");
  __syncthreads();
  volatile unsigned* sst = (volatile unsigned*)(smem + 12);
  unsigned mygen = 0u;
  if (threadIdx.x == 0) {
    unsigned* bar = b.bar;
    __builtin_amdgcn_s_waitcnt(0);
    unsigned nloc = b.st[0], nx = b.st[1];
    if (nloc == 0u) { xcd_barrier_complete(bar, b.x, nloc, nx); b.st[0] = nloc; b.st[1] = nx; }
    const unsigned old = xb_add(&bar[XB_XSUB(b.x)], 1u);
    const unsigned gen = old / nloc;
    mygen = gen;
    if (old + 1u == (gen + 1u) * nloc) {
      __builtin_amdgcn_fence(__ATOMIC_RELEASE, "agent");
      asm volatile("s_waitcnt vmcnt(0)" ::: "memory");
      const unsigned og = xb_add(&bar[XB_TOP], 1u);
      const unsigned tg = og / nx;
      if (og + 1u == (tg + 1u) * nx) xb_add(&bar[XB_TOPGEN], 1u);
      else XB_SPIN(xb_ld(&bar[XB_TOPGEN]) == tg, bar);
      __builtin_amdgcn_fence(__ATOMIC_ACQUIRE, "agent");
      xb_add(&bar[XB_XGEN(b.x)], 1u);
      asm volatile("s_waitcnt vmcnt(0)" ::: "memory");
      *sst = 1u;
    } else {
      *sst = 0u;
    }
  }
  __syncthreads();
  if (*sst == 0u) {
    bool more = true;
    unsigned polls = 0u;
    for (;;) {
      if (threadIdx.x == 0) {
        bool rel = xb_ld(&b.bar[XB_XGEN(b.x)]) != mygen;
        if (!rel && (++polls & 1023u) == 0u) { if (xb_ld(&b.bar[XB_TMO])) rel = true; else if (polls > XB_SPIN_CAP) { atomicAdd(&b.bar[XB_TMO], 1u); rel = true; } }
        *sst = rel ? 2u : 0u;
      }
      __syncthreads();
      const unsigned stv = *sst;
      if (stv == 2u) break;
      if (more) more = bg(); else __builtin_amdgcn_s_sleep(2);
      __syncthreads();
    }
    if (threadIdx.x == 0) {
      __builtin_amdgcn_fence(__ATOMIC_ACQUIRE, "agent");
      asm volatile("s_waitcnt vmcnt(0)" ::: "memory");
    }
    __syncthreads();
  }
}

template <bool SWAP, class Epi>
DI void gemm_tile(const u16* __restrict__ A, int lda, const u16* __restrict__ Bt, int ldb, int K, int m0, int n0, char* smem, Epi&& epi) {
  u16* As = (u16*)(smem + 16);
  u16* Bs = As + 2 * 128 * 72;
  const int tid = threadIdx.x, lane = tid & 63, w = tid >> 6, wm = w >> 1, wn = w & 1;
  const int r = lane & 31, hi = lane >> 5;
  f32x16 acc[2][2];
#pragma unroll
  for (int a = 0; a < 2; ++a)
#pragma unroll
    for (int b = 0; b < 2; ++b)
#pragma unroll
      for (int i = 0; i < 16; ++i) acc[a][b][i] = 0.f;
  const int srow = tid >> 3, skc = tid & 7;
  const u16* ag = A + (size_t)(m0 + srow) * lda + skc * 8;
  const u16* bg = Bt + (size_t)(n0 + srow) * ldb + skc * 8;
  u16* asw = As + srow * 72 + skc * 8;
  u16* bsw = Bs + srow * 72 + skc * 8;
  u32x4 ra0[4], rb0[4], ra1[4], rb1[4];
#pragma unroll
  for (int i = 0; i < 4; ++i) { ra0[i] = *(const u32x4*)(ag + (size_t)i * 32 * lda); rb0[i] = *(const u32x4*)(bg + (size_t)i * 32 * ldb); }
#pragma unroll
  for (int i = 0; i < 4; ++i) { ra1[i] = *(const u32x4*)(ag + (size_t)i * 32 * lda + 64); rb1[i] = *(const u32x4*)(bg + (size_t)i * 32 * ldb + 64); }
  __syncthreads();
#pragma unroll
  for (int i = 0; i < 4; ++i) { *(u32x4*)(asw + 32 * i * 72) = ra0[i]; *(u32x4*)(bsw + 32 * i * 72) = rb0[i]; }
  __syncthreads();
  const int KT = K >> 6;
  const u16* Asb = As + (wm * 64 + r) * 72 + hi * 8;
  const u16* Bsb = Bs + (wn * 64 + r) * 72 + hi * 8;
  auto compute = [&](int buf) __attribute__((always_inline)) {
    bf16x8 af[2][2], bfr[2][2];
    af[0][0] = *(const bf16x8*)(Asb + buf * 128 * 72);
    af[0][1] = *(const bf16x8*)(Asb + buf * 128 * 72 + 32 * 72);
    bfr[0][0] = *(const bf16x8*)(Bsb + buf * 128 * 72);
    bfr[0][1] = *(const bf16x8*)(Bsb + buf * 128 * 72 + 32 * 72);
#pragma unroll
    for (int ks = 0; ks < 4; ++ks) {
      const int c = ks & 1, n = c ^ 1;
      if (ks < 3) {
        af[n][0] = *(const bf16x8*)(Asb + buf * 128 * 72 + (ks + 1) * 16);
        af[n][1] = *(const bf16x8*)(Asb + buf * 128 * 72 + 32 * 72 + (ks + 1) * 16);
        bfr[n][0] = *(const bf16x8*)(Bsb + buf * 128 * 72 + (ks + 1) * 16);
        bfr[n][1] = *(const bf16x8*)(Bsb + buf * 128 * 72 + 32 * 72 + (ks + 1) * 16);
      }
      __builtin_amdgcn_sched_barrier(0);
#pragma unroll
      for (int mi = 0; mi < 2; ++mi)
#pragma unroll
        for (int ni = 0; ni < 2; ++ni) {
          if (SWAP) acc[mi][ni] = MFMA(bfr[c][ni], af[c][mi], acc[mi][ni]);
          else acc[mi][ni] = MFMA(af[c][mi], bfr[c][ni], acc[mi][ni]);
        }
      __builtin_amdgcn_sched_barrier(0);
    }
  };
  for (int kt = 0; kt < KT; kt += 2) {
    if (kt + 2 < KT) {
      const int k0 = (kt + 2) << 6;
#pragma unroll
      for (int i = 0; i < 4; ++i) { ra0[i] = *(const u32x4*)(ag + (size_t)i * 32 * lda + k0); rb0[i] = *(const u32x4*)(bg + (size_t)i * 32 * ldb + k0); }
    }
    compute(0);
#pragma unroll
    for (int i = 0; i < 4; ++i) { *(u32x4*)(asw + 128 * 72 + 32 * i * 72) = ra1[i]; *(u32x4*)(bsw + 128 * 72 + 32 * i * 72) = rb1[i]; }
    __syncthreads();
    if (kt + 3 < KT) {
      const int k0 = (kt + 3) << 6;
#pragma unroll
      for (int i = 0; i < 4; ++i) { ra1[i] = *(const u32x4*)(ag + (size_t)i * 32 * lda + k0); rb1[i] = *(const u32x4*)(bg + (size_t)i * 32 * ldb + k0); }
    }
    compute(1);
    if (kt + 2 < KT) {
#pragma unroll
      for (int i = 0; i < 4; ++i) { *(u32x4*)(asw + 32 * i * 72) = ra0[i]; *(u32x4*)(bsw + 32 * i * 72) = rb0[i]; }
    }
    __syncthreads();
  }
  epi(acc, m0 + wm * 64, n0 + wn * 64, r, hi);
}

DI void tile_rstd512(const u16* __restrict__ A, int lda, int m0, float* rs) {
  const int tid = threadIdx.x, row = tid >> 1, half = tid & 1;
  const uint4* p = (const uint4*)(A + (size_t)(m0 + row) * lda + half * 256);
  float ss = 0.f;
#pragma unroll 8
  for (int i = 0; i < 32; ++i) {
    uint4 v = p[i];
    ss = dot2(v.x, v.x, ss); ss = dot2(v.y, v.y, ss); ss = dot2(v.z, v.z, ss); ss = dot2(v.w, v.w, ss);
  }
  ss += __shfl_xor(ss, 1);
  if (half == 0) rs[row] = rsqrtf(ss * (1.f / 512.f) + EPS);
}

DI void transpose_item(const float* __restrict__ src, int N, int K, const float* __restrict__ scale, u16* __restrict__ dst, int tk, int tn, char* smem) {
  float* tile = (float*)(smem + 16);
  const int t = threadIdx.x;
  __syncthreads();
  {
    const int rr = t >> 4, c4 = (t & 15) * 4;
#pragma unroll
    for (int ps = 0; ps < 4; ++ps) {
      const int kk = ps * 16 + rr, k = tk * 64 + kk;
      float4 v = nt_load4(src + (size_t)k * N + tn * 64 + c4);
      const float sc = scale ? scale[k] : 1.f;
      tile[kk * 65 + c4 + 0] = v.x * sc; tile[kk * 65 + c4 + 1] = v.y * sc; tile[kk * 65 + c4 + 2] = v.z * sc; tile[kk * 65 + c4 + 3] = v.w * sc;
    }
  }
  __syncthreads();
  {
    const int n = t & 63, kc = (t >> 6) * 16;
    unsigned o[8];
#pragma unroll
    for (int j = 0; j < 8; ++j) o[j] = pk2(tile[(kc + 2 * j) * 65 + n], tile[(kc + 2 * j + 1) * 65 + n]);
    uint4* d = (uint4*)(dst + (size_t)(tn * 64 + n) * K + tk * 64 + kc);
    d[0] = make_uint4(o[0], o[1], o[2], o[3]); d[1] = make_uint4(o[4], o[5], o[6], o[7]);
  }
}

DI void convert_item(const float* __restrict__ src, u16* __restrict__ dst, size_t base) {
  const int t = threadIdx.x;
#pragma unroll
  for (int st = 0; st < 4; ++st) {
    const size_t idx = base + st * 2048 + t * 8;
    float4 a = *(const float4*)(src + idx), b = *(const float4*)(src + idx + 4);
    *(uint4*)(dst + idx) = make_uint4(pk2(a.x, a.y), pk2(a.z, a.w), pk2(b.x, b.y), pk2(b.z, b.w));
  }
}

DI float wave_max(float v) {
#pragma unroll
  for (int o = 32; o >= 1; o >>= 1) v = fmaxf(v, __shfl_xor(v, o));
  return v;
}
DI void fp8_rows_item(const float* __restrict__ src, unsigned char* __restrict__ dst, float* __restrict__ scales, int item) {
  const int lane = threadIdx.x & 63, w = threadIdx.x >> 6;
  const int row = item * 4 + w;
  const float* sr = src + (size_t)row * 2048 + lane * 16;
  f32x4v v[8];
  float amax = 0.f;
#pragma unroll
  for (int j = 0; j < 2; ++j)
#pragma unroll
    for (int q = 0; q < 4; ++q) {
      const f32x4v t = __builtin_nontemporal_load((const f32x4v*)(sr + 1024 * j + q * 4));
      v[j * 4 + q] = t;
      amax = fmaxf(amax, fmaxf(fmaxf(fabsf(t[0]), fabsf(t[1])), fmaxf(fabsf(t[2]), fabsf(t[3]))));
    }
  amax = wave_max(amax);
  int e = 0;
  if (amax > 0.f) e = (int)floorf(log2f(384.f / amax));
  e = e < -100 ? -100 : (e > 100 ? 100 : e);
  const float sc = ldexpf(1.f, e);
  if (lane == 0) scales[row] = ldexpf(1.f, -e);
#pragma unroll
  for (int j = 0; j < 2; ++j) {
    unsigned d[4];
#pragma unroll
    for (int q = 0; q < 4; ++q) {
      const f32x4v t = v[j * 4 + q];
      unsigned pk = __builtin_amdgcn_cvt_pk_fp8_f32(t[0] * sc, t[1] * sc, 0, false);
      pk = __builtin_amdgcn_cvt_pk_fp8_f32(t[2] * sc, t[3] * sc, pk, true);
      d[q] = pk;
    }
    nt_store4(dst + (size_t)row * 2048 + 1024 * j + lane * 16, d[0], d[1], d[2], d[3]);
  }
}

DI unsigned pack_i8x4(float a, float b, float c, float d) {
  const int ia = __float2int_rn(a), ib = __float2int_rn(b), ic = __float2int_rn(c), id = __float2int_rn(d);
  return (unsigned)(ia & 0xff) | ((unsigned)(ib & 0xff) << 8) | ((unsigned)(ic & 0xff) << 16) | ((unsigned)id << 24);
}
DI void i8_rows_item(const float* __restrict__ src, unsigned char* __restrict__ dst, float* __restrict__ scales, int item) {
  const int lane = threadIdx.x & 63, w = threadIdx.x >> 6;
  const int row = item * 4 + w;
  const float* sr = src + (size_t)row * 2048 + lane * 16;
  f32x4v v[8];
  float amax = 0.f;
#pragma unroll
  for (int j = 0; j < 2; ++j)
#pragma unroll
    for (int q = 0; q < 4; ++q) {
      const f32x4v t = __builtin_nontemporal_load((const f32x4v*)(sr + 1024 * j + q * 4));
      v[j * 4 + q] = t;
      amax = fmaxf(amax, fmaxf(fmaxf(fabsf(t[0]), fabsf(t[1])), fmaxf(fabsf(t[2]), fabsf(t[3]))));
    }
  amax = wave_max(amax);
  const float sc = amax > 0.f ? 127.f / amax : 0.f;
  if (lane == 0) scales[row] = amax * (1.f / 127.f);
#pragma unroll
  for (int j = 0; j < 2; ++j) {
    unsigned d[4];
#pragma unroll
    for (int q = 0; q < 4; ++q) { const f32x4v t = v[j * 4 + q]; d[q] = pack_i8x4(t[0] * sc, t[1] * sc, t[2] * sc, t[3] * sc); }
    nt_store4(dst + (size_t)row * 2048 + 1024 * j + lane * 16, d[0], d[1], d[2], d[3]);
  }
}

DI void conv_rows_item(const float* __restrict__ src, unsigned char* __restrict__ dst, float* __restrict__ scales, int item, bool i8) {
  const int lane = threadIdx.x & 63, w = threadIdx.x >> 6;
  const int row = item * 4 + w;
  const float* sr = src + (size_t)row * 2048 + lane * 16;
  f32x4v v[8];
  float amax = 0.f;
#pragma unroll
  for (int j = 0; j < 2; ++j)
#pragma unroll
    for (int q = 0; q < 4; ++q) {
      const f32x4v t = __builtin_nontemporal_load((const f32x4v*)(sr + 1024 * j + q * 4));
      v[j * 4 + q] = t;
      amax = fmaxf(amax, fmaxf(fmaxf(fabsf(t[0]), fabsf(t[1])), fmaxf(fabsf(t[2]), fabsf(t[3]))));
    }
  amax = wave_max(amax);
  int e = 0;
  if (amax > 0.f) e = (int)floorf(log2f(384.f / amax));
  e = e < -100 ? -100 : (e > 100 ? 100 : e);
  const float sc = i8 ? (amax > 0.f ? 127.f / amax : 0.f) : ldexpf(1.f, e);
  const float inv = i8 ? amax * (1.f / 127.f) : ldexpf(1.f, -e);
  if (lane == 0) scales[row] = inv;
#pragma unroll
  for (int j = 0; j < 2; ++j) {
    unsigned d0, d1, d2, d3;
    {
      const f32x4v t0 = v[j * 4] * sc, t1 = v[j * 4 + 1] * sc, t2 = v[j * 4 + 2] * sc, t3 = v[j * 4 + 3] * sc;
      if (i8) { d0 = pack_i8x4(t0[0], t0[1], t0[2], t0[3]); d1 = pack_i8x4(t1[0], t1[1], t1[2], t1[3]); d2 = pack_i8x4(t2[0], t2[1], t2[2], t2[3]); d3 = pack_i8x4(t3[0], t3[1], t3[2], t3[3]); }
      else {
        d0 = __builtin_amdgcn_cvt_pk_fp8_f32(t0[2], t0[3], __builtin_amdgcn_cvt_pk_fp8_f32(t0[0], t0[1], 0, false), true);
        d1 = __builtin_amdgcn_cvt_pk_fp8_f32(t1[2], t1[3], __builtin_amdgcn_cvt_pk_fp8_f32(t1[0], t1[1], 0, false), true);
        d2 = __builtin_amdgcn_cvt_pk_fp8_f32(t2[2], t2[3], __builtin_amdgcn_cvt_pk_fp8_f32(t2[0], t2[1], 0, false), true);
        d3 = __builtin_amdgcn_cvt_pk_fp8_f32(t3[2], t3[3], __builtin_amdgcn_cvt_pk_fp8_f32(t3[0], t3[1], 0, false), true);
      }
    }
    nt_store4(dst + (size_t)row * 2048 + 1024 * j + lane * 16, d0, d1, d2, d3);
  }
}

DI void mod_item(const Params& p, int item, char* smem) {
  float* cact = (float*)(smem + 16);
  float* red = cact + 4 * 512;
  const int t = threadIdx.x;
  const int cgi = item % 192, ksp = item / 192, kbase = ksp * 512;
  const float* c = p.in[1]; const float* W = p.in[2];
  float* mod = (float*)(p.ws + WS_MODP);
  __syncthreads();
  for (int i = t; i < 4 * 512; i += 256) { float v = c[(i >> 9) * 2048 + kbase + (i & 511)]; cact[i] = v / (1.f + __expf(-v)); }
  __syncthreads();
  const int cq = t & 15, kl = t >> 4, c0 = cgi * 64;
  float acc[4][4];
#pragma unroll
  for (int b = 0; b < 4; ++b)
#pragma unroll
    for (int j = 0; j < 4; ++j) acc[b][j] = 0.f;
  const float* wp = W + (size_t)(kbase + kl) * 12288 + c0 + cq * 4;
#pragma unroll 8
  for (int i = 0; i < 32; ++i) {
    const int k = kl + 16 * i;
    float4 w4 = nt_load4(wp + (size_t)i * 16 * 12288);
#pragma unroll
    for (int b = 0; b < 4; ++b) {
      const float a = cact[b * 512 + k];
      acc[b][0] += a * w4.x; acc[b][1] += a * w4.y; acc[b][2] += a * w4.z; acc[b][3] += a * w4.w;
    }
  }
#pragma unroll
  for (int b = 0; b < 4; ++b)
#pragma unroll
    for (int j = 0; j < 4; ++j) red[(kl * 16 + cq) * 17 + b * 4 + j] = acc[b][j];
  __syncthreads();
  {
    const int b = t >> 6, col = t & 63, q = col >> 2, j = col & 3;
    float s = 0.f;
#pragma unroll
    for (int k2 = 0; k2 < 16; ++k2) s += red[(k2 * 16 + q) * 17 + b * 4 + j];
    mod[(size_t)ksp * 49152 + b * 12288 + c0 + col] = s;
  }
}

constexpr int P0_MOD = 768;
constexpr int P0_TIN = 32 * 65, P0_TUQ = 8 * 24, P0_TUKV = 8 * 32, P0_TOUT = 32 * 32, P0_TWQ = 32 * 32;
constexpr int P0_SK = 32, P0_UV = 0, P0_ROPE = 32;
DI void phase0(const Params& p, char* smem) {
  constexpr int o1 = P0_MOD, o2 = o1 + P0_TIN, o3 = o2 + P0_TUQ, o4 = o3 + P0_TUKV, o5 = o4 + P0_TOUT, o6 = o5 + P0_TWQ, o7 = o6 + P0_SK, o8 = o7 + P0_UV, o9 = o8 + P0_UV, o10 = o9 + P0_ROPE;
  for (int it = blockIdx.x; it < o10; it += gridDim.x) {
    if (it < o1) mod_item(p, it, smem);
    else if (it < o2) { int j = it - o1; transpose_item(p.in[5], INC, 2048, nullptr, (u16*)(p.ws + WS_WINT), j / 65, j % 65, smem); }
    else if (it < o3) { int j = it - o2; transpose_item(p.in[8], 1536, 512, p.in[7], (u16*)(p.ws + WS_WUQT), j / 24, j % 24, smem); }
    else if (it < o4) { int j = it - o3; transpose_item(p.in[10], 2048, 512, p.in[9], (u16*)(p.ws + WS_WUKVT), j / 32, j % 32, smem); }
    else if (it < o5) { int j = it - o4; int tk = j / 32; transpose_item(p.in[13], 2048, 2048, tk < 16 ? p.in[11] : p.in[12] - 1024, (u16*)(p.ws + WS_WOUTT), tk, j % 32, smem); }
    else if (it < o6) { int j = it - o5; transpose_item(p.in[15], 2048, 2048, nullptr, (u16*)(p.ws + WS_WQT), j / 32, j % 32, smem); }
    else if (it < o7) convert_item(p.in[16], (u16*)(p.ws + WS_SK), (size_t)(it - o6) * 8192);
    else if (it < o8) fp8_rows_item(p.in[17], (unsigned char*)(p.ws + WS_U), (float*)(p.ws + WS_USC), it - o7);
    else if (it < o9) fp8_rows_item(p.in[18], (unsigned char*)(p.ws + WS_V), (float*)(p.ws + WS_VSC), it - o8);
    else {
      float2* rope = (float2*)(p.ws + WS_ROPE);
      const int base = (it - o9) * 2048;
      for (int e = threadIdx.x; e < 2048; e += 256) {
        const int idx = base + e, pos = idx >> 5, j = idx & 31;
        const float inv = 1.0f / powf(10000.0f, (float)(2 * j) / 64.0f);
        const float ang = (float)pos * inv;
        rope[idx] = make_float2(cosf(ang), sinf(ang));
      }
    }
  }
}

template <bool Q8, bool XBF>
DI void norm_rows(const float* __restrict__ X, const float* __restrict__ g, const float* mod, int bstride, u16* __restrict__ out, unsigned char* __restrict__ outq, float* __restrict__ qscale,
                  int row_start, int row_step, int row_end) {
  const int lane = threadIdx.x & 63, w = threadIdx.x >> 6;
  for (int row = row_start + w; row < row_end; row += row_step) {
    const float* xr = X + (size_t)row * D_;
    float4 v[8];
    float ss = 0.f;
#pragma unroll
    for (int j = 0; j < 8; ++j) {
      if (XBF) { const uint2 t = *(const uint2*)((const u16*)X + (size_t)row * D_ + j * 256 + lane * 4); v[j] = make_float4(bflo(t.x), bfhi(t.x), bflo(t.y), bfhi(t.y)); }
      else v[j] = *(const float4*)(xr + j * 256 + lane * 4);
      ss += v[j].x * v[j].x + v[j].y * v[j].y + v[j].z * v[j].z + v[j].w * v[j].w;
    }
    ss = wave_sum(ss);
    const float rstd = rsqrtf(ss * (1.f / D_) + EPS);
    const int b = row >> 11;
    const float* sh = mod + b * bstride;
    const float* sc = sh + 2048;
    float amax = 0.f;
#pragma unroll
    for (int j = 0; j < 8; ++j) {
      const int d = j * 256 + lane * 4;
      const float4 gg = *(const float4*)(g + d), s4 = *(const float4*)(sc + d), h4 = *(const float4*)(sh + d);
      const float o0 = v[j].x * rstd * gg.x * (1.f + s4.x) + h4.x;
      const float o1 = v[j].y * rstd * gg.y * (1.f + s4.y) + h4.y;
      const float o2 = v[j].z * rstd * gg.z * (1.f + s4.z) + h4.z;
      const float o3 = v[j].w * rstd * gg.w * (1.f + s4.w) + h4.w;
      *(uint2*)(out + (size_t)row * D_ + d) = make_uint2(pk2(o0, o1), pk2(o2, o3));
      if (Q8) { v[j] = make_float4(o0, o1, o2, o3); amax = fmaxf(amax, fmaxf(fmaxf(fabsf(o0), fabsf(o1)), fmaxf(fabsf(o2), fabsf(o3)))); }
    }
    if (Q8) {
      amax = wave_max(amax);
      const float qs = amax > 0.f ? 127.f / amax : 0.f;
      if (lane == 0) qscale[row] = amax * (1.f / 127.f);
#pragma unroll
      for (int j = 0; j < 8; ++j) *(unsigned*)(outq + (size_t)row * D_ + j * 256 + lane * 4) = pack_i8x4(v[j].x * qs, v[j].y * qs, v[j].z * qs, v[j].w * qs);
    }
  }
}
DI void phase1(const Params& p, char* smem) {
  const float* mp = (const float*)(p.ws + WS_MODP); float* mod = (float*)(p.ws + WS_MOD); const float* bias = p.in[3];
  for (int i = blockIdx.x * 256 + threadIdx.x; i < 49152; i += gridDim.x * 256)
    mod[i] = ((mp[i] + mp[49152 + i]) + mp[2 * 49152 + i]) + mp[3 * 49152 + i] + bias[i % 12288];
  const int rpb = T_ / (int)gridDim.x, row0 = (int)blockIdx.x * rpb, bb = row0 >> 11;
  float* lm = (float*)(smem + 16);
  __syncthreads();
  for (int c = threadIdx.x; c < 4096; c += 256) {
    const int src = bb * 12288 + c;
    lm[c] = ((mp[src] + mp[49152 + src]) + mp[2 * 49152 + src]) + mp[3 * 49152 + src] + bias[c];
  }
  __syncthreads();
  norm_rows<false, false>(p.in[0], p.in[4], lm, 0, (u16*)(p.ws + WS_H), nullptr, nullptr, row0, 4, row0 + rpb);
}

constexpr int CTR_TILE = 3520, CTR_CHUNK = 3584;
DI int grab(unsigned* ctr, char* smem) {
  __syncthreads();
  if (threadIdx.x == 0) *(volatile unsigned*)(smem + 8) = atomicAdd(ctr, 1u);
  __syncthreads();
  return (int)*(volatile unsigned*)(smem + 8);
}
DI void uv_chunk(const Params& p, int c) {
#pragma unroll 1
  for (int i = 0; i < 4; ++i) {
    const int item = c * 4 + i;
    if (item < 4096) i8_rows_item(p.in[17], (unsigned char*)(p.ws + WS_U), (float*)(p.ws + WS_USC), item);
    else fp8_rows_item(p.in[18], (unsigned char*)(p.ws + WS_V), (float*)(p.ws + WS_VSC), item - 4096);
  }
}
DI void phase2(const Params& p, char* smem, int rep) {
  const u16* H = (const u16*)(p.ws + WS_H); const u16* W = (const u16*)(p.ws + WS_WINT); u16* P = (u16*)(p.ws + WS_P); float* SSQ = (float*)(p.ws + WS_SSQ);
  (void)rep;
  for (int it = blockIdx.x; it < 64 * 32; it += gridDim.x) {
    const int tn = it / 64, tm = it % 64;
    gemm_tile<true>(H, D_, W, D_, D_, tm * 128, tn * 128, smem, [&](f32x16 (&acc)[2][2], int mb, int nb, int r, int hi) __attribute__((always_inline)) {
#pragma unroll
      for (int mi = 0; mi < 2; ++mi)
#pragma unroll
        for (int ni = 0; ni < 2; ++ni)
#pragma unroll
          for (int g = 0; g < 4; ++g) {
            const int row = mb + mi * 32 + r, col = nb + ni * 32 + hi * 4 + 8 * g;
            *(uint2*)(P + (size_t)row * INC + col) = make_uint2(pk2(acc[mi][ni][4 * g], acc[mi][ni][4 * g + 1]), pk2(acc[mi][ni][4 * g + 2], acc[mi][ni][4 * g + 3]));
          }
      if (nb >= 3072) {
#pragma unroll
        for (int mi = 0; mi < 2; ++mi) {
          float ss = 0.f;
#pragma unroll
          for (int ni = 0; ni < 2; ++ni)
#pragma unroll
            for (int i = 0; i < 16; ++i) ss += acc[mi][ni][i] * acc[mi][ni][i];
          ss += __shfl_xor(ss, 32);
          if (hi == 0) SSQ[(size_t)(mb + mi * 32 + r) * 16 + ((nb - 3072) >> 6)] = ss;
        }
      }
    });
  }
}

DI void phase3(const Params& p, char* smem) {
  const u16* P = (const u16*)(p.ws + WS_P);
  u16* Q = (u16*)(p.ws + WS_Q); u16* Kb = (u16*)(p.ws + WS_K); u16* VT = (u16*)(p.ws + WS_VT); u16* MG = (u16*)(p.ws + WS_MG);
  const float2* rope = (const float2*)(p.ws + WS_ROPE); const float* SSQ = (const float*)(p.ws + WS_SSQ);
  float* rs = (float*)(smem + 16 + 2 * 2 * 128 * 72 * 2);
  constexpr int NQ = 64 * 12, NKV = 64 * 16, NKR = 1024, NCV = 1024;
  const float qscale = 0.07216878364870322f * 1.4426950408889634f;
  const int G = (int)gridDim.x, bid = (int)blockIdx.x;
  if (bid < 64) {
    for (int tm = bid; tm < 64; tm += 64) {
      gemm_tile<true>((const u16*)(p.ws + WS_H), D_, (const u16*)(p.ws + WS_WINT), D_, D_, tm * 128, 4096, smem, [&](f32x16 (&acc)[2][2], int mb, int nb, int r, int hi) __attribute__((always_inline)) {
        if (nb != 4096) return;
#pragma unroll
        for (int mi = 0; mi < 2; ++mi) {
          const int row = mb + mi * 32 + r, pos = row & (S_ - 1);
#pragma unroll
          for (int g = 0; g < 4; ++g) {
            const int j = hi * 4 + 8 * g;
            float a0[4], a1[4];
#pragma unroll
            for (int e = 0; e < 4; ++e) {
              const float2 cs = rope[pos * 32 + j + e];
              const float x1 = acc[mi][0][4 * g + e], x2 = acc[mi][1][4 * g + e];
              a0[e] = x1 * cs.x - x2 * cs.y; a1[e] = x2 * cs.x + x1 * cs.y;
            }
            const uint2 lo = make_uint2(pk2(a0[0], a0[1]), pk2(a0[2], a0[3])), hi2 = make_uint2(pk2(a1[0], a1[1]), pk2(a1[2], a1[3]));
#pragma unroll
            for (int h = 0; h < 8; ++h) { *(uint2*)(Kb + (size_t)row * 1536 + h * 192 + 128 + j) = lo; *(uint2*)(Kb + (size_t)row * 1536 + h * 192 + 160 + j) = hi2; }
          }
        }
      });
    }
  }
  const int t_begin = bid < 64 ? NQ + NKV : bid - 64, t_step = G - 64;
  for (int it = t_begin; it < NQ + NKV; it += t_step) {
    if (it < NQ) {
      const int tn = it / 64, tm = it % 64;
      __syncthreads();
      if (threadIdx.x < 128) { const float4* sp = (const float4*)(SSQ + (size_t)(tm * 128 + threadIdx.x) * 16); const float4 a = sp[0], b = sp[1]; rs[threadIdx.x] = rsqrtf((((a.x + a.y) + (a.z + a.w)) + ((b.x + b.y) + (b.z + b.w))) * (1.f / 512.f) + EPS); }
      gemm_tile<true>(P + 3072, INC, (const u16*)(p.ws + WS_WUQT), 512, 512, tm * 128, tn * 128, smem, [&](f32x16 (&acc)[2][2], int mb, int nb, int r, int hi) __attribute__((always_inline)) {
        const bool is_rope = ((nb >> 6) % 3) == 2;
#pragma unroll
        for (int mi = 0; mi < 2; ++mi) {
          const int row = mb + mi * 32 + r;
          const float sc = rs[row - tm * 128] * qscale;
          const int pos = row & (S_ - 1);
#pragma unroll
          for (int g = 0; g < 4; ++g) {
            const int j = hi * 4 + 8 * g;
            float a0[4], a1[4];
#pragma unroll
            for (int e = 0; e < 4; ++e) { a0[e] = acc[mi][0][4 * g + e] * sc; a1[e] = acc[mi][1][4 * g + e] * sc; }
            if (is_rope) {
#pragma unroll
              for (int e = 0; e < 4; ++e) {
                const float2 cs = rope[pos * 32 + j + e];
                const float x1 = a0[e], x2 = a1[e];
                a0[e] = x1 * cs.x - x2 * cs.y; a1[e] = x2 * cs.x + x1 * cs.y;
              }
            }
            *(uint2*)(Q + (size_t)row * 1536 + nb + j) = make_uint2(pk2(a0[0], a0[1]), pk2(a0[2], a0[3]));
            *(uint2*)(Q + (size_t)row * 1536 + nb + 32 + j) = make_uint2(pk2(a1[0], a1[1]), pk2(a1[2], a1[3]));
          }
        }
      });
    } else if (it < NQ + NKV) {
      const int j2 = it - NQ, tn = j2 / 64, tm = j2 % 64;
      __syncthreads();
      if (threadIdx.x < 128) { const float4* sp = (const float4*)(SSQ + (size_t)(tm * 128 + threadIdx.x) * 16 + 8); const float4 a = sp[0], b = sp[1]; rs[threadIdx.x] = rsqrtf((((a.x + a.y) + (a.z + a.w)) + ((b.x + b.y) + (b.z + b.w))) * (1.f / 512.f) + EPS); }
      const int head = tn >> 1;
      if ((tn & 1) == 0) {
        gemm_tile<true>(P + 3584, INC, (const u16*)(p.ws + WS_WUKVT), 512, 512, tm * 128, tn * 128, smem, [&](f32x16 (&acc)[2][2], int mb, int nb, int r, int hi) __attribute__((always_inline)) {
#pragma unroll
          for (int mi = 0; mi < 2; ++mi) {
            const int row = mb + mi * 32 + r;
            const float sc = rs[row - tm * 128];
#pragma unroll
            for (int ni = 0; ni < 2; ++ni)
#pragma unroll
              for (int g = 0; g < 4; ++g) {
                const int d = (nb & 127) + ni * 32 + hi * 4 + 8 * g;
                *(uint2*)(Kb + (size_t)row * 1536 + head * 192 + d) = make_uint2(pk2(acc[mi][ni][4 * g] * sc, acc[mi][ni][4 * g + 1] * sc), pk2(acc[mi][ni][4 * g + 2] * sc, acc[mi][ni][4 * g + 3] * sc));
              }
          }
        });
      } else {
        gemm_tile<false>(P + 3584, INC, (const u16*)(p.ws + WS_WUKVT), 512, 512, tm * 128, tn * 128, smem, [&](f32x16 (&acc)[2][2], int mb, int nb, int r, int hi) __attribute__((always_inline)) {
#pragma unroll
          for (int mi = 0; mi < 2; ++mi)
#pragma unroll
            for (int g = 0; g < 4; ++g) {
              const int row0 = mb + mi * 32 + hi * 4 + 8 * g;
              const float s0 = rs[row0 - tm * 128], s1 = rs[row0 + 1 - tm * 128], s2 = rs[row0 + 2 - tm * 128], s3 = rs[row0 + 3 - tm * 128];
              const int b = row0 >> 11, t = row0 & (S_ - 1);
#pragma unroll
              for (int ni = 0; ni < 2; ++ni) {
                const int d = (nb & 127) + ni * 32 + r;
                *(uint2*)(VT + ((size_t)((b * 8 + head) * 128 + d)) * S_ + t) = make_uint2(pk2(acc[mi][ni][4 * g] * s0, acc[mi][ni][4 * g + 1] * s1), pk2(acc[mi][ni][4 * g + 2] * s2, acc[mi][ni][4 * g + 3] * s3));
              }
            }
        });
      }
    }
  }
}

DI void conv_items(const Params& p) {
  const u16* P = (const u16*)(p.ws + WS_P); u16* MG = (u16*)(p.ws + WS_MG);
  const float* cw = p.in[6];
  const int lane = threadIdx.x & 63;
  for (int j2 = blockIdx.x; j2 < 512; j2 += gridDim.x) {
    const int wv = j2 * 4 + (threadIdx.x >> 6);
    const int quad = wv & 1, run = wv >> 1;
    const int row0 = run * 8, t0 = row0 & (S_ - 1);
    const int ch = (quad * 4 + (lane >> 4)) * 128 + (lane & 15) * 8;
    float w0[8], w1[8], w2[8];
#pragma unroll
    for (int q = 0; q < 2; ++q) {
      const float4 a = *(const float4*)(cw + ch + q * 4), b2 = *(const float4*)(cw + 1024 + ch + q * 4), c2 = *(const float4*)(cw + 2048 + ch + q * 4);
      w0[q * 4] = a.x; w0[q * 4 + 1] = a.y; w0[q * 4 + 2] = a.z; w0[q * 4 + 3] = a.w;
      w1[q * 4] = b2.x; w1[q * 4 + 1] = b2.y; w1[q * 4 + 2] = b2.z; w1[q * 4 + 3] = b2.w;
      w2[q * 4] = c2.x; w2[q * 4 + 1] = c2.y; w2[q * 4 + 2] = c2.z; w2[q * 4 + 3] = c2.w;
    }
    float zm1[8], zm2[8];
#pragma unroll
    for (int e = 0; e < 8; ++e) { zm1[e] = 0.f; zm2[e] = 0.f; }
    if (t0 > 0) {
      const u32x4 c1 = *(const u32x4*)(P + (size_t)(row0 - 1) * INC + 1024 + ch), h1 = *(const u32x4*)(P + (size_t)(row0 - 1) * INC + 2048 + ch);
      const u32x4 c2 = *(const u32x4*)(P + (size_t)(row0 - 2) * INC + 1024 + ch), h2 = *(const u32x4*)(P + (size_t)(row0 - 2) * INC + 2048 + ch);
#pragma unroll
      for (int d = 0; d < 4; ++d) {
        zm1[2 * d] = bflo(c1[d]) * bflo(h1[d]); zm1[2 * d + 1] = bfhi(c1[d]) * bfhi(h1[d]);
        zm2[2 * d] = bflo(c2[d]) * bflo(h2[d]); zm2[2 * d + 1] = bfhi(c2[d]) * bfhi(h2[d]);
      }
    }
#pragma unroll 4
    for (int tt = 0; tt < 8; ++tt) {
      const size_t ro = (size_t)(row0 + tt) * INC;
      const u32x4 bb = *(const u32x4*)(P + ro + ch), cc = *(const u32x4*)(P + ro + 1024 + ch), hh = *(const u32x4*)(P + ro + 2048 + ch);
      float y[8];
      float ss = 0.f;
#pragma unroll
      for (int d = 0; d < 4; ++d) {
        const float za = bflo(cc[d]) * bflo(hh[d]), zb = bfhi(cc[d]) * bfhi(hh[d]);
        y[2 * d] = bflo(bb[d]) * (w0[2 * d] * zm2[2 * d] + w1[2 * d] * zm1[2 * d] + w2[2 * d] * za);
        y[2 * d + 1] = bfhi(bb[d]) * (w0[2 * d + 1] * zm2[2 * d + 1] + w1[2 * d + 1] * zm1[2 * d + 1] + w2[2 * d + 1] * zb);
        zm2[2 * d] = zm1[2 * d]; zm2[2 * d + 1] = zm1[2 * d + 1]; zm1[2 * d] = za; zm1[2 * d + 1] = zb;
        ss += y[2 * d] * y[2 * d] + y[2 * d + 1] * y[2 * d + 1];
      }
      ss += __shfl_xor(ss, 8); ss += __shfl_xor(ss, 4); ss += __shfl_xor(ss, 2); ss += __shfl_xor(ss, 1);
      const float rstd = rsqrtf(ss * (1.f / 128.f) + EPS);
      const u32x4 o = {pk2(y[0] * rstd, y[1] * rstd), pk2(y[2] * rstd, y[3] * rstd), pk2(y[4] * rstd, y[5] * rstd), pk2(y[6] * rstd, y[7] * rstd)};
      *(u32x4*)(MG + (size_t)(row0 + tt) * D_ + ch) = o;
    }
  }
}

DI void phase4(const Params& p, char* smem) {
  const u16* Q = (const u16*)(p.ws + WS_Q); const u16* Kb = (const u16*)(p.ws + WS_K); const u16* VT = (const u16*)(p.ws + WS_VT);
  u16* MG = (u16*)(p.ws + WS_MG);
  u16* Ks = (u16*)(smem + 16);
  u16* Vs = Ks + 64 * 200;
  float* mrg = (float*)(smem + 16);
  const int tid = threadIdx.x, lane = tid & 63, w = tid >> 6, qh = w & 1, kh = w >> 1, r = lane & 31, hi = lane >> 5;
  for (int it = blockIdx.x; it < 512; it += gridDim.x) {
    const int xq = it & 7, jq = it >> 3, bh = xq + 8 * (jq >> 4);
    const int pi = jq & 15, h = bh & 7, b = bh >> 3;
    for (int sub = 0; sub < 2; ++sub) {
      const int c = sub ? (31 - pi) : pi;
      const size_t qrow = (size_t)b * S_ + c * 64 + qh * 32 + r;
      bf16x8 qf[12];
#pragma unroll
      for (int ks = 0; ks < 12; ++ks) qf[ks] = *(const bf16x8*)(Q + qrow * 1536 + h * 192 + ks * 16 + hi * 8);
      f32x16 O[4];
#pragma unroll
      for (int dt = 0; dt < 4; ++dt)
#pragma unroll
        for (int i = 0; i < 16; ++i) O[dt][i] = 0.f;
      float m = -1e30f, l = 0.f;
      u32x4 kr[6]; u32x4 vr[4];
      const u16* kg = Kb + ((size_t)b * S_ + (tid >> 2)) * 1536 + h * 192 + (tid & 3) * 8;
      const u16* vg = VT + ((size_t)((b * 8 + h) * 128 + (tid >> 1))) * S_ + (tid & 1) * 8;
      u16* ksw = Ks + (tid >> 2) * 200 + (tid & 3) * 8;
      u16* vsw = Vs + (tid >> 1) * 68 + (tid & 1) * 8;
      auto load_tile = [&]() __attribute__((always_inline)) {
#pragma unroll
        for (int i = 0; i < 6; ++i) kr[i] = *(const u32x4*)(kg + i * 32);
#pragma unroll
        for (int i = 0; i < 4; ++i) vr[i] = *(const u32x4*)(vg + i * 16);
        kg += 64 * 1536; vg += 64;
      };
      load_tile();
      for (int kt = 0; kt <= c; ++kt) {
        __syncthreads();
#pragma unroll
        for (int i = 0; i < 6; ++i) *(u32x4*)(ksw + i * 32) = kr[i];
#pragma unroll
        for (int i = 0; i < 4; ++i) { u32x2 lo2 = {vr[i][0], vr[i][1]}, hi2 = {vr[i][2], vr[i][3]}; *(u32x2*)(vsw + i * 16) = lo2; *(u32x2*)(vsw + i * 16 + 4) = hi2; }
        __syncthreads();
        if (kt < c) load_tile();
        f32x16 s;
#pragma unroll
        for (int i = 0; i < 16; ++i) s[i] = 0.f;
        const u16* kp = Ks + (kh * 32 + r) * 200 + hi * 8;
        {
          bf16x8 kf[4];
#pragma unroll
          for (int i = 0; i < 4; ++i) kf[i] = *(const bf16x8*)(kp + i * 16);
#pragma unroll
          for (int ks = 0; ks < 12; ++ks) {
            __builtin_amdgcn_sched_barrier(0);
            s = MFMA(kf[ks & 3], qf[ks], s);
            if (ks + 4 < 12) kf[ks & 3] = *(const bf16x8*)(kp + (ks + 4) * 16);
          }
          __builtin_amdgcn_sched_barrier(0);
        }
        bf16x8 vf0[4];
#pragma unroll
        for (int dt = 0; dt < 4; ++dt) {
          const u16* vp = Vs + (dt * 32 + r) * 68 + kh * 32 + 4 * hi;
          const u32x2 v0 = *(const u32x2*)vp, v1 = *(const u32x2*)(vp + 8);
          const u32x4 vv = {v0[0], v0[1], v1[0], v1[1]};
          vf0[dt] = __builtin_bit_cast(bf16x8, vv);
        }
        float mx = s[0];
#pragma unroll
        for (int i = 1; i < 16; ++i) mx = fmaxf(mx, s[i]);
        mx = fmaxf(mx, __shfl_xor(mx, 32));
        const float mn = fmaxf(m, mx);
        const float alpha = __builtin_amdgcn_exp2f(m - mn);
        const bool resc = __builtin_amdgcn_ballot_w64(mn > m) != 0ull;
        m = mn;
        float rsum = 0.f;
#pragma unroll
        for (int i = 0; i < 16; ++i) { s[i] = __builtin_amdgcn_exp2f(s[i] - mn); rsum += s[i]; }
        l = l * alpha + rsum;
        if (resc) {
#pragma unroll
          for (int dt = 0; dt < 4; ++dt)
#pragma unroll
            for (int i = 0; i < 16; ++i) O[dt][i] *= alpha;
        }
        {
          const u32x4 pu0 = {pk2(s[0], s[1]), pk2(s[2], s[3]), pk2(s[4], s[5]), pk2(s[6], s[7])};
          const u32x4 pu1 = {pk2(s[8], s[9]), pk2(s[10], s[11]), pk2(s[12], s[13]), pk2(s[14], s[15])};
          const bf16x8 pf0 = __builtin_bit_cast(bf16x8, pu0), pf1 = __builtin_bit_cast(bf16x8, pu1);
          bf16x8 vf1[4];
#pragma unroll
          for (int dt = 0; dt < 4; ++dt) {
            const u16* vp = Vs + (dt * 32 + r) * 68 + kh * 32 + 16 + 4 * hi;
            const u32x2 v0 = *(const u32x2*)vp, v1 = *(const u32x2*)(vp + 8);
            const u32x4 vv = {v0[0], v0[1], v1[0], v1[1]};
            vf1[dt] = __builtin_bit_cast(bf16x8, vv);
          }
          __builtin_amdgcn_sched_barrier(0);
#pragma unroll
          for (int dt = 0; dt < 4; ++dt) O[dt] = MFMA(vf0[dt], pf0, O[dt]);
#pragma unroll
          for (int dt = 0; dt < 4; ++dt) O[dt] = MFMA(vf1[dt], pf1, O[dt]);
        }
      }
      l += __shfl_xor(l, 32);
      __syncthreads();
      float* mq = mrg + qh * 66 * 64;
      if (kh == 1) {
#pragma unroll
        for (int dt = 0; dt < 4; ++dt)
#pragma unroll
          for (int i = 0; i < 16; ++i) mq[(dt * 16 + i) * 64 + lane] = O[dt][i];
        mq[64 * 64 + lane] = m; mq[65 * 64 + lane] = l;
      }
      __syncthreads();
      if (kh == 0) {
        const float m1 = mq[64 * 64 + lane], l1 = mq[65 * 64 + lane];
        const float mt = fmaxf(m, m1), a0 = exp2f(m - mt), a1 = exp2f(m1 - mt);
        const float inv = 1.f / (l * a0 + l1 * a1);
        float ss = 0.f;
#pragma unroll
        for (int dt = 0; dt < 4; ++dt)
#pragma unroll
          for (int i = 0; i < 16; ++i) { const float o = (O[dt][i] * a0 + mq[(dt * 16 + i) * 64 + lane] * a1) * inv; O[dt][i] = o; ss += o * o; }
        ss += __shfl_xor(ss, 32);
        const float rstd = rsqrtf(ss * (1.f / 128.f) + EPS);
#pragma unroll
        for (int dt = 0; dt < 4; ++dt)
#pragma unroll
          for (int g = 0; g < 4; ++g) {
            const int d = dt * 32 + hi * 4 + 8 * g;
            *(uint2*)(MG + qrow * D_ + 1024 + h * 128 + d) = make_uint2(pk2(O[dt][4 * g] * rstd, O[dt][4 * g + 1] * rstd), pk2(O[dt][4 * g + 2] * rstd, O[dt][4 * g + 3] * rstd));
          }
      }
    }
  }
}

DI void phase5(const Params& p, char* smem) {
  const u16* MG = (const u16*)(p.ws + WS_MG); const u16* W = (const u16*)(p.ws + WS_WOUTT);
  const float* X = p.in[0]; const float* mod = (const float*)(p.ws + WS_MOD); u16* X1 = (u16*)(p.ws + WS_X1);
  for (int it = blockIdx.x; it < 64 * 16; it += gridDim.x) {
    const int tn = it / 64, tm = it % 64;
    gemm_tile<true>(MG, D_, W, D_, D_, tm * 128, tn * 128, smem, [&](f32x16 (&acc)[2][2], int mb, int nb, int r, int hi) __attribute__((always_inline)) {
#pragma unroll
      for (int mi = 0; mi < 2; ++mi) {
        const int row = mb + mi * 32 + r, b = row >> 11;
        const float* gt = mod + b * 12288 + 2 * 2048;
#pragma unroll
        for (int ni = 0; ni < 2; ++ni)
#pragma unroll
          for (int g = 0; g < 4; ++g) {
            const int col = nb + ni * 32 + hi * 4 + 8 * g;
            const float4 xv = *(const float4*)(X + (size_t)row * D_ + col), gv = *(const float4*)(gt + col);
            float4 o;
            o.x = xv.x + gv.x * acc[mi][ni][4 * g]; o.y = xv.y + gv.y * acc[mi][ni][4 * g + 1]; o.z = xv.z + gv.z * acc[mi][ni][4 * g + 2]; o.w = xv.w + gv.w * acc[mi][ni][4 * g + 3];
            *(uint2*)(X1 + (size_t)row * D_ + col) = make_uint2(pk2(o.x, o.y), pk2(o.z, o.w));
          }
      }
    });
  }
}

DI void phase7(const Params& p, char* smem) {
  const u16* H2 = (const u16*)(p.ws + WS_H); const u16* W = (const u16*)(p.ws + WS_WQT); u16* PQ = (u16*)(p.ws + WS_P);
  for (int it = blockIdx.x; it < 64 * 16; it += gridDim.x) {
    const int tn = it / 64, tm = it % 64;
    gemm_tile<true>(H2, D_, W, D_, D_, tm * 128, tn * 128, smem, [&](f32x16 (&acc)[2][2], int mb, int nb, int r, int hi) __attribute__((always_inline)) {
#pragma unroll
      for (int mi = 0; mi < 2; ++mi)
#pragma unroll
        for (int ni = 0; ni < 2; ++ni)
#pragma unroll
          for (int g = 0; g < 4; ++g) {
            const int row = mb + mi * 32 + r, col = nb + ni * 32 + hi * 4 + 8 * g;
            *(uint2*)(PQ + (size_t)row * D_ + col) = make_uint2(pk2(acc[mi][ni][4 * g], acc[mi][ni][4 * g + 1]), pk2(acc[mi][ni][4 * g + 2], acc[mi][ni][4 * g + 3]));
          }
    });
  }
}

DI unsigned f2ord(float v) { unsigned u = __float_as_uint(v); return u ^ ((unsigned)((int)u >> 31) | 0x80000000u); }
DI unsigned med3u(unsigned a, unsigned b, unsigned c) { return max(min(a, b), min(max(a, b), c)); }
#define TOPK_INSERT(keys, x) { _Pragma("unroll") for (int _j = 15; _j >= 1; --_j) keys[_j] = med3u(keys[_j - 1], keys[_j], x); keys[0] = max(keys[0], x); }
DI void phase8(const Params& p, char* smem) {
  const u16* PQ = (const u16*)(p.ws + WS_P); const u16* SK = (const u16*)(p.ws + WS_SK);
  int* IDS = (int*)(p.ws + WS_IDS); float* GATE = (float*)(p.ws + WS_GATE);
  float* sc = (float*)(smem + 16);
  const int tid = threadIdx.x, lane = tid & 63, w = tid >> 6, r = lane & 31, hi = lane >> 5;
  for (int it = blockIdx.x; it < 128 * 8; it += gridDim.x) {
    const int h = it & 7, tile = it >> 3;
    const int pp = w >> 1, rh = w & 1;
    __syncthreads();
    {
      f32x16 acc[4];
#pragma unroll
      for (int nt = 0; nt < 4; ++nt)
#pragma unroll
        for (int i = 0; i < 16; ++i) acc[nt][i] = 0.f;
      const u16* ap = PQ + (size_t)(tile * 64 + rh * 32 + r) * D_ + h * 256 + pp * 128 + hi * 8;
      const u16* bp = SK + ((size_t)(h * 2 + pp) * 128 + r) * 128 + hi * 8;
      bf16x8 afr[8];
#pragma unroll
      for (int ks = 0; ks < 8; ++ks) afr[ks] = *(const bf16x8*)(ap + ks * 16);
#pragma unroll
      for (int hf = 0; hf < 2; ++hf) {
        bf16x8 bfr[4][4];
#pragma unroll
        for (int k2 = 0; k2 < 4; ++k2)
#pragma unroll
          for (int nt = 0; nt < 4; ++nt) bfr[k2][nt] = *(const bf16x8*)(bp + nt * 32 * 128 + (hf * 4 + k2) * 16);
        __builtin_amdgcn_sched_barrier(0);
#pragma unroll
        for (int k2 = 0; k2 < 4; ++k2)
#pragma unroll
          for (int nt = 0; nt < 4; ++nt) acc[nt] = MFMA(afr[hf * 4 + k2], bfr[k2][nt], acc[nt]);
        __builtin_amdgcn_sched_barrier(0);
      }
#pragma unroll
      for (int nt = 0; nt < 4; ++nt)
#pragma unroll
        for (int i = 0; i < 16; ++i) sc[(pp * 64 + rh * 32 + hi * 4 + (i & 3) + 8 * (i >> 2)) * 129 + nt * 32 + r] = acc[nt][i];
    }
    __syncthreads();
    {
      const int rowi = tid & 127, half = tid >> 7;
      float* row = sc + rowi * 129;
      unsigned* mk = (unsigned*)(smem + 16 + 128 * 129 * 4);
      unsigned keys[16];
#pragma unroll
      for (int j = 0; j < 16; ++j) keys[j] = 0u;
#pragma unroll 4
      for (int n2 = 0; n2 < 64; ++n2) {
        const int n = half * 64 + n2;
        unsigned x = (f2ord(row[n]) & 0xFFFFFF80u) | (unsigned)(127 - n);
        TOPK_INSERT(keys, x);
      }
      if (half == 1) {
#pragma unroll
        for (int j = 0; j < 16; ++j) mk[j * 128 + rowi] = keys[j];
      }
      __syncthreads();
      if (half == 0) {
#pragma unroll
        for (int j = 0; j < 16; ++j) { unsigned x = mk[j * 128 + rowi]; TOPK_INSERT(keys, x); }
        float vals[16];
#pragma unroll
        for (int j = 0; j < 16; ++j) vals[j] = row[127 - (keys[j] & 127u)];
#pragma unroll
        for (int j = 0; j < 16; ++j) { row[j] = vals[j]; row[16 + j] = __int_as_float((int)(127 - (keys[j] & 127u))); }
      }
    }
    __syncthreads();
    if (tid < 64) {
      const float* ra = sc + tid * 129; const float* rb = sc + (64 + tid) * 129;
      float a[16], bq[16];
#pragma unroll
      for (int j = 0; j < 16; ++j) { a[j] = ra[j]; bq[j] = rb[j]; }
      unsigned keys[16];
#pragma unroll
      for (int j = 0; j < 16; ++j) keys[j] = 0u;
#pragma unroll
      for (int i = 0; i < 16; ++i)
#pragma unroll
        for (int j = 0; j < 16; ++j)
          if ((i + 1) * (j + 1) <= 16) {
            unsigned x = (f2ord(a[i] + bq[j]) & 0xFFFFFF00u) | (unsigned)(255 - (i * 16 + j));
            TOPK_INSERT(keys, x);
          }
      float bv[16]; int ex[16];
      float mx = -1e30f;
#pragma unroll
      for (int q = 0; q < 16; ++q) {
        const int flat = 255 - (int)(keys[q] & 255u), i = flat >> 4, j = flat & 15;
        bv[q] = ra[i] + rb[j];
        ex[q] = __float_as_int(ra[16 + i]) * 128 + __float_as_int(rb[16 + j]);
        mx = fmaxf(mx, bv[q]);
      }
      float sum = 0.f;
#pragma unroll
      for (int q = 0; q < 16; ++q) { bv[q] = __expf(bv[q] - mx); sum += bv[q]; }
      const float inv = 1.f / sum;
      const size_t o = (size_t)(tile * 64 + tid) * 128 + h * 16;
#pragma unroll
      for (int q = 0; q < 16; q += 4) {
        *(int4*)(IDS + o + q) = make_int4(ex[q], ex[q + 1], ex[q + 2], ex[q + 3]);
        *(float4*)(GATE + o + q) = make_float4(bv[q] * inv, bv[q + 1] * inv, bv[q + 2] * inv, bv[q + 3] * inv);
      }
    }
  }
}

constexpr int CTR_UQ = 4096, CTR_VQ = 4608;
DI f2_t cvt8lo(unsigned w) { return __builtin_amdgcn_cvt_pk_f32_fp8(w, false); }
DI f2_t cvt8hi(unsigned w) { return __builtin_amdgcn_cvt_pk_f32_fp8(w, true); }
template <class F>
DI void xcd_queue(unsigned* ctrs, int nchunks, char* smem, F&& f) {
  const int x0 = (int)(xb_xcc_id() & 7u);
#pragma unroll 1
  for (int k = 0; k < 8; ++k) {
    const int s = (x0 + k) & 7;
    for (;;) { const int c = grab(ctrs + 64 * s, smem); if (c >= nchunks) break; f(s, c); }
  }
}
DI void wave_lds_sync() { asm volatile("s_waitcnt lgkmcnt(0)" ::: "memory"); __builtin_amdgcn_wave_barrier(); }

DI void phase9(const Params& p, char* smem, int rep) {
  const unsigned char* H2Q = (const unsigned char*)(p.ws + WS_H2Q); const unsigned char* U8 = (const unsigned char*)(p.ws + WS_U);
  const int* IDS = (const int*)(p.ws + WS_IDS); int* PA = (int*)(p.ws + WS_PA);
  const int lane = threadIdx.x & 63, w = threadIdx.x >> 6, g = lane >> 4, l15 = lane & 15;
  const int b3 = (lane >> 3) & 1, b2 = (lane >> 2) & 1, b1 = (lane >> 1) & 1, b0 = lane & 1;
  int* lw = (int*)(smem + 16) + w * 256;
  xcd_queue((unsigned*)(p.ws + WS_BAR) + CTR_UQ + rep * 8, 512, smem, [&](int s, int c) __attribute__((always_inline)) {
#pragma unroll 1
    for (int t = 0; t < 4; ++t) {
      const int tok = __builtin_amdgcn_readfirstlane(c * 16 + w * 4 + t);
      const int i0 = IDS[(size_t)tok * 128 + lane], i1 = IDS[(size_t)tok * 128 + 64 + lane];
      const u32x4 hq = *(const u32x4*)(H2Q + (size_t)tok * D_ + s * 256 + l15 * 16);
      wave_lds_sync();
      lw[(lane & 3) * 32 + (lane >> 2)] = i0;
      lw[(lane & 3) * 32 + 16 + (lane >> 2)] = i1;
      wave_lds_sync();
      const unsigned char* ub = U8 + s * 256 + l15 * 16;
#pragma unroll
      for (int batch = 0; batch < 2; ++batch) {
        int ida[16];
#pragma unroll
        for (int q = 0; q < 4; ++q) { const int4 v = *(const int4*)(lw + g * 32 + batch * 16 + q * 4); ida[q * 4] = v.x; ida[q * 4 + 1] = v.y; ida[q * 4 + 2] = v.z; ida[q * 4 + 3] = v.w; }
        u32x4 rows[16];
#pragma unroll
        for (int k = 0; k < 16; ++k) rows[k] = *(const u32x4*)(ub + (size_t)ida[k] * 2048);
        int part[16];
#pragma unroll
        for (int k = 0; k < 16; ++k) {
          int acc = 0;
#pragma unroll
          for (int d = 0; d < 4; ++d) acc = __builtin_amdgcn_sdot4((int)rows[k][d], (int)hq[d], acc, false);
          part[k] = acc;
        }
        int q8[8], q4[4], q2[2];
#pragma unroll
        for (int k = 0; k < 8; ++k) q8[k] = (b3 ? part[8 + k] : part[k]) + __shfl_xor(b3 ? part[k] : part[8 + k], 8);
#pragma unroll
        for (int k = 0; k < 4; ++k) q4[k] = (b2 ? q8[4 + k] : q8[k]) + __shfl_xor(b2 ? q8[k] : q8[4 + k], 4);
#pragma unroll
        for (int k = 0; k < 2; ++k) q2[k] = (b1 ? q4[2 + k] : q4[k]) + __shfl_xor(b1 ? q4[k] : q4[2 + k], 2);
        const int rr = (b0 ? q2[1] : q2[0]) + __shfl_xor(b0 ? q2[0] : q2[1], 1);
        PA[((size_t)s * T_ + tok) * 128 + 4 * (batch * 16 + l15) + g] = rr;
      }
    }
  });
}

DI void phase10(const Params& p) {
  const int* PA = (const int*)(p.ws + WS_PA); float* ACT = (float*)(p.ws + WS_ACT); const float* HSC = (const float*)(p.ws + WS_HSC);
  const int* IDS = (const int*)(p.ws + WS_IDS); const float* GATE = (const float*)(p.ws + WS_GATE);
  const float* USC = (const float*)(p.ws + WS_USC); const float* VSC = (const float*)(p.ws + WS_VSC);
  for (int i = blockIdx.x * 256 + threadIdx.x; i < T_ * 128; i += gridDim.x * 256) {
    int ai = 0;
#pragma unroll
    for (int s = 0; s < 8; ++s) ai += PA[(size_t)s * T_ * 128 + i];
    const int id = IDS[i];
    const float a = (float)ai * USC[id] * HSC[i >> 7];
    ACT[i] = 0.5f * a * (1.f + erff(a * 0.70710678118654752f)) * GATE[i] * VSC[id];
  }
}

DI void phase11(const Params& p, char* smem, int rep) {
  const unsigned char* V8 = (const unsigned char*)(p.ws + WS_V);
  const int* IDS = (const int*)(p.ws + WS_IDS); const float* ACT = (const float*)(p.ws + WS_ACT); u16* OUTP = (u16*)(p.ws + WS_OUTP);
  const int lane = threadIdx.x & 63, w = threadIdx.x >> 6, g = lane >> 4, l15 = lane & 15;
  const int b5 = (lane >> 5) & 1, b4 = (lane >> 4) & 1;
  int* lw = (int*)(smem + 16) + w * 256;
  float* lf = (float*)(lw + 128);
  xcd_queue((unsigned*)(p.ws + WS_BAR) + CTR_VQ + rep * 8, 512, smem, [&](int s, int c) __attribute__((always_inline)) {
#pragma unroll 1
    for (int t = 0; t < 4; ++t) {
      const int tok = __builtin_amdgcn_readfirstlane(c * 16 + w * 4 + t);
      const int i0 = IDS[(size_t)tok * 128 + lane], i1 = IDS[(size_t)tok * 128 + 64 + lane];
      const float a0 = ACT[(size_t)tok * 128 + lane], a1 = ACT[(size_t)tok * 128 + 64 + lane];
      wave_lds_sync();
      lw[(lane & 3) * 32 + (lane >> 2)] = i0; lw[(lane & 3) * 32 + 16 + (lane >> 2)] = i1;
      lf[(lane & 3) * 32 + (lane >> 2)] = a0; lf[(lane & 3) * 32 + 16 + (lane >> 2)] = a1;
      wave_lds_sync();
      f2_t o[8];
#pragma unroll
      for (int i = 0; i < 8; ++i) o[i] = f2_t{0.f, 0.f};
      const unsigned char* vb = V8 + s * 256 + l15 * 16;
#pragma unroll
      for (int batch = 0; batch < 2; ++batch) {
        int ida[16]; float aa[16];
#pragma unroll
        for (int q = 0; q < 4; ++q) {
          const int4 v = *(const int4*)(lw + g * 32 + batch * 16 + q * 4); ida[q * 4] = v.x; ida[q * 4 + 1] = v.y; ida[q * 4 + 2] = v.z; ida[q * 4 + 3] = v.w;
          const float4 f = *(const float4*)(lf + g * 32 + batch * 16 + q * 4); aa[q * 4] = f.x; aa[q * 4 + 1] = f.y; aa[q * 4 + 2] = f.z; aa[q * 4 + 3] = f.w;
        }
        u32x4 rows[16];
#pragma unroll
        for (int k = 0; k < 16; ++k) rows[k] = *(const u32x4*)(vb + (size_t)ida[k] * 2048);
#pragma unroll
        for (int k = 0; k < 16; ++k) {
          const f2_t a2 = {aa[k], aa[k]};
#pragma unroll
          for (int d = 0; d < 4; ++d) { const unsigned ww = rows[k][d]; o[2 * d] += a2 * cvt8lo(ww); o[2 * d + 1] += a2 * cvt8hi(ww); }
        }
      }
      float ov[16];
#pragma unroll
      for (int d = 0; d < 4; ++d) { ov[4 * d] = o[2 * d].x; ov[4 * d + 1] = o[2 * d].y; ov[4 * d + 2] = o[2 * d + 1].x; ov[4 * d + 3] = o[2 * d + 1].y; }
      float q8[8], q4[4];
#pragma unroll
      for (int k = 0; k < 8; ++k) q8[k] = (b5 ? ov[8 + k] : ov[k]) + __shfl_xor(b5 ? ov[k] : ov[8 + k], 32);
#pragma unroll
      for (int k = 0; k < 4; ++k) q4[k] = (b4 ? q8[4 + k] : q8[k]) + __shfl_xor(b4 ? q8[k] : q8[4 + k], 16);
      *(uint2*)(OUTP + (size_t)tok * D_ + s * 256 + l15 * 16 + 8 * b5 + 4 * b4) = make_uint2(pk2(q4[0], q4[1]), pk2(q4[2], q4[3]));
    }
  });
}

DI void phase12(const Params& p) {
  const u16* X1 = (const u16*)(p.ws + WS_X1); const u16* OUTP = (const u16*)(p.ws + WS_OUTP);
  const float* mod = (const float*)(p.ws + WS_MOD); const float* gfin = p.in[19];
  const int lane = threadIdx.x & 63, w = threadIdx.x >> 6;
  for (int row = blockIdx.x * 4 + w; row < T_; row += gridDim.x * 4) {
    const float* gt = mod + (row >> 11) * 12288 + 5 * 2048;
    float4 v[8];
    float ss = 0.f;
#pragma unroll
    for (int j = 0; j < 8; ++j) {
      const int d = j * 256 + lane * 4;
      const uint2 xb2 = *(const uint2*)(X1 + (size_t)row * D_ + d);
      const float4 xv = make_float4(bflo(xb2.x), bfhi(xb2.x), bflo(xb2.y), bfhi(xb2.y)), gv = *(const float4*)(gt + d);
      const uint2 ob = *(const uint2*)(OUTP + (size_t)row * D_ + d);
      const float4 ov = make_float4(bflo(ob.x), bfhi(ob.x), bflo(ob.y), bfhi(ob.y));
      v[j] = make_float4(xv.x + gv.x * ov.x, xv.y + gv.y * ov.y, xv.z + gv.z * ov.z, xv.w + gv.w * ov.w);
      ss += v[j].x * v[j].x + v[j].y * v[j].y + v[j].z * v[j].z + v[j].w * v[j].w;
    }
    ss = wave_sum(ss);
    const float rstd = rsqrtf(ss * (1.f / D_) + EPS);
#pragma unroll
    for (int j = 0; j < 8; ++j) {
      const int d = j * 256 + lane * 4;
      const float4 gv = *(const float4*)(gfin + d);
      { const f32x4v t = {v[j].x * rstd * gv.x, v[j].y * rstd * gv.y, v[j].z * rstd * gv.z, v[j].w * rstd * gv.w}; __builtin_nontemporal_store(t, (f32x4v*)(p.out + (size_t)row * D_ + d)); }
    }
  }
}

DI void phase6(const Params& p) {
  norm_rows<true, true>((const float*)(p.ws + WS_X1), p.in[14], (const float*)(p.ws + WS_MOD) + 3 * 2048, 12288, (u16*)(p.ws + WS_H), (unsigned char*)(p.ws + WS_H2Q), (float*)(p.ws + WS_HSC), (int)blockIdx.x * 4, (int)gridDim.x * 4, T_);
}

__global__ void __launch_bounds__(256, 2) mega(Params p) {
  extern __shared__ __attribute__((aligned(16))) char smem[];
  XcdBarrier xb;
  const bool multi = (p.ph_hi - p.ph_lo) > 1;
  if (multi) {
    if (threadIdx.x == 0) *(uint4*)smem = make_uint4(0u, 0u, 0u, 0u);
    __syncthreads();
    xb = xcd_barrier_post((unsigned*)(p.ws + WS_BAR), (volatile LAS unsigned*)smem);
  }
#ifndef PHMASK
#define PHMASK 0x1fff
#endif
#ifndef REPMASK
#define REPMASK 0
#endif
  int rep = 0;
  constexpr int CTR_BG = 3776, BG_CHUNKS = 4096;
  auto bg_unit = [&]() __attribute__((always_inline)) -> bool {
    const int c = grab((unsigned*)(p.ws + WS_BAR) + CTR_BG, smem);
    if (c >= BG_CHUNKS) return false;
#pragma unroll 1
    for (int i = 0; i < 2; ++i) {
      const int item = c * 2 + i;
      const bool isu = item < 4096;
      conv_rows_item(isu ? p.in[17] : p.in[18], (unsigned char*)(p.ws + (isu ? WS_U : WS_V)), (float*)(p.ws + (isu ? WS_USC : WS_VSC)), isu ? item : item - 4096, isu);
    }
    return true;
  };
#define RUN_PHASE(n, call) if (p.ph_lo <= (n) && (n) < p.ph_hi) { \
    if ((n) > p.ph_lo) { if ((n) <= 7) xcd_barrier_bg(xb, smem, bg_unit); else xcd_barrier(xb); } \
    if (PHMASK & (1 << (n))) { call; if (REPMASK & (1 << (n))) { xcd_barrier(xb); rep = 1; call; rep = 0; } } \
    if ((n) == 7) { while (bg_unit()) {} } }
  RUN_PHASE(0, phase0(p, smem))
  RUN_PHASE(1, phase1(p, smem))
#ifdef BARX
  for (int i = 0; i < BARX; ++i) xcd_barrier(xb);
#endif
  RUN_PHASE(2, phase2(p, smem, rep))
  RUN_PHASE(3, phase3(p, smem))
  RUN_PHASE(4, (conv_items(p), phase4(p, smem)))
  RUN_PHASE(5, phase5(p, smem))
  RUN_PHASE(6, phase6(p))
  RUN_PHASE(7, phase7(p, smem))
  RUN_PHASE(8, phase8(p, smem))
  RUN_PHASE(9, phase9(p, smem, rep))
  RUN_PHASE(10, phase10(p))
  RUN_PHASE(11, phase11(p, smem, rep))
  RUN_PHASE(12, phase12(p))
}

extern "C" void kernel_launch(void* const* d_in, const int* in_sizes, int n_in, void* d_out, int out_size, void* d_ws, size_t ws_size, hipStream_t stream) {
  static int grid = 0;
  if (grid == 0) {
    if (n_in != 20 || ws_size < WS_END) { fprintf(stderr, "kernel_launch: unexpected n_in %d / ws_size %zu (need %zu)\n", n_in, ws_size, (size_t)WS_END); grid = -1; return; }
    int dev = 0, cus = 0, per_cu = 0;
    hipGetDevice(&dev);
    hipDeviceGetAttribute(&cus, hipDeviceAttributeMultiprocessorCount, dev);
    hipFuncSetAttribute((const void*)mega, hipFuncAttributeMaxDynamicSharedMemorySize, LDS_BYTES);
    hipOccupancyMaxActiveBlocksPerMultiprocessor(&per_cu, (const void*)mega, 256, LDS_BYTES);
    if (per_cu < 1) { fprintf(stderr, "kernel_launch: occupancy query says %d\n", per_cu); per_cu = 1; }
    if (per_cu > 2) per_cu = 2;
    grid = cus * per_cu;
    fprintf(stderr, "kernel_launch: grid %d (%d per CU)\n", grid, per_cu);
  }
  if (grid < 0) return;
  Params p{};
  for (int i = 0; i < 20; ++i) p.in[i] = (const float*)d_in[i];
  p.out = (float*)d_out; p.ws = (char*)d_ws;
#if N_LAUNCH_PER_PHASE
  p.coop = 0;
  for (int ph = 0; ph < NPH; ++ph) {
    p.ph_lo = ph; p.ph_hi = ph + 1;
    hipLaunchKernelGGL(mega, dim3(grid), dim3(256), LDS_BYTES, stream, p);
  }
#else
  hipMemsetAsync((char*)d_ws + WS_BAR, 0, WS_MOD, stream);
  p.coop = 0; p.ph_lo = 0; p.ph_hi = NPH;
  void* args[] = {&p};
  hipError_t e = hipLaunchCooperativeKernel((const void*)mega, dim3(grid), dim3(256), args, LDS_BYTES, stream);
  if (e != hipSuccess) fprintf(stderr, "cooperative launch failed: %s (grid %d)\n", hipGetErrorString(e), grid);
#endif
}
```

```cpp
#include <hip/hip_runtime.h>
#include <cstdio>
#include <cstdint>

#define DI __device__ __forceinline__
typedef unsigned short u16;
typedef __attribute__((ext_vector_type(8))) short bf16x8;
typedef __attribute__((ext_vector_type(16))) float f32x16;
typedef __attribute__((ext_vector_type(2))) __bf16 bf2_t;
typedef __attribute__((ext_vector_type(2))) float f2_t;
typedef __attribute__((ext_vector_type(4))) unsigned u32x4;
typedef __attribute__((ext_vector_type(2))) unsigned u32x2;
typedef __attribute__((ext_vector_type(4))) float f32x4v;
DI float4 nt_load4(const float* p) { const f32x4v t = __builtin_nontemporal_load((const f32x4v*)p); return make_float4(t[0], t[1], t[2], t[3]); }
DI void nt_store4(void* p, unsigned a, unsigned b, unsigned c, unsigned d) { const u32x4 t = {a, b, c, d}; __builtin_nontemporal_store(t, (u32x4*)p); }
#define MFMA(a, b, c) __builtin_amdgcn_mfma_f32_32x32x16_bf16((a), (b), (c), 0, 0, 0)

constexpr int T_ = 8192, D_ = 2048, S_ = 2048;
constexpr int INC = 4160;
constexpr float EPS = 1e-6f;
constexpr int NPH = 13;

constexpr size_t al256(size_t x) { return (x + 255) & ~(size_t)255; }
constexpr size_t WS_BAR = 0;
constexpr size_t WS_MOD = 32768;
constexpr size_t WS_ROPE = WS_MOD + al256(4 * 12288 * 4);
constexpr size_t WS_WINT = WS_ROPE + al256(2048 * 32 * 8);
constexpr size_t WS_WUQT = WS_WINT + al256((size_t)4224 * 2048 * 2);
constexpr size_t WS_WUKVT = WS_WUQT + al256((size_t)1536 * 512 * 2);
constexpr size_t WS_WOUTT = WS_WUKVT + al256((size_t)2048 * 512 * 2);
constexpr size_t WS_WQT = WS_WOUTT + al256((size_t)2048 * 2048 * 2);
constexpr size_t WS_SK = WS_WQT + al256((size_t)2048 * 2048 * 2);
constexpr size_t WS_U = WS_SK + al256((size_t)262144 * 2);
constexpr size_t WS_V = WS_U + al256((size_t)16384 * 2048);
constexpr size_t WS_H = WS_V + al256((size_t)16384 * 2048);
constexpr size_t WS_P = WS_H + al256((size_t)T_ * D_ * 2);
constexpr size_t WS_Q = WS_P + al256((size_t)T_ * INC * 2);
constexpr size_t WS_K = WS_Q + al256((size_t)T_ * 1536 * 2);
constexpr size_t WS_VT = WS_K + al256((size_t)T_ * 1536 * 2);
constexpr size_t WS_MG = WS_VT + al256((size_t)T_ * 1024 * 2);
constexpr size_t WS_X1 = WS_MG + al256((size_t)T_ * D_ * 2);
constexpr size_t WS_IDS = WS_X1 + al256((size_t)T_ * D_ * 4);
constexpr size_t WS_GATE = WS_IDS + al256((size_t)T_ * 128 * 4);
constexpr size_t WS_USC = WS_GATE + al256((size_t)T_ * 128 * 4);
constexpr size_t WS_VSC = WS_USC + 65536;
constexpr size_t WS_MODP = WS_VSC + 65536;
constexpr size_t WS_ACT = WS_MODP + al256((size_t)4 * 4 * 12288 * 4);
constexpr size_t WS_H2Q = WS_ACT + al256((size_t)T_ * 128 * 4);
constexpr size_t WS_HSC = WS_H2Q + al256((size_t)T_ * D_);
constexpr size_t WS_SSQ = WS_HSC + al256((size_t)T_ * 4);
constexpr size_t WS_END = WS_SSQ + al256((size_t)T_ * 16 * 4);
constexpr size_t WS_PA = WS_MG;
constexpr size_t WS_OUTP = WS_Q;
static_assert(WS_VT + (size_t)T_ * 1024 * 2 - WS_Q >= (size_t)T_ * D_ * 4, "OUTP alias");
static_assert((size_t)8 * T_ * 128 * 4 <= (size_t)T_ * D_ * 2, "PA alias");

constexpr int LDS_BYTES = 16 + 2 * 2 * 128 * 72 * 2 + 512;

struct Params {
  const float* in[20];
  float* out;
  char* ws;
  int ph_lo, ph_hi, coop, pad;
};

DI unsigned pk2(float a, float b) { f2_t v = {a, b}; bf2_t r = __builtin_convertvector(v, bf2_t); return __builtin_bit_cast(unsigned, r); }
DI float bflo(unsigned u) { return __uint_as_float(u << 16); }
DI float bfhi(unsigned u) { return __uint_as_float(u & 0xffff0000u); }
DI float dot2(unsigned a, unsigned b, float c) { return __builtin_amdgcn_fdot2_f32_bf16(__builtin_bit_cast(bf2_t, a), __builtin_bit_cast(bf2_t, b), c, false); }
DI float wave_sum(float v) {
#pragma unroll
  for (int o = 32; o >= 1; o >>= 1) v += __shfl_xor(v, o);
  return v;
}

#define XB_TMO      128
#define XB_XCNT(j)  (256  + 64 * (j))
#define XB_XSUB(j)  (1280 + 64 * (j))
#define XB_XGEN(j)  (2304 + 64 * (j))
#define XB_TOP      3328
#define XB_TOPGEN   3392
#define XCD_BAR_WORDS 3456
#define XB_SPIN_CAP (1u << 22)
#define LAS __attribute__((address_space(3)))
DI unsigned xb_ld(unsigned* p) { return __hip_atomic_load(p, __ATOMIC_RELAXED, __HIP_MEMORY_SCOPE_AGENT); }
DI unsigned xb_add(unsigned* p, unsigned v) { return __hip_atomic_fetch_add(p, v, __ATOMIC_RELAXED, __HIP_MEMORY_SCOPE_AGENT); }
DI unsigned xb_xcc_id() { return (unsigned)__builtin_amdgcn_s_getreg((3 << 11) | 20) & 0xFu; }
#define XB_SPIN(cond, bar) do { unsigned _sp = 0; while (cond) { __builtin_amdgcn_s_sleep(1); \
    if ((++_sp & 255u) == 0u) { if (xb_ld(&(bar)[XB_TMO])) break; if (_sp > XB_SPIN_CAP) { atomicAdd(&(bar)[XB_TMO], 1u); break; } } } } while (0)
struct XcdBarrier { unsigned* bar; unsigned x; volatile LAS unsigned* st; };
DI XcdBarrier xcd_barrier_post(unsigned* bar, volatile LAS unsigned* st) {
  XcdBarrier b; b.bar = bar; b.x = xb_xcc_id(); b.st = st;
  if (threadIdx.x == 0) (void)xb_add(&bar[XB_XCNT(b.x)], 1u);
  return b;
}
DI void xcd_barrier_complete(unsigned* bar, unsigned x, unsigned& nloc, unsigned& nx) {
  const unsigned G = gridDim.x * gridDim.y * gridDim.z;
  unsigned sum, cnt, mine, sp = 0u;
  for (;;) {
    sum = 0u; cnt = 0u; mine = 0u;
#pragma unroll
    for (unsigned j = 0; j < 16; ++j) { const unsigned c = xb_ld(&bar[XB_XCNT(j)]); sum += c; cnt += (c > 0u) ? 1u : 0u; mine = (j == x) ? c : mine; }
    if (sum == G) break;
    __builtin_amdgcn_s_sleep(1);
    if ((++sp & 255u) == 0u) { if (xb_ld(&bar[XB_TMO])) break; if (sp > XB_SPIN_CAP) { atomicAdd(&bar[XB_TMO], 1u); break; } }
  }
  nloc = mine > 0u ? mine : 1u; nx = cnt > 0u ? cnt : 1u;
}
DI void xcd_barrier(const XcdBarrier& b) {
  asm volatile("s_waitcnt vmcnt(0)" ::: "memory");
  __syncthreads();
  if (threadIdx.x == 0) {
    unsigned* bar = b.bar;
    __builtin_amdgcn_s_waitcnt(0);
    unsigned nloc = b.st[0], nx = b.st[1];
    if (nloc == 0u) { xcd_barrier_complete(bar, b.x, nloc, nx); b.st[0] = nloc; b.st[1] = nx; }
    const unsigned old = xb_add(&bar[XB_XSUB(b.x)], 1u);
    const unsigned gen = old / nloc;
    if (old + 1u == (gen + 1u) * nloc) {
      __builtin_amdgcn_fence(__ATOMIC_RELEASE, "agent");
      asm volatile("s_waitcnt vmcnt(0)" ::: "memory");
      const unsigned og = xb_add(&bar[XB_TOP], 1u);
      const unsigned tg = og / nx;
      if (og + 1u == (tg + 1u) * nx) xb_add(&bar[XB_TOPGEN], 1u);
      else XB_SPIN(xb_ld(&bar[XB_TOPGEN]) == tg, bar);
      __builtin_amdgcn_fence(__ATOMIC_ACQUIRE, "agent");
      xb_add(&bar[XB_XGEN(b.x)], 1u);
      asm volatile("s_waitcnt vmcnt(0)" ::: "memory");
    } else {
      XB_SPIN(xb_ld(&bar[XB_XGEN(b.x)]) == gen, bar);
      __builtin_amdgcn_fence(__ATOMIC_ACQUIRE, "agent");
      asm volatile("s_waitcnt vmcnt(0)" ::: "memory");
    }
  }
  __syncthreads();
}

template <class BG>
DI void xcd_barrier_bg(const XcdBarrier b, char* smem, BG bg) {
  asm volatile("s_waitcnt vmcnt(0)" ::: "memory");
  __syncthreads();
  volatile unsigned* sst = (volatile unsigned*)(smem + 12);
  unsigned mygen = 0u;
  if (threadIdx.x == 0) {
    unsigned* bar = b.bar;
    __builtin_amdgcn_s_waitcnt(0);
    unsigned nloc = b.st[0], nx = b.st[1];
    if (nloc == 0u) { xcd_barrier_complete(bar, b.x, nloc, nx); b.st[0] = nloc; b.st[1] = nx; }
    const unsigned old = xb_add(&bar[XB_XSUB(b.x)], 1u);
    const unsigned gen = old / nloc;
    mygen = gen;
    if (old + 1u == (gen + 1u) * nloc) {
      __builtin_amdgcn_fence(__ATOMIC_RELEASE, "agent");
      asm volatile("s_waitcnt vmcnt(0)" ::: "memory");
      const unsigned og = xb_add(&bar[XB_TOP], 1u);
      const unsigned tg = og / nx;
      if (og + 1u == (tg + 1u) * nx) xb_add(&bar[XB_TOPGEN], 1u);
      else XB_SPIN(xb_ld(&bar[XB_TOPGEN]) == tg, bar);
      __builtin_amdgcn_fence(__ATOMIC_ACQUIRE, "agent");
      xb_add(&bar[XB_XGEN(b.x)], 1u);
      asm volatile("s_waitcnt vmcnt(0)" ::: "memory");
      *sst = 1u;
    } else {
      *sst = 0u;
    }
  }
  __syncthreads();
  if (*sst == 0u) {
    bool more = true;
    unsigned polls = 0u;
    for (;;) {
      if (threadIdx.x == 0) {
        bool rel = xb_ld(&b.bar[XB_XGEN(b.x)]) != mygen;
        if (!rel && (++polls & 1023u) == 0u) { if (xb_ld(&b.bar[XB_TMO])) rel = true; else if (polls > XB_SPIN_CAP) { atomicAdd(&b.bar[XB_TMO], 1u); rel = true; } }
        *sst = rel ? 2u : 0u;
      }
      __syncthreads();
      const unsigned stv = *sst;
      if (stv == 2u) break;
      if (more) more = bg(); else __builtin_amdgcn_s_sleep(2);
      __syncthreads();
    }
    if (threadIdx.x == 0) {
      __builtin_amdgcn_fence(__ATOMIC_ACQUIRE, "agent");
      asm volatile("s_waitcnt vmcnt(0)" ::: "memory");
    }
    __syncthreads();
  }
}

template <bool SWAP, class Epi>
DI void gemm_tile(const u16* __restrict__ A, int lda, const u16* __restrict__ Bt, int ldb, int K, int m0, int n0, char* smem, Epi&& epi) {
  u16* As = (u16*)(smem + 16);
  u16* Bs = As + 2 * 128 * 72;
  const int tid = threadIdx.x, lane = tid & 63, w = tid >> 6, wm = w >> 1, wn = w & 1;
  const int r = lane & 31, hi = lane >> 5;
  f32x16 acc[2][2];
#pragma unroll
  for (int a = 0; a < 2; ++a)
#pragma unroll
    for (int b = 0; b < 2; ++b)
#pragma unroll
      for (int i = 0; i < 16; ++i) acc[a][b][i] = 0.f;
  const int srow = tid >> 3, skc = tid & 7;
  const u16* ag = A + (size_t)(m0 + srow) * lda + skc * 8;
  const u16* bg = Bt + (size_t)(n0 + srow) * ldb + skc * 8;
  u16* asw = As + srow * 72 + skc * 8;
  u16* bsw = Bs + srow * 72 + skc * 8;
  u32x4 ra0[4], rb0[4], ra1[4], rb1[4];
#pragma unroll
  for (int i = 0; i < 4; ++i) { ra0[i] = *(const u32x4*)(ag + (size_t)i * 32 * lda); rb0[i] = *(const u32x4*)(bg + (size_t)i * 32 * ldb); }
#pragma unroll
  for (int i = 0; i < 4; ++i) { ra1[i] = *(const u32x4*)(ag + (size_t)i * 32 * lda + 64); rb1[i] = *(const u32x4*)(bg + (size_t)i * 32 * ldb + 64); }
  __syncthreads();
#pragma unroll
  for (int i = 0; i < 4; ++i) { *(u32x4*)(asw + 32 * i * 72) = ra0[i]; *(u32x4*)(bsw + 32 * i * 72) = rb0[i]; }
  __syncthreads();
  const int KT = K >> 6;
  const u16* Asb = As + (wm * 64 + r) * 72 + hi * 8;
  const u16* Bsb = Bs + (wn * 64 + r) * 72 + hi * 8;
  auto compute = [&](int buf) __attribute__((always_inline)) {
    bf16x8 af[2][2], bfr[2][2];
    af[0][0] = *(const bf16x8*)(Asb + buf * 128 * 72);
    af[0][1] = *(const bf16x8*)(Asb + buf * 128 * 72 + 32 * 72);
    bfr[0][0] = *(const bf16x8*)(Bsb + buf * 128 * 72);
    bfr[0][1] = *(const bf16x8*)(Bsb + buf * 128 * 72 + 32 * 72);
#pragma unroll
    for (int ks = 0; ks < 4; ++ks) {
      const int c = ks & 1, n = c ^ 1;
      if (ks < 3) {
        af[n][0] = *(const bf16x8*)(Asb + buf * 128 * 72 + (ks + 1) * 16);
        af[n][1] = *(const bf16x8*)(Asb + buf * 128 * 72 + 32 * 72 + (ks + 1) * 16);
        bfr[n][0] = *(const bf16x8*)(Bsb + buf * 128 * 72 + (ks + 1) * 16);
        bfr[n][1] = *(const bf16x8*)(Bsb + buf * 128 * 72 + 32 * 72 + (ks + 1) * 16);
      }
      __builtin_amdgcn_sched_barrier(0);
#pragma unroll
      for (int mi = 0; mi < 2; ++mi)
#pragma unroll
        for (int ni = 0; ni < 2; ++ni) {
          if (SWAP) acc[mi][ni] = MFMA(bfr[c][ni], af[c][mi], acc[mi][ni]);
          else acc[mi][ni] = MFMA(af[c][mi], bfr[c][ni], acc[mi][ni]);
        }
      __builtin_amdgcn_sched_barrier(0);
    }
  };
  for (int kt = 0; kt < KT; kt += 2) {
    if (kt + 2 < KT) {
      const int k0 = (kt + 2) << 6;
#pragma unroll
      for (int i = 0; i < 4; ++i) { ra0[i] = *(const u32x4*)(ag + (size_t)i * 32 * lda + k0); rb0[i] = *(const u32x4*)(bg + (size_t)i * 32 * ldb + k0); }
    }
    compute(0);
#pragma unroll
    for (int i = 0; i < 4; ++i) { *(u32x4*)(asw + 128 * 72 + 32 * i * 72) = ra1[i]; *(u32x4*)(bsw + 128 * 72 + 32 * i * 72) = rb1[i]; }
    __syncthreads();
    if (kt + 3 < KT) {
      const int k0 = (kt + 3) << 6;
#pragma unroll
      for (int i = 0; i < 4; ++i) { ra1[i] = *(const u32x4*)(ag + (size_t)i * 32 * lda + k0); rb1[i] = *(const u32x4*)(bg + (size_t)i * 32 * ldb + k0); }
    }
    compute(1);
    if (kt + 2 < KT) {
#pragma unroll
      for (int i = 0; i < 4; ++i) { *(u32x4*)(asw + 32 * i * 72) = ra0[i]; *(u32x4*)(bsw + 32 * i * 72) = rb0[i]; }
    }
    __syncthreads();
  }
  epi(acc, m0 + wm * 64, n0 + wn * 64, r, hi);
}

DI void transpose_item(const float* __restrict__ src, int N, int K, const float* __restrict__ scale, u16* __restrict__ dst, int tk, int tn, char* smem) {
  float* tile = (float*)(smem + 16);
  const int t = threadIdx.x;
  __syncthreads();
  {
    const int rr = t >> 4, c4 = (t & 15) * 4;
#pragma unroll
    for (int ps = 0; ps < 4; ++ps) {
      const int kk = ps * 16 + rr, k = tk * 64 + kk;
      float4 v = nt_load4(src + (size_t)k * N + tn * 64 + c4);
      const float sc = scale ? scale[k] : 1.f;
      tile[kk * 65 + c4 + 0] = v.x * sc; tile[kk * 65 + c4 + 1] = v.y * sc; tile[kk * 65 + c4 + 2] = v.z * sc; tile[kk * 65 + c4 + 3] = v.w * sc;
    }
  }
  __syncthreads();
  {
    const int n = t & 63, kc = (t >> 6) * 16;
    unsigned o[8];
#pragma unroll
    for (int j = 0; j < 8; ++j) o[j] = pk2(tile[(kc + 2 * j) * 65 + n], tile[(kc + 2 * j + 1) * 65 + n]);
    uint4* d = (uint4*)(dst + (size_t)(tn * 64 + n) * K + tk * 64 + kc);
    d[0] = make_uint4(o[0], o[1], o[2], o[3]); d[1] = make_uint4(o[4], o[5], o[6], o[7]);
  }
}

DI void convert_item(const float* __restrict__ src, u16* __restrict__ dst, size_t base) {
  const int t = threadIdx.x;
#pragma unroll
  for (int st = 0; st < 4; ++st) {
    const size_t idx = base + st * 2048 + t * 8;
    float4 a = *(const float4*)(src + idx), b = *(const float4*)(src + idx + 4);
    *(uint4*)(dst + idx) = make_uint4(pk2(a.x, a.y), pk2(a.z, a.w), pk2(b.x, b.y), pk2(b.z, b.w));
  }
}

DI float wave_max(float v) {
#pragma unroll
  for (int o = 32; o >= 1; o >>= 1) v = fmaxf(v, __shfl_xor(v, o));
  return v;
}
DI unsigned pack_i8x4(float a, float b, float c, float d) {
  const int ia = __float2int_rn(a), ib = __float2int_rn(b), ic = __float2int_rn(c), id = __float2int_rn(d);
  return (unsigned)(ia & 0xff) | ((unsigned)(ib & 0xff) << 8) | ((unsigned)(ic & 0xff) << 16) | ((unsigned)id << 24);
}
DI void conv_rows_item(const float* __restrict__ src, unsigned char* __restrict__ dst, float* __restrict__ scales, int item, bool i8) {
  const int lane = threadIdx.x & 63, w = threadIdx.x >> 6;
  const int row = item * 4 + w;
  const float* sr = src + (size_t)row * 2048 + lane * 16;
  f32x4v v[8];
  float amax = 0.f;
#pragma unroll
  for (int j = 0; j < 2; ++j)
#pragma unroll
    for (int q = 0; q < 4; ++q) {
      const f32x4v t = __builtin_nontemporal_load((const f32x4v*)(sr + 1024 * j + q * 4));
      v[j * 4 + q] = t;
      amax = fmaxf(amax, fmaxf(fmaxf(fabsf(t[0]), fabsf(t[1])), fmaxf(fabsf(t[2]), fabsf(t[3]))));
    }
  amax = wave_max(amax);
  int e = 0;
  if (amax > 0.f) e = (int)floorf(log2f(384.f / amax));
  e = e < -100 ? -100 : (e > 100 ? 100 : e);
  const float sc = i8 ? (amax > 0.f ? 127.f / amax : 0.f) : ldexpf(1.f, e);
  const float inv = i8 ? amax * (1.f / 127.f) : ldexpf(1.f, -e);
  if (lane == 0) scales[row] = inv;
#pragma unroll
  for (int j = 0; j < 2; ++j) {
    unsigned d0, d1, d2, d3;
    {
      const f32x4v t0 = v[j * 4] * sc, t1 = v[j * 4 + 1] * sc, t2 = v[j * 4 + 2] * sc, t3 = v[j * 4 + 3] * sc;
      if (i8) { d0 = pack_i8x4(t0[0], t0[1], t0[2], t0[3]); d1 = pack_i8x4(t1[0], t1[1], t1[2], t1[3]); d2 = pack_i8x4(t2[0], t2[1], t2[2], t2[3]); d3 = pack_i8x4(t3[0], t3[1], t3[2], t3[3]); }
      else {
        d0 = __builtin_amdgcn_cvt_pk_fp8_f32(t0[2], t0[3], __builtin_amdgcn_cvt_pk_fp8_f32(t0[0], t0[1], 0, false), true);
        d1 = __builtin_amdgcn_cvt_pk_fp8_f32(t1[2], t1[3], __builtin_amdgcn_cvt_pk_fp8_f32(t1[0], t1[1], 0, false), true);
        d2 = __builtin_amdgcn_cvt_pk_fp8_f32(t2[2], t2[3], __builtin_amdgcn_cvt_pk_fp8_f32(t2[0], t2[1], 0, false), true);
        d3 = __builtin_amdgcn_cvt_pk_fp8_f32(t3[2], t3[3], __builtin_amdgcn_cvt_pk_fp8_f32(t3[0], t3[1], 0, false), true);
      }
    }
    nt_store4(dst + (size_t)row * 2048 + 1024 * j + lane * 16, d0, d1, d2, d3);
  }
}

DI void mod_item(const Params& p, int item, char* smem) {
  float* cact = (float*)(smem + 16);
  float* red = cact + 4 * 512;
  const int t = threadIdx.x;
  const int cgi = item % 192, ksp = item / 192, kbase = ksp * 512;
  const float* c = p.in[1]; const float* W = p.in[2];
  float* mod = (float*)(p.ws + WS_MODP);
  __syncthreads();
  for (int i = t; i < 4 * 512; i += 256) { float v = c[(i >> 9) * 2048 + kbase + (i & 511)]; cact[i] = v / (1.f + __expf(-v)); }
  __syncthreads();
  const int cq = t & 15, kl = t >> 4, c0 = cgi * 64;
  float acc[4][4];
#pragma unroll
  for (int b = 0; b < 4; ++b)
#pragma unroll
    for (int j = 0; j < 4; ++j) acc[b][j] = 0.f;
  const float* wp = W + (size_t)(kbase + kl) * 12288 + c0 + cq * 4;
#pragma unroll 8
  for (int i = 0; i < 32; ++i) {
    const int k = kl + 16 * i;
    float4 w4 = nt_load4(wp + (size_t)i * 16 * 12288);
#pragma unroll
    for (int b = 0; b < 4; ++b) {
      const float a = cact[b * 512 + k];
      acc[b][0] += a * w4.x; acc[b][1] += a * w4.y; acc[b][2] += a * w4.z; acc[b][3] += a * w4.w;
    }
  }
#pragma unroll
  for (int b = 0; b < 4; ++b)
#pragma unroll
    for (int j = 0; j < 4; ++j) red[(kl * 16 + cq) * 17 + b * 4 + j] = acc[b][j];
  __syncthreads();
  {
    const int b = t >> 6, col = t & 63, q = col >> 2, j = col & 3;
    float s = 0.f;
#pragma unroll
    for (int k2 = 0; k2 < 16; ++k2) s += red[(k2 * 16 + q) * 17 + b * 4 + j];
    mod[(size_t)ksp * 49152 + b * 12288 + c0 + col] = s;
  }
}

constexpr int P0_MOD = 768;
constexpr int P0_TIN = 32 * 65, P0_TUQ = 8 * 24, P0_TUKV = 8 * 32, P0_TOUT = 32 * 32, P0_TWQ = 32 * 32;
constexpr int P0_SK = 32, P0_UV = 0, P0_ROPE = 32;
DI void phase0(const Params& p, char* smem) {
  constexpr int o1 = P0_MOD, o2 = o1 + P0_TIN, o3 = o2 + P0_TUQ, o4 = o3 + P0_TUKV, o5 = o4 + P0_TOUT, o6 = o5 + P0_TWQ, o7 = o6 + P0_SK, o8 = o7 + P0_UV, o9 = o8 + P0_UV, o10 = o9 + P0_ROPE;
  for (int it = blockIdx.x; it < o10; it += gridDim.x) {
    if (it < o1) mod_item(p, it, smem);
    else if (it < o2) { int j = it - o1; transpose_item(p.in[5], INC, 2048, nullptr, (u16*)(p.ws + WS_WINT), j / 65, j % 65, smem); }
    else if (it < o3) { int j = it - o2; transpose_item(p.in[8], 1536, 512, p.in[7], (u16*)(p.ws + WS_WUQT), j / 24, j % 24, smem); }
    else if (it < o4) { int j = it - o3; transpose_item(p.in[10], 2048, 512, p.in[9], (u16*)(p.ws + WS_WUKVT), j / 32, j % 32, smem); }
    else if (it < o5) { int j = it - o4; int tk = j / 32; transpose_item(p.in[13], 2048, 2048, tk < 16 ? p.in[11] : p.in[12] - 1024, (u16*)(p.ws + WS_WOUTT), tk, j % 32, smem); }
    else if (it < o6) { int j = it - o5; transpose_item(p.in[15], 2048, 2048, nullptr, (u16*)(p.ws + WS_WQT), j / 32, j % 32, smem); }
    else if (it < o7) convert_item(p.in[16], (u16*)(p.ws + WS_SK), (size_t)(it - o6) * 8192);
    else {
      float2* rope = (float2*)(p.ws + WS_ROPE);
      const int base = (it - o9) * 2048;
      for (int e = threadIdx.x; e < 2048; e += 256) {
        const int idx = base + e, pos = idx >> 5, j = idx & 31;
        const float inv = 1.0f / powf(10000.0f, (float)(2 * j) / 64.0f);
        const float ang = (float)pos * inv;
        rope[idx] = make_float2(cosf(ang), sinf(ang));
      }
    }
  }
}

template <bool Q8, bool XBF>
DI void norm_rows(const float* __restrict__ X, const float* __restrict__ g, const float* mod, int bstride, u16* __restrict__ out, unsigned char* __restrict__ outq, float* __restrict__ qscale,
                  int row_start, int row_step, int row_end) {
  const int lane = threadIdx.x & 63, w = threadIdx.x >> 6;
  for (int row = row_start + w; row < row_end; row += row_step) {
    const float* xr = X + (size_t)row * D_;
    float4 v[8];
    float ss = 0.f;
#pragma unroll
    for (int j = 0; j < 8; ++j) {
      if (XBF) { const uint2 t = *(const uint2*)((const u16*)X + (size_t)row * D_ + j * 256 + lane * 4); v[j] = make_float4(bflo(t.x), bfhi(t.x), bflo(t.y), bfhi(t.y)); }
      else v[j] = *(const float4*)(xr + j * 256 + lane * 4);
      ss += v[j].x * v[j].x + v[j].y * v[j].y + v[j].z * v[j].z + v[j].w * v[j].w;
    }
    ss = wave_sum(ss);
    const float rstd = rsqrtf(ss * (1.f / D_) + EPS);
    const int b = row >> 11;
    const float* sh = mod + b * bstride;
    const float* sc = sh + 2048;
    float amax = 0.f;
#pragma unroll
    for (int j = 0; j < 8; ++j) {
      const int d = j * 256 + lane * 4;
      const float4 gg = *(const float4*)(g + d), s4 = *(const float4*)(sc + d), h4 = *(const float4*)(sh + d);
      const float o0 = v[j].x * rstd * gg.x * (1.f + s4.x) + h4.x;
      const float o1 = v[j].y * rstd * gg.y * (1.f + s4.y) + h4.y;
      const float o2 = v[j].z * rstd * gg.z * (1.f + s4.z) + h4.z;
      const float o3 = v[j].w * rstd * gg.w * (1.f + s4.w) + h4.w;
      *(uint2*)(out + (size_t)row * D_ + d) = make_uint2(pk2(o0, o1), pk2(o2, o3));
      if (Q8) { v[j] = make_float4(o0, o1, o2, o3); amax = fmaxf(amax, fmaxf(fmaxf(fabsf(o0), fabsf(o1)), fmaxf(fabsf(o2), fabsf(o3)))); }
    }
    if (Q8) {
      amax = wave_max(amax);
      const float qs = amax > 0.f ? 127.f / amax : 0.f;
      if (lane == 0) qscale[row] = amax * (1.f / 127.f);
#pragma unroll
      for (int j = 0; j < 8; ++j) *(unsigned*)(outq + (size_t)row * D_ + j * 256 + lane * 4) = pack_i8x4(v[j].x * qs, v[j].y * qs, v[j].z * qs, v[j].w * qs);
    }
  }
}
DI void phase1(const Params& p, char* smem) {
  const float* mp = (const float*)(p.ws + WS_MODP); float* mod = (float*)(p.ws + WS_MOD); const float* bias = p.in[3];
  for (int i = blockIdx.x * 256 + threadIdx.x; i < 49152; i += gridDim.x * 256)
    mod[i] = ((mp[i] + mp[49152 + i]) + mp[2 * 49152 + i]) + mp[3 * 49152 + i] + bias[i % 12288];
  const int rpb = T_ / (int)gridDim.x, row0 = (int)blockIdx.x * rpb, bb = row0 >> 11;
  float* lm = (float*)(smem + 16);
  __syncthreads();
  for (int c = threadIdx.x; c < 4096; c += 256) {
    const int src = bb * 12288 + c;
    lm[c] = ((mp[src] + mp[49152 + src]) + mp[2 * 49152 + src]) + mp[3 * 49152 + src] + bias[c];
  }
  __syncthreads();
  norm_rows<false, false>(p.in[0], p.in[4], lm, 0, (u16*)(p.ws + WS_H), nullptr, nullptr, row0, 4, row0 + rpb);
}

constexpr int CTR_TILE = 3520, CTR_CHUNK = 3584;
DI int grab(unsigned* ctr, char* smem) {
  __syncthreads();
  if (threadIdx.x == 0) *(volatile unsigned*)(smem + 8) = atomicAdd(ctr, 1u);
  __syncthreads();
  return (int)*(volatile unsigned*)(smem + 8);
}
DI void phase2(const Params& p, char* smem, int rep) {
  const u16* H = (const u16*)(p.ws + WS_H); const u16* W = (const u16*)(p.ws + WS_WINT); u16* P = (u16*)(p.ws + WS_P); float* SSQ = (float*)(p.ws + WS_SSQ);
  (void)rep;
  for (int it = blockIdx.x; it < 64 * 32; it += gridDim.x) {
    const int tn = it / 64, tm = it % 64;
    gemm_tile<true>(H, D_, W, D_, D_, tm * 128, tn * 128, smem, [&](f32x16 (&acc)[2][2], int mb, int nb, int r, int hi) __attribute__((always_inline)) {
#pragma unroll
      for (int mi = 0; mi < 2; ++mi)
#pragma unroll
        for (int ni = 0; ni < 2; ++ni)
#pragma unroll
          for (int g = 0; g < 4; ++g) {
            const int row = mb + mi * 32 + r, col = nb + ni * 32 + hi * 4 + 8 * g;
            *(uint2*)(P + (size_t)row * INC + col) = make_uint2(pk2(acc[mi][ni][4 * g], acc[mi][ni][4 * g + 1]), pk2(acc[mi][ni][4 * g + 2], acc[mi][ni][4 * g + 3]));
          }
      if (nb >= 3072) {
#pragma unroll
        for (int mi = 0; mi < 2; ++mi) {
          float ss = 0.f;
#pragma unroll
          for (int ni = 0; ni < 2; ++ni)
#pragma unroll
            for (int i = 0; i < 16; ++i) ss += acc[mi][ni][i] * acc[mi][ni][i];
          ss += __shfl_xor(ss, 32);
          if (hi == 0) SSQ[(size_t)(mb + mi * 32 + r) * 16 + ((nb - 3072) >> 6)] = ss;
        }
      }
    });
  }
}

DI void phase3(const Params& p, char* smem) {
  const u16* P = (const u16*)(p.ws + WS_P);
  u16* Q = (u16*)(p.ws + WS_Q); u16* Kb = (u16*)(p.ws + WS_K); u16* VT = (u16*)(p.ws + WS_VT); u16* MG = (u16*)(p.ws + WS_MG);
  const float2* rope = (const float2*)(p.ws + WS_ROPE); const float* SSQ = (const float*)(p.ws + WS_SSQ);
  float* rs = (float*)(smem + 16 + 2 * 2 * 128 * 72 * 2);
  constexpr int NQ = 64 * 12, NKV = 64 * 16, NKR = 1024, NCV = 1024;
  const float qscale = 0.07216878364870322f * 1.4426950408889634f;
  const int G = (int)gridDim.x, bid = (int)blockIdx.x;
  if (bid < 64) {
    for (int tm = bid; tm < 64; tm += 64) {
      gemm_tile<true>((const u16*)(p.ws + WS_H), D_, (const u16*)(p.ws + WS_WINT), D_, D_, tm * 128, 4096, smem, [&](f32x16 (&acc)[2][2], int mb, int nb, int r, int hi) __attribute__((always_inline)) {
        if (nb != 4096) return;
#pragma unroll
        for (int mi = 0; mi < 2; ++mi) {
          const int row = mb + mi * 32 + r, pos = row & (S_ - 1);
#pragma unroll
          for (int g = 0; g < 4; ++g) {
            const int j = hi * 4 + 8 * g;
            float a0[4], a1[4];
#pragma unroll
            for (int e = 0; e < 4; ++e) {
              const float2 cs = rope[pos * 32 + j + e];
              const float x1 = acc[mi][0][4 * g + e], x2 = acc[mi][1][4 * g + e];
              a0[e] = x1 * cs.x - x2 * cs.y; a1[e] = x2 * cs.x + x1 * cs.y;
            }
            const uint2 lo = make_uint2(pk2(a0[0], a0[1]), pk2(a0[2], a0[3])), hi2 = make_uint2(pk2(a1[0], a1[1]), pk2(a1[2], a1[3]));
#pragma unroll
            for (int h = 0; h < 8; ++h) { *(uint2*)(Kb + (size_t)row * 1536 + h * 192 + 128 + j) = lo; *(uint2*)(Kb + (size_t)row * 1536 + h * 192 + 160 + j) = hi2; }
          }
        }
      });
    }
  }
  const int t_begin = bid < 64 ? NQ + NKV : bid - 64, t_step = G - 64;
  for (int it = t_begin; it < NQ + NKV; it += t_step) {
    if (it < NQ) {
      const int tn = it / 64, tm = it % 64;
      __syncthreads();
      if (threadIdx.x < 128) { const float4* sp = (const float4*)(SSQ + (size_t)(tm * 128 + threadIdx.x) * 16); const float4 a = sp[0], b = sp[1]; rs[threadIdx.x] = rsqrtf((((a.x + a.y) + (a.z + a.w)) + ((b.x + b.y) + (b.z + b.w))) * (1.f / 512.f) + EPS); }
      gemm_tile<true>(P + 3072, INC, (const u16*)(p.ws + WS_WUQT), 512, 512, tm * 128, tn * 128, smem, [&](f32x16 (&acc)[2][2], int mb, int nb, int r, int hi) __attribute__((always_inline)) {
        const bool is_rope = ((nb >> 6) % 3) == 2;
#pragma unroll
        for (int mi = 0; mi < 2; ++mi) {
          const int row = mb + mi * 32 + r;
          const float sc = rs[row - tm * 128] * qscale;
          const int pos = row & (S_ - 1);
#pragma unroll
          for (int g = 0; g < 4; ++g) {
            const int j = hi * 4 + 8 * g;
            float a0[4], a1[4];
#pragma unroll
            for (int e = 0; e < 4; ++e) { a0[e] = acc[mi][0][4 * g + e] * sc; a1[e] = acc[mi][1][4 * g + e] * sc; }
            if (is_rope) {
#pragma unroll
              for (int e = 0; e < 4; ++e) {
                const float2 cs = rope[pos * 32 + j + e];
                const float x1 = a0[e], x2 = a1[e];
                a0[e] = x1 * cs.x - x2 * cs.y; a1[e] = x2 * cs.x + x1 * cs.y;
              }
            }
            *(uint2*)(Q + (size_t)row * 1536 + nb + j) = make_uint2(pk2(a0[0], a0[1]), pk2(a0[2], a0[3]));
            *(uint2*)(Q + (size_t)row * 1536 + nb + 32 + j) = make_uint2(pk2(a1[0], a1[1]), pk2(a1[2], a1[3]));
          }
        }
      });
    } else if (it < NQ + NKV) {
      const int j2 = it - NQ, tn = j2 / 64, tm = j2 % 64;
      __syncthreads();
      if (threadIdx.x < 128) { const float4* sp = (const float4*)(SSQ + (size_t)(tm * 128 + threadIdx.x) * 16 + 8); const float4 a = sp[0], b = sp[1]; rs[threadIdx.x] = rsqrtf((((a.x + a.y) + (a.z + a.w)) + ((b.x + b.y) + (b.z + b.w))) * (1.f / 512.f) + EPS); }
      const int head = tn >> 1;
      if ((tn & 1) == 0) {
        gemm_tile<true>(P + 3584, INC, (const u16*)(p.ws + WS_WUKVT), 512, 512, tm * 128, tn * 128, smem, [&](f32x16 (&acc)[2][2], int mb, int nb, int r, int hi) __attribute__((always_inline)) {
#pragma unroll
          for (int mi = 0; mi < 2; ++mi) {
            const int row = mb + mi * 32 + r;
            const float sc = rs[row - tm * 128];
#pragma unroll
            for (int ni = 0; ni < 2; ++ni)
#pragma unroll
              for (int g = 0; g < 4; ++g) {
                const int d = (nb & 127) + ni * 32 + hi * 4 + 8 * g;
                *(uint2*)(Kb + (size_t)row * 1536 + head * 192 + d) = make_uint2(pk2(acc[mi][ni][4 * g] * sc, acc[mi][ni][4 * g + 1] * sc), pk2(acc[mi][ni][4 * g + 2] * sc, acc[mi][ni][4 * g + 3] * sc));
              }
          }
        });
      } else {
        gemm_tile<false>(P + 3584, INC, (const u16*)(p.ws + WS_WUKVT), 512, 512, tm * 128, tn * 128, smem, [&](f32x16 (&acc)[2][2], int mb, int nb, int r, int hi) __attribute__((always_inline)) {
#pragma unroll
          for (int mi = 0; mi < 2; ++mi)
#pragma unroll
            for (int g = 0; g < 4; ++g) {
              const int row0 = mb + mi * 32 + hi * 4 + 8 * g;
              const float s0 = rs[row0 - tm * 128], s1 = rs[row0 + 1 - tm * 128], s2 = rs[row0 + 2 - tm * 128], s3 = rs[row0 + 3 - tm * 128];
              const int b = row0 >> 11, t = row0 & (S_ - 1);
#pragma unroll
              for (int ni = 0; ni < 2; ++ni) {
                const int d = (nb & 127) + ni * 32 + r;
                *(uint2*)(VT + ((size_t)((b * 8 + head) * 128 + d)) * S_ + t) = make_uint2(pk2(acc[mi][ni][4 * g] * s0, acc[mi][ni][4 * g + 1] * s1), pk2(acc[mi][ni][4 * g + 2] * s2, acc[mi][ni][4 * g + 3] * s3));
              }
            }
        });
      }
    }
  }
}

DI void conv_items(const Params& p) {
  const u16* P = (const u16*)(p.ws + WS_P); u16* MG = (u16*)(p.ws + WS_MG);
  const float* cw = p.in[6];
  const int lane = threadIdx.x & 63;
  for (int j2 = blockIdx.x; j2 < 512; j2 += gridDim.x) {
    const int wv = j2 * 4 + (threadIdx.x >> 6);
    const int quad = wv & 1, run = wv >> 1;
    const int row0 = run * 8, t0 = row0 & (S_ - 1);
    const int ch = (quad * 4 + (lane >> 4)) * 128 + (lane & 15) * 8;
    float w0[8], w1[8], w2[8];
#pragma unroll
    for (int q = 0; q < 2; ++q) {
      const float4 a = *(const float4*)(cw + ch + q * 4), b2 = *(const float4*)(cw + 1024 + ch + q * 4), c2 = *(const float4*)(cw + 2048 + ch + q * 4);
      w0[q * 4] = a.x; w0[q * 4 + 1] = a.y; w0[q * 4 + 2] = a.z; w0[q * 4 + 3] = a.w;
      w1[q * 4] = b2.x; w1[q * 4 + 1] = b2.y; w1[q * 4 + 2] = b2.z; w1[q * 4 + 3] = b2.w;
      w2[q * 4] = c2.x; w2[q * 4 + 1] = c2.y; w2[q * 4 + 2] = c2.z; w2[q * 4 + 3] = c2.w;
    }
    float zm1[8], zm2[8];
#pragma unroll
    for (int e = 0; e < 8; ++e) { zm1[e] = 0.f; zm2[e] = 0.f; }
    if (t0 > 0) {
      const u32x4 c1 = *(const u32x4*)(P + (size_t)(row0 - 1) * INC + 1024 + ch), h1 = *(const u32x4*)(P + (size_t)(row0 - 1) * INC + 2048 + ch);
      const u32x4 c2 = *(const u32x4*)(P + (size_t)(row0 - 2) * INC + 1024 + ch), h2 = *(const u32x4*)(P + (size_t)(row0 - 2) * INC + 2048 + ch);
#pragma unroll
      for (int d = 0; d < 4; ++d) {
        zm1[2 * d] = bflo(c1[d]) * bflo(h1[d]); zm1[2 * d + 1] = bfhi(c1[d]) * bfhi(h1[d]);
        zm2[2 * d] = bflo(c2[d]) * bflo(h2[d]); zm2[2 * d + 1] = bfhi(c2[d]) * bfhi(h2[d]);
      }
    }
#pragma unroll 4
    for (int tt = 0; tt < 8; ++tt) {
      const size_t ro = (size_t)(row0 + tt) * INC;
      const u32x4 bb = *(const u32x4*)(P + ro + ch), cc = *(const u32x4*)(P + ro + 1024 + ch), hh = *(const u32x4*)(P + ro + 2048 + ch);
      float y[8];
      float ss = 0.f;
#pragma unroll
      for (int d = 0; d < 4; ++d) {
        const float za = bflo(cc[d]) * bflo(hh[d]), zb = bfhi(cc[d]) * bfhi(hh[d]);
        y[2 * d] = bflo(bb[d]) * (w0[2 * d] * zm2[2 * d] + w1[2 * d] * zm1[2 * d] + w2[2 * d] * za);
        y[2 * d + 1] = bfhi(bb[d]) * (w0[2 * d + 1] * zm2[2 * d + 1] + w1[2 * d + 1] * zm1[2 * d + 1] + w2[2 * d + 1] * zb);
        zm2[2 * d] = zm1[2 * d]; zm2[2 * d + 1] = zm1[2 * d + 1]; zm1[2 * d] = za; zm1[2 * d + 1] = zb;
        ss += y[2 * d] * y[2 * d] + y[2 * d + 1] * y[2 * d + 1];
      }
      ss += __shfl_xor(ss, 8); ss += __shfl_xor(ss, 4); ss += __shfl_xor(ss, 2); ss += __shfl_xor(ss, 1);
      const float rstd = rsqrtf(ss * (1.f / 128.f) + EPS);
      const u32x4 o = {pk2(y[0] * rstd, y[1] * rstd), pk2(y[2] * rstd, y[3] * rstd), pk2(y[4] * rstd, y[5] * rstd), pk2(y[6] * rstd, y[7] * rstd)};
      *(u32x4*)(MG + (size_t)(row0 + tt) * D_ + ch) = o;
    }
  }
}

DI void phase4(const Params& p, char* smem) {
  const u16* Q = (const u16*)(p.ws + WS_Q); const u16* Kb = (const u16*)(p.ws + WS_K); const u16* VT = (const u16*)(p.ws + WS_VT);
  u16* MG = (u16*)(p.ws + WS_MG);
  u16* Ks = (u16*)(smem + 16);
  u16* Vs = Ks + 64 * 200;
  float* mrg = (float*)(smem + 16);
  const int tid = threadIdx.x, lane = tid & 63, w = tid >> 6, qh = w & 1, kh = w >> 1, r = lane & 31, hi = lane >> 5;
  for (int it = blockIdx.x; it < 512; it += gridDim.x) {
    const int xq = it & 7, jq = it >> 3, bh = xq + 8 * (jq >> 4);
    const int pi = jq & 15, h = bh & 7, b = bh >> 3;
    for (int sub = 0; sub < 2; ++sub) {
      const int c = sub ? (31 - pi) : pi;
      const size_t qrow = (size_t)b * S_ + c * 64 + qh * 32 + r;
      bf16x8 qf[12];
#pragma unroll
      for (int ks = 0; ks < 12; ++ks) qf[ks] = *(const bf16x8*)(Q + qrow * 1536 + h * 192 + ks * 16 + hi * 8);
      f32x16 O[4];
#pragma unroll
      for (int dt = 0; dt < 4; ++dt)
#pragma unroll
        for (int i = 0; i < 16; ++i) O[dt][i] = 0.f;
      float m = -1e30f, l = 0.f;
      u32x4 kr[6]; u32x4 vr[4];
      const u16* kg = Kb + ((size_t)b * S_ + (tid >> 2)) * 1536 + h * 192 + (tid & 3) * 8;
      const u16* vg = VT + ((size_t)((b * 8 + h) * 128 + (tid >> 1))) * S_ + (tid & 1) * 8;
      u16* ksw = Ks + (tid >> 2) * 200 + (tid & 3) * 8;
      u16* vsw = Vs + (tid >> 1) * 68 + (tid & 1) * 8;
      auto load_tile = [&]() __attribute__((always_inline)) {
#pragma unroll
        for (int i = 0; i < 6; ++i) kr[i] = *(const u32x4*)(kg + i * 32);
#pragma unroll
        for (int i = 0; i < 4; ++i) vr[i] = *(const u32x4*)(vg + i * 16);
        kg += 64 * 1536; vg += 64;
      };
      load_tile();
      for (int kt = 0; kt <= c; ++kt) {
        __syncthreads();
#pragma unroll
        for (int i = 0; i < 6; ++i) *(u32x4*)(ksw + i * 32) = kr[i];
#pragma unroll
        for (int i = 0; i < 4; ++i) { u32x2 lo2 = {vr[i][0], vr[i][1]}, hi2 = {vr[i][2], vr[i][3]}; *(u32x2*)(vsw + i * 16) = lo2; *(u32x2*)(vsw + i * 16 + 4) = hi2; }
        __syncthreads();
        if (kt < c) load_tile();
        f32x16 s;
#pragma unroll
        for (int i = 0; i < 16; ++i) s[i] = 0.f;
        const u16* kp = Ks + (kh * 32 + r) * 200 + hi * 8;
        {
          bf16x8 kf[4];
#pragma unroll
          for (int i = 0; i < 4; ++i) kf[i] = *(const bf16x8*)(kp + i * 16);
#pragma unroll
          for (int ks = 0; ks < 12; ++ks) {
            __builtin_amdgcn_sched_barrier(0);
            s = MFMA(kf[ks & 3], qf[ks], s);
            if (ks + 4 < 12) kf[ks & 3] = *(const bf16x8*)(kp + (ks + 4) * 16);
          }
          __builtin_amdgcn_sched_barrier(0);
        }
        bf16x8 vf0[4];
#pragma unroll
        for (int dt = 0; dt < 4; ++dt) {
          const u16* vp = Vs + (dt * 32 + r) * 68 + kh * 32 + 4 * hi;
          const u32x2 v0 = *(const u32x2*)vp, v1 = *(const u32x2*)(vp + 8);
          const u32x4 vv = {v0[0], v0[1], v1[0], v1[1]};
          vf0[dt] = __builtin_bit_cast(bf16x8, vv);
        }
        float mx = s[0];
#pragma unroll
        for (int i = 1; i < 16; ++i) mx = fmaxf(mx, s[i]);
        mx = fmaxf(mx, __shfl_xor(mx, 32));
        const float mn = fmaxf(m, mx);
        const float alpha = __builtin_amdgcn_exp2f(m - mn);
        const bool resc = __builtin_amdgcn_ballot_w64(mn > m) != 0ull;
        m = mn;
        float rsum = 0.f;
#pragma unroll
        for (int i = 0; i < 16; ++i) { s[i] = __builtin_amdgcn_exp2f(s[i] - mn); rsum += s[i]; }
        l = l * alpha + rsum;
        if (resc) {
#pragma unroll
          for (int dt = 0; dt < 4; ++dt)
#pragma unroll
            for (int i = 0; i < 16; ++i) O[dt][i] *= alpha;
        }
        {
          const u32x4 pu0 = {pk2(s[0], s[1]), pk2(s[2], s[3]), pk2(s[4], s[5]), pk2(s[6], s[7])};
          const u32x4 pu1 = {pk2(s[8], s[9]), pk2(s[10], s[11]), pk2(s[12], s[13]), pk2(s[14], s[15])};
          const bf16x8 pf0 = __builtin_bit_cast(bf16x8, pu0), pf1 = __builtin_bit_cast(bf16x8, pu1);
          bf16x8 vf1[4];
#pragma unroll
          for (int dt = 0; dt < 4; ++dt) {
            const u16* vp = Vs + (dt * 32 + r) * 68 + kh * 32 + 16 + 4 * hi;
            const u32x2 v0 = *(const u32x2*)vp, v1 = *(const u32x2*)(vp + 8);
            const u32x4 vv = {v0[0], v0[1], v1[0], v1[1]};
            vf1[dt] = __builtin_bit_cast(bf16x8, vv);
          }
          __builtin_amdgcn_sched_barrier(0);
#pragma unroll
          for (int dt = 0; dt < 4; ++dt) O[dt] = MFMA(vf0[dt], pf0, O[dt]);
#pragma unroll
          for (int dt = 0; dt < 4; ++dt) O[dt] = MFMA(vf1[dt], pf1, O[dt]);
        }
      }
      l += __shfl_xor(l, 32);
      __syncthreads();
      float* mq = mrg + qh * 66 * 64;
      if (kh == 1) {
#pragma unroll
        for (int dt = 0; dt < 4; ++dt)
#pragma unroll
          for (int i = 0; i < 16; ++i) mq[(dt * 16 + i) * 64 + lane] = O[dt][i];
        mq[64 * 64 + lane] = m; mq[65 * 64 + lane] = l;
      }
      __syncthreads();
      if (kh == 0) {
        const float m1 = mq[64 * 64 + lane], l1 = mq[65 * 64 + lane];
        const float mt = fmaxf(m, m1), a0 = exp2f(m - mt), a1 = exp2f(m1 - mt);
        const float inv = 1.f / (l * a0 + l1 * a1);
        float ss = 0.f;
#pragma unroll
        for (int dt = 0; dt < 4; ++dt)
#pragma unroll
          for (int i = 0; i < 16; ++i) { const float o = (O[dt][i] * a0 + mq[(dt * 16 + i) * 64 + lane] * a1) * inv; O[dt][i] = o; ss += o * o; }
        ss += __shfl_xor(ss, 32);
        const float rstd = rsqrtf(ss * (1.f / 128.f) + EPS);
#pragma unroll
        for (int dt = 0; dt < 4; ++dt)
#pragma unroll
          for (int g = 0; g < 4; ++g) {
            const int d = dt * 32 + hi * 4 + 8 * g;
            *(uint2*)(MG + qrow * D_ + 1024 + h * 128 + d) = make_uint2(pk2(O[dt][4 * g] * rstd, O[dt][4 * g + 1] * rstd), pk2(O[dt][4 * g + 2] * rstd, O[dt][4 * g + 3] * rstd));
          }
      }
    }
  }
}

DI void phase5(const Params& p, char* smem) {
  const u16* MG = (const u16*)(p.ws + WS_MG); const u16* W = (const u16*)(p.ws + WS_WOUTT);
  const float* X = p.in[0]; const float* mod = (const float*)(p.ws + WS_MOD); u16* X1 = (u16*)(p.ws + WS_X1);
  for (int it = blockIdx.x; it < 64 * 16; it += gridDim.x) {
    const int tn = it / 64, tm = it % 64;
    gemm_tile<true>(MG, D_, W, D_, D_, tm * 128, tn * 128, smem, [&](f32x16 (&acc)[2][2], int mb, int nb, int r, int hi) __attribute__((always_inline)) {
#pragma unroll
      for (int mi = 0; mi < 2; ++mi) {
        const int row = mb + mi * 32 + r, b = row >> 11;
        const float* gt = mod + b * 12288 + 2 * 2048;
#pragma unroll
        for (int ni = 0; ni < 2; ++ni)
#pragma unroll
          for (int g = 0; g < 4; ++g) {
            const int col = nb + ni * 32 + hi * 4 + 8 * g;
            const float4 xv = *(const float4*)(X + (size_t)row * D_ + col), gv = *(const float4*)(gt + col);
            float4 o;
            o.x = xv.x + gv.x * acc[mi][ni][4 * g]; o.y = xv.y + gv.y * acc[mi][ni][4 * g + 1]; o.z = xv.z + gv.z * acc[mi][ni][4 * g + 2]; o.w = xv.w + gv.w * acc[mi][ni][4 * g + 3];
            *(uint2*)(X1 + (size_t)row * D_ + col) = make_uint2(pk2(o.x, o.y), pk2(o.z, o.w));
          }
      }
    });
  }
}

DI void phase7(const Params& p, char* smem) {
  const u16* H2 = (const u16*)(p.ws + WS_H); const u16* W = (const u16*)(p.ws + WS_WQT); u16* PQ = (u16*)(p.ws + WS_P);
  for (int it = blockIdx.x; it < 64 * 16; it += gridDim.x) {
    const int tn = it / 64, tm = it % 64;
    gemm_tile<true>(H2, D_, W, D_, D_, tm * 128, tn * 128, smem, [&](f32x16 (&acc)[2][2], int mb, int nb, int r, int hi) __attribute__((always_inline)) {
#pragma unroll
      for (int mi = 0; mi < 2; ++mi)
#pragma unroll
        for (int ni = 0; ni < 2; ++ni)
#pragma unroll
          for (int g = 0; g < 4; ++g) {
            const int row = mb + mi * 32 + r, col = nb + ni * 32 + hi * 4 + 8 * g;
            *(uint2*)(PQ + (size_t)row * D_ + col) = make_uint2(pk2(acc[mi][ni][4 * g], acc[mi][ni][4 * g + 1]), pk2(acc[mi][ni][4 * g + 2], acc[mi][ni][4 * g + 3]));
          }
    });
  }
}

DI unsigned f2ord(float v) { unsigned u = __float_as_uint(v); return u ^ ((unsigned)((int)u >> 31) | 0x80000000u); }
DI unsigned med3u(unsigned a, unsigned b, unsigned c) { return max(min(a, b), min(max(a, b), c)); }
#define TOPK_INSERT(keys, x) { _Pragma("unroll") for (int _j = 15; _j >= 1; --_j) keys[_j] = med3u(keys[_j - 1], keys[_j], x); keys[0] = max(keys[0], x); }
DI void phase8(const Params& p, char* smem) {
  const u16* PQ = (const u16*)(p.ws + WS_P); const u16* SK = (const u16*)(p.ws + WS_SK);
  int* IDS = (int*)(p.ws + WS_IDS); float* GATE = (float*)(p.ws + WS_GATE);
  float* sc = (float*)(smem + 16);
  const int tid = threadIdx.x, lane = tid & 63, w = tid >> 6, r = lane & 31, hi = lane >> 5;
  for (int it = blockIdx.x; it < 128 * 8; it += gridDim.x) {
    const int h = it & 7, tile = it >> 3;
    const int pp = w >> 1, rh = w & 1;
    __syncthreads();
    {
      f32x16 acc[4];
#pragma unroll
      for (int nt = 0; nt < 4; ++nt)
#pragma unroll
        for (int i = 0; i < 16; ++i) acc[nt][i] = 0.f;
      const u16* ap = PQ + (size_t)(tile * 64 + rh * 32 + r) * D_ + h * 256 + pp * 128 + hi * 8;
      const u16* bp = SK + ((size_t)(h * 2 + pp) * 128 + r) * 128 + hi * 8;
      bf16x8 afr[8];
#pragma unroll
      for (int ks = 0; ks < 8; ++ks) afr[ks] = *(const bf16x8*)(ap + ks * 16);
#pragma unroll
      for (int hf = 0; hf < 2; ++hf) {
        bf16x8 bfr[4][4];
#pragma unroll
        for (int k2 = 0; k2 < 4; ++k2)
#pragma unroll
          for (int nt = 0; nt < 4; ++nt) bfr[k2][nt] = *(const bf16x8*)(bp + nt * 32 * 128 + (hf * 4 + k2) * 16);
        __builtin_amdgcn_sched_barrier(0);
#pragma unroll
        for (int k2 = 0; k2 < 4; ++k2)
#pragma unroll
          for (int nt = 0; nt < 4; ++nt) acc[nt] = MFMA(afr[hf * 4 + k2], bfr[k2][nt], acc[nt]);
        __builtin_amdgcn_sched_barrier(0);
      }
#pragma unroll
      for (int nt = 0; nt < 4; ++nt)
#pragma unroll
        for (int i = 0; i < 16; ++i) sc[(pp * 64 + rh * 32 + hi * 4 + (i & 3) + 8 * (i >> 2)) * 129 + nt * 32 + r] = acc[nt][i];
    }
    __syncthreads();
    {
      const int rowi = tid & 127, half = tid >> 7;
      float* row = sc + rowi * 129;
      unsigned* mk = (unsigned*)(smem + 16 + 128 * 129 * 4);
      unsigned keys[16];
#pragma unroll
      for (int j = 0; j < 16; ++j) keys[j] = 0u;
#pragma unroll 4
      for (int n2 = 0; n2 < 64; ++n2) {
        const int n = half * 64 + n2;
        unsigned x = (f2ord(row[n]) & 0xFFFFFF80u) | (unsigned)(127 - n);
        TOPK_INSERT(keys, x);
      }
      if (half == 1) {
#pragma unroll
        for (int j = 0; j < 16; ++j) mk[j * 128 + rowi] = keys[j];
      }
      __syncthreads();
      if (half == 0) {
#pragma unroll
        for (int j = 0; j < 16; ++j) { unsigned x = mk[j * 128 + rowi]; TOPK_INSERT(keys, x); }
        float vals[16];
#pragma unroll
        for (int j = 0; j < 16; ++j) vals[j] = row[127 - (keys[j] & 127u)];
#pragma unroll
        for (int j = 0; j < 16; ++j) { row[j] = vals[j]; row[16 + j] = __int_as_float((int)(127 - (keys[j] & 127u))); }
      }
    }
    __syncthreads();
    if (tid < 64) {
      const float* ra = sc + tid * 129; const float* rb = sc + (64 + tid) * 129;
      float a[16], bq[16];
#pragma unroll
      for (int j = 0; j < 16; ++j) { a[j] = ra[j]; bq[j] = rb[j]; }
      unsigned keys[16];
#pragma unroll
      for (int j = 0; j < 16; ++j) keys[j] = 0u;
#pragma unroll
      for (int i = 0; i < 16; ++i)
#pragma unroll
        for (int j = 0; j < 16; ++j)
          if ((i + 1) * (j + 1) <= 16) {
            unsigned x = (f2ord(a[i] + bq[j]) & 0xFFFFFF00u) | (unsigned)(255 - (i * 16 + j));
            TOPK_INSERT(keys, x);
          }
      float bv[16]; int ex[16];
      float mx = -1e30f;
#pragma unroll
      for (int q = 0; q < 16; ++q) {
        const int flat = 255 - (int)(keys[q] & 255u), i = flat >> 4, j = flat & 15;
        bv[q] = ra[i] + rb[j];
        ex[q] = __float_as_int(ra[16 + i]) * 128 + __float_as_int(rb[16 + j]);
        mx = fmaxf(mx, bv[q]);
      }
      float sum = 0.f;
#pragma unroll
      for (int q = 0; q < 16; ++q) { bv[q] = __expf(bv[q] - mx); sum += bv[q]; }
      const float inv = 1.f / sum;
      const size_t o = (size_t)(tile * 64 + tid) * 128 + h * 16;
#pragma unroll
      for (int q = 0; q < 16; q += 4) {
        *(int4*)(IDS + o + q) = make_int4(ex[q], ex[q + 1], ex[q + 2], ex[q + 3]);
        *(float4*)(GATE + o + q) = make_float4(bv[q] * inv, bv[q + 1] * inv, bv[q + 2] * inv, bv[q + 3] * inv);
      }
    }
  }
}

constexpr int CTR_UQ = 4096, CTR_VQ = 4608;
DI f2_t cvt8lo(unsigned w) { return __builtin_amdgcn_cvt_pk_f32_fp8(w, false); }
DI f2_t cvt8hi(unsigned w) { return __builtin_amdgcn_cvt_pk_f32_fp8(w, true); }
template <class F>
DI void xcd_queue(unsigned* ctrs, int nchunks, char* smem, F&& f) {
  const int x0 = (int)(xb_xcc_id() & 7u);
#pragma unroll 1
  for (int k = 0; k < 8; ++k) {
    const int s = (x0 + k) & 7;
    for (;;) { const int c = grab(ctrs + 64 * s, smem); if (c >= nchunks) break; f(s, c); }
  }
}
DI void wave_lds_sync() { asm volatile("s_waitcnt lgkmcnt(0)" ::: "memory"); __builtin_amdgcn_wave_barrier(); }

DI void phase9(const Params& p, char* smem, int rep) {
  const unsigned char* H2Q = (const unsigned char*)(p.ws + WS_H2Q); const unsigned char* U8 = (const unsigned char*)(p.ws + WS_U);
  const int* IDS = (const int*)(p.ws + WS_IDS); int* PA = (int*)(p.ws + WS_PA);
  const int lane = threadIdx.x & 63, w = threadIdx.x >> 6, g = lane >> 4, l15 = lane & 15;
  const int b3 = (lane >> 3) & 1, b2 = (lane >> 2) & 1, b1 = (lane >> 1) & 1, b0 = lane & 1;
  int* lw = (int*)(smem + 16) + w * 256;
  xcd_queue((unsigned*)(p.ws + WS_BAR) + CTR_UQ + rep * 8, 512, smem, [&](int s, int c) __attribute__((always_inline)) {
#pragma unroll 1
    for (int t = 0; t < 4; ++t) {
      const int tok = __builtin_amdgcn_readfirstlane(c * 16 + w * 4 + t);
      const int i0 = IDS[(size_t)tok * 128 + lane], i1 = IDS[(size_t)tok * 128 + 64 + lane];
      const u32x4 hq = *(const u32x4*)(H2Q + (size_t)tok * D_ + s * 256 + l15 * 16);
      wave_lds_sync();
      lw[(lane & 3) * 32 + (lane >> 2)] = i0;
      lw[(lane & 3) * 32 + 16 + (lane >> 2)] = i1;
      wave_lds_sync();
      const unsigned char* ub = U8 + s * 256 + l15 * 16;
#pragma unroll
      for (int batch = 0; batch < 2; ++batch) {
        int ida[16];
#pragma unroll
        for (int q = 0; q < 4; ++q) { const int4 v = *(const int4*)(lw + g * 32 + batch * 16 + q * 4); ida[q * 4] = v.x; ida[q * 4 + 1] = v.y; ida[q * 4 + 2] = v.z; ida[q * 4 + 3] = v.w; }
        u32x4 rows[16];
#pragma unroll
        for (int k = 0; k < 16; ++k) rows[k] = *(const u32x4*)(ub + (size_t)ida[k] * 2048);
        int part[16];
#pragma unroll
        for (int k = 0; k < 16; ++k) {
          int acc = 0;
#pragma unroll
          for (int d = 0; d < 4; ++d) acc = __builtin_amdgcn_sdot4((int)rows[k][d], (int)hq[d], acc, false);
          part[k] = acc;
        }
        int q8[8], q4[4], q2[2];
#pragma unroll
        for (int k = 0; k < 8; ++k) q8[k] = (b3 ? part[8 + k] : part[k]) + __shfl_xor(b3 ? part[k] : part[8 + k], 8);
#pragma unroll
        for (int k = 0; k < 4; ++k) q4[k] = (b2 ? q8[4 + k] : q8[k]) + __shfl_xor(b2 ? q8[k] : q8[4 + k], 4);
#pragma unroll
        for (int k = 0; k < 2; ++k) q2[k] = (b1 ? q4[2 + k] : q4[k]) + __shfl_xor(b1 ? q4[k] : q4[2 + k], 2);
        const int rr = (b0 ? q2[1] : q2[0]) + __shfl_xor(b0 ? q2[0] : q2[1], 1);
        PA[((size_t)s * T_ + tok) * 128 + 4 * (batch * 16 + l15) + g] = rr;
      }
    }
  });
}

DI void phase10(const Params& p) {
  const int* PA = (const int*)(p.ws + WS_PA); float* ACT = (float*)(p.ws + WS_ACT); const float* HSC = (const float*)(p.ws + WS_HSC);
  const int* IDS = (const int*)(p.ws + WS_IDS); const float* GATE = (const float*)(p.ws + WS_GATE);
  const float* USC = (const float*)(p.ws + WS_USC); const float* VSC = (const float*)(p.ws + WS_VSC);
  for (int i = blockIdx.x * 256 + threadIdx.x; i < T_ * 128; i += gridDim.x * 256) {
    int ai = 0;
#pragma unroll
    for (int s = 0; s < 8; ++s) ai += PA[(size_t)s * T_ * 128 + i];
    const int id = IDS[i];
    const float a = (float)ai * USC[id] * HSC[i >> 7];
    ACT[i] = 0.5f * a * (1.f + erff(a * 0.70710678118654752f)) * GATE[i] * VSC[id];
  }
}

DI void phase11(const Params& p, char* smem, int rep) {
  const unsigned char* V8 = (const unsigned char*)(p.ws + WS_V);
  const int* IDS = (const int*)(p.ws + WS_IDS); const float* ACT = (const float*)(p.ws + WS_ACT); u16* OUTP = (u16*)(p.ws + WS_OUTP);
  const int lane = threadIdx.x & 63, w = threadIdx.x >> 6, g = lane >> 4, l15 = lane & 15;
  const int b5 = (lane >> 5) & 1, b4 = (lane >> 4) & 1;
  int* lw = (int*)(smem + 16) + w * 256;
  float* lf = (float*)(lw + 128);
  xcd_queue((unsigned*)(p.ws + WS_BAR) + CTR_VQ + rep * 8, 512, smem, [&](int s, int c) __attribute__((always_inline)) {
#pragma unroll 1
    for (int t = 0; t < 4; ++t) {
      const int tok = __builtin_amdgcn_readfirstlane(c * 16 + w * 4 + t);
      const int i0 = IDS[(size_t)tok * 128 + lane], i1 = IDS[(size_t)tok * 128 + 64 + lane];
      const float a0 = ACT[(size_t)tok * 128 + lane], a1 = ACT[(size_t)tok * 128 + 64 + lane];
      wave_lds_sync();
      lw[(lane & 3) * 32 + (lane >> 2)] = i0; lw[(lane & 3) * 32 + 16 + (lane >> 2)] = i1;
      lf[(lane & 3) * 32 + (lane >> 2)] = a0; lf[(lane & 3) * 32 + 16 + (lane >> 2)] = a1;
      wave_lds_sync();
      f2_t o[8];
#pragma unroll
      for (int i = 0; i < 8; ++i) o[i] = f2_t{0.f, 0.f};
      const unsigned char* vb = V8 + s * 256 + l15 * 16;
#pragma unroll
      for (int batch = 0; batch < 2; ++batch) {
        int ida[16]; float aa[16];
#pragma unroll
        for (int q = 0; q < 4; ++q) {
          const int4 v = *(const int4*)(lw + g * 32 + batch * 16 + q * 4); ida[q * 4] = v.x; ida[q * 4 + 1] = v.y; ida[q * 4 + 2] = v.z; ida[q * 4 + 3] = v.w;
          const float4 f = *(const float4*)(lf + g * 32 + batch * 16 + q * 4); aa[q * 4] = f.x; aa[q * 4 + 1] = f.y; aa[q * 4 + 2] = f.z; aa[q * 4 + 3] = f.w;
        }
        u32x4 rows[16];
#pragma unroll
        for (int k = 0; k < 16; ++k) rows[k] = *(const u32x4*)(vb + (size_t)ida[k] * 2048);
#pragma unroll
        for (int k = 0; k < 16; ++k) {
          const f2_t a2 = {aa[k], aa[k]};
#pragma unroll
          for (int d = 0; d < 4; ++d) { const unsigned ww = rows[k][d]; o[2 * d] += a2 * cvt8lo(ww); o[2 * d + 1] += a2 * cvt8hi(ww); }
        }
      }
      float ov[16];
#pragma unroll
      for (int d = 0; d < 4; ++d) { ov[4 * d] = o[2 * d].x; ov[4 * d + 1] = o[2 * d].y; ov[4 * d + 2] = o[2 * d + 1].x; ov[4 * d + 3] = o[2 * d + 1].y; }
      float q8[8], q4[4];
#pragma unroll
      for (int k = 0; k < 8; ++k) q8[k] = (b5 ? ov[8 + k] : ov[k]) + __shfl_xor(b5 ? ov[k] : ov[8 + k], 32);
#pragma unroll
      for (int k = 0; k < 4; ++k) q4[k] = (b4 ? q8[4 + k] : q8[k]) + __shfl_xor(b4 ? q8[k] : q8[4 + k], 16);
      *(uint2*)(OUTP + (size_t)tok * D_ + s * 256 + l15 * 16 + 8 * b5 + 4 * b4) = make_uint2(pk2(q4[0], q4[1]), pk2(q4[2], q4[3]));
    }
  });
}

DI void phase12(const Params& p) {
  const u16* X1 = (const u16*)(p.ws + WS_X1); const u16* OUTP = (const u16*)(p.ws + WS_OUTP);
  const float* mod = (const float*)(p.ws + WS_MOD); const float* gfin = p.in[19];
  const int lane = threadIdx.x & 63, w = threadIdx.x >> 6;
  for (int row = blockIdx.x * 4 + w; row < T_; row += gridDim.x * 4) {
    const float* gt = mod + (row >> 11) * 12288 + 5 * 2048;
    float4 v[8];
    float ss = 0.f;
#pragma unroll
    for (int j = 0; j < 8; ++j) {
      const int d = j * 256 + lane * 4;
      const uint2 xb2 = *(const uint2*)(X1 + (size_t)row * D_ + d);
      const float4 xv = make_float4(bflo(xb2.x), bfhi(xb2.x), bflo(xb2.y), bfhi(xb2.y)), gv = *(const float4*)(gt + d);
      const uint2 ob = *(const uint2*)(OUTP + (size_t)row * D_ + d);
      const float4 ov = make_float4(bflo(ob.x), bfhi(ob.x), bflo(ob.y), bfhi(ob.y));
      v[j] = make_float4(xv.x + gv.x * ov.x, xv.y + gv.y * ov.y, xv.z + gv.z * ov.z, xv.w + gv.w * ov.w);
      ss += v[j].x * v[j].x + v[j].y * v[j].y + v[j].z * v[j].z + v[j].w * v[j].w;
    }
    ss = wave_sum(ss);
    const float rstd = rsqrtf(ss * (1.f / D_) + EPS);
#pragma unroll
    for (int j = 0; j < 8; ++j) {
      const int d = j * 256 + lane * 4;
      const float4 gv = *(const float4*)(gfin + d);
      { const f32x4v t = {v[j].x * rstd * gv.x, v[j].y * rstd * gv.y, v[j].z * rstd * gv.z, v[j].w * rstd * gv.w}; __builtin_nontemporal_store(t, (f32x4v*)(p.out + (size_t)row * D_ + d)); }
    }
  }
}

DI void phase6(const Params& p) {
  norm_rows<true, true>((const float*)(p.ws + WS_X1), p.in[14], (const float*)(p.ws + WS_MOD) + 3 * 2048, 12288, (u16*)(p.ws + WS_H), (unsigned char*)(p.ws + WS_H2Q), (float*)(p.ws + WS_HSC), (int)blockIdx.x * 4, (int)gridDim.x * 4, T_);
}

__global__ void __launch_bounds__(256, 2) mega(Params p) {
  extern __shared__ __attribute__((aligned(16))) char smem[];
  XcdBarrier xb;
  const bool multi = (p.ph_hi - p.ph_lo) > 1;
  if (multi) {
    if (threadIdx.x == 0) *(uint4*)smem = make_uint4(0u, 0u, 0u, 0u);
    __syncthreads();
    xb = xcd_barrier_post((unsigned*)(p.ws + WS_BAR), (volatile LAS unsigned*)smem);
  }
#ifndef PHMASK
#define PHMASK 0x1fff
#endif
#ifndef REPMASK
#define REPMASK 0
#endif
  int rep = 0;
  constexpr int CTR_BG = 3776, BG_CHUNKS = 4096;
  auto bg_unit = [&]() __attribute__((always_inline)) -> bool {
    const int c = grab((unsigned*)(p.ws + WS_BAR) + CTR_BG, smem);
    if (c >= BG_CHUNKS) return false;
#pragma unroll 1
    for (int i = 0; i < 2; ++i) {
      const int item = c * 2 + i;
      const bool isu = item < 4096;
      conv_rows_item(isu ? p.in[17] : p.in[18], (unsigned char*)(p.ws + (isu ? WS_U : WS_V)), (float*)(p.ws + (isu ? WS_USC : WS_VSC)), isu ? item : item - 4096, isu);
    }
    return true;
  };
#define RUN_PHASE(n, call) if (p.ph_lo <= (n) && (n) < p.ph_hi) { \
    if ((n) > p.ph_lo) { if ((n) <= 7) xcd_barrier_bg(xb, smem, bg_unit); else xcd_barrier(xb); } \
    if (PHMASK & (1 << (n))) { call; if (REPMASK & (1 << (n))) { xcd_barrier(xb); rep = 1; call; rep = 0; } } \
    if ((n) == 7) { while (bg_unit()) {} } }
  RUN_PHASE(0, phase0(p, smem))
  RUN_PHASE(1, phase1(p, smem))
#ifdef BARX
  for (int i = 0; i < BARX; ++i) xcd_barrier(xb);
#endif
  RUN_PHASE(2, phase2(p, smem, rep))
  RUN_PHASE(3, phase3(p, smem))
  RUN_PHASE(4, (conv_items(p), phase4(p, smem)))
  RUN_PHASE(5, phase5(p, smem))
  RUN_PHASE(6, phase6(p))
  RUN_PHASE(7, phase7(p, smem))
  RUN_PHASE(8, phase8(p, smem))
  RUN_PHASE(9, phase9(p, smem, rep))
  RUN_PHASE(10, phase10(p))
  RUN_PHASE(11, phase11(p, smem, rep))
  RUN_PHASE(12, phase12(p))
}

extern "C" void kernel_launch(void* const* d_in, const int* in_sizes, int n_in, void* d_out, int out_size, void* d_ws, size_t ws_size, hipStream_t stream) {
  static int grid = 0;
  if (grid == 0) {
    if (n_in != 20 || ws_size < WS_END) { fprintf(stderr, "kernel_launch: unexpected n_in %d / ws_size %zu (need %zu)\n", n_in, ws_size, (size_t)WS_END); grid = -1; return; }
    int dev = 0, cus = 0, per_cu = 0;
    hipGetDevice(&dev);
    hipDeviceGetAttribute(&cus, hipDeviceAttributeMultiprocessorCount, dev);
    hipFuncSetAttribute((const void*)mega, hipFuncAttributeMaxDynamicSharedMemorySize, LDS_BYTES);
    hipOccupancyMaxActiveBlocksPerMultiprocessor(&per_cu, (const void*)mega, 256, LDS_BYTES);
    if (per_cu < 1) { fprintf(stderr, "kernel_launch: occupancy query says %d\n", per_cu); per_cu = 1; }
    if (per_cu > 2) per_cu = 2;
    grid = cus * per_cu;
    fprintf(stderr, "kernel_launch: grid %d (%d per CU)\n", grid, per_cu);
  }
  if (grid < 0) return;
  Params p{};
  for (int i = 0; i < 20; ++i) p.in[i] = (const float*)d_in[i];
  p.out = (float*)d_out; p.ws = (char*)d_ws;
  hipMemsetAsync((char*)d_ws + WS_BAR, 0, WS_MOD, stream);
  p.coop = 0; p.ph_lo = 0; p.ph_hi = NPH;
  void* args[] = {&p};
  hipError_t e = hipLaunchCooperativeKernel((const void*)mega, dim3(grid), dim3(256), args, LDS_BYTES, stream);
  if (e != hipSuccess) fprintf(stderr, "cooperative launch failed: %s (grid %d)\n", hipGetErrorString(e), grid);
}
```
